# Optimizing an MI355X kernel written in HIP

```python
import jax
import jax.numpy as jnp
from jax import lax
import numpy as np

D_MODEL = 1024
BATCH = 32
SEQ = 2048
DEPTH = 2

CTX_LEN = 256
GRID_W = 64
HEAD_DIM = 64
Q_BLOCK = 128
ROPE_THETA = 10000.0
NORM_EPS = 1e-6
NEG_INF = -1e30

A_HEADS = 8
A_KV_HEADS = 2
A_GROUP = A_HEADS // A_KV_HEADS
A_WINDOW = 128
B_HEADS = 8
NA_ROWS = 8
NA_COLS = 16
NA_QCOLS = 16
NA_KCOLS = 32
C_HEADS = 8
C_Q_LORA = 384
C_KV_LORA = 256
C_NOPE = 64
C_ROPE = 32
C_V = 64
D_HEADS = 8
D_KV_HEADS = 2
D_GROUP = D_HEADS // D_KV_HEADS
N_EXPERTS = 64
TOP_K = 6
EXPERT_FF = 256
SHARED_FF = 256
ROUTED_SCALE = 2.5

A_Q = A_HEADS * HEAD_DIM
A_KV = A_KV_HEADS * HEAD_DIM
B_QKV = B_HEADS * HEAD_DIM
EVEN_SPLITS = (A_Q, A_Q + A_KV, A_Q + 2 * A_KV, A_Q + 2 * A_KV + B_QKV, A_Q + 2 * A_KV + 2 * B_QKV)
EVEN_IN = A_Q + 2 * A_KV + 3 * B_QKV
D_Q = D_HEADS * HEAD_DIM
D_KV = D_KV_HEADS * HEAD_DIM
ODD_Q = C_Q_LORA + D_Q
ODD_KV_SPLITS = (C_KV_LORA, C_KV_LORA + C_ROPE, C_KV_LORA + C_ROPE + D_KV)
ODD_IN = ODD_Q + C_KV_LORA + C_ROPE + 2 * D_KV
MIX_OUT = A_HEADS * HEAD_DIM + B_HEADS * HEAD_DIM

kernel_name = "hybrid_dit_window_na_mla_gqa_moe"


def rms_norm(x, g):
    xf = x.astype(jnp.float32)
    y = xf * lax.rsqrt(jnp.mean(xf * xf, axis=-1, keepdims=True) + NORM_EPS)
    return (y * g.astype(jnp.float32)).astype(x.dtype)


def ada_params(cond, w_ada, b_ada):
    return jnp.split(jax.nn.silu(cond) @ w_ada + b_ada, 6, axis=-1)


def modulate(h, shift, scale):
    return h * (1 + scale) + shift


def axial_rope(n_tokens, rot_dim):
    t = jnp.arange(n_tokens, dtype=jnp.int32)
    row = (t // GRID_W).astype(jnp.float32)
    col = (t % GRID_W).astype(jnp.float32)
    n_axis = rot_dim // 4
    inv_freq = ROPE_THETA ** (-jnp.arange(n_axis, dtype=jnp.float32) / n_axis)
    ang = jnp.concatenate([row[:, None] * inv_freq, col[:, None] * inv_freq], axis=-1)
    return jnp.cos(ang), jnp.sin(ang)


def apply_rope(x, cos, sin):
    bshape = (cos.shape[0],) + (1,) * (x.ndim - 3) + (cos.shape[1],)
    cs, sn = cos.reshape(bshape), sin.reshape(bshape)
    xp = x.astype(jnp.float32).reshape(x.shape[:-1] + (x.shape[-1] // 2, 2))
    x0, x1 = xp[..., 0], xp[..., 1]
    out = jnp.stack([x0 * cs - x1 * sn, x0 * sn + x1 * cs], axis=-1)
    return out.reshape(x.shape).astype(x.dtype)


def softmax_with_sink(s, sink):
    m = jnp.maximum(jnp.max(s, axis=-1, keepdims=True), sink)
    e = jnp.exp(s - m)
    return e / (jnp.sum(e, axis=-1, keepdims=True) + jnp.exp(sink - m))


def context_attention(q, k, v, sink=None):
    s = jnp.einsum('bqhgd,bkhd->bhgqk', q, k).astype(jnp.float32) * q.shape[-1] ** -0.5
    if sink is None:
        p = jax.nn.softmax(s, axis=-1)
    else:
        p = softmax_with_sink(s, sink[None, :, :, None, None].astype(jnp.float32))
    return jnp.einsum('bhgqk,bkhd->bqhgd', p.astype(v.dtype), v)


def sweep_attention(q, k, v, scale):
    B, Sq, Hk, G, dq = q.shape
    nb = Sq // Q_BLOCK
    qb = jnp.moveaxis(q.reshape(B, nb, Q_BLOCK, Hk, G, dq), 1, 0)

    def one_block(qi):
        s = jnp.einsum('bqhgd,bkhd->bhgqk', qi, k).astype(jnp.float32) * scale
        p = jax.nn.softmax(s, axis=-1).astype(v.dtype)
        return jnp.einsum('bhgqk,bkhd->bqhgd', p, v)

    out = lax.map(one_block, qb)
    return jnp.moveaxis(out, 0, 1).reshape(B, Sq, Hk, G, v.shape[-1])


def window_attention_sink(q, k, v, kc, vc, sink):
    B, S, Hk, G, d = q.shape
    nb = S // Q_BLOCK
    span = Q_BLOCK + 2 * A_WINDOW
    n_ctx = kc.shape[1]
    pad = ((0, 0), (A_WINDOW, A_WINDOW), (0, 0), (0, 0))
    kp, vp = jnp.pad(k, pad), jnp.pad(v, pad)
    qb = jnp.moveaxis(q.reshape(B, nb, Q_BLOCK, Hk, G, d), 1, 0)
    band = jnp.abs(jnp.arange(Q_BLOCK)[:, None] - jnp.arange(span)[None, :] + A_WINDOW) <= A_WINDOW
    sink_b = sink[None, :, :, None, None].astype(jnp.float32)
    scale = d ** -0.5

    def one_block(args):
        n, qi = args
        start = n * Q_BLOCK
        kb = lax.dynamic_slice_in_dim(kp, start, span, axis=1)
        vb = lax.dynamic_slice_in_dim(vp, start, span, axis=1)
        kpos = start + jnp.arange(span) - A_WINDOW
        valid = band & ((kpos >= 0) & (kpos < S))[None, :]
        s_loc = jnp.einsum('bqhgd,bkhd->bhgqk', qi, kb).astype(jnp.float32) * scale
        s_loc = jnp.where(valid, s_loc, NEG_INF)
        s_ctx = jnp.einsum('bqhgd,bkhd->bhgqk', qi, kc).astype(jnp.float32) * scale
        p = softmax_with_sink(jnp.concatenate([s_ctx, s_loc], axis=-1), sink_b).astype(v.dtype)
        return (jnp.einsum('bhgqk,bkhd->bqhgd', p[..., :n_ctx], vc)
                + jnp.einsum('bhgqk,bkhd->bqhgd', p[..., n_ctx:], vb))

    out = lax.map(one_block, (jnp.arange(nb), qb))
    return jnp.moveaxis(out, 0, 1).reshape(B, S, Hk * G * d)


def neighbourhood_attention(q, k, v, kc, vc, rpb):
    B, S, H, d = q.shape
    rows = S // GRID_W
    kr = min(NA_ROWS, rows)
    n_cb = GRID_W // NA_QCOLS
    n_ctx = kc.shape[1]
    qcol = np.arange(GRID_W).reshape(n_cb, NA_QCOLS)
    kcol = np.clip(qcol[:, :1] - NA_COLS // 2, 0, GRID_W - NA_KCOLS) + np.arange(NA_KCOLS)
    cstart = np.clip(qcol - NA_COLS // 2, 0, GRID_W - NA_COLS)[:, :, None]
    kcb = kcol[:, None, :]
    col_ok = (kcb >= cstart) & (kcb < cstart + NA_COLS)
    dc_idx = np.clip(kcb - qcol[:, :, None] + NA_COLS - 1, 0, 2 * NA_COLS - 2)
    rpb_c = rpb[:, :, dc_idx]
    qg = jnp.moveaxis(q.reshape(B, rows, n_cb, NA_QCOLS, H, d), 1, 0)
    kg = k.reshape(B, rows, GRID_W, H, d)
    vg = v.reshape(B, rows, GRID_W, H, d)
    mask = col_ok[:, None, :, None, :]
    scale = d ** -0.5

    def one_row(args):
        r, qr = args
        rs = jnp.clip(r - kr // 2, 0, rows - kr)
        kb = lax.dynamic_slice_in_dim(kg, rs, kr, axis=1)[:, :, kcol]
        vb = lax.dynamic_slice_in_dim(vg, rs, kr, axis=1)[:, :, kcol]
        dr_idx = rs + jnp.arange(kr) - r + NA_ROWS - 1
        bias = jnp.transpose(rpb_c[:, dr_idx], (2, 0, 3, 1, 4)).astype(jnp.float32)
        s_loc = jnp.einsum('bcqhd,brcjhd->bchqrj', qr, kb).astype(jnp.float32) * scale + bias
        s_loc = jnp.where(mask, s_loc, NEG_INF).reshape(B, n_cb, H, NA_QCOLS, kr * NA_KCOLS)
        s_ctx = jnp.einsum('bcqhd,bkhd->bchqk', qr, kc).astype(jnp.float32) * scale
        p = jax.nn.softmax(jnp.concatenate([s_ctx, s_loc], axis=-1), axis=-1).astype(v.dtype)
        p_loc = p[..., n_ctx:].reshape(B, n_cb, H, NA_QCOLS, kr, NA_KCOLS)
        return (jnp.einsum('bchqk,bkhd->bcqhd', p[..., :n_ctx], vc)
                + jnp.einsum('bchqrj,brcjhd->bcqhd', p_loc, vb))

    out = lax.map(one_row, (jnp.arange(rows), qg))
    return jnp.moveaxis(out, 0, 1).reshape(B, S, H * d)


def even_mixer(h, hc, w_in, sink, rpb, w_out, cos, sin):
    def heads(p):
        qa, ka, va, qb, kb, vb = jnp.split(p, EVEN_SPLITS, axis=-1)
        lead = p.shape[:-1]
        return (qa.reshape(lead + (A_KV_HEADS, A_GROUP, HEAD_DIM)), ka.reshape(lead + (A_KV_HEADS, HEAD_DIM)),
                va.reshape(lead + (A_KV_HEADS, HEAD_DIM)), qb.reshape(lead + (B_HEADS, HEAD_DIM)),
                kb.reshape(lead + (B_HEADS, HEAD_DIM)), vb.reshape(lead + (B_HEADS, HEAD_DIM)))

    B, S = h.shape[:2]
    n_ctx = hc.shape[1]
    qa, ka, va, qb, kb, vb = heads(h @ w_in)
    qa_c, ka_c, va_c, qb_c, kb_c, vb_c = heads(hc @ w_in)
    qa, ka = apply_rope(qa, cos, sin), apply_rope(ka, cos, sin)
    sink_hg = sink.reshape(A_KV_HEADS, A_GROUP)
    ya = window_attention_sink(qa, ka, va, ka_c, va_c, sink_hg)
    yb = neighbourhood_attention(qb, kb, vb, kb_c, vb_c, rpb)
    y = jnp.concatenate([ya, yb], axis=-1) @ w_out
    ya_c = context_attention(qa_c, ka_c, va_c, sink_hg).reshape(B, n_ctx, -1)
    yb_c = context_attention(qb_c[:, :, :, None, :], kb_c, vb_c).reshape(B, n_ctx, -1)
    y_c = jnp.concatenate([ya_c, yb_c], axis=-1) @ w_out
    return y, y_c


def odd_mixer(h, hc, w_in, g_q_lora, w_uq, g_kv_lora, w_ukv, g_qn, g_kn, w_out, cos_h, sin_h, cos_r, sin_r):
    B, S = h.shape[:2]

    def kv_heads(pkv):
        ckv, k_rope, kd, vd = jnp.split(pkv, ODD_KV_SPLITS, axis=-1)
        lead = pkv.shape[:-1]
        kv = (rms_norm(ckv, g_kv_lora) @ w_ukv).reshape(lead + (C_HEADS, C_NOPE + C_V))
        kd = rms_norm(kd.reshape(lead + (D_KV_HEADS, HEAD_DIM)), g_kn)
        return kv[..., :C_NOPE], kv[..., C_NOPE:], k_rope, kd, vd.reshape(lead + (D_KV_HEADS, HEAD_DIM))

    def mla_keys(k_nope, k_rope):
        return jnp.concatenate([k_nope, jnp.broadcast_to(k_rope[..., None, :], k_nope.shape[:-1] + (C_ROPE,))], axis=-1)

    p = h @ w_in
    cq, qd = jnp.split(p[..., :ODD_Q], (C_Q_LORA,), axis=-1)
    k_nope, v_m, k_rope, kd, vd = kv_heads(p[..., ODD_Q:])
    k_nope_c, v_m_c, k_rope_c, kd_c, vd_c = kv_heads(hc @ w_in[:, ODD_Q:])
    qm = (rms_norm(cq, g_q_lora) @ w_uq).reshape(B, S, C_HEADS, C_NOPE + C_ROPE)
    qm = jnp.concatenate([qm[..., :C_NOPE], apply_rope(qm[..., C_NOPE:], cos_r, sin_r)], axis=-1)
    k_rope = apply_rope(k_rope, cos_r, sin_r)
    km = jnp.concatenate([mla_keys(k_nope_c, k_rope_c), mla_keys(k_nope, k_rope)], axis=1)
    vm = jnp.concatenate([v_m_c, v_m], axis=1)
    ym = sweep_attention(qm[:, :, :, None, :], km, vm, (C_NOPE + C_ROPE) ** -0.5).reshape(B, S, -1)
    qd = apply_rope(rms_norm(qd.reshape(B, S, D_HEADS, HEAD_DIM), g_qn), cos_h, sin_h)
    qd = qd.reshape(B, S, D_KV_HEADS, D_GROUP, HEAD_DIM)
    kd = apply_rope(kd, cos_h, sin_h)
    yd = sweep_attention(qd, jnp.concatenate([kd_c, kd], axis=1), jnp.concatenate([vd_c, vd], axis=1),
                         HEAD_DIM ** -0.5).reshape(B, S, -1)
    return jnp.concatenate([ym, yd], axis=-1) @ w_out


def moe_ffn(h, w_router, b_router, w_gate, w_up, w_down, ws_gate, ws_up, ws_down):
    def per_sample(ht):
        scores = jax.nn.sigmoid((ht @ w_router).astype(jnp.float32))
        _, idx = lax.top_k(scores + b_router.astype(jnp.float32), TOP_K)
        sel = jnp.take_along_axis(scores, idx, axis=-1)
        wts = ROUTED_SCALE * sel / jnp.sum(sel, axis=-1, keepdims=True)
        combine = jnp.einsum('tk,tke->te', wts, jax.nn.one_hot(idx, N_EXPERTS, dtype=jnp.float32)).astype(ht.dtype)
        act = jax.nn.silu(jnp.einsum('td,edf->tef', ht, w_gate)) * jnp.einsum('td,edf->tef', ht, w_up)
        routed = jnp.einsum('tef,te,efd->td', act, combine, w_down)
        shared = (jax.nn.silu(ht @ ws_gate) * (ht @ ws_up)) @ ws_down
        return routed + shared
    return lax.map(per_sample, h)


def setup_inputs(seed: int = 0) -> dict:
    key = jax.random.key(seed)
    keys = iter(jax.random.split(key, 64))

    def normal(shape, scale):
        return jax.random.normal(next(keys), shape, jnp.float32) * scale

    def gain(n):
        return 1.0 + normal((n,), 0.01)

    inp = {}
    inp["x"] = normal((BATCH, SEQ, D_MODEL), 1.0)
    inp["c"] = normal((BATCH, D_MODEL), 1.0)
    inp["ctx"] = normal((BATCH, CTX_LEN, D_MODEL), 1.0)
    inp["c_ctx"] = normal((D_MODEL,), 1.0)

    def ada(p):
        inp[p + "w_ada"] = normal((D_MODEL, 6 * D_MODEL), 0.5 * D_MODEL ** -0.5)
        inp[p + "b_ada"] = normal((6 * D_MODEL,), 0.01)
        inp[p + "g_mix"] = gain(D_MODEL)

    def moe(p):
        inp[p + "g_moe"] = gain(D_MODEL)
        inp[p + "w_router"] = normal((D_MODEL, N_EXPERTS), D_MODEL ** -0.5)
        inp[p + "b_router"] = normal((N_EXPERTS,), 0.01)
        inp[p + "w_gate"] = normal((N_EXPERTS, D_MODEL, EXPERT_FF), D_MODEL ** -0.5)
        inp[p + "w_up"] = normal((N_EXPERTS, D_MODEL, EXPERT_FF), D_MODEL ** -0.5)
        inp[p + "w_down"] = normal((N_EXPERTS, EXPERT_FF, D_MODEL), EXPERT_FF ** -0.5)
        inp[p + "ws_gate"] = normal((D_MODEL, SHARED_FF), D_MODEL ** -0.5)
        inp[p + "ws_up"] = normal((D_MODEL, SHARED_FF), D_MODEL ** -0.5)
        inp[p + "ws_down"] = normal((SHARED_FF, D_MODEL), SHARED_FF ** -0.5)

    ada("l0_")
    inp["l0_w_in"] = normal((D_MODEL, EVEN_IN), D_MODEL ** -0.5)
    inp["l0_sink"] = normal((A_HEADS,), 0.5)
    inp["l0_rpb"] = normal((B_HEADS, 2 * NA_ROWS - 1, 2 * NA_COLS - 1), 0.1)
    inp["l0_w_out"] = normal((MIX_OUT, D_MODEL), MIX_OUT ** -0.5)
    moe("l0_")
    ada("l1_")
    inp["l1_w_in"] = normal((D_MODEL, ODD_IN), D_MODEL ** -0.5)
    inp["l1_g_q_lora"] = gain(C_Q_LORA)
    inp["l1_w_uq"] = normal((C_Q_LORA, C_HEADS * (C_NOPE + C_ROPE)), C_Q_LORA ** -0.5)
    inp["l1_g_kv_lora"] = gain(C_KV_LORA)
    inp["l1_w_ukv"] = normal((C_KV_LORA, C_HEADS * (C_NOPE + C_V)), C_KV_LORA ** -0.5)
    inp["l1_g_qn"] = gain(HEAD_DIM)
    inp["l1_g_kn"] = gain(HEAD_DIM)
    inp["l1_w_out"] = normal((MIX_OUT, D_MODEL), MIX_OUT ** -0.5)
    moe("l1_")
    inp["g_final"] = gain(D_MODEL)
    return inp


def reference(x, c, ctx, c_ctx,
              l0_w_ada, l0_b_ada, l0_g_mix, l0_w_in, l0_sink, l0_rpb, l0_w_out,
              l0_g_moe, l0_w_router, l0_b_router, l0_w_gate, l0_w_up, l0_w_down, l0_ws_gate, l0_ws_up, l0_ws_down,
              l1_w_ada, l1_b_ada, l1_g_mix, l1_w_in, l1_g_q_lora, l1_w_uq, l1_g_kv_lora, l1_w_ukv, l1_g_qn, l1_g_kn,
              l1_w_out,
              l1_g_moe, l1_w_router, l1_b_router, l1_w_gate, l1_w_up, l1_w_down, l1_ws_gate, l1_ws_up, l1_ws_down,
              g_final):
    S = x.shape[1]
    n_ctx = ctx.shape[1]
    cos_h, sin_h = axial_rope(S, HEAD_DIM)
    cos_r, sin_r = axial_rope(S, C_ROPE)
    ada = ((l0_w_ada, l0_b_ada), (l1_w_ada, l1_b_ada))
    g_mix = (l0_g_mix, l1_g_mix)
    g_moe = (l0_g_moe, l1_g_moe)
    moe_w = ((l0_w_router, l0_b_router, l0_w_gate, l0_w_up, l0_w_down, l0_ws_gate, l0_ws_up, l0_ws_down),
             (l1_w_router, l1_b_router, l1_w_gate, l1_w_up, l1_w_down, l1_ws_gate, l1_ws_up, l1_ws_down))
    mix_w = ((l0_w_in, l0_sink, l0_rpb, l0_w_out),
             (l1_w_in, l1_g_q_lora, l1_w_uq, l1_g_kv_lora, l1_w_ukv, l1_g_qn, l1_g_kn, l1_w_out))

    for layer in range(DEPTH):
        last = layer == DEPTH - 1
        sh1, sc1, gt1, sh2, sc2, gt2 = [m[:, None, :] for m in ada_params(c, *ada[layer])]
        sh1c, sc1c, gt1c, sh2c, sc2c, gt2c = ada_params(c_ctx, *ada[layer])
        h = modulate(rms_norm(x, g_mix[layer]), sh1, sc1)
        hc = modulate(rms_norm(ctx, g_mix[layer]), sh1c, sc1c)
        if layer % 2 == 0:
            y, y_c = even_mixer(h, hc, *mix_w[layer], cos_h, sin_h)
            ctx = ctx + gt1c * y_c
        else:
            y = odd_mixer(h, hc, *mix_w[layer], cos_h, sin_h, cos_r, sin_r)
        x = x + gt1 * y
        h = modulate(rms_norm(x, g_moe[layer]), sh2, sc2)
        if last:
            x = x + gt2 * moe_ffn(h, *moe_w[layer])
        else:
            hc = modulate(rms_norm(ctx, g_moe[layer]), sh2c, sc2c)
            y_all = moe_ffn(jnp.concatenate([hc, h], axis=1), *moe_w[layer])
            ctx = ctx + gt2c * y_all[:, :n_ctx]
            x = x + gt2 * y_all[:, n_ctx:]
    return rms_norm(x, g_final)
```

```cpp
#include <hip/hip_runtime.h>
#include <stdint.h>
#include <stdio.h>

#ifndef ONE_LAUNCH
#define ONE_LAUNCH 1
#endif

#define LAS __attribute__((address_space(3)))
typedef unsigned short bf16_t;
typedef short bf16x8 __attribute__((ext_vector_type(8)));
typedef short s16x4 __attribute__((ext_vector_type(4)));
typedef float f32x4 __attribute__((ext_vector_type(4)));
typedef float f32x16 __attribute__((ext_vector_type(16)));
typedef unsigned u32x4 __attribute__((ext_vector_type(4)));
typedef unsigned u32x2 __attribute__((ext_vector_type(2)));

constexpr int NB = 32, SEQ = 2048, DM = 1024, CTX = 256, TOK = CTX + SEQ, MROWS = NB * TOK;
constexpr int NEXP = 64, NGRP = 65, NCHUNK = 4, NG = NCHUNK * NGRP;
constexpr int CAP = MROWS / NCHUNK;
constexpr int CHUNK_ROWS = MROWS / NCHUNK;
constexpr int CHUNK_B = NB / NCHUNK;
constexpr float LOG2E = 1.4426950408889634f;
constexpr float QS64 = 0.125f * LOG2E;
constexpr float QS96 = 0.10206207261596575f * LOG2E;
constexpr float EPS = 1e-6f;

constexpr size_t MiB = 1048576;
constexpr size_t WS_CTL = 0;
constexpr size_t CTL_BYTES = 65536;
constexpr size_t CTL_CNT = 16384;
constexpr size_t CTL_XRANK = 24576;
constexpr size_t WS_ADA = 65536;
constexpr size_t WS_ROPE = WS_ADA + 2 * MiB;
constexpr size_t WO_IN = 0, WO_OUT = WO_IN + 2304 * 1024, WO_RT = WO_OUT + 1024 * 1024, WO_UQ = WO_RT + 2 * 64 * 1024, WO_UKV = WO_UQ + 768 * 384,
                 WO_GU = WO_UKV + 1024 * 256, WO_D = WO_GU + (size_t)65 * 512 * 1024, W_ELEMS = WO_D + (size_t)65 * 1024 * 256;
constexpr size_t W_BYTES = ((W_ELEMS * 2 + 255) / 256) * 256;
constexpr size_t WS_W0 = WS_ROPE + 1 * MiB;
constexpr size_t WS_W1 = WS_W0 + W_BYTES;
constexpr size_t WS_XC = WS_W1 + W_BYTES;
constexpr size_t WS_H = WS_XC + 32 * MiB;
constexpr size_t WS_RSTD = WS_H + 144 * MiB;
constexpr size_t WS_SROW = WS_RSTD + 1 * MiB;
constexpr size_t WS_SW = WS_SROW + (size_t)NCHUNK * 64 * CAP * 4;
constexpr size_t WS_TSLOT = WS_SW + (size_t)NCHUNK * 64 * CAP * 4;
constexpr size_t WS_BIG = ((WS_TSLOT + (size_t)MROWS * 6 * 4 + 255) / 256) * 256;
constexpr size_t BIG_QKV = 0;
constexpr size_t BIG_P = 0;
constexpr size_t BIG_QM = BIG_P + (size_t)MROWS * 1536 * 2;
constexpr size_t BIG_KVX = BIG_QM + (size_t)MROWS * 768 * 2;
constexpr size_t BIG_HLO = 0;
constexpr size_t MAXSLOT = (size_t)MROWS * 7 + (size_t)NG * 256;
constexpr size_t BIG_ACT = 0;
constexpr size_t BIG_SLAB = BIG_ACT + MAXSLOT * 512;
constexpr size_t SLAB_SLOTS = (size_t)CHUNK_ROWS * 7 + (size_t)NGRP * 256;
constexpr size_t WS_END = WS_BIG + BIG_SLAB + SLAB_SLOTS * 2048;

constexpr int LDS_BYTES = 139264;
constexpr int LDS_TAB = 131072;
constexpr int LDS_BARW = LDS_BYTES - 16;

struct Params {
    const float* in[41];
    float* out;
    char* ws;
};
typedef const Params __attribute__((address_space(4)))* PP;
__device__ __forceinline__ PP get_pp() { PP p = (PP)__builtin_amdgcn_kernarg_segment_ptr(); asm volatile("" : "+s"(p)); return p; }
__device__ __forceinline__ int ltid() { int t = threadIdx.x; asm volatile("" : "+v"(t)); return t; }

__device__ __forceinline__ unsigned pk2(float lo, float hi) {
    typedef float f2 __attribute__((ext_vector_type(2))); typedef __bf16 b2 __attribute__((ext_vector_type(2)));
    f2 v = {lo, hi}; b2 b = __builtin_convertvector(v, b2); return __builtin_bit_cast(unsigned, b);
}
__device__ __forceinline__ float bflo(unsigned u) { return __uint_as_float(u << 16); }
__device__ __forceinline__ float bfhi(unsigned u) { return __uint_as_float(u & 0xffff0000u); }
__device__ __forceinline__ float wave_sum(float v) {
#pragma unroll
    for (int o = 32; o > 0; o >>= 1) v += __shfl_xor(v, o);
    return v;
}
__device__ __forceinline__ int ld_ctl(const int* p) { return __hip_atomic_load(p, __ATOMIC_RELAXED, __HIP_MEMORY_SCOPE_AGENT); }

#define XB_TMO      128
#define XB_XCNT(j)  (256  + 64 * (j))
#define XB_XSUB(j)  (1280 + 64 * (j))
#define XB_XGEN(j)  (2304 + 64 * (j))
#define XB_TOP      3328
#define XB_TOPGEN   3392
#define XCD_BAR_WORDS 3456
#define XB_SPIN_CAP (1u << 18)

__device__ __forceinline__ unsigned xb_ld(unsigned* p)              { return __hip_atomic_load(p, __ATOMIC_RELAXED, __HIP_MEMORY_SCOPE_AGENT); }
__device__ __forceinline__ unsigned xb_add(unsigned* p, unsigned v) { return __hip_atomic_fetch_add(p, v, __ATOMIC_RELAXED, __HIP_MEMORY_SCOPE_AGENT); }
__device__ __forceinline__ unsigned xb_xcc_id() { return (unsigned)__builtin_amdgcn_s_getreg((3 << 11) | 20) & 0xFu; }
#define XB_SPIN(cond, bar) do { unsigned _sp = 0; while (cond) { __builtin_amdgcn_s_sleep(1); \
    if ((++_sp & 255u) == 0u) { if (xb_ld(&(bar)[XB_TMO])) break; if (_sp > XB_SPIN_CAP) { atomicAdd(&(bar)[XB_TMO], 1u); break; } } } } while (0)

struct XcdBarrier { unsigned* bar; unsigned x; volatile LAS unsigned* st; };

__device__ __forceinline__ XcdBarrier xcd_barrier_post(unsigned* bar, volatile LAS unsigned* st) {
    XcdBarrier b; b.bar = bar; b.x = xb_xcc_id(); b.st = st;
    if (threadIdx.x == 0) (void)xb_add(&bar[XB_XCNT(b.x)], 1u);
    return b;
}
__device__ __forceinline__ void xcd_barrier_complete(unsigned* bar, unsigned x, unsigned& nloc, unsigned& nx) {
    const unsigned G = gridDim.x * gridDim.y * gridDim.z;
    unsigned sum, cnt, mine, sp = 0u;
    for (;;) {
        sum = 0u; cnt = 0u; mine = 0u;
#pragma unroll
        for (unsigned j = 0; j < 16; ++j) { const unsigned c = xb_ld(&bar[XB_XCNT(j)]); sum += c; cnt += (c > 0u) ? 1u : 0u; mine = (j == x) ? c : mine; }
        if (sum == G) break;
        __builtin_amdgcn_s_sleep(1);
        if ((++sp & 255u) == 0u) { if (xb_ld(&bar[XB_TMO])) break; if (sp > XB_SPIN_CAP) { atomicAdd(&bar[XB_TMO], 1u); break; } }
    }
    nloc = mine > 0u ? mine : 1u; nx = cnt > 0u ? cnt : 1u;
}
__device__ __forceinline__ void xcd_barrier(const XcdBarrier& b) {
    asm volatile("s_waitcnt vmcnt(0)" ::: "memory");
    __syncthreads();
    if (threadIdx.x == 0) {
        unsigned* bar = b.bar;
        __builtin_amdgcn_s_waitcnt(0);
        unsigned nloc = b.st[0], nx = b.st[1];
        if (nloc == 0u) { xcd_barrier_complete(bar, b.x, nloc, nx); b.st[0] = nloc; b.st[1] = nx; }
        const unsigned old = xb_add(&bar[XB_XSUB(b.x)], 1u);
        const unsigned gen = old / nloc;
        if (old + 1u == (gen + 1u) * nloc) {
            __builtin_amdgcn_fence(__ATOMIC_RELEASE, "agent");
            asm volatile("s_waitcnt vmcnt(0)" ::: "memory");
            const unsigned og = xb_add(&bar[XB_TOP], 1u);
            const unsigned tg = og / nx;
            if (og + 1u == (tg + 1u) * nx) xb_add(&bar[XB_TOPGEN], 1u);
            else XB_SPIN(xb_ld(&bar[XB_TOPGEN]) == tg, bar);
            __builtin_amdgcn_fence(__ATOMIC_ACQUIRE, "agent");
            xb_add(&bar[XB_XGEN(b.x)], 1u);
            asm volatile("s_waitcnt vmcnt(0)" ::: "memory");
        } else {
            XB_SPIN(xb_ld(&bar[XB_XGEN(b.x)]) == gen, bar);
            __builtin_amdgcn_fence(__ATOMIC_ACQUIRE, "agent");
            asm volatile("s_waitcnt vmcnt(0)" ::: "memory");
        }
    }
    __syncthreads();
}

namespace gm {
constexpr int BM = 256, BK = 64, HALF = 128, HTB = HALF * BK * 2, STAGE_BYTES = 8 * HTB, NXCD = 8, WGM = 8;
__device__ __forceinline__ int lds_byte(int r, int c) { const int st = (r >> 4) * 2 + (c >> 5), rr = r & 15, cc = c & 31, ob = rr * 64 + cc * 2; return st * 1024 + (ob ^ (((ob >> 9) & 1) << 5)); }
__device__ __forceinline__ void stage_rc(int b, int& R, int& C) { const int st = b / 1024, sb = b % 1024, swz = sb ^ (((sb >> 9) & 1) << 5); R = (st >> 1) * 16 + swz / 64; C = (st & 1) * 32 + (swz % 64) / 2; }
__device__ __forceinline__ int perm32(int rho) { const int n = rho >> 4, i = rho & 15; return 8 * (i >> 2) + 4 * n + (i & 3); }

struct Unit { int pm, pn, g, mt, cnt, sbase; };
struct Desc { const char* A; unsigned lda; const char* B; unsigned ldb; int K; };

struct DenseSched {
    int nMt, nN, nwg, G, c, mmode;
    __device__ __forceinline__ void init(int mmode_, int nN_, int G_, int c_) { mmode = mmode_; nMt = mmode_ ? 256 : 288; nN = nN_; nwg = nMt * nN_; G = G_; c = c_; }
    __device__ __forceinline__ bool next(int i, Unit& u) const {
        const long L = (long)i * G + c; if (L >= nwg) return false;
        int wgid = (int)L; { const int q = nwg / NXCD, r = nwg % NXCD, xcd = wgid % NXCD, off = wgid / NXCD; wgid = (xcd < r ? xcd * (q + 1) : r * (q + 1) + (xcd - r) * q) + off; }
        const int nig = WGM * nN, gid = wgid / nig, fm = gid * WGM, gsz = (nMt - fm) < WGM ? (nMt - fm) : WGM;
        const int pmi = fm + ((wgid % nig) % gsz); u.pn = (wgid % nig) / gsz;
        u.pm = mmode ? (pmi >> 3) * 9 + 1 + (pmi & 7) : pmi; u.g = 0; u.mt = 0; u.cnt = 256; u.sbase = 0; return true;
    }
    __device__ __forceinline__ int a_row(const Unit& u, int r) const { return u.pm * 256 + r; }
    __device__ __forceinline__ int b_row(const Unit& u) const { return u.pn * 256; }
};

template <int WHICH  >
struct MoeSched {
    LAS const int* toff; const int* slot_row; int nN, G, c, bN, layer, t_lo, t_hi;
    __device__ __forceinline__ bool next(int i, Unit& u) const {
        const int L = i * G + c; if (L >= (t_hi - t_lo) * nN) return false;
        const int tau = L / nN; u.pn = L - tau * nN; const int T = t_lo + tau;
        int lo = 0, hi = NG;
        while (hi - lo > 1) { const int mid = (lo + hi) >> 1; if (toff[mid] <= T) lo = mid; else hi = mid; }
        u.g = lo; u.mt = T - toff[lo]; u.pm = T; u.sbase = T * 256; u.cnt = toff[272 + lo]; return true;
    }
    __device__ __forceinline__ int a_row(const Unit& u, int r) const {
        if (WHICH == 2) return u.sbase + r;
        const int e = u.g % NGRP, ch = u.g / NGRP, idx = u.mt * 256 + r;
        const bool in = (e < NEXP) && (idx < u.cnt);
        const int lrow = slot_row[(size_t)(ch * 64 + (e < NEXP ? e : 0)) * CAP + (in ? idx : 0)];
        const int b1 = ch * CHUNK_B + (idx >> 11);
        const int srow = (layer == 0) ? (ch * CHUNK_ROWS + idx) : (b1 * TOK + CTX + (idx & 2047));
        return (e == NEXP) ? srow : (in ? lrow : 0);
    }
    __device__ __forceinline__ int b_row(const Unit& u) const { return (u.g % NGRP) * bN + u.pn * 256; }
};

template <class Epi, class Sched>
__device__ __forceinline__ void gemm_phase(LAS unsigned char* lds, const Desc g, const Sched& S, const Epi& E) {
    const int tid = ltid(), wid = __builtin_amdgcn_readfirstlane(tid >> 6), lane = tid & 63, wr = wid >> 2, wc = wid & 3, fr = lane & 15, fq = lane >> 4;
    const int nt = g.K / BK;
    unsigned voffB[2][2];
#pragma unroll
    for (int i = 0; i < 2; ++i) { int R, C; stage_rc(tid * 16 + i * 8192, R, C); const int Rl = Epi::PERM ? perm32(R & 31) : (R & 31);
#pragma unroll
        for (int h = 0; h < 2; ++h) { const int Rb = Epi::WIDE ? (64 * (R >> 5) + 32 * h + Rl) : (128 * h + (R & ~31) + Rl);
            voffB[h][i] = (unsigned)Rb * g.ldb + (unsigned)C * 2u; } }
    const size_t kstep = (size_t)(BK * 2);
    const unsigned ldsw = (unsigned)wid * 1024u;
    const int aoff = lds_byte(wr * 64 + fr, fq * 8), boff = lds_byte(wc * 32 + fr, fq * 8);
#define GM_SA(b, h) (((b) * 2 + (h)) * HTB)
#define GM_SB(b, h) ((4 + (b) * 2 + (h)) * HTB)
#define GM_STAGE_A(bufoff, kb, va, h) do { _Pragma("unroll") for (int _i = 0; _i < 2; ++_i) \
        __builtin_amdgcn_global_load_lds((const unsigned*)(g.A + (kb) + (va)[h][_i]), (LAS unsigned*)(lds + (bufoff) + ldsw + _i * 8192), 16, 0, 0); } while (0)
#define GM_STAGE_B(bufoff, bp, h) do { _Pragma("unroll") for (int _i = 0; _i < 2; ++_i) \
        __builtin_amdgcn_global_load_lds((const unsigned*)((bp) + voffB[h][_i]), (LAS unsigned*)(lds + (bufoff) + ldsw + _i * 8192), 16, 0, 0); } while (0)
#define GM_LDA(dst, b, h) do { _Pragma("unroll") for (int m = 0; m < 4; ++m) _Pragma("unroll") for (int k = 0; k < 2; ++k) dst[m][k] = *(const LAS bf16x8*)(lds + GM_SA(b, h) + aoff + m * 2048 + k * 1024); } while (0)
#define GM_LDB(dst, b, h) do { _Pragma("unroll") for (int n = 0; n < 2; ++n) _Pragma("unroll") for (int k = 0; k < 2; ++k) dst[n][k] = *(const LAS bf16x8*)(lds + GM_SB(b, h) + boff + n * 2048 + k * 1024); } while (0)
#define GM_MMA(ai, bj, At, Bt) do { __builtin_amdgcn_s_setprio(1); _Pragma("unroll") for (int m = 0; m < 4; ++m) _Pragma("unroll") for (int n = 0; n < 2; ++n) _Pragma("unroll") for (int k = 0; k < 2; ++k) \
        acc[ai][bj][m][n] = __builtin_amdgcn_mfma_f32_16x16x32_bf16(Bt[n][k], At[m][k], acc[ai][bj][m][n], 0, 0, 0); __builtin_amdgcn_s_setprio(0); } while (0)
#define GM_WAIT_V(n) asm volatile("s_waitcnt vmcnt(" #n ")" ::: "memory")
#define GM_WAIT_L(n) asm volatile("s_waitcnt lgkmcnt(" #n ")" ::: "memory")
#define GM_BAR __builtin_amdgcn_s_barrier()
#define GM_SCHED __builtin_amdgcn_sched_barrier(0)
#define GM_CALC_VA(va, u) do { int _tz = tid; asm volatile("" : "+v"(_tz)); int _rw[2][2]; unsigned _cc[2]; \
        _Pragma("unroll") for (int _i = 0; _i < 2; ++_i) { int _R, _C; stage_rc(_tz * 16 + _i * 8192, _R, _C); _cc[_i] = (unsigned)_C * 2u; \
            _Pragma("unroll") for (int _h = 0; _h < 2; ++_h) _rw[_h][_i] = S.a_row((u), _h * HALF + _R); } \
        _Pragma("unroll") for (int _i = 0; _i < 2; ++_i) _Pragma("unroll") for (int _h = 0; _h < 2; ++_h) (va)[_h][_i] = (unsigned)_rw[_h][_i] * g.lda + _cc[_i]; } while (0)
    Unit cur, nxt; int ui = 0;
    if (!S.next(0, cur)) return;
    f32x4 acc[2][2][4][2];
#pragma unroll
    for (int a = 0; a < 2; ++a)
#pragma unroll
        for (int b = 0; b < 2; ++b)
#pragma unroll
            for (int m = 0; m < 4; ++m)
#pragma unroll
                for (int n = 0; n < 2; ++n) acc[a][b][m][n] = (f32x4){0.f, 0.f, 0.f, 0.f};
    bf16x8 At[4][2], B0[2][2], B1[2][2];
    unsigned vaC[2][2];
    GM_CALC_VA(vaC, cur);
    const char* cB = g.B + (size_t)S.b_row(cur) * g.ldb;
    GM_STAGE_B(GM_SB(0, 0), cB, 0); GM_STAGE_A(GM_SA(0, 0), (size_t)0, vaC, 0); GM_STAGE_B(GM_SB(0, 1), cB, 1); GM_STAGE_A(GM_SA(0, 1), (size_t)0, vaC, 1);
    if (wr == 1) GM_BAR;
    GM_WAIT_V(4); GM_BAR;
    GM_STAGE_B(GM_SB(1, 0), cB + kstep, 0); GM_STAGE_A(GM_SA(1, 0), kstep, vaC, 0); GM_STAGE_B(GM_SB(1, 1), cB + kstep, 1);
    GM_WAIT_V(6); GM_BAR;
    for (;;) {
        const bool has_next = S.next(ui + 1, nxt);
        const char* nB = cB;
        if (has_next) nB = g.B + (size_t)S.b_row(nxt) * g.ldb;
        unsigned va2[2][2];
#pragma clang loop unroll(disable)
        for (int t = 0; t < nt; t += 2) {
            const bool last = (t == nt - 2);
            const size_t k1 = (size_t)(t + 1) * kstep;
            const size_t k2 = last ? (size_t)0 : (size_t)(t + 2) * kstep, k3 = k2 + kstep;
            const char* b2 = last ? nB : cB + k2; const char* b3 = b2 + kstep;
#pragma unroll
            for (int _h = 0; _h < 2; ++_h)
#pragma unroll
                for (int _i = 0; _i < 2; ++_i) va2[_h][_i] = vaC[_h][_i];
            if (last && has_next) GM_CALC_VA(va2, nxt);
            GM_LDB(B0, 0, 0); GM_SCHED; GM_LDA(At, 0, 0); GM_STAGE_A(GM_SA(1, 1), k1, vaC, 1);
            GM_WAIT_L(8); GM_BAR; GM_WAIT_L(0); GM_MMA(0, 0, At, B0); GM_BAR; GM_SCHED;
            GM_LDB(B1, 0, 1); GM_STAGE_B(GM_SB(0, 0), b2, 0);
            GM_BAR; GM_WAIT_L(0); GM_MMA(0, 1, At, B1); GM_BAR;
            GM_LDA(At, 0, 1); GM_STAGE_A(GM_SA(0, 0), k2, va2, 0);
            GM_BAR; GM_WAIT_L(0); GM_MMA(1, 0, At, B0); GM_BAR; GM_SCHED;
            GM_STAGE_B(GM_SB(0, 1), b2, 1);
            GM_WAIT_V(6); GM_BAR; GM_MMA(1, 1, At, B1); GM_BAR;
            GM_LDB(B0, 1, 0); GM_SCHED; GM_LDA(At, 1, 0); GM_STAGE_A(GM_SA(0, 1), k2, va2, 1);
            GM_WAIT_L(8); GM_BAR; GM_WAIT_L(0); GM_MMA(0, 0, At, B0); GM_BAR; GM_SCHED;
            GM_LDB(B1, 1, 1); GM_STAGE_B(GM_SB(1, 0), b3, 0);
            GM_BAR; GM_WAIT_L(0); GM_MMA(0, 1, At, B1); GM_BAR;
            GM_LDA(At, 1, 1); GM_STAGE_A(GM_SA(1, 0), k3, va2, 0);
            GM_BAR; GM_WAIT_L(0); GM_MMA(1, 0, At, B0); GM_BAR; GM_SCHED;
            GM_STAGE_B(GM_SB(1, 1), b3, 1);
            GM_WAIT_V(6); GM_BAR; GM_MMA(1, 1, At, B1); GM_BAR;
        }
        { int tz = tid; asm volatile("" : "+v"(tz));
          const int wid2 = __builtin_amdgcn_readfirstlane(tz >> 6), ln2 = tz & 63; E(acc, cur, wid2 >> 2, wid2 & 3, ln2 & 15, ln2 >> 4); }
        if (!has_next) break;
#pragma unroll
        for (int a = 0; a < 2; ++a)
#pragma unroll
            for (int b = 0; b < 2; ++b)
#pragma unroll
                for (int m = 0; m < 4; ++m)
#pragma unroll
                    for (int n = 0; n < 2; ++n) acc[a][b][m][n] = (f32x4){0.f, 0.f, 0.f, 0.f};
        cur = nxt; cB = nB; ++ui;
#pragma unroll
        for (int _h = 0; _h < 2; ++_h)
#pragma unroll
            for (int _i = 0; _i < 2; ++_i) vaC[_h][_i] = va2[_h][_i];
    }
    GM_WAIT_V(0);
    if (wr == 0) GM_BAR;
    GM_BAR;
#undef GM_SA
#undef GM_SB
#undef GM_STAGE_A
#undef GM_STAGE_B
#undef GM_LDA
#undef GM_LDB
#undef GM_MMA
#undef GM_WAIT_V
#undef GM_WAIT_L
#undef GM_BAR
#undef GM_SCHED
#undef GM_CALC_VA
}

typedef const f32x4 (&AccRef)[2][2][4][2];

struct EpiQKV0 {
    static constexpr bool PERM = false; static constexpr int WIDE = 0;
    bf16_t* O; const float* cosT; const float* sinT;
    __device__ __forceinline__ void operator()(AccRef acc, const Unit& u, int wr, int wc, int fr, int fq) const {
        const int tq = u.pm % 9; const bool ctx = (tq == 0); const int tbase = tq * 256 - 256;
        const int colg0 = 256 * u.pn + 32 * wc; const bool rope0 = (colg0 < 640) && !ctx, rope1 = (colg0 + 128 < 640) && !ctx; const int gi = 16 * (wc & 1) + 4 * fq;
        f32x4 cs[8], sn[8];
        if (rope0) {
#pragma unroll
            for (int q = 0; q < 8; ++q) { const int rl = 128 * (q >> 2) + 64 * wr + 16 * (q & 3) + fr; cs[q] = *(const f32x4*)(cosT + (size_t)(tbase + rl) * 32 + gi); sn[q] = *(const f32x4*)(sinT + (size_t)(tbase + rl) * 32 + gi); }
        }
#pragma unroll
        for (int bj = 0; bj < 2; ++bj) {
            const int colg = colg0 + 128 * bj; const bool rope = bj ? rope1 : rope0;
#pragma unroll
            for (int ai = 0; ai < 2; ++ai)
#pragma unroll
                for (int m = 0; m < 4; ++m) {
                    const int rl = 128 * ai + 64 * wr + 16 * m + fr; const size_t row = (size_t)u.pm * 256 + rl;
                    f32x4 v0 = acc[ai][bj][m][0], v1 = acc[ai][bj][m][1];
                    if (rope) { const f32x4 c4 = cs[4 * ai + m], s4 = sn[4 * ai + m]; const f32x4 x0 = v0 * c4 - v1 * s4, x1 = v0 * s4 + v1 * c4; v0 = x0; v1 = x1; }
                    bf16_t* p = O + row * 2304 + colg + 4 * fq;
                    u32x2 w0, w1; w0.x = pk2(v0[0], v0[1]); w0.y = pk2(v0[2], v0[3]); w1.x = pk2(v1[0], v1[1]); w1.y = pk2(v1[2], v1[3]);
                    *(u32x2*)p = w0; *(u32x2*)(p + 16) = w1;
                }
        }
    }
};
struct EpiP1 {
    static constexpr bool PERM = true; static constexpr int WIDE = 1;
    bf16_t* O; int ldc; const float* rs; int rsel;
    __device__ __forceinline__ void operator()(AccRef acc, const Unit& u, int wr, int wc, int fr, int fq) const {
        float scv[8];
#pragma unroll
        for (int q = 0; q < 8; ++q) { const size_t row = (size_t)u.pm * 256 + 128 * (q >> 2) + 64 * wr + 16 * (q & 3) + fr; scv[q] = rs ? rs[row * 2 + rsel] : 1.f; }
        const bool lo = fr < 8; const int col = 256 * u.pn + 64 * wc + 8 * fq + (lo ? 0 : 32);
#pragma unroll
        for (int ai = 0; ai < 2; ++ai)
#pragma unroll
            for (int m = 0; m < 4; ++m) { const size_t row = (size_t)u.pm * 256 + 128 * ai + 64 * wr + 16 * m + (fr & 7); const float sc = scv[4 * ai + m];
                u32x4 x0, x1;
                { const f32x4 v0 = acc[ai][0][m][0] * sc, v1 = acc[ai][0][m][1] * sc; x0.x = pk2(v0[0], v0[1]); x0.y = pk2(v0[2], v0[3]); x0.z = pk2(v1[0], v1[1]); x0.w = pk2(v1[2], v1[3]); }
                { const f32x4 v0 = acc[ai][1][m][0] * sc, v1 = acc[ai][1][m][1] * sc; x1.x = pk2(v0[0], v0[1]); x1.y = pk2(v0[2], v0[3]); x1.z = pk2(v1[0], v1[1]); x1.w = pk2(v1[2], v1[3]); }
                u32x4 rc;
#pragma unroll
                for (int q = 0; q < 4; ++q) rc[q] = (unsigned)__shfl_xor((int)(lo ? x1[q] : x0[q]), 8);
                const u32x4 da = lo ? x0 : rc, db = lo ? rc : x1;
                *(u32x4*)(O + row * ldc + col) = da; *(u32x4*)(O + (row + 8) * ldc + col) = db; }
    }
};
struct EpiUQ {
    static constexpr bool PERM = false; static constexpr int WIDE = 0;
    bf16_t* O; const float* rs; const float* cosT; const float* sinT;
    __device__ __forceinline__ void operator()(AccRef acc, const Unit& u, int wr, int wc, int fr, int fq) const {
        const int tq = u.pm % 9; const bool ctx = (tq == 0); const int tbase = tq * 256 - 256;
        const int colg0 = 256 * u.pn + 32 * wc, colg1 = colg0 + 128;
        const bool rope0 = ((colg0 >> 5) % 3 == 2) && !ctx, rope1 = ((colg1 >> 5) % 3 == 2) && !ctx;
        float scv[8]; f32x4 cs[8], sn[8];
#pragma unroll
        for (int q = 0; q < 8; ++q) { const int rl = 128 * (q >> 2) + 64 * wr + 16 * (q & 3) + fr; scv[q] = rs[((size_t)u.pm * 256 + rl) * 2]; }
        if (rope0 || rope1) {
#pragma unroll
            for (int q = 0; q < 8; ++q) { const int rl = 128 * (q >> 2) + 64 * wr + 16 * (q & 3) + fr; cs[q] = *(const f32x4*)(cosT + (size_t)(tbase + rl) * 16 + 4 * fq); sn[q] = *(const f32x4*)(sinT + (size_t)(tbase + rl) * 16 + 4 * fq); }
        }
#pragma unroll
        for (int ai = 0; ai < 2; ++ai)
#pragma unroll
            for (int m = 0; m < 4; ++m) {
                const int rl = 128 * ai + 64 * wr + 16 * m + fr; const size_t row = (size_t)u.pm * 256 + rl; const float sc = scv[4 * ai + m];
#pragma unroll
                for (int bj = 0; bj < 2; ++bj) {
                    f32x4 v0 = acc[ai][bj][m][0] * sc, v1 = acc[ai][bj][m][1] * sc;
                    if (bj ? rope1 : rope0) { const f32x4 c4 = cs[4 * ai + m], s4 = sn[4 * ai + m]; const f32x4 x0 = v0 * c4 - v1 * s4, x1 = v0 * s4 + v1 * c4; v0 = x0; v1 = x1; }
                    bf16_t* p = O + row * 768 + (bj ? colg1 : colg0) + 4 * fq;
                    u32x2 w0, w1; w0.x = pk2(v0[0], v0[1]); w0.y = pk2(v0[2], v0[3]); w1.x = pk2(v1[0], v1[1]); w1.y = pk2(v1[2], v1[3]);
                    *(u32x2*)p = w0; *(u32x2*)(p + 16) = w1;
                }
            }
    }
};
struct EpiG1 {
    static constexpr bool PERM = false; static constexpr int WIDE = 0;
    bf16_t* act; const float* slot_w;
    __device__ __forceinline__ void operator()(AccRef acc, const Unit& u, int wr, int wc, int fr, int fq) const {
        const int e = u.g % NGRP, ch = u.g / NGRP;
        float wv[8];
        const float* wp = slot_w + (size_t)(ch * 64 + (e < NEXP ? e : NEXP - 1)) * CAP;
#pragma unroll
        for (int q = 0; q < 8; ++q) { const int idx = u.mt * 256 + 128 * (q >> 2) + 64 * wr + 16 * (q & 3) + fr; const bool in = idx < u.cnt;
            const float lw = __hip_atomic_load(wp + (in ? idx : 0), __ATOMIC_RELAXED, __HIP_MEMORY_SCOPE_AGENT);
            wv[q] = (e == NEXP) ? 1.f : (in ? lw : 0.f); }
#pragma unroll
        for (int ai = 0; ai < 2; ++ai)
#pragma unroll
            for (int m = 0; m < 4; ++m) {
                const int rl = 128 * ai + 64 * wr + 16 * m + fr; const float w = wv[4 * ai + m];
#pragma unroll
                for (int bj = 0; bj < 2; ++bj) {
                    const f32x4 gt = acc[ai][bj][m][0], up = acc[ai][bj][m][1]; float r[4];
#pragma unroll
                    for (int j = 0; j < 4; ++j) r[j] = gt[j] * __builtin_amdgcn_rcpf(1.f + __expf(-gt[j])) * up[j] * w;
                    u32x2 o; o.x = pk2(r[0], r[1]); o.y = pk2(r[2], r[3]);
                    *(u32x2*)(act + ((size_t)u.sbase + rl) * 256 + 16 * (8 * u.pn + 4 * bj + wc) + 4 * fq) = o;
                }
            }
    }
};
struct EpiG2 {
    static constexpr bool PERM = true, WIDE = true;
    bf16_t* slab; int sbase0;
    __device__ __forceinline__ void operator()(AccRef acc, const Unit& u, int wr, int wc, int fr, int fq) const {
        const bool lo = fr < 8; const int col = 256 * u.pn + 64 * wc + 8 * fq + (lo ? 0 : 32);
#pragma unroll
        for (int ai = 0; ai < 2; ++ai)
#pragma unroll
            for (int m = 0; m < 4; ++m) { const size_t row = (size_t)(u.sbase - sbase0) + 128 * ai + 64 * wr + 16 * m + (fr & 7);
                u32x4 x0, x1;
                { const f32x4 v0 = acc[ai][0][m][0], v1 = acc[ai][0][m][1]; x0.x = pk2(v0[0], v0[1]); x0.y = pk2(v0[2], v0[3]); x0.z = pk2(v1[0], v1[1]); x0.w = pk2(v1[2], v1[3]); }
                { const f32x4 v0 = acc[ai][1][m][0], v1 = acc[ai][1][m][1]; x1.x = pk2(v0[0], v0[1]); x1.y = pk2(v0[2], v0[3]); x1.z = pk2(v1[0], v1[1]); x1.w = pk2(v1[2], v1[3]); }
                u32x4 rc;
#pragma unroll
                for (int q = 0; q < 4; ++q) rc[q] = (unsigned)__shfl_xor((int)(lo ? x1[q] : x0[q]), 8);
                const u32x4 da = lo ? x0 : rc, db = lo ? rc : x1;
                __builtin_nontemporal_store(da, (u32x4*)(slab + row * 1024 + col)); __builtin_nontemporal_store(db, (u32x4*)(slab + (row + 8) * 1024 + col)); }
    }
};
}

struct AU {
    const bf16_t* qptr;
    bf16_t* optr;
    const bf16_t* kbase; unsigned kpitch;
    const bf16_t* vbase; unsigned vpitch;
    const bf16_t* k2base; unsigned k2pitch;
    int row_ctx, row_lat;
    int nt;
    int j0;
    int qoff;
    int start;
    float m0, l0;
};
constexpr int ATT_RPB = 122880;
constexpr float THR = 8.f;
__device__ __forceinline__ void glds16(const void* gsrc, unsigned lds_dst) { unsigned keep;
    asm volatile("s_mov_b32 %0, m0\n\ts_mov_b32 m0, %2\n\ts_nop 0\n\tglobal_load_lds_dwordx4 %1, off\n\ts_mov_b32 m0, %0" : "=&s"(keep) : "v"(gsrc), "s"(lds_dst) : "memory"); }
__device__ __forceinline__ float max3f(float a, float b, float c) { float r; asm("v_max3_f32 %0, %1, %2, %3" : "=v"(r) : "v"(a), "v"(b), "v"(c)); return r; }
__device__ __forceinline__ float max2f(float a, float b) { float r; asm("v_max_f32_e32 %0, %1, %2" : "=v"(r) : "v"(a), "v"(b)); return r; }

template <int MODE  , int DQ  >
__device__ __forceinline__ void attn_unit(LAS unsigned char* lds, const AU& a) {
    constexpr int NS = DQ / 16;
    constexpr int BUFB = (DQ == 96) ? 20480 : 16384;
    const int tid = ltid(), lane = tid & 63, wid = __builtin_amdgcn_readfirstlane(tid >> 6), r32 = lane & 31, hi = lane >> 5;
    const bool upper = wid >= 4;
    const int kr = tid >> 3, cp = tid & 7;
    const int ksrc = (cp ^ ((kr >> 1) & 7)) * 8, vsrc = (cp ^ (((kr >> 1) & 1) << 2)) * 8;
    const int kr2 = 16 * wid + (lane >> 2), k2src = ((lane & 3) ^ ((kr2 >> 2) & 3)) * 8;
    unsigned koff[NS];
#pragma unroll
    for (int s = 0; s < NS; ++s) koff[s] = (s < 4) ? (unsigned)(r32 * 128 + (((2 * s + hi) ^ ((r32 >> 1) & 7)) << 4))
                                                   : (unsigned)(16384 + r32 * 64 + (((2 * (s - 4) + hi) ^ ((r32 >> 2) & 3)) << 4));
    const int vg = (lane >> 4) & 1, vq = (lane & 15) >> 2, vp = lane & 3, vsw = (vq >> 1) & 1;
    const unsigned voff0 = (unsigned)(8192 + (4 * hi + vq) * 128 + 64 * vsw + 32 * vg + 8 * vp);
    const unsigned voff1 = (unsigned)(8192 + (4 * hi + vq) * 128 + 64 * (1 - vsw) + 32 * vg + 8 * vp);
    bf16x8 qf[NS];
#pragma unroll
    for (int s = 0; s < NS; ++s) qf[s] = *(const bf16x8*)(a.qptr + 16 * s + 8 * hi);
    f32x16 o0, o1, negm, p0, p1;
    float m = a.m0, l = a.l0;
#pragma unroll
    for (int r = 0; r < 16; ++r) { o0[r] = 0.f; o1[r] = 0.f; negm[r] = -m; p0[r] = 0.f; p1[r] = 0.f; }
    const int nt = a.nt;
    auto krow = [&](int t, int r) -> int {
        if (MODE == 0) return a.row_ctx + 64 * t + r;
        if (t < 4) return a.row_ctx + 64 * t + r;
        if (MODE == 1) return a.row_lat + a.start - 128 + 64 * (a.j0 + t - 4) + r;
        return a.row_lat + 64 * (a.j0 + t - 4) + r;
    };
    const unsigned lds0 = (unsigned)(uintptr_t)lds + (unsigned)wid * 1024u;
    auto dma = [&](int t, int boff) {
        const size_t r = (size_t)krow(t, kr);
        glds16(a.kbase + r * a.kpitch + ksrc, (unsigned)__builtin_amdgcn_readfirstlane((int)(lds0 + boff)));
        glds16(a.vbase + r * a.vpitch + vsrc, (unsigned)__builtin_amdgcn_readfirstlane((int)(lds0 + boff + 8192)));
        if (DQ == 96) { if (!upper) { const size_t r2 = (size_t)krow(t, kr2);
            glds16(a.k2base + r2 * a.k2pitch + k2src, (unsigned)__builtin_amdgcn_readfirstlane((int)(lds0 + boff + 16384))); } }
    };
    auto tile_active = [&](int t) -> bool {
        if (MODE != 2 || t < 4) return true;
        const int qrow = a.qoff >> 6; int rs = qrow - 4; rs = rs < 0 ? 0 : (rs > 24 ? 24 : rs); const int kgr = a.j0 + t - 4;
        return __builtin_amdgcn_readfirstlane((int)((kgr >= rs) && (kgr < rs + 8))) != 0;
    };
    auto QK = [&](int t, int boff) {
        const LAS unsigned char* Bb = lds + boff;
        bf16x8 kf[2 * NS];
#pragma unroll
        for (int s = 0; s < NS; ++s) { kf[2 * s] = *(const LAS bf16x8*)(Bb + koff[s]); kf[2 * s + 1] = *(const LAS bf16x8*)(Bb + koff[s] + (s < 4 ? 4096 : 2048)); }
#pragma unroll
        for (int s = 0; s < NS; ++s) {
            if (s == 0) { p0 = __builtin_amdgcn_mfma_f32_32x32x16_bf16(kf[0], qf[0], negm, 0, 0, 0); p1 = __builtin_amdgcn_mfma_f32_32x32x16_bf16(kf[1], qf[0], negm, 0, 0, 0); }
            else { p0 = __builtin_amdgcn_mfma_f32_32x32x16_bf16(kf[2 * s], qf[s], p0, 0, 0, 0); p1 = __builtin_amdgcn_mfma_f32_32x32x16_bf16(kf[2 * s + 1], qf[s], p1, 0, 0, 0); }
        }
        __builtin_amdgcn_sched_group_barrier(0x100, 2 * NS, 0);
        __builtin_amdgcn_sched_group_barrier(0x008, 2 * NS, 0);
        if (MODE == 1 && t >= 4) {
            const int j = a.j0 + t - 4;
            if (j == 0 || j == 4) {
                const int dbase = -128 + 64 * j - a.qoff + 4 * hi;
#pragma unroll
                for (int r = 0; r < 16; ++r) { const int d = dbase + (r & 3) + 8 * (r >> 2);
                    if ((unsigned)(d + 128) > 256u) p0[r] = -1e30f; if ((unsigned)(d + 32 + 128) > 256u) p1[r] = -1e30f; }
            }
        }
        if (MODE == 2 && t >= 4) {
            const int qrow = a.qoff >> 6, qcol = a.qoff & 63; int cs = qcol - 8; cs = cs < 0 ? 0 : (cs > 48 ? 48 : cs);
            const int krel = a.j0 + t - 4 - qrow + 7;
            const LAS float* bt = (const LAS float*)(lds + ATT_RPB) + krel * 128 + (63 - qcol) + 4 * hi;
            const int cb = 4 * hi - cs;
#pragma unroll
            for (int r = 0; r < 16; ++r) { const int kc = (r & 3) + 8 * (r >> 2);
                const float b0 = bt[kc], b1 = bt[kc + 32];
                p0[r] = ((unsigned)(cb + kc) < 16u) ? p0[r] + b0 : -1e30f;
                p1[r] = ((unsigned)(cb + kc + 32) < 16u) ? p1[r] + b1 : -1e30f; }
        }
    };
    bf16x8 pf0, pf1, pf2, pf3;
    auto SM = [&](bool first) {
        asm volatile("s_nop 15\n\ts_nop 7" : "+v"(p0), "+v"(p1));
        float ra = max3f(p0[0], p0[1], p1[0]), rb = max3f(p0[2], p0[3], p1[1]); ra = max3f(ra, p1[2], p1[3]);
#pragma unroll
        for (int r = 4; r < 16; r += 4) { ra = max3f(ra, p0[r], p0[r + 1]); rb = max3f(rb, p0[r + 2], p0[r + 3]); ra = max3f(ra, p1[r], p1[r + 1]); rb = max3f(rb, p1[r + 2], p1[r + 3]); }
        float rm = max2f(ra, rb);
        { auto rr = __builtin_amdgcn_permlane32_swap(__float_as_uint(rm), __float_as_uint(rm), false, false); rm = max2f(__uint_as_float(rr[0]), __uint_as_float(rr[1])); }
        if (first || __any(rm > THR)) {
            const float dl = first ? rm : fmaxf(rm, 0.f);
            m += dl; const float f = __builtin_amdgcn_exp2f(-dl); l *= f;
#pragma unroll
            for (int r = 0; r < 16; ++r) { p0[r] -= dl; p1[r] -= dl; o0[r] *= f; o1[r] *= f; negm[r] = -m; }
        }
        float ls = 0.f;
#pragma unroll
        for (int r = 0; r < 16; ++r) { p0[r] = __builtin_amdgcn_exp2f(p0[r]); p1[r] = __builtin_amdgcn_exp2f(p1[r]); ls += p0[r] + p1[r]; }
        l += ls;
        u32x4 w;
        w.x = pk2(p0[0], p0[1]); w.y = pk2(p0[2], p0[3]); w.z = pk2(p0[4], p0[5]); w.w = pk2(p0[6], p0[7]); pf0 = __builtin_bit_cast(bf16x8, w);
        w.x = pk2(p0[8], p0[9]); w.y = pk2(p0[10], p0[11]); w.z = pk2(p0[12], p0[13]); w.w = pk2(p0[14], p0[15]); pf1 = __builtin_bit_cast(bf16x8, w);
        w.x = pk2(p1[0], p1[1]); w.y = pk2(p1[2], p1[3]); w.z = pk2(p1[4], p1[5]); w.w = pk2(p1[6], p1[7]); pf2 = __builtin_bit_cast(bf16x8, w);
        w.x = pk2(p1[8], p1[9]); w.y = pk2(p1[10], p1[11]); w.z = pk2(p1[12], p1[13]); w.w = pk2(p1[14], p1[15]); pf3 = __builtin_bit_cast(bf16x8, w);
    };
    auto PV = [&](int boff) {
        const LAS unsigned char* Bb = lds + boff;
        s16x4 va0[4], va1[4], vc0[4], vc1[4];
#pragma unroll
        for (int kk = 0; kk < 4; ++kk) {
            const LAS unsigned char* vb = Bb + kk * 2048;
            va0[kk] = __builtin_bit_cast(s16x4, __builtin_amdgcn_ds_read_tr16_b64_v4i16((LAS s16x4*)(vb + voff0)));
            va1[kk] = __builtin_bit_cast(s16x4, __builtin_amdgcn_ds_read_tr16_b64_v4i16((LAS s16x4*)(vb + voff0 + 1024)));
            vc0[kk] = __builtin_bit_cast(s16x4, __builtin_amdgcn_ds_read_tr16_b64_v4i16((LAS s16x4*)(vb + voff1)));
            vc1[kk] = __builtin_bit_cast(s16x4, __builtin_amdgcn_ds_read_tr16_b64_v4i16((LAS s16x4*)(vb + voff1 + 1024)));
        }
#pragma unroll
        for (int kk = 0; kk < 4; ++kk) {
            const bf16x8 va = (bf16x8){va0[kk][0], va0[kk][1], va0[kk][2], va0[kk][3], va1[kk][0], va1[kk][1], va1[kk][2], va1[kk][3]};
            const bf16x8 vc = (bf16x8){vc0[kk][0], vc0[kk][1], vc0[kk][2], vc0[kk][3], vc1[kk][0], vc1[kk][1], vc1[kk][2], vc1[kk][3]};
            const bf16x8 pk = kk == 0 ? pf0 : (kk == 1 ? pf1 : (kk == 2 ? pf2 : pf3));
            o0 = __builtin_amdgcn_mfma_f32_32x32x16_bf16(va, pk, o0, 0, 0, 0);
            o1 = __builtin_amdgcn_mfma_f32_32x32x16_bf16(vc, pk, o1, 0, 0, 0);
        }
        __builtin_amdgcn_sched_group_barrier(0x100, 16, 0);
        __builtin_amdgcn_sched_group_barrier(0x008, 8, 0);
    };
#define ATT_WAIT_BAR(N) do { asm volatile("s_waitcnt vmcnt(" #N ") lgkmcnt(0)" ::: "memory"); __builtin_amdgcn_s_barrier(); asm volatile("" ::: "memory"); } while (0)
    constexpr int RING = 6, DIST = RING - 1;
    auto wait_bar = [&](int ntiles) {
        if (DQ == 96 && !upper) { switch (ntiles) { case 4: ATT_WAIT_BAR(12); break; case 3: ATT_WAIT_BAR(9); break; case 2: ATT_WAIT_BAR(6); break; case 1: ATT_WAIT_BAR(3); break; default: ATT_WAIT_BAR(0); } }
        else { switch (ntiles) { case 4: ATT_WAIT_BAR(8); break; case 3: ATT_WAIT_BAR(6); break; case 2: ATT_WAIT_BAR(4); break; case 1: ATT_WAIT_BAR(2); break; default: ATT_WAIT_BAR(0); } } };
    if (upper) __builtin_amdgcn_s_setprio(1);
    int issued = 0;
    for (; issued < DIST && issued < nt; ++issued) dma(issued, issued * BUFB);
    wait_bar(issued - 1);
    int b_cur = 0, b_iss = (DIST % RING) * BUFB;
    for (int t = 0; t < nt; ++t) {
        if (issued < nt) { dma(issued, b_iss); ++issued; b_iss += BUFB; if (b_iss == RING * BUFB) b_iss = 0; }
        if (tile_active(t)) { QK(t, b_cur); SM(t == 0); PV(b_cur); }
        { const int infl = issued - t - 2; wait_bar(infl < 0 ? 0 : infl); }
        b_cur += BUFB; if (b_cur == RING * BUFB) b_cur = 0;
    }
#undef ATT_WAIT_BAR
    if (upper) __builtin_amdgcn_s_setprio(0);
    { auto rr = __builtin_amdgcn_permlane32_swap(__float_as_uint(l), __float_as_uint(l), false, false); l = __uint_as_float(rr[0]) + __uint_as_float(rr[1]); }
    const float inv = 1.f / l;
#pragma unroll
    for (int ig = 0; ig < 4; ++ig) {
        u32x2 w0, w1;
        w0.x = pk2(o0[4 * ig] * inv, o0[4 * ig + 1] * inv); w0.y = pk2(o0[4 * ig + 2] * inv, o0[4 * ig + 3] * inv);
        w1.x = pk2(o1[4 * ig] * inv, o1[4 * ig + 1] * inv); w1.y = pk2(o1[4 * ig + 2] * inv, o1[4 * ig + 3] * inv);
        *(u32x2*)(a.optr + 8 * ig + 4 * hi) = w0;
        *(u32x2*)(a.optr + 32 + 8 * ig + 4 * hi) = w1;
    }
}

struct AU2 {
    const bf16_t* qptr; unsigned qpitch;
    bf16_t* optr;
    const bf16_t* kbase; unsigned kpitch; const bf16_t* vbase; unsigned vpitch; const bf16_t* k2base; unsigned k2pitch;
    int row_ctx, nt;
};
template <int DQ  >
__device__ __forceinline__ void attn_unit2(LAS unsigned char* lds, const AU2& a) {
    constexpr int NS = DQ / 16;
    constexpr int BUFB = (DQ == 96) ? 20480 : 16384;
    const int tid = ltid(), lane = tid & 63, wid = __builtin_amdgcn_readfirstlane(tid >> 6), r32 = lane & 31, hi = lane >> 5;
    const bool upper = wid >= 4;
    const int kr = tid >> 3, cp = tid & 7;
    const int ksrc = (cp ^ ((kr >> 1) & 7)) * 8, vsrc = (cp ^ (((kr >> 1) & 1) << 2)) * 8;
    const int kr2 = 16 * wid + (lane >> 2), k2src = ((lane & 3) ^ ((kr2 >> 2) & 3)) * 8;
    unsigned koff[NS];
#pragma unroll
    for (int s = 0; s < NS; ++s) koff[s] = (s < 4) ? (unsigned)(r32 * 128 + (((2 * s + hi) ^ ((r32 >> 1) & 7)) << 4))
                                                   : (unsigned)(16384 + r32 * 64 + (((2 * (s - 4) + hi) ^ ((r32 >> 2) & 3)) << 4));
    const int vg = (lane >> 4) & 1, vq = (lane & 15) >> 2, vp = lane & 3, vsw = (vq >> 1) & 1;
    const unsigned voff0 = (unsigned)(8192 + (4 * hi + vq) * 128 + 64 * vsw + 32 * vg + 8 * vp);
    const unsigned voff1 = (unsigned)(8192 + (4 * hi + vq) * 128 + 64 * (1 - vsw) + 32 * vg + 8 * vp);
    bf16x8 qA[NS], qB[NS];
#pragma unroll
    for (int s = 0; s < NS; ++s) { qA[s] = *(const bf16x8*)(a.qptr + 16 * s + 8 * hi); qB[s] = *(const bf16x8*)(a.qptr + (size_t)32 * a.qpitch + 16 * s + 8 * hi); }
    f32x16 oA0, oA1, oB0, oB1, pA0, pA1, pB0, pB1;
    float mA = 0.f, lA = 0.f, mB = 0.f, lB = 0.f;
#pragma unroll
    for (int r = 0; r < 16; ++r) { oA0[r] = 0.f; oA1[r] = 0.f; oB0[r] = 0.f; oB1[r] = 0.f; }
    const int nt = a.nt;
    const unsigned lds0 = (unsigned)(uintptr_t)lds + (unsigned)wid * 1024u;
    auto dma = [&](int t, int boff) {
        const size_t r = (size_t)(a.row_ctx + 64 * t + kr);
        glds16(a.kbase + r * a.kpitch + ksrc, (unsigned)__builtin_amdgcn_readfirstlane((int)(lds0 + boff)));
        glds16(a.vbase + r * a.vpitch + vsrc, (unsigned)__builtin_amdgcn_readfirstlane((int)(lds0 + boff + 8192)));
        if (DQ == 96) { if (!upper) { const size_t r2 = (size_t)(a.row_ctx + 64 * t + kr2);
            glds16(a.k2base + r2 * a.k2pitch + k2src, (unsigned)__builtin_amdgcn_readfirstlane((int)(lds0 + boff + 16384))); } }
    };
    const f32x16 zero16 = {0.f, 0.f, 0.f, 0.f, 0.f, 0.f, 0.f, 0.f, 0.f, 0.f, 0.f, 0.f, 0.f, 0.f, 0.f, 0.f};
    auto QK = [&](int boff) {
        const LAS unsigned char* Bb = lds + boff;
        bf16x8 kf[2 * NS];
#pragma unroll
        for (int s = 0; s < NS; ++s) { kf[2 * s] = *(const LAS bf16x8*)(Bb + koff[s]); kf[2 * s + 1] = *(const LAS bf16x8*)(Bb + koff[s] + (s < 4 ? 4096 : 2048)); }
#pragma unroll
        for (int s = 0; s < NS; ++s) {
            pA0 = __builtin_amdgcn_mfma_f32_32x32x16_bf16(kf[2 * s], qA[s], s == 0 ? zero16 : pA0, 0, 0, 0); pA1 = __builtin_amdgcn_mfma_f32_32x32x16_bf16(kf[2 * s + 1], qA[s], s == 0 ? zero16 : pA1, 0, 0, 0);
            pB0 = __builtin_amdgcn_mfma_f32_32x32x16_bf16(kf[2 * s], qB[s], s == 0 ? zero16 : pB0, 0, 0, 0); pB1 = __builtin_amdgcn_mfma_f32_32x32x16_bf16(kf[2 * s + 1], qB[s], s == 0 ? zero16 : pB1, 0, 0, 0);
        }
        __builtin_amdgcn_sched_group_barrier(0x100, 2 * NS, 0);
        __builtin_amdgcn_sched_group_barrier(0x008, 4 * NS, 0);
    };
    auto SM = [&](f32x16& p0, f32x16& p1, f32x16& o0, f32x16& o1, float& m, float& l, bool first, bf16x8 (&pf)[4]) {
        asm volatile("s_nop 15\n\ts_nop 7" : "+v"(p0), "+v"(p1));
        float ra = max3f(p0[0], p0[1], p1[0]), rb = max3f(p0[2], p0[3], p1[1]); ra = max3f(ra, p1[2], p1[3]);
#pragma unroll
        for (int r = 4; r < 16; r += 4) { ra = max3f(ra, p0[r], p0[r + 1]); rb = max3f(rb, p0[r + 2], p0[r + 3]); ra = max3f(ra, p1[r], p1[r + 1]); rb = max3f(rb, p1[r + 2], p1[r + 3]); }
        float rm = max2f(ra, rb);
        { auto rr = __builtin_amdgcn_permlane32_swap(__float_as_uint(rm), __float_as_uint(rm), false, false); rm = max2f(__uint_as_float(rr[0]), __uint_as_float(rr[1])); }
        if (first) m = rm;
        else if (__any(rm - m > THR)) { const float mn = fmaxf(m, rm); const float f = __builtin_amdgcn_exp2f(m - mn); m = mn; l *= f;
#pragma unroll
            for (int r = 0; r < 16; ++r) { o0[r] *= f; o1[r] *= f; } }
        float ls = 0.f;
#pragma unroll
        for (int r = 0; r < 16; ++r) { p0[r] = __builtin_amdgcn_exp2f(p0[r] - m); p1[r] = __builtin_amdgcn_exp2f(p1[r] - m); ls += p0[r] + p1[r]; }
        l += ls;
        u32x4 w;
        w.x = pk2(p0[0], p0[1]); w.y = pk2(p0[2], p0[3]); w.z = pk2(p0[4], p0[5]); w.w = pk2(p0[6], p0[7]); pf[0] = __builtin_bit_cast(bf16x8, w);
        w.x = pk2(p0[8], p0[9]); w.y = pk2(p0[10], p0[11]); w.z = pk2(p0[12], p0[13]); w.w = pk2(p0[14], p0[15]); pf[1] = __builtin_bit_cast(bf16x8, w);
        w.x = pk2(p1[0], p1[1]); w.y = pk2(p1[2], p1[3]); w.z = pk2(p1[4], p1[5]); w.w = pk2(p1[6], p1[7]); pf[2] = __builtin_bit_cast(bf16x8, w);
        w.x = pk2(p1[8], p1[9]); w.y = pk2(p1[10], p1[11]); w.z = pk2(p1[12], p1[13]); w.w = pk2(p1[14], p1[15]); pf[3] = __builtin_bit_cast(bf16x8, w);
    };
    bf16x8 pfA[4], pfB[4];
    auto PV = [&](int boff) {
        const LAS unsigned char* Bb = lds + boff;
        s16x4 va0[4], va1[4], vc0[4], vc1[4];
#pragma unroll
        for (int kk = 0; kk < 4; ++kk) {
            const LAS unsigned char* vb = Bb + kk * 2048;
            va0[kk] = __builtin_bit_cast(s16x4, __builtin_amdgcn_ds_read_tr16_b64_v4i16((LAS s16x4*)(vb + voff0)));
            va1[kk] = __builtin_bit_cast(s16x4, __builtin_amdgcn_ds_read_tr16_b64_v4i16((LAS s16x4*)(vb + voff0 + 1024)));
            vc0[kk] = __builtin_bit_cast(s16x4, __builtin_amdgcn_ds_read_tr16_b64_v4i16((LAS s16x4*)(vb + voff1)));
            vc1[kk] = __builtin_bit_cast(s16x4, __builtin_amdgcn_ds_read_tr16_b64_v4i16((LAS s16x4*)(vb + voff1 + 1024)));
        }
#pragma unroll
        for (int kk = 0; kk < 4; ++kk) {
            const bf16x8 va = (bf16x8){va0[kk][0], va0[kk][1], va0[kk][2], va0[kk][3], va1[kk][0], va1[kk][1], va1[kk][2], va1[kk][3]};
            const bf16x8 vc = (bf16x8){vc0[kk][0], vc0[kk][1], vc0[kk][2], vc0[kk][3], vc1[kk][0], vc1[kk][1], vc1[kk][2], vc1[kk][3]};
            oA0 = __builtin_amdgcn_mfma_f32_32x32x16_bf16(va, pfA[kk], oA0, 0, 0, 0); oA1 = __builtin_amdgcn_mfma_f32_32x32x16_bf16(vc, pfA[kk], oA1, 0, 0, 0);
            oB0 = __builtin_amdgcn_mfma_f32_32x32x16_bf16(va, pfB[kk], oB0, 0, 0, 0); oB1 = __builtin_amdgcn_mfma_f32_32x32x16_bf16(vc, pfB[kk], oB1, 0, 0, 0);
        }
        __builtin_amdgcn_sched_group_barrier(0x100, 16, 0);
        __builtin_amdgcn_sched_group_barrier(0x008, 16, 0);
    };
#define ATT_WAIT_BAR(N) do { asm volatile("s_waitcnt vmcnt(" #N ") lgkmcnt(0)" ::: "memory"); __builtin_amdgcn_s_barrier(); asm volatile("" ::: "memory"); } while (0)
    constexpr int RING = 6, DIST = RING - 1;
    auto wait_bar = [&](int ntiles) {
        if (DQ == 96 && !upper) { switch (ntiles) { case 4: ATT_WAIT_BAR(12); break; case 3: ATT_WAIT_BAR(9); break; case 2: ATT_WAIT_BAR(6); break; case 1: ATT_WAIT_BAR(3); break; default: ATT_WAIT_BAR(0); } }
        else { switch (ntiles) { case 4: ATT_WAIT_BAR(8); break; case 3: ATT_WAIT_BAR(6); break; case 2: ATT_WAIT_BAR(4); break; case 1: ATT_WAIT_BAR(2); break; default: ATT_WAIT_BAR(0); } } };
    if (upper) __builtin_amdgcn_s_setprio(1);
    int issued = 0;
    for (; issued < DIST && issued < nt; ++issued) dma(issued, issued * BUFB);
    wait_bar(issued - 1);
    int b_cur = 0, b_iss = (DIST % RING) * BUFB;
    for (int t = 0; t < nt; ++t) {
        if (issued < nt) { dma(issued, b_iss); ++issued; b_iss += BUFB; if (b_iss == RING * BUFB) b_iss = 0; }
        QK(b_cur);
        SM(pA0, pA1, oA0, oA1, mA, lA, t == 0, pfA);
        SM(pB0, pB1, oB0, oB1, mB, lB, t == 0, pfB);
        PV(b_cur);
        { const int infl = issued - t - 2; wait_bar(infl < 0 ? 0 : infl); }
        b_cur += BUFB; if (b_cur == RING * BUFB) b_cur = 0;
    }
#undef ATT_WAIT_BAR
    if (upper) __builtin_amdgcn_s_setprio(0);
    { auto rr = __builtin_amdgcn_permlane32_swap(__float_as_uint(lA), __float_as_uint(lA), false, false); lA = __uint_as_float(rr[0]) + __uint_as_float(rr[1]); }
    { auto rr = __builtin_amdgcn_permlane32_swap(__float_as_uint(lB), __float_as_uint(lB), false, false); lB = __uint_as_float(rr[0]) + __uint_as_float(rr[1]); }
    const float invA = 1.f / lA, invB = 1.f / lB; bf16_t* oB = a.optr + (size_t)32 * 1024;
#pragma unroll
    for (int ig = 0; ig < 4; ++ig) {
        u32x2 w0, w1;
        w0.x = pk2(oA0[4 * ig] * invA, oA0[4 * ig + 1] * invA); w0.y = pk2(oA0[4 * ig + 2] * invA, oA0[4 * ig + 3] * invA);
        w1.x = pk2(oA1[4 * ig] * invA, oA1[4 * ig + 1] * invA); w1.y = pk2(oA1[4 * ig + 2] * invA, oA1[4 * ig + 3] * invA);
        *(u32x2*)(a.optr + 8 * ig + 4 * hi) = w0; *(u32x2*)(a.optr + 32 + 8 * ig + 4 * hi) = w1;
        w0.x = pk2(oB0[4 * ig] * invB, oB0[4 * ig + 1] * invB); w0.y = pk2(oB0[4 * ig + 2] * invB, oB0[4 * ig + 3] * invB);
        w1.x = pk2(oB1[4 * ig] * invB, oB1[4 * ig + 1] * invB); w1.y = pk2(oB1[4 * ig + 2] * invB, oB1[4 * ig + 3] * invB);
        *(u32x2*)(oB + 8 * ig + 4 * hi) = w0; *(u32x2*)(oB + 32 + 8 * ig + 4 * hi) = w1;
    }
}

struct Job { const float* src; bf16_t* dst; int K, N, ldd, nb; size_t sbs, dbs; int mode; const float* rscale; };

__device__ __forceinline__ int hperm64(int c) { const int base = c & ~63, cl = c & 63, p = cl >> 1, n = cl & 1, g = p >> 4, i = p & 15; return base + 32 * g + 16 * n + i; }
__device__ __forceinline__ int rowmap(int mode, int c) {
    switch (mode) {
        case 1: return c < 640 ? hperm64(c) : c;
        case 2: if ((c >= 384 && c < 896) || (c >= 1184 && c < 1312)) { const int b0 = (c >= 1184) ? 1184 : 384; return b0 + hperm64(c - b0); }
                if (c >= 1152 && c < 1184) { const int cl = c - 1152; return 1152 + 16 * (cl & 1) + (cl >> 1); }
                return c;
        case 3: { const int h = c / 96, cl = c % 96; if (cl < 64) return c; const int r = cl - 64; return h * 96 + 64 + 16 * (r & 1) + (r >> 1); }
        case 4: return 32 * (c >> 4) + (c & 15);
        case 5: return 32 * (c >> 4) + 16 + (c & 15);
        default: return c;
    }
}
__device__ __forceinline__ float colscale(int mode, int c) {
    if (mode == 1) return (c < 512 || (c >= 768 && c < 1280)) ? QS64 : 1.f;
    if (mode == 3) return QS96;
    return 1.f;
}
__device__ __forceinline__ bool get_job(PP P, int j, Job& J) {
    const int layer = j >= 9 ? 1 : 0, jj = layer ? j - 9 : j; const int ib = layer ? 20 : 4;
    bf16_t* W = (bf16_t*)(P->ws + (layer ? WS_W1 : WS_W0));
    J.nb = 1; J.sbs = 0; J.dbs = 0; J.rscale = nullptr; J.mode = 0; J.ldd = 1024; J.K = 1024;
    switch (jj) {
        case 0: J.src = P->in[ib + 3]; J.dst = W + WO_IN; J.N = layer ? 1440 : 2304; J.mode = layer ? 2 : 1; break;
        case 1: J.src = P->in[layer ? 30 : 10]; J.dst = W + WO_OUT; J.N = 1024; break;
        case 2: J.src = P->in[layer ? 32 : 12]; J.dst = W + WO_RT; J.N = 64; J.mode = 7; break;
        case 3: J.src = P->in[layer ? 34 : 14]; J.dst = W + WO_GU; J.N = 256; J.nb = 64; J.sbs = (size_t)1024 * 256; J.dbs = (size_t)512 * 1024; J.mode = 4; break;
        case 4: J.src = P->in[layer ? 35 : 15]; J.dst = W + WO_GU; J.N = 256; J.nb = 64; J.sbs = (size_t)1024 * 256; J.dbs = (size_t)512 * 1024; J.mode = 5; break;
        case 5: J.src = P->in[layer ? 36 : 16]; J.dst = W + WO_D; J.K = 256; J.N = 1024; J.ldd = 256; J.nb = 64; J.sbs = (size_t)256 * 1024; J.dbs = (size_t)1024 * 256; break;
        case 6: J.src = P->in[layer ? 37 : 17]; J.dst = W + WO_GU + (size_t)64 * 512 * 1024; J.N = 256; J.mode = 4; break;
        case 7: J.src = P->in[layer ? 38 : 18]; J.dst = W + WO_GU + (size_t)64 * 512 * 1024; J.N = 256; J.mode = 5; break;
        case 8: J.src = P->in[layer ? 39 : 19]; J.dst = W + WO_D + (size_t)64 * 1024 * 256; J.K = 256; J.N = 1024; J.ldd = 256; break;
        case 9: J.src = P->in[25]; J.dst = W + WO_UQ; J.K = 384; J.N = 768; J.ldd = 384; J.mode = 3; J.rscale = P->in[24]; break;
        case 10: J.src = P->in[27]; J.dst = W + WO_UKV; J.K = 256; J.N = 1024; J.ldd = 256; J.mode = 6; J.rscale = P->in[26]; break;
        default: return false;
    }
    return true;
}
constexpr int NJOBS = 20;
__device__ __forceinline__ int job_tiles(const Job& J) { return J.nb * (J.K >> 6) * ((J.N + 255) >> 8); }

__device__ __forceinline__ void conv_tile(const Job& J, int tile, LAS float* T) {
    const int tid = ltid(); const int ntn = (J.N + 255) >> 8, ntk = J.K >> 6;
    const int b = tile / (ntn * ntk), r = tile % (ntn * ntk), tk = r / ntn, tn = r % ntn;
    const float* src = J.src + (size_t)b * J.sbs; bf16_t* dst = J.dst + (size_t)b * J.dbs; const int k0 = tk * 64, n0 = tn * 256;
    { const int n4 = (tid & 63) * 4; const bool ok = (n0 + n4) < J.N;
      f32x4 v[8];
#pragma unroll
      for (int j = 0; j < 8; ++j) { const int k = (tid >> 6) + 8 * j; v[j] = ok ? *(const f32x4*)(src + (size_t)(k0 + k) * J.N + n0 + n4) : (f32x4){0.f, 0.f, 0.f, 0.f}; }
      f32x4 cs; cs[0] = colscale(J.mode, n0 + n4); cs[1] = colscale(J.mode, n0 + n4 + 1); cs[2] = colscale(J.mode, n0 + n4 + 2); cs[3] = colscale(J.mode, n0 + n4 + 3);
#pragma unroll
      for (int j = 0; j < 8; ++j) { const int k = (tid >> 6) + 8 * j; f32x4 x = v[j] * cs; if (J.rscale) x = x * J.rscale[k0 + k]; *(LAS f32x4*)(T + k * 260 + n4) = x; } }
    __syncthreads();
    { const int nn = tid >> 1, kh = (tid & 1) * 32;
      if (n0 + nn < J.N) { const int drow = rowmap(J.mode, n0 + nn); bf16_t* dp = dst + (size_t)drow * J.ldd + k0 + kh;
#pragma unroll
          for (int q = 0; q < 4; ++q) { float v[8];
#pragma unroll
              for (int j = 0; j < 8; ++j) v[j] = T[(kh + 8 * q + j) * 260 + nn];
              u32x4 w; w.x = pk2(v[0], v[1]); w.y = pk2(v[2], v[3]); w.z = pk2(v[4], v[5]); w.w = pk2(v[6], v[7]);
              *(u32x4*)(dp + 8 * q) = w;
              if (J.mode == 7) { u32x4 w2;
                  w2.x = pk2(v[0] - bflo(w.x), v[1] - bfhi(w.x)); w2.y = pk2(v[2] - bflo(w.y), v[3] - bfhi(w.y));
                  w2.z = pk2(v[4] - bflo(w.z), v[5] - bfhi(w.z)); w2.w = pk2(v[6] - bflo(w.w), v[7] - bfhi(w.w));
                  *(u32x4*)(dp + (size_t)64 * 1024 + 8 * q) = w2; } } } }
    __syncthreads();
}

__device__ __forceinline__ void ada_item(PP P, int item, LAS float* S) {
    const int tid = ltid(); const int layer = item / 96, chunk = item % 96;
    for (int idx = tid; idx < 33 * 1024; idx += 512) { const int r = idx >> 10, k = idx & 1023; const float x = (r < 32) ? P->in[1][r * 1024 + k] : P->in[3][k]; S[idx] = x / (1.f + expf(-x)); }
    __syncthreads();
    const int col = chunk * 64 + (tid & 63), kg = tid >> 6;
    float acc[33];
#pragma unroll
    for (int r = 0; r < 33; ++r) acc[r] = 0.f;
    const float* W = P->in[layer ? 20 : 4] + col;
    for (int k = kg * 128; k < kg * 128 + 128; ++k) { const float w = W[(size_t)k * 6144];
#pragma unroll
        for (int r = 0; r < 33; ++r) acc[r] += S[r * 1024 + k] * w; }
    __syncthreads();
#pragma unroll
    for (int r = 0; r < 33; ++r) S[(kg * 33 + r) * 64 + (tid & 63)] = acc[r];
    __syncthreads();
    float* ada = (float*)(P->ws + WS_ADA) + (size_t)layer * 33 * 6144; const float* bias = P->in[layer ? 21 : 5];
    for (int idx = tid; idx < 33 * 64; idx += 512) { const int r = idx >> 6, cc = idx & 63; float s = 0.f;
#pragma unroll
        for (int g = 0; g < 8; ++g) s += S[(g * 33 + r) * 64 + cc];
        ada[(size_t)r * 6144 + chunk * 64 + cc] = s + bias[chunk * 64 + cc]; }
    __syncthreads();
}

__device__ __forceinline__ void phase_prologue(PP P, LAS unsigned char* lds, int c, int G) {
    const int tid = ltid();
    for (int it = c; it < 192; it += G) ada_item(P, it, (LAS float*)lds);
    { float* rp = (float*)(P->ws + WS_ROPE); float* cosh_ = rp; float* sinh_ = rp + 2048 * 32; float* cosr_ = rp + 2 * 2048 * 32; float* sinr_ = cosr_ + 2048 * 16;
      for (int idx = c * 512 + tid; idx < 2048 * 48; idx += G * 512) {
          if (idx < 2048 * 32) { const int t = idx >> 5, p = idx & 31; const float pos = (p < 16) ? (float)(t >> 6) : (float)(t & 63); const int i = p & 15;
              const float inv = powf(10000.0f, -(float)i / 16.0f); const float ang = pos * inv; cosh_[idx] = cosf(ang); sinh_[idx] = sinf(ang); }
          else { const int k = idx - 2048 * 32; const int t = k >> 4, p = k & 15; const float pos = (p < 8) ? (float)(t >> 6) : (float)(t & 63); const int i = p & 7;
              const float inv = powf(10000.0f, -(float)i / 8.0f); const float ang = pos * inv; cosr_[k] = cosf(ang); sinr_[k] = sinf(ang); } } }
    { u32x4* z = (u32x4*)((bf16_t*)(P->ws + WS_W1) + WO_IN + (size_t)1440 * 1024); for (int idx = c * 512 + tid; idx < 96 * 1024 / 8; idx += G * 512) z[idx] = (u32x4){0u, 0u, 0u, 0u}; }
    { int base = 0; int tile = c;
      for (int j = 0; j < NJOBS; ++j) { Job J; get_job(P, j, J); const int n = job_tiles(J);
          while (tile < base + n) { conv_tile(J, tile - base, (LAS float*)lds); tile += G; }
          base += n; } }
}

__device__ __forceinline__ void phase_norm(PP P, int c, int G, const float* xlat, const float* xctx, const float* g, const float* ada  , int sh_off, int sc_off, bool latent_only, bf16_t* H, bf16_t* HLO,
                                           const bool resid = false, float* xlat_dst = nullptr, float* xctx_dst = nullptr) {
    const int tid_ = ltid(); const int lane = tid_ & 63, wv = c * 8 + (tid_ >> 6), nw = G * 8;
    for (int row = wv; row < MROWS; row += nw) {
        const int b = row / TOK, t = row % TOK; const bool ctx = t < CTX;
        if (ctx && latent_only) continue;
        const float* x = ctx ? xctx + ((size_t)b * CTX + t) * 1024 : xlat + ((size_t)b * SEQ + t - CTX) * 1024;
        const float* ap = ada + (size_t)(ctx ? 32 : b) * 6144;
        f32x4 v[4]; float ss = 0.f;
#pragma unroll
        for (int i = 0; i < 2; ++i) { v[2 * i] = *(const f32x4*)(x + 512 * i + 8 * lane); v[2 * i + 1] = *(const f32x4*)(x + 512 * i + 8 * lane + 4); }
        if (resid) {
            float* xd = ctx ? xctx_dst + ((size_t)b * CTX + t) * 1024 : xlat_dst + ((size_t)b * SEQ + t - CTX) * 1024;
#pragma unroll
            for (int i = 0; i < 2; ++i) { const u32x4 yw = *(const u32x4*)(HLO + (size_t)row * 1024 + 512 * i + 8 * lane);
                const f32x4 g0 = *(const f32x4*)(ap + 2048 + 512 * i + 8 * lane), g1 = *(const f32x4*)(ap + 2048 + 512 * i + 8 * lane + 4);
                v[2 * i][0] += g0[0] * bflo(yw.x); v[2 * i][1] += g0[1] * bfhi(yw.x); v[2 * i][2] += g0[2] * bflo(yw.y); v[2 * i][3] += g0[3] * bfhi(yw.y);
                v[2 * i + 1][0] += g1[0] * bflo(yw.z); v[2 * i + 1][1] += g1[1] * bfhi(yw.z); v[2 * i + 1][2] += g1[2] * bflo(yw.w); v[2 * i + 1][3] += g1[3] * bfhi(yw.w);
                *(f32x4*)(xd + 512 * i + 8 * lane) = v[2 * i]; *(f32x4*)(xd + 512 * i + 8 * lane + 4) = v[2 * i + 1]; }
        }
#pragma unroll
        for (int i = 0; i < 4; ++i) ss += v[i][0] * v[i][0] + v[i][1] * v[i][1] + v[i][2] * v[i][2] + v[i][3] * v[i][3];
        ss = wave_sum(ss); const float rstd = rsqrtf(ss * (1.f / 1024.f) + EPS);
#pragma unroll
        for (int i = 0; i < 2; ++i) { const int col = 512 * i + 8 * lane; float o[8];
#pragma unroll
            for (int h = 0; h < 2; ++h) { const f32x4 gg = *(const f32x4*)(g + col + 4 * h), sc = *(const f32x4*)(ap + sc_off + col + 4 * h), sh = *(const f32x4*)(ap + sh_off + col + 4 * h);
#pragma unroll
                for (int j = 0; j < 4; ++j) o[4 * h + j] = v[2 * i + h][j] * rstd * gg[j] * (1.f + sc[j]) + sh[j]; }
            u32x4 w; w.x = pk2(o[0], o[1]); w.y = pk2(o[2], o[3]); w.z = pk2(o[4], o[5]); w.w = pk2(o[6], o[7]);
            *(u32x4*)(H + (size_t)row * 1024 + col) = w;
            if (HLO) { u32x4 w2; w2.x = pk2(o[0] - bflo(w.x), o[1] - bfhi(w.x)); w2.y = pk2(o[2] - bflo(w.y), o[3] - bfhi(w.y)); w2.z = pk2(o[4] - bflo(w.z), o[5] - bfhi(w.z)); w2.w = pk2(o[6] - bflo(w.w), o[7] - bfhi(w.w));
                *(u32x4*)(HLO + (size_t)row * 1024 + col) = w2; } }
    }
}

__device__ __forceinline__ void phase_post1(PP P, int c, int G) {
    const int tid_ = ltid(); const int lane = tid_ & 63, wv = c * 8 + (tid_ >> 6), nw = G * 8;
    bf16_t* Pb = (bf16_t*)(P->ws + WS_BIG + BIG_P); float* RS = (float*)(P->ws + WS_RSTD);
    const float* rp = (const float*)(P->ws + WS_ROPE); const float* cosh_ = rp; const float* sinh_ = rp + 2048 * 32; const float* cosr_ = rp + 2 * 2048 * 32; const float* sinr_ = cosr_ + 2048 * 16;
    const float* gqn = P->in[28]; const float* gkn = P->in[29];
    for (int row = wv; row < MROWS; row += nw) {
        bf16_t* pr = Pb + (size_t)row * 1536; const int t = row % TOK; const bool lat = t >= CTX; const int tt = t - CTX;
        float s1 = 0.f, s2 = 0.f;
        if (lane < 48) { const u32x4 w = *(const u32x4*)(pr + 8 * lane); const float a0 = bflo(w.x), a1 = bfhi(w.x), a2 = bflo(w.y), a3 = bfhi(w.y), a4 = bflo(w.z), a5 = bfhi(w.z), a6 = bflo(w.w), a7 = bfhi(w.w);
            s1 = a0 * a0 + a1 * a1 + a2 * a2 + a3 * a3 + a4 * a4 + a5 * a5 + a6 * a6 + a7 * a7; }
        if (lane < 32) { const u32x4 w = *(const u32x4*)(pr + 896 + 8 * lane); const float a0 = bflo(w.x), a1 = bfhi(w.x), a2 = bflo(w.y), a3 = bfhi(w.y), a4 = bflo(w.z), a5 = bfhi(w.z), a6 = bflo(w.w), a7 = bfhi(w.w);
            s2 = a0 * a0 + a1 * a1 + a2 * a2 + a3 * a3 + a4 * a4 + a5 * a5 + a6 * a6 + a7 * a7; }
        s1 = wave_sum(s1); s2 = wave_sum(s2);
        if (lane == 0) { RS[(size_t)row * 2] = rsqrtf(s1 * (1.f / 384.f) + EPS); RS[(size_t)row * 2 + 1] = rsqrtf(s2 * (1.f / 256.f) + EPS); }
#pragma unroll
        for (int ps = 0; ps < 2; ++ps) {
            const int Gi = lane >> 2, qd = lane & 3; const bool on = (ps == 0) || (lane < 16);
            bf16_t* base = pr + (ps == 0 ? 384 : 1184) + 32 * Gi + 4 * qd;
            float x0[4] = {0.f, 0.f, 0.f, 0.f}, x1[4] = {0.f, 0.f, 0.f, 0.f};
            if (on) { const u32x2 w0 = *(const u32x2*)base, w1 = *(const u32x2*)(base + 16);
                x0[0] = bflo(w0.x); x0[1] = bfhi(w0.x); x0[2] = bflo(w0.y); x0[3] = bfhi(w0.y); x1[0] = bflo(w1.x); x1[1] = bfhi(w1.x); x1[2] = bflo(w1.y); x1[3] = bfhi(w1.y); }
            float ss = 0.f;
#pragma unroll
            for (int j = 0; j < 4; ++j) ss += x0[j] * x0[j] + x1[j] * x1[j];
            ss += __shfl_xor(ss, 1); ss += __shfl_xor(ss, 2); ss += __shfl_xor(ss, 4);
            const float rstd = rsqrtf(ss * (1.f / 64.f) + EPS);
            const int gsel = Gi & 1; const float* gn = ps == 0 ? gqn : gkn; const float qs = ps == 0 ? QS64 : 1.f;
            if (on) { float y0[4], y1[4];
#pragma unroll
                for (int j = 0; j < 4; ++j) { const int pidx = 16 * gsel + 4 * qd + j; y0[j] = x0[j] * rstd * gn[2 * pidx]; y1[j] = x1[j] * rstd * gn[2 * pidx + 1];
                    if (lat) { const float cs = cosh_[(size_t)tt * 32 + pidx], sn = sinh_[(size_t)tt * 32 + pidx]; const float a = y0[j] * cs - y1[j] * sn, bb = y0[j] * sn + y1[j] * cs; y0[j] = a; y1[j] = bb; }
                    y0[j] *= qs; y1[j] *= qs; }
                u32x2 w0, w1; w0.x = pk2(y0[0], y0[1]); w0.y = pk2(y0[2], y0[3]); w1.x = pk2(y1[0], y1[1]); w1.y = pk2(y1[2], y1[3]);
                *(u32x2*)base = w0; *(u32x2*)(base + 16) = w1; }
        }
        if (lat && lane < 4) { bf16_t* base = pr + 1152 + 4 * lane; const u32x2 w0 = *(const u32x2*)base, w1 = *(const u32x2*)(base + 16);
            float x0[4] = {bflo(w0.x), bfhi(w0.x), bflo(w0.y), bfhi(w0.y)}, x1[4] = {bflo(w1.x), bfhi(w1.x), bflo(w1.y), bfhi(w1.y)}; float y0[4], y1[4];
#pragma unroll
            for (int j = 0; j < 4; ++j) { const int pidx = 4 * lane + j; const float cs = cosr_[(size_t)tt * 16 + pidx], sn = sinr_[(size_t)tt * 16 + pidx]; y0[j] = x0[j] * cs - x1[j] * sn; y1[j] = x0[j] * sn + x1[j] * cs; }
            u32x2 o0, o1; o0.x = pk2(y0[0], y0[1]); o0.y = pk2(y0[2], y0[3]); o1.x = pk2(y1[0], y1[1]); o1.y = pk2(y1[2], y1[3]);
            *(u32x2*)base = o0; *(u32x2*)(base + 16) = o1; }
    }
}

__device__ __forceinline__ void phase_router(PP P, LAS unsigned char* lds, int c, int G, int layer) {
    const int tid = ltid(), lane = tid & 63, wid = tid >> 6, r32 = lane & 31, hi = lane >> 5;
    const bf16_t* H = (const bf16_t*)(P->ws + WS_H); const bf16_t* HLO = (const bf16_t*)(P->ws + WS_BIG + BIG_HLO);
    const bf16_t* W = (const bf16_t*)(P->ws + (layer ? WS_W1 : WS_W0)) + WO_RT; const bf16_t* WL = W + 64 * 1024;
    const float* brt = P->in[layer ? 33 : 13];
    int* cnt = (int*)(P->ws + WS_CTL + CTL_CNT) + layer * NG; int* srow = (int*)(P->ws + WS_SROW); float* sw = (float*)(P->ws + WS_SW); int* tslot = (int*)(P->ws + WS_TSLOT);
    LAS float* L = (LAS float*)lds + wid * (32 * 65);
    const int ngroups = MROWS / 32;
    for (int gidx = c * 8 + wid; gidx < ngroups; gidx += G * 8) {
        const int row0 = gidx * 32; const int t0 = row0 % TOK;
        if (layer == 1 && t0 < CTX) continue;
        f32x16 a0, a1;
#pragma unroll
        for (int r = 0; r < 16; ++r) { a0[r] = 0.f; a1[r] = 0.f; }
        const bf16_t* hp = H + (size_t)(row0 + r32) * 1024 + 8 * hi; const bf16_t* hl = HLO + (size_t)(row0 + r32) * 1024 + 8 * hi;
        const bf16_t* w0 = W + (size_t)r32 * 1024 + 8 * hi; const bf16_t* wl0 = WL + (size_t)r32 * 1024 + 8 * hi;
#pragma unroll 4
        for (int s = 0; s < 64; ++s) {
            const bf16x8 xh = *(const bf16x8*)(hp + 16 * s), xl = *(const bf16x8*)(hl + 16 * s);
            const bf16x8 wa = *(const bf16x8*)(w0 + 16 * s), wb = *(const bf16x8*)(w0 + 32 * 1024 + 16 * s);
            const bf16x8 la = *(const bf16x8*)(wl0 + 16 * s), lb = *(const bf16x8*)(wl0 + 32 * 1024 + 16 * s);
            a0 = __builtin_amdgcn_mfma_f32_32x32x16_bf16(wa, xh, a0, 0, 0, 0); a1 = __builtin_amdgcn_mfma_f32_32x32x16_bf16(wb, xh, a1, 0, 0, 0);
            a0 = __builtin_amdgcn_mfma_f32_32x32x16_bf16(wa, xl, a0, 0, 0, 0); a1 = __builtin_amdgcn_mfma_f32_32x32x16_bf16(wb, xl, a1, 0, 0, 0);
            a0 = __builtin_amdgcn_mfma_f32_32x32x16_bf16(la, xh, a0, 0, 0, 0); a1 = __builtin_amdgcn_mfma_f32_32x32x16_bf16(lb, xh, a1, 0, 0, 0);
        }
#pragma unroll
        for (int r = 0; r < 16; ++r) { const int e = (r & 3) + 8 * (r >> 2) + 4 * hi; L[r32 * 65 + e] = a0[r]; L[r32 * 65 + e + 32] = a1[r]; }
        __builtin_amdgcn_s_waitcnt(0xC07F);
        __builtin_amdgcn_wave_barrier();
        if (lane < 32) {
            const int row = row0 + lane; float bk[6], bs[6]; int bi[6];
#pragma unroll
            for (int k = 0; k < 6; ++k) { bk[k] = -1e30f; bs[k] = 0.f; bi[k] = 0; }
            for (int e = 0; e < 64; ++e) { const float x = L[lane * 65 + e]; const float sc = 1.f / (1.f + expf(-x)); float key = sc + brt[e]; float s = sc; int id = e;
#pragma unroll
                for (int k = 0; k < 6; ++k) { if (key > bk[k]) { const float tk = bk[k], ts = bs[k]; const int ti = bi[k]; bk[k] = key; bs[k] = s; bi[k] = id; key = tk; s = ts; id = ti; } } }
            float tot = 0.f;
#pragma unroll
            for (int k = 0; k < 6; ++k) tot += bs[k];
            const float sc = 2.5f / tot; const int ch = row / CHUNK_ROWS;
#pragma unroll
            for (int k = 0; k < 6; ++k) { const int e = bi[k]; const int pos = atomicAdd(cnt + ch * NGRP + e, 1);
                if (pos < CAP) { srow[(size_t)(ch * 64 + e) * CAP + pos] = row; sw[(size_t)(ch * 64 + e) * CAP + pos] = bs[k] * sc; }
                tslot[(size_t)row * 6 + k] = (e << 20) | pos; }
        }
        __builtin_amdgcn_wave_barrier();
    }
    if (c == 0 && tid < NCHUNK) cnt[tid * NGRP + NEXP] = layer ? CHUNK_B * SEQ : CHUNK_ROWS;
}

__device__ __forceinline__ void build_toff(LAS int* toff, const int* cnt) {
    const int tid = ltid();
    if (tid < 64) { int v[5], s = 0;
#pragma unroll
        for (int j = 0; j < 5; ++j) { const int g = tid * 5 + j; const int cv = (g < NG) ? ld_ctl(cnt + g) : 0; if (g < NG) toff[272 + g] = cv; v[j] = (cv + 255) >> 8; s += v[j]; }
        int inc = s;
#pragma unroll
        for (int o = 1; o < 64; o <<= 1) { const int t = __shfl_up(inc, o); if (tid >= o) inc += t; }
        int ex = inc - s;
#pragma unroll
        for (int j = 0; j < 5; ++j) { const int g = tid * 5 + j; if (g <= NG) toff[g] = ex; ex += v[j]; } }
    __syncthreads();
}

__device__ __forceinline__ void phase_combine(PP P, LAS unsigned char* lds, int c, int G, int layer, int ch) {
    const int tid_ = ltid(); const int lane = tid_ & 63, wv = c * 8 + (tid_ >> 6), nw = G * 8;
    LAS const int* toff = (LAS const int*)(lds + LDS_TAB);
    const bf16_t* slab = (const bf16_t*)(P->ws + WS_BIG + BIG_SLAB); const int* tslot = (const int*)(P->ws + WS_TSLOT);
    const float* ada = (const float*)(P->ws + WS_ADA) + (size_t)layer * 33 * 6144; const float* ada1 = (const float*)(P->ws + WS_ADA) + (size_t)33 * 6144;
    float* xc = (float*)(P->ws + WS_XC); bf16_t* H = (bf16_t*)(P->ws + WS_H);
    const int t0 = toff[ch * NGRP];
    for (int rr = wv; rr < CHUNK_ROWS; rr += nw) {
        const int row = ch * CHUNK_ROWS + rr; const int b = row / TOK, t = row % TOK; const bool ctx = t < CTX;
        if (ctx && layer == 1) continue;
        int sidx = 0;
        if (lane < 6) { const int v = __hip_atomic_load(tslot + (size_t)row * 6 + lane, __ATOMIC_RELAXED, __HIP_MEMORY_SCOPE_AGENT); sidx = (toff[ch * NGRP + (v >> 20)] - t0) * 256 + (v & 0xfffff); }
        if (lane == 6) { const int rank = layer ? ((b - ch * CHUNK_B) * SEQ + t - CTX) : rr; sidx = (toff[ch * NGRP + NEXP] - t0) * 256 + rank; }
        float* x = ctx ? xc + ((size_t)b * CTX + t) * 1024 : P->out + ((size_t)b * SEQ + t - CTX) * 1024;
        const float* ap = ada + (size_t)(ctx ? 32 : b) * 6144 + 5 * 1024;
        f32x4 xv[4];
#pragma unroll
        for (int i = 0; i < 4; ++i) xv[i] = *(const f32x4*)(x + 512 * (i >> 1) + 8 * lane + 4 * (i & 1));
        float acc[16];
#pragma unroll
        for (int j = 0; j < 16; ++j) acc[j] = 0.f;
#pragma unroll
        for (int k = 0; k < 7; ++k) { const int s = __shfl(sidx, k); const bf16_t* sp = slab + (size_t)s * 1024;
#pragma unroll
            for (int i = 0; i < 2; ++i) { const u32x4 w = __builtin_nontemporal_load((const u32x4*)(sp + 512 * i + 8 * lane));
                acc[8 * i + 0] += bflo(w.x); acc[8 * i + 1] += bfhi(w.x); acc[8 * i + 2] += bflo(w.y); acc[8 * i + 3] += bfhi(w.y);
                acc[8 * i + 4] += bflo(w.z); acc[8 * i + 5] += bfhi(w.z); acc[8 * i + 6] += bflo(w.w); acc[8 * i + 7] += bfhi(w.w); } }
        float v[16]; float ss = 0.f;
#pragma unroll
        for (int i = 0; i < 4; ++i) { const f32x4 gq = *(const f32x4*)(ap + 512 * (i >> 1) + 8 * lane + 4 * (i & 1));
#pragma unroll
            for (int j = 0; j < 4; ++j) { const float y = xv[i][j] + gq[j] * acc[4 * i + j]; v[4 * i + j] = y; ss += y * y; } }
        ss = wave_sum(ss); const float rstd = rsqrtf(ss * (1.f / 1024.f) + EPS);
        if (layer == 0) {
            const float* gm1 = P->in[22]; const float* a1 = ada1 + (size_t)(ctx ? 32 : b) * 6144; float o[16];
#pragma unroll
            for (int i = 0; i < 4; ++i) { const int col = 512 * (i >> 1) + 8 * lane + 4 * (i & 1);
                *(f32x4*)(x + col) = (f32x4){v[4 * i], v[4 * i + 1], v[4 * i + 2], v[4 * i + 3]};
                const f32x4 gg = *(const f32x4*)(gm1 + col), sc = *(const f32x4*)(a1 + 1024 + col), sh = *(const f32x4*)(a1 + col);
#pragma unroll
                for (int j = 0; j < 4; ++j) o[4 * i + j] = v[4 * i + j] * rstd * gg[j] * (1.f + sc[j]) + sh[j]; }
#pragma unroll
            for (int i = 0; i < 2; ++i) { u32x4 w; w.x = pk2(o[8 * i], o[8 * i + 1]); w.y = pk2(o[8 * i + 2], o[8 * i + 3]); w.z = pk2(o[8 * i + 4], o[8 * i + 5]); w.w = pk2(o[8 * i + 6], o[8 * i + 7]);
                *(u32x4*)(H + (size_t)row * 1024 + 512 * i + 8 * lane) = w; }
        } else {
            const float* gf = P->in[40];
#pragma unroll
            for (int i = 0; i < 4; ++i) { const int col = 512 * (i >> 1) + 8 * lane + 4 * (i & 1); const f32x4 gg = *(const f32x4*)(gf + col); f32x4 o;
#pragma unroll
                for (int j = 0; j < 4; ++j) o[j] = v[4 * i + j] * rstd * gg[j];
                *(f32x4*)(x + col) = o; }
        }
    }
}

__device__ __forceinline__ int remap64(int c, int i, int G) { return c + i * G; }
__device__ __forceinline__ int remap8(int c, int G) { return c; }
__device__ __forceinline__ void phase_attn0(PP P, LAS unsigned char* lds, int c, int G) {
    const int tid = ltid(), lane = tid & 63, wid = __builtin_amdgcn_readfirstlane(tid >> 6), r32 = lane & 31;
    const bf16_t* QKV = (const bf16_t*)(P->ws + WS_BIG + BIG_QKV); bf16_t* ATT = (bf16_t*)(P->ws + WS_H);
    const float* sink = P->in[8]; const float* rpb = P->in[9];
    for (int i = 0; c + i * G < 2048; ++i) {
        const int u = remap64(c, i, G); const int b = u >> 6, kvh = (u >> 5) & 1, blk = u & 31; const int g = wid & 3, ts = wid >> 2; const int head = kvh * 4 + g;
        AU a; const int tok = blk * 64 + 32 * ts + r32; const size_t qrow = (size_t)b * TOK + CTX + tok;
        a.qptr = QKV + qrow * 2304 + head * 64; a.optr = ATT + qrow * 1024 + head * 64;
        a.kbase = QKV + 512 + kvh * 64; a.kpitch = 2304; a.vbase = QKV + 640 + kvh * 64; a.vpitch = 2304; a.k2base = nullptr; a.k2pitch = 0;
        a.row_ctx = b * TOK; a.row_lat = b * TOK + CTX; a.start = blk * 64;
        const int jlo = blk >= 2 ? 0 : 2 - blk; int jhi = (2048 + 128 - blk * 64) / 64; jhi = jhi > 5 ? 5 : jhi;
        a.j0 = jlo; a.nt = 4 + (jhi - jlo); a.qoff = 32 * ts + r32; a.m0 = sink[head] * LOG2E; a.l0 = 1.f;
        attn_unit<1, 64>(lds, a);
    }
    for (int i = 0; c + i * G < 2048; ++i) {
        const int u = remap64(c, i, G); const int b = u >> 6, head = (u >> 3) & 7, uu = u & 7;
        { LAS float* bt = (LAS float*)(lds + ATT_RPB);
          for (int idx = tid; idx < 15 * 128; idx += 512) { const int dr = idx >> 7, dc = (idx & 127) - 48; bt[idx] = (dc >= 0 && dc <= 30) ? rpb[(head * 15 + dr) * 31 + dc] * LOG2E : 0.f; } }
        AU a; const int qr = 4 * uu + (wid >> 1), qc = 32 * (wid & 1) + r32; const int tok = qr * 64 + qc; const size_t qrow = (size_t)b * TOK + CTX + tok;
        a.qptr = QKV + qrow * 2304 + 768 + head * 64; a.optr = ATT + qrow * 1024 + 512 + head * 64;
        a.kbase = QKV + 1280 + head * 64; a.kpitch = 2304; a.vbase = QKV + 1792 + head * 64; a.vpitch = 2304; a.k2base = nullptr; a.k2pitch = 0;
        a.row_ctx = b * TOK; a.row_lat = b * TOK + CTX; a.start = 0;
        int rs0 = 4 * uu - 4; rs0 = rs0 < 0 ? 0 : (rs0 > 24 ? 24 : rs0); int rl = 4 * uu - 1; rl = rl < 0 ? 0 : (rl > 24 ? 24 : rl);
        a.j0 = rs0; a.nt = 4 + (rl + 8 - rs0); a.qoff = tok; a.m0 = 0.f; a.l0 = 0.f;
        attn_unit<2, 64>(lds, a);
    }
    for (int u0 = c; u0 < 256; u0 += G) {
        const int u = remap8(u0, G); const int b = u >> 3, kvh = (u >> 2) & 1, cb = u & 3; const int g = wid & 3, ts = wid >> 2; const int head = kvh * 4 + g;
        AU a; const int tok = cb * 64 + 32 * ts + r32; const size_t qrow = (size_t)b * TOK + tok;
        a.qptr = QKV + qrow * 2304 + head * 64; a.optr = ATT + qrow * 1024 + head * 64;
        a.kbase = QKV + 512 + kvh * 64; a.kpitch = 2304; a.vbase = QKV + 640 + kvh * 64; a.vpitch = 2304; a.k2base = nullptr; a.k2pitch = 0;
        a.row_ctx = b * TOK; a.row_lat = 0; a.start = 0; a.j0 = 0; a.nt = 4; a.qoff = 0; a.m0 = sink[head] * LOG2E; a.l0 = 1.f;
        attn_unit<0, 64>(lds, a);
    }
    for (int u0 = c; u0 < 256; u0 += G) {
        const int u = remap8(u0, G); const int b = u >> 3, head = u & 7;
        AU a; const int tok = 32 * wid + r32; const size_t qrow = (size_t)b * TOK + tok;
        a.qptr = QKV + qrow * 2304 + 768 + head * 64; a.optr = ATT + qrow * 1024 + 512 + head * 64;
        a.kbase = QKV + 1280 + head * 64; a.kpitch = 2304; a.vbase = QKV + 1792 + head * 64; a.vpitch = 2304; a.k2base = nullptr; a.k2pitch = 0;
        a.row_ctx = b * TOK; a.row_lat = 0; a.start = 0; a.j0 = 0; a.nt = 4; a.qoff = 0; a.m0 = 0.f; a.l0 = 0.f;
        attn_unit<0, 64>(lds, a);
    }
}
__device__ __forceinline__ void phase_attn1(PP P, LAS unsigned char* lds, int c, int G) {
    const int tid = ltid(), lane = tid & 63, wid = __builtin_amdgcn_readfirstlane(tid >> 6), r32 = lane & 31;
    const bf16_t* PB = (const bf16_t*)(P->ws + WS_BIG + BIG_P); const bf16_t* QM = (const bf16_t*)(P->ws + WS_BIG + BIG_QM); const bf16_t* KVX = (const bf16_t*)(P->ws + WS_BIG + BIG_KVX);
    bf16_t* ATT = (bf16_t*)(P->ws + WS_H);
    for (int u = c; u < 1024; u += G) {
        const int b = u >> 5, head = (u >> 2) & 7, qb = u & 3;
        AU2 a; const int tok = qb * 512 + 64 * wid + r32; const size_t qrow = (size_t)b * TOK + CTX + tok;
        a.qptr = QM + qrow * 768 + head * 96; a.qpitch = 768; a.optr = ATT + qrow * 1024 + head * 64;
        a.kbase = KVX + head * 128; a.kpitch = 1024; a.vbase = KVX + head * 128 + 64; a.vpitch = 1024; a.k2base = PB + 1152; a.k2pitch = 1536;
        a.row_ctx = b * TOK; a.nt = 36;
        attn_unit2<96>(lds, a);
    }
    for (int u = c; u < 1024; u += G) {
        const int b = u >> 5, kvh = (u >> 4) & 1, blk = u & 15; const int g = wid & 3, hf = wid >> 2; const int head = kvh * 4 + g;
        AU2 a; const int tok = blk * 128 + 64 * hf + r32; const size_t qrow = (size_t)b * TOK + CTX + tok;
        a.qptr = PB + qrow * 1536 + 384 + head * 64; a.qpitch = 1536; a.optr = ATT + qrow * 1024 + 512 + head * 64;
        a.kbase = PB + 1184 + kvh * 64; a.kpitch = 1536; a.vbase = PB + 1312 + kvh * 64; a.vpitch = 1536; a.k2base = nullptr; a.k2pitch = 0;
        a.row_ctx = b * TOK; a.nt = 36;
        attn_unit2<64>(lds, a);
    }
}

constexpr int PH_MOE0 = 7, PH_L1 = PH_MOE0 + 1 + 2 * NCHUNK, PH_MOE1 = PH_L1 + 7, NPH = PH_MOE1 + 1 + 2 * NCHUNK;
template <int PH>
__device__ __forceinline__ void run_phase(LAS unsigned char* lds, int c, int G) {
    const PP P = get_pp();
    const float* rp = (const float*)(P->ws + WS_ROPE);
    const float* ada0 = (const float*)(P->ws + WS_ADA); const float* ada1 = ada0 + (size_t)33 * 6144;
    bf16_t* W0 = (bf16_t*)(P->ws + WS_W0); bf16_t* W1 = (bf16_t*)(P->ws + WS_W1);
    bf16_t* H = (bf16_t*)(P->ws + WS_H); char* BIG = P->ws + WS_BIG; float* XC = (float*)(P->ws + WS_XC);
    if constexpr (PH == 0) { phase_prologue(P, lds, c, G); }
    else if constexpr (PH == 1) { phase_norm(P, c, G, P->in[0], P->in[2], P->in[6], ada0, 0, 1024, false, H, nullptr); }
    else if constexpr (PH == 2) {
        gm::DenseSched S; S.init(0, 9, G, c); gm::Desc d{(const char*)H, 2048u, (const char*)(W0 + WO_IN), 2048u, 1024};
        gm::EpiQKV0 E{(bf16_t*)(BIG + BIG_QKV), rp, rp + 2048 * 32}; gm::gemm_phase(lds, d, S, E); }
    else if constexpr (PH == 3) { phase_attn0(P, lds, ONE_LAUNCH ? (int)*(volatile LAS int*)(lds + LDS_BARW + 8) : c, G); }
    else if constexpr (PH == 4) {
        gm::DenseSched S; S.init(0, 4, G, c); gm::Desc d{(const char*)H, 2048u, (const char*)(W0 + WO_OUT), 2048u, 1024};
        gm::EpiP1 E{(bf16_t*)(BIG + BIG_HLO), 1024, nullptr, 0}; gm::gemm_phase(lds, d, S, E); }
    else if constexpr (PH == 5) { phase_norm(P, c, G, P->in[0], P->in[2], P->in[11], ada0, 3072, 4096, false, H, (bf16_t*)(BIG + BIG_HLO), true, P->out, XC); }
    else if constexpr (PH == 6) { phase_router(P, lds, c, G, 0); }
    else if constexpr (PH == PH_L1) {
        gm::DenseSched S; S.init(0, 6, G, c); gm::Desc d{(const char*)H, 2048u, (const char*)(W1 + WO_IN), 2048u, 1024};
        gm::EpiP1 E{(bf16_t*)(BIG + BIG_P), 1536, nullptr, 0}; gm::gemm_phase(lds, d, S, E); }
    else if constexpr (PH == PH_L1 + 1) { phase_post1(P, c, G); }
    else if constexpr (PH == PH_L1 + 2) {
        { gm::DenseSched S; S.init(1, 3, G, c); gm::Desc d{(const char*)(BIG + BIG_P), 3072u, (const char*)(W1 + WO_UQ), 768u, 384};
          gm::EpiUQ E{(bf16_t*)(BIG + BIG_QM), (const float*)(P->ws + WS_RSTD), rp + 2 * 2048 * 32, rp + 2 * 2048 * 32 + 2048 * 16}; gm::gemm_phase(lds, d, S, E); }
        { gm::DenseSched S; S.init(0, 4, G, c); gm::Desc d{(const char*)(BIG + BIG_P) + 896 * 2, 3072u, (const char*)(W1 + WO_UKV), 512u, 256};
          gm::EpiP1 E{(bf16_t*)(BIG + BIG_KVX), 1024, (const float*)(P->ws + WS_RSTD), 1}; gm::gemm_phase(lds, d, S, E); } }
    else if constexpr (PH == PH_L1 + 3) { phase_attn1(P, lds, ONE_LAUNCH ? (int)*(volatile LAS int*)(lds + LDS_BARW + 8) : c, G); }
    else if constexpr (PH == PH_L1 + 4) {
        gm::DenseSched S; S.init(1, 4, G, c); gm::Desc d{(const char*)H, 2048u, (const char*)(W1 + WO_OUT), 2048u, 1024};
        gm::EpiP1 E{(bf16_t*)(BIG + BIG_HLO), 1024, nullptr, 0}; gm::gemm_phase(lds, d, S, E); }
    else if constexpr (PH == PH_L1 + 5) { phase_norm(P, c, G, P->out, XC, P->in[31], ada1, 3072, 4096, true, H, (bf16_t*)(BIG + BIG_HLO), true, P->out, XC); }
    else if constexpr (PH == PH_L1 + 6) { phase_router(P, lds, c, G, 1); }
    else {
        constexpr int layer = PH >= PH_MOE1 ? 1 : 0; constexpr int rel = PH - (layer ? PH_MOE1 : PH_MOE0);
        const int* cnt = (const int*)(P->ws + WS_CTL + CTL_CNT) + layer * NG;
        LAS int* toff = (LAS int*)(lds + LDS_TAB);
        bf16_t* W = layer ? W1 : W0;
        build_toff(toff, cnt);
        if constexpr (rel == 0) {
            gm::MoeSched<1> S; S.toff = toff; S.slot_row = (const int*)(P->ws + WS_SROW); S.t_lo = 0; S.t_hi = toff[NG]; S.nN = 2; S.G = G; S.c = c; S.bN = 512; S.layer = layer;
            gm::Desc d{(const char*)H, 2048u, (const char*)(W + WO_GU), 2048u, 1024};
            gm::EpiG1 E{(bf16_t*)(BIG + BIG_ACT), (const float*)(P->ws + WS_SW)}; gm::gemm_phase(lds, d, S, E);
        } else if constexpr ((rel & 1) == 1) {
            constexpr int ch = (rel - 1) >> 1;
            gm::MoeSched<2> S; S.toff = toff; S.slot_row = nullptr; S.t_lo = toff[ch * NGRP]; S.t_hi = toff[(ch + 1) * NGRP]; S.nN = 4; S.G = G; S.c = c; S.bN = 1024; S.layer = layer;
            gm::Desc d{(const char*)(BIG + BIG_ACT), 512u, (const char*)(W + WO_D), 512u, 256};
            gm::EpiG2 E{(bf16_t*)(BIG + BIG_SLAB), toff[ch * NGRP] * 256};
            gm::gemm_phase(lds, d, S, E);
        } else {
            constexpr int ch = (rel - 2) >> 1;
            phase_combine(P, lds, c, G, layer, ch);
        }
    }
}

template <int PH> struct PhaseLoop {
    static __device__ __forceinline__ void run(LAS unsigned char* lds, const XcdBarrier& bar) {
        run_phase<PH>(lds, (int)blockIdx.x, (int)gridDim.x);
        if constexpr (PH + 1 < NPH) { xcd_barrier(bar); PhaseLoop<PH + 1>::run(lds, bar); }
    }
};

extern __shared__ __attribute__((aligned(16))) unsigned char smem_raw[];

#if ONE_LAUNCH
__global__ void __launch_bounds__(512, 2) mega_fwd(Params Pk) {
    LAS unsigned char* lds = (LAS unsigned char*)smem_raw;
    volatile LAS unsigned* st = (volatile LAS unsigned*)(lds + LDS_BARW);
    if (threadIdx.x == 0) { st[0] = 0u; st[1] = 0u; st[2] = 0u; st[3] = 0u; }
    __syncthreads();
    XcdBarrier bar = xcd_barrier_post((unsigned*)(Pk.ws + WS_CTL), st);
    int* xr = (int*)(Pk.ws + WS_CTL + CTL_XRANK);
    int myrank = 0; if (threadIdx.x == 0) myrank = atomicAdd(xr + 64 * (int)bar.x, 1);
    run_phase<0>(lds, (int)blockIdx.x, (int)gridDim.x);
    xcd_barrier(bar);
    if (threadIdx.x == 0) { int base = 0; for (int j = 0; j < (int)bar.x; ++j) base += ld_ctl(xr + 64 * j); st[2] = (unsigned)(base + myrank); }
    __syncthreads();
    PhaseLoop<1>::run(lds, bar);
}
#else
template <int PH> __global__ void __launch_bounds__(512, 2) phase_kernel(Params Pk) {
    LAS unsigned char* lds = (LAS unsigned char*)smem_raw;
    run_phase<PH>(lds, (int)blockIdx.x, (int)gridDim.x);
}
template <int PH> struct PhaseLaunch {
    static void run(const Params& P, int grid, hipStream_t s) {
        (void)hipFuncSetAttribute((const void*)phase_kernel<PH>, hipFuncAttributeMaxDynamicSharedMemorySize, LDS_BYTES);
        hipLaunchKernelGGL(phase_kernel<PH>, dim3(grid), dim3(512), LDS_BYTES, s, P);
        if constexpr (PH + 1 < NPH) PhaseLaunch<PH + 1>::run(P, grid, s);
    }
};
#endif

extern "C" void kernel_launch(void* const* d_in, const int* in_sizes, int n_in, void* d_out, int out_size, void* d_ws, size_t ws_size, hipStream_t stream) {
    static int grid = 0;
    if (n_in != 41 || ws_size < WS_END) { fprintf(stderr, "kernel_launch: need 41 inputs and %zu bytes of workspace (got %d, %zu)\n", (size_t)WS_END, n_in, ws_size); return; }
    if (!grid) {
        int dev = 0, cus = 0;
        (void)hipGetDevice(&dev); (void)hipDeviceGetAttribute(&cus, hipDeviceAttributeMultiprocessorCount, dev);
#if ONE_LAUNCH
        (void)hipFuncSetAttribute((const void*)mega_fwd, hipFuncAttributeMaxDynamicSharedMemorySize, LDS_BYTES);
        int per_cu = 0; (void)hipOccupancyMaxActiveBlocksPerMultiprocessor(&per_cu, (const void*)mega_fwd, 512, LDS_BYTES);
        if (per_cu < 1) fprintf(stderr, "kernel_launch: occupancy query says %d blocks per CU\n", per_cu);
#endif
        grid = cus > 0 ? cus : 256;
    }
    Params P{};
    for (int i = 0; i < 41; ++i) P.in[i] = (const float*)d_in[i];
    P.out = (float*)d_out; P.ws = (char*)d_ws;
    (void)hipMemsetAsync((char*)d_ws + WS_CTL, 0, CTL_BYTES, stream);
#if ONE_LAUNCH
    hipLaunchKernelGGL(mega_fwd, dim3(grid), dim3(512), LDS_BYTES, stream, P);
#else
    PhaseLaunch<0>::run(P, grid, stream);
#endif
}
```

```cpp
#include <hip/hip_runtime.h>
#include <stdint.h>
#include <stdio.h>

#ifndef ONE_LAUNCH
#define ONE_LAUNCH 1
#endif

#define LAS __attribute__((address_space(3)))
typedef unsigned short bf16_t;
typedef short bf16x8 __attribute__((ext_vector_type(8)));
typedef short s16x4 __attribute__((ext_vector_type(4)));
typedef float f32x4 __attribute__((ext_vector_type(4)));
typedef float f32x16 __attribute__((ext_vector_type(16)));
typedef unsigned u32x4 __attribute__((ext_vector_type(4)));
typedef unsigned u32x2 __attribute__((ext_vector_type(2)));

constexpr int NB = 32, SEQ = 2048, DM = 1024, CTX = 256, TOK = CTX + SEQ, MROWS = NB * TOK;
constexpr int NEXP = 64, NGRP = 65, NCHUNK = 4, NG = NCHUNK * NGRP;
constexpr int CAP = MROWS / NCHUNK;
constexpr int CHUNK_ROWS = MROWS / NCHUNK;
constexpr int CHUNK_B = NB / NCHUNK;
constexpr float LOG2E = 1.4426950408889634f;
constexpr float QS64 = 0.125f * LOG2E;
constexpr float QS96 = 0.10206207261596575f * LOG2E;
constexpr float EPS = 1e-6f;

constexpr size_t MiB = 1048576;
constexpr size_t WS_CTL = 0;
constexpr size_t CTL_BYTES = 65536;
constexpr size_t CTL_CNT = 16384;
constexpr size_t CTL_XRANK = 24576;
constexpr size_t WS_ADA = 65536;
constexpr size_t WS_ROPE = WS_ADA + 2 * MiB;
constexpr size_t WO_IN = 0, WO_OUT = WO_IN + 2304 * 1024, WO_RT = WO_OUT + 1024 * 1024, WO_UQ = WO_RT + 2 * 64 * 1024, WO_UKV = WO_UQ + 768 * 384,
                 WO_GU = WO_UKV + 1024 * 256, WO_D = WO_GU + (size_t)65 * 512 * 1024, W_ELEMS = WO_D + (size_t)65 * 1024 * 256;
constexpr size_t W_BYTES = ((W_ELEMS * 2 + 255) / 256) * 256;
constexpr size_t WS_W0 = WS_ROPE + 1 * MiB;
constexpr size_t WS_W1 = WS_W0 + W_BYTES;
constexpr size_t WS_XC = WS_W1 + W_BYTES;
constexpr size_t WS_H = WS_XC + 32 * MiB;
constexpr size_t WS_RSTD = WS_H + 144 * MiB;
constexpr size_t WS_SROW = WS_RSTD + 1 * MiB;
constexpr size_t WS_SW = WS_SROW + (size_t)NCHUNK * 64 * CAP * 4;
constexpr size_t WS_TSLOT = WS_SW + (size_t)NCHUNK * 64 * CAP * 4;
constexpr size_t WS_BIG = ((WS_TSLOT + (size_t)MROWS * 6 * 4 + 255) / 256) * 256;
constexpr size_t BIG_QKV = 0;
constexpr size_t BIG_P = 0;
constexpr size_t BIG_QM = BIG_P + (size_t)MROWS * 1536 * 2;
constexpr size_t BIG_KVX = BIG_QM + (size_t)MROWS * 768 * 2;
constexpr size_t BIG_HLO = 0;
constexpr size_t MAXSLOT = (size_t)MROWS * 7 + (size_t)NG * 256;
constexpr size_t BIG_ACT = 0;
constexpr size_t BIG_SLAB = BIG_ACT + MAXSLOT * 512;
constexpr size_t SLAB_SLOTS = (size_t)CHUNK_ROWS * 7 + (size_t)NGRP * 256;
constexpr size_t WS_END = WS_BIG + BIG_SLAB + SLAB_SLOTS * 2048;

constexpr int LDS_BYTES = 139264;
constexpr int LDS_TAB = 131072;
constexpr int LDS_BARW = LDS_BYTES - 16;

struct Params {
    const float* in[41];
    float* out;
    char* ws;
};
typedef const Params __attribute__((address_space(4)))* PP;
__device__ __forceinline__ PP get_pp() { PP p = (PP)__builtin_amdgcn_kernarg_segment_ptr(); asm volatile("" : "+s"(p)); return p; }
__device__ __forceinline__ int ltid() { int t = threadIdx.x; asm volatile("" : "+v"(t)); return t; }

__device__ __forceinline__ unsigned pk2(float lo, float hi) {
    typedef float f2 __attribute__((ext_vector_type(2))); typedef __bf16 b2 __attribute__((ext_vector_type(2)));
    f2 v = {lo, hi}; b2 b = __builtin_convertvector(v, b2); return __builtin_bit_cast(unsigned, b);
}
__device__ __forceinline__ float bflo(unsigned u) { return __uint_as_float(u << 16); }
__device__ __forceinline__ float bfhi(unsigned u) { return __uint_as_float(u & 0xffff0000u); }
__device__ __forceinline__ float wave_sum(float v) {
#pragma unroll
    for (int o = 32; o > 0; o >>= 1) v += __shfl_xor(v, o);
    return v;
}
__device__ __forceinline__ int ld_ctl(const int* p) { return __hip_atomic_load(p, __ATOMIC_RELAXED, __HIP_MEMORY_SCOPE_AGENT); }

#define XB_TMO      128
#define XB_XCNT(j)  (256  + 64 * (j))
#define XB_XSUB(j)  (1280 + 64 * (j))
#define XB_XGEN(j)  (2304 + 64 * (j))
#define XB_TOP      3328
#define XB_TOPGEN   3392
#define XCD_BAR_WORDS 3456
#define XB_SPIN_CAP (1u << 18)

__device__ __forceinline__ unsigned xb_ld(unsigned* p)              { return __hip_atomic_load(p, __ATOMIC_RELAXED, __HIP_MEMORY_SCOPE_AGENT); }
__device__ __forceinline__ unsigned xb_add(unsigned* p, unsigned v) { return __hip_atomic_fetch_add(p, v, __ATOMIC_RELAXED, __HIP_MEMORY_SCOPE_AGENT); }
__device__ __forceinline__ unsigned xb_xcc_id() { return (unsigned)__builtin_amdgcn_s_getreg((3 << 11) | 20) & 0xFu; }
#define XB_SPIN(cond, bar) do { unsigned _sp = 0; while (cond) { __builtin_amdgcn_s_sleep(1); \
    if ((++_sp & 255u) == 0u) { if (xb_ld(&(bar)[XB_TMO])) break; if (_sp > XB_SPIN_CAP) { atomicAdd(&(bar)[XB_TMO], 1u); break; } } } } while (0)

struct XcdBarrier { unsigned* bar; unsigned x; volatile LAS unsigned* st; };

__device__ __forceinline__ XcdBarrier xcd_barrier_post(unsigned* bar, volatile LAS unsigned* st) {
    XcdBarrier b; b.bar = bar; b.x = xb_xcc_id(); b.st = st;
    if (threadIdx.x == 0) (void)xb_add(&bar[XB_XCNT(b.x)], 1u);
    return b;
}
__device__ __forceinline__ void xcd_barrier_complete(unsigned* bar, unsigned x, unsigned& nloc, unsigned& nx) {
    const unsigned G = gridDim.x * gridDim.y * gridDim.z;
    unsigned sum, cnt, mine, sp = 0u;
    for (;;) {
        sum = 0u; cnt = 0u; mine = 0u;
#pragma unroll
        for (unsigned j = 0; j < 16; ++j) { const unsigned c = xb_ld(&bar[XB_XCNT(j)]); sum += c; cnt += (c > 0u) ? 1u : 0u; mine = (j == x) ? c : mine; }
        if (sum == G) break;
        __builtin_amdgcn_s_sleep(1);
        if ((++sp & 255u) == 0u) { if (xb_ld(&bar[XB_TMO])) break; if (sp > XB_SPIN_CAP) { atomicAdd(&bar[XB_TMO], 1u); break; } }
    }
    nloc = mine > 0u ? mine : 1u; nx = cnt > 0u ? cnt : 1u;
}
__device__ __forceinline__ void xcd_barrier(const XcdBarrier& b) {
    asm volatile("s_waitcnt vmcnt(0)" ::: "memory");
    __syncthreads();
    if (threadIdx.x == 0) {
        unsigned* bar = b.bar;
        __builtin_amdgcn_s_waitcnt(0);
        unsigned nloc = b.st[0], nx = b.st[1];
        if (nloc == 0u) { xcd_barrier_complete(bar, b.x, nloc, nx); b.st[0] = nloc; b.st[1] = nx; }
        const unsigned old = xb_add(&bar[XB_XSUB(b.x)], 1u);
        const unsigned gen = old / nloc;
        if (old + 1u == (gen + 1u) * nloc) {
            __builtin_amdgcn_fence(__ATOMIC_RELEASE, "agent");
            asm volatile("s_waitcnt vmcnt(0)" ::: "memory");
            const unsigned og = xb_add(&bar[XB_TOP], 1u);
            const unsigned tg = og / nx;
            if (og + 1u == (tg + 1u) * nx) xb_add(&bar[XB_TOPGEN], 1u);
            else XB_SPIN(xb_ld(&bar[XB_TOPGEN]) == tg, bar);
            __builtin_amdgcn_fence(__ATOMIC_ACQUIRE, "agent");
            xb_add(&bar[XB_XGEN(b.x)], 1u);
            asm volatile("s_waitcnt vmcnt(0)" ::: "memory");
        } else {
            XB_SPIN(xb_ld(&bar[XB_XGEN(b.x)]) == gen, bar);
            __builtin_amdgcn_fence(__ATOMIC_ACQUIRE, "agent");
            asm volatile("s_waitcnt vmcnt(0)" ::: "memory");
        }
    }
    __syncthreads();
}

namespace gm {
constexpr int BM = 256, BK = 64, HALF = 128, HTB = HALF * BK * 2, STAGE_BYTES = 8 * HTB, NXCD = 8, WGM = 8;
__device__ __forceinline__ int lds_byte(int r, int c) { const int st = (r >> 4) * 2 + (c >> 5), rr = r & 15, cc = c & 31, ob = rr * 64 + cc * 2; return st * 1024 + (ob ^ (((ob >> 9) & 1) << 5)); }
__device__ __forceinline__ void stage_rc(int b, int& R, int& C) { const int st = b / 1024, sb = b % 1024, swz = sb ^ (((sb >> 9) & 1) << 5); R = (st >> 1) * 16 + swz / 64; C = (st & 1) * 32 + (swz % 64) / 2; }
__device__ __forceinline__ int perm32(int rho) { const int n = rho >> 4, i = rho & 15; return 8 * (i >> 2) + 4 * n + (i & 3); }

struct Unit { int pm, pn, g, mt, cnt, sbase; };
struct Desc { const char* A; unsigned lda; const char* B; unsigned ldb; int K; };

struct DenseSched {
    int nMt, nN, nwg, G, c, mmode;
    __device__ __forceinline__ void init(int mmode_, int nN_, int G_, int c_) { mmode = mmode_; nMt = mmode_ ? 256 : 288; nN = nN_; nwg = nMt * nN_; G = G_; c = c_; }
    __device__ __forceinline__ bool next(int i, Unit& u) const {
        const long L = (long)i * G + c; if (L >= nwg) return false;
        int wgid = (int)L; { const int q = nwg / NXCD, r = nwg % NXCD, xcd = wgid % NXCD, off = wgid / NXCD; wgid = (xcd < r ? xcd * (q + 1) : r * (q + 1) + (xcd - r) * q) + off; }
        const int nig = WGM * nN, gid = wgid / nig, fm = gid * WGM, gsz = (nMt - fm) < WGM ? (nMt - fm) : WGM;
        const int pmi = fm + ((wgid % nig) % gsz); u.pn = (wgid % nig) / gsz;
        u.pm = mmode ? (pmi >> 3) * 9 + 1 + (pmi & 7) : pmi; u.g = 0; u.mt = 0; u.cnt = 256; u.sbase = 0; return true;
    }
    __device__ __forceinline__ int a_row(const Unit& u, int r) const { return u.pm * 256 + r; }
    __device__ __forceinline__ int b_row(const Unit& u) const { return u.pn * 256; }
};

template <int WHICH  >
struct MoeSched {
    LAS const int* toff; const int* slot_row; int nN, G, c, bN, layer, t_lo, t_hi;
    __device__ __forceinline__ bool next(int i, Unit& u) const {
        const int L = i * G + c; if (L >= (t_hi - t_lo) * nN) return false;
        const int tau = L / nN; u.pn = L - tau * nN; const int T = t_lo + tau;
        int lo = 0, hi = NG;
        while (hi - lo > 1) { const int mid = (lo + hi) >> 1; if (toff[mid] <= T) lo = mid; else hi = mid; }
        u.g = lo; u.mt = T - toff[lo]; u.pm = T; u.sbase = T * 256; u.cnt = toff[272 + lo]; return true;
    }
    __device__ __forceinline__ int a_row(const Unit& u, int r) const {
        if (WHICH == 2) return u.sbase + r;
        const int e = u.g % NGRP, ch = u.g / NGRP, idx = u.mt * 256 + r;
        const bool in = (e < NEXP) && (idx < u.cnt);
        const int lrow = slot_row[(size_t)(ch * 64 + (e < NEXP ? e : 0)) * CAP + (in ? idx : 0)];
        const int b1 = ch * CHUNK_B + (idx >> 11);
        const int srow = (layer == 0) ? (ch * CHUNK_ROWS + idx) : (b1 * TOK + CTX + (idx & 2047));
        return (e == NEXP) ? srow : (in ? lrow : 0);
    }
    __device__ __forceinline__ int b_row(const Unit& u) const { return (u.g % NGRP) * bN + u.pn * 256; }
};

template <class Epi, class Sched>
__device__ __forceinline__ void gemm_phase(LAS unsigned char* lds, const Desc g, const Sched& S, const Epi& E) {
    const int tid = ltid(), wid = __builtin_amdgcn_readfirstlane(tid >> 6), lane = tid & 63, wr = wid >> 2, wc = wid & 3, fr = lane & 15, fq = lane >> 4;
    const int nt = g.K / BK;
    unsigned voffB[2][2];
#pragma unroll
    for (int i = 0; i < 2; ++i) { int R, C; stage_rc(tid * 16 + i * 8192, R, C); const int Rl = Epi::PERM ? perm32(R & 31) : (R & 31);
#pragma unroll
        for (int h = 0; h < 2; ++h) { const int Rb = Epi::WIDE ? (64 * (R >> 5) + 32 * h + Rl) : (128 * h + (R & ~31) + Rl);
            voffB[h][i] = (unsigned)Rb * g.ldb + (unsigned)C * 2u; } }
    const size_t kstep = (size_t)(BK * 2);
    const unsigned ldsw = (unsigned)wid * 1024u;
    const int aoff = lds_byte(wr * 64 + fr, fq * 8), boff = lds_byte(wc * 32 + fr, fq * 8);
#define GM_SA(b, h) (((b) * 2 + (h)) * HTB)
#define GM_SB(b, h) ((4 + (b) * 2 + (h)) * HTB)
#define GM_STAGE_A(bufoff, kb, va, h) do { _Pragma("unroll") for (int _i = 0; _i < 2; ++_i) \
        __builtin_amdgcn_global_load_lds((const unsigned*)(g.A + (kb) + (va)[h][_i]), (LAS unsigned*)(lds + (bufoff) + ldsw + _i * 8192), 16, 0, 0); } while (0)
#define GM_STAGE_B(bufoff, bp, h) do { _Pragma("unroll") for (int _i = 0; _i < 2; ++_i) \
        __builtin_amdgcn_global_load_lds((const unsigned*)((bp) + voffB[h][_i]), (LAS unsigned*)(lds + (bufoff) + ldsw + _i * 8192), 16, 0, 0); } while (0)
#define GM_LDA(dst, b, h) do { _Pragma("unroll") for (int m = 0; m < 4; ++m) _Pragma("unroll") for (int k = 0; k < 2; ++k) dst[m][k] = *(const LAS bf16x8*)(lds + GM_SA(b, h) + aoff + m * 2048 + k * 1024); } while (0)
#define GM_LDB(dst, b, h) do { _Pragma("unroll") for (int n = 0; n < 2; ++n) _Pragma("unroll") for (int k = 0; k < 2; ++k) dst[n][k] = *(const LAS bf16x8*)(lds + GM_SB(b, h) + boff + n * 2048 + k * 1024); } while (0)
#define GM_MMA(ai, bj, At, Bt) do { __builtin_amdgcn_s_setprio(1); _Pragma("unroll") for (int m = 0; m < 4; ++m) _Pragma("unroll") for (int n = 0; n < 2; ++n) _Pragma("unroll") for (int k = 0; k < 2; ++k) \
        acc[ai][bj][m][n] = __builtin_amdgcn_mfma_f32_16x16x32_bf16(Bt[n][k], At[m][k], acc[ai][bj][m][n], 0, 0, 0); __builtin_amdgcn_s_setprio(0); } while (0)
#define GM_WAIT_V(n) asm volatile("s_waitcnt vmcnt(" #n ")" ::: "memory")
#define GM_WAIT_L(n) asm volatile("s_waitcnt lgkmcnt(" #n ")" ::: "memory")
#define GM_BAR __builtin_amdgcn_s_barrier()
#define GM_SCHED __builtin_amdgcn_sched_barrier(0)
#define GM_CALC_VA(va, u) do { int _tz = tid; asm volatile("" : "+v"(_tz)); int _rw[2][2]; unsigned _cc[2]; \
        _Pragma("unroll") for (int _i = 0; _i < 2; ++_i) { int _R, _C; stage_rc(_tz * 16 + _i * 8192, _R, _C); _cc[_i] = (unsigned)_C * 2u; \
            _Pragma("unroll") for (int _h = 0; _h < 2; ++_h) _rw[_h][_i] = S.a_row((u), _h * HALF + _R); } \
        _Pragma("unroll") for (int _i = 0; _i < 2; ++_i) _Pragma("unroll") for (int _h = 0; _h < 2; ++_h) (va)[_h][_i] = (unsigned)_rw[_h][_i] * g.lda + _cc[_i]; } while (0)
    Unit cur, nxt; int ui = 0;
    if (!S.next(0, cur)) return;
    f32x4 acc[2][2][4][2];
#pragma unroll
    for (int a = 0; a < 2; ++a)
#pragma unroll
        for (int b = 0; b < 2; ++b)
#pragma unroll
            for (int m = 0; m < 4; ++m)
#pragma unroll
                for (int n = 0; n < 2; ++n) acc[a][b][m][n] = (f32x4){0.f, 0.f, 0.f, 0.f};
    bf16x8 At[4][2], B0[2][2], B1[2][2];
    unsigned vaC[2][2];
    GM_CALC_VA(vaC, cur);
    const char* cB = g.B + (size_t)S.b_row(cur) * g.ldb;
    GM_STAGE_B(GM_SB(0, 0), cB, 0); GM_STAGE_A(GM_SA(0, 0), (size_t)0, vaC, 0); GM_STAGE_B(GM_SB(0, 1), cB, 1); GM_STAGE_A(GM_SA(0, 1), (size_t)0, vaC, 1);
    if (wr == 1) GM_BAR;
    GM_WAIT_V(4); GM_BAR;
    GM_STAGE_B(GM_SB(1, 0), cB + kstep, 0); GM_STAGE_A(GM_SA(1, 0), kstep, vaC, 0); GM_STAGE_B(GM_SB(1, 1), cB + kstep, 1);
    GM_WAIT_V(6); GM_BAR;
    for (;;) {
        const bool has_next = S.next(ui + 1, nxt);
        const char* nB = cB;
        if (has_next) nB = g.B + (size_t)S.b_row(nxt) * g.ldb;
        unsigned va2[2][2];
#pragma clang loop unroll(disable)
        for (int t = 0; t < nt; t += 2) {
            const bool last = (t == nt - 2);
            const size_t k1 = (size_t)(t + 1) * kstep;
            const size_t k2 = last ? (size_t)0 : (size_t)(t + 2) * kstep, k3 = k2 + kstep;
            const char* b2 = last ? nB : cB + k2; const char* b3 = b2 + kstep;
#pragma unroll
            for (int _h = 0; _h < 2; ++_h)
#pragma unroll
                for (int _i = 0; _i < 2; ++_i) va2[_h][_i] = vaC[_h][_i];
            if (last && has_next) GM_CALC_VA(va2, nxt);
            GM_LDB(B0, 0, 0); GM_SCHED; GM_LDA(At, 0, 0); GM_STAGE_A(GM_SA(1, 1), k1, vaC, 1);
            GM_WAIT_L(8); GM_BAR; GM_WAIT_L(0); GM_MMA(0, 0, At, B0); GM_BAR; GM_SCHED;
            GM_LDB(B1, 0, 1); GM_STAGE_B(GM_SB(0, 0), b2, 0);
            GM_BAR; GM_WAIT_L(0); GM_MMA(0, 1, At, B1); GM_BAR;
            GM_LDA(At, 0, 1); GM_STAGE_A(GM_SA(0, 0), k2, va2, 0);
            GM_BAR; GM_WAIT_L(0); GM_MMA(1, 0, At, B0); GM_BAR; GM_SCHED;
            GM_STAGE_B(GM_SB(0, 1), b2, 1);
            GM_WAIT_V(6); GM_BAR; GM_MMA(1, 1, At, B1); GM_BAR;
            GM_LDB(B0, 1, 0); GM_SCHED; GM_LDA(At, 1, 0); GM_STAGE_A(GM_SA(0, 1), k2, va2, 1);
            GM_WAIT_L(8); GM_BAR; GM_WAIT_L(0); GM_MMA(0, 0, At, B0); GM_BAR; GM_SCHED;
            GM_LDB(B1, 1, 1); GM_STAGE_B(GM_SB(1, 0), b3, 0);
            GM_BAR; GM_WAIT_L(0); GM_MMA(0, 1, At, B1); GM_BAR;
            GM_LDA(At, 1, 1); GM_STAGE_A(GM_SA(1, 0), k3, va2, 0);
            GM_BAR; GM_WAIT_L(0); GM_MMA(1, 0, At, B0); GM_BAR; GM_SCHED;
            GM_STAGE_B(GM_SB(1, 1), b3, 1);
            GM_WAIT_V(6); GM_BAR; GM_MMA(1, 1, At, B1); GM_BAR;
        }
        { int tz = tid; asm volatile("" : "+v"(tz));
          const int wid2 = __builtin_amdgcn_readfirstlane(tz >> 6), ln2 = tz & 63; E(acc, cur, wid2 >> 2, wid2 & 3, ln2 & 15, ln2 >> 4); }
        if (!has_next) break;
#pragma unroll
        for (int a = 0; a < 2; ++a)
#pragma unroll
            for (int b = 0; b < 2; ++b)
#pragma unroll
                for (int m = 0; m < 4; ++m)
#pragma unroll
                    for (int n = 0; n < 2; ++n) acc[a][b][m][n] = (f32x4){0.f, 0.f, 0.f, 0.f};
        cur = nxt; cB = nB; ++ui;
#pragma unroll
        for (int _h = 0; _h < 2; ++_h)
#pragma unroll
            for (int _i = 0; _i < 2; ++_i) vaC[_h][_i] = va2[_h][_i];
    }
    GM_WAIT_V(0);
    if (wr == 0) GM_BAR;
    GM_BAR;
#undef GM_SA
#undef GM_SB
#undef GM_STAGE_A
#undef GM_STAGE_B
#undef GM_LDA
#undef GM_LDB
#undef GM_MMA
#undef GM_WAIT_V
#undef GM_WAIT_L
#undef GM_BAR
#undef GM_SCHED
#undef GM_CALC_VA
}

typedef const f32x4 (&AccRef)[2][2][4][2];

struct EpiQKV0 {
    static constexpr bool PERM = false; static constexpr int WIDE = 0;
    bf16_t* O; const float* cosT; const float* sinT;
    __device__ __forceinline__ void operator()(AccRef acc, const Unit& u, int wr, int wc, int fr, int fq) const {
        const int tq = u.pm % 9; const bool ctx = (tq == 0); const int tbase = tq * 256 - 256;
        const int colg0 = 256 * u.pn + 32 * wc; const bool rope0 = (colg0 < 640) && !ctx, rope1 = (colg0 + 128 < 640) && !ctx; const int gi = 16 * (wc & 1) + 4 * fq;
        f32x4 cs[8], sn[8];
        if (rope0) {
#pragma unroll
            for (int q = 0; q < 8; ++q) { const int rl = 128 * (q >> 2) + 64 * wr + 16 * (q & 3) + fr; cs[q] = *(const f32x4*)(cosT + (size_t)(tbase + rl) * 32 + gi); sn[q] = *(const f32x4*)(sinT + (size_t)(tbase + rl) * 32 + gi); }
        }
#pragma unroll
        for (int bj = 0; bj < 2; ++bj) {
            const int colg = colg0 + 128 * bj; const bool rope = bj ? rope1 : rope0;
#pragma unroll
            for (int ai = 0; ai < 2; ++ai)
#pragma unroll
                for (int m = 0; m < 4; ++m) {
                    const int rl = 128 * ai + 64 * wr + 16 * m + fr; const size_t row = (size_t)u.pm * 256 + rl;
                    f32x4 v0 = acc[ai][bj][m][0], v1 = acc[ai][bj][m][1];
                    if (rope) { const f32x4 c4 = cs[4 * ai + m], s4 = sn[4 * ai + m]; const f32x4 x0 = v0 * c4 - v1 * s4, x1 = v0 * s4 + v1 * c4; v0 = x0; v1 = x1; }
                    bf16_t* p = O + row * 2304 + colg + 4 * fq;
                    u32x2 w0, w1; w0.x = pk2(v0[0], v0[1]); w0.y = pk2(v0[2], v0[3]); w1.x = pk2(v1[0], v1[1]); w1.y = pk2(v1[2], v1[3]);
                    *(u32x2*)p = w0; *(u32x2*)(p + 16) = w1;
                }
        }
    }
};
struct EpiP1 {
    static constexpr bool PERM = true; static constexpr int WIDE = 1;
    bf16_t* O; int ldc; const float* rs; int rsel;
    __device__ __forceinline__ void operator()(AccRef acc, const Unit& u, int wr, int wc, int fr, int fq) const {
        float scv[8];
#pragma unroll
        for (int q = 0; q < 8; ++q) { const size_t row = (size_t)u.pm * 256 + 128 * (q >> 2) + 64 * wr + 16 * (q & 3) + fr; scv[q] = rs ? rs[row * 2 + rsel] : 1.f; }
        const bool lo = fr < 8; const int col = 256 * u.pn + 64 * wc + 8 * fq + (lo ? 0 : 32);
#pragma unroll
        for (int ai = 0; ai < 2; ++ai)
#pragma unroll
            for (int m = 0; m < 4; ++m) { const size_t row = (size_t)u.pm * 256 + 128 * ai + 64 * wr + 16 * m + (fr & 7); const float sc = scv[4 * ai + m];
                u32x4 x0, x1;
                { const f32x4 v0 = acc[ai][0][m][0] * sc, v1 = acc[ai][0][m][1] * sc; x0.x = pk2(v0[0], v0[1]); x0.y = pk2(v0[2], v0[3]); x0.z = pk2(v1[0], v1[1]); x0.w = pk2(v1[2], v1[3]); }
                { const f32x4 v0 = acc[ai][1][m][0] * sc, v1 = acc[ai][1][m][1] * sc; x1.x = pk2(v0[0], v0[1]); x1.y = pk2(v0[2], v0[3]); x1.z = pk2(v1[0], v1[1]); x1.w = pk2(v1[2], v1[3]); }
                u32x4 rc;
#pragma unroll
                for (int q = 0; q < 4; ++q) rc[q] = (unsigned)__shfl_xor((int)(lo ? x1[q] : x0[q]), 8);
                const u32x4 da = lo ? x0 : rc, db = lo ? rc : x1;
                *(u32x4*)(O + row * ldc + col) = da; *(u32x4*)(O + (row + 8) * ldc + col) = db; }
    }
};
struct EpiUQ {
    static constexpr bool PERM = false; static constexpr int WIDE = 0;
    bf16_t* O; const float* rs; const float* cosT; const float* sinT;
    __device__ __forceinline__ void operator()(AccRef acc, const Unit& u, int wr, int wc, int fr, int fq) const {
        const int tq = u.pm % 9; const bool ctx = (tq == 0); const int tbase = tq * 256 - 256;
        const int colg0 = 256 * u.pn + 32 * wc, colg1 = colg0 + 128;
        const bool rope0 = ((colg0 >> 5) % 3 == 2) && !ctx, rope1 = ((colg1 >> 5) % 3 == 2) && !ctx;
        float scv[8]; f32x4 cs[8], sn[8];
#pragma unroll
        for (int q = 0; q < 8; ++q) { const int rl = 128 * (q >> 2) + 64 * wr + 16 * (q & 3) + fr; scv[q] = rs[((size_t)u.pm * 256 + rl) * 2]; }
        if (rope0 || rope1) {
#pragma unroll
            for (int q = 0; q < 8; ++q) { const int rl = 128 * (q >> 2) + 64 * wr + 16 * (q & 3) + fr; cs[q] = *(const f32x4*)(cosT + (size_t)(tbase + rl) * 16 + 4 * fq); sn[q] = *(const f32x4*)(sinT + (size_t)(tbase + rl) * 16 + 4 * fq); }
        }
#pragma unroll
        for (int ai = 0; ai < 2; ++ai)
#pragma unroll
            for (int m = 0; m < 4; ++m) {
                const int rl = 128 * ai + 64 * wr + 16 * m + fr; const size_t row = (size_t)u.pm * 256 + rl; const float sc = scv[4 * ai + m];
#pragma unroll
                for (int bj = 0; bj < 2; ++bj) {
                    f32x4 v0 = acc[ai][bj][m][0] * sc, v1 = acc[ai][bj][m][1] * sc;
                    if (bj ? rope1 : rope0) { const f32x4 c4 = cs[4 * ai + m], s4 = sn[4 * ai + m]; const f32x4 x0 = v0 * c4 - v1 * s4, x1 = v0 * s4 + v1 * c4; v0 = x0; v1 = x1; }
                    bf16_t* p = O + row * 768 + (bj ? colg1 : colg0) + 4 * fq;
                    u32x2 w0, w1; w0.x = pk2(v0[0], v0[1]); w0.y = pk2(v0[2], v0[3]); w1.x = pk2(v1[0], v1[1]); w1.y = pk2(v1[2], v1[3]);
                    *(u32x2*)p = w0; *(u32x2*)(p + 16) = w1;
                }
            }
    }
};
struct EpiG1 {
    static constexpr bool PERM = false; static constexpr int WIDE = 0;
    bf16_t* act; const float* slot_w;
    __device__ __forceinline__ void operator()(AccRef acc, const Unit& u, int wr, int wc, int fr, int fq) const {
        const int e = u.g % NGRP, ch = u.g / NGRP;
        float wv[8];
        const float* wp = slot_w + (size_t)(ch * 64 + (e < NEXP ? e : NEXP - 1)) * CAP;
#pragma unroll
        for (int q = 0; q < 8; ++q) { const int idx = u.mt * 256 + 128 * (q >> 2) + 64 * wr + 16 * (q & 3) + fr; const bool in = idx < u.cnt;
            const float lw = __hip_atomic_load(wp + (in ? idx : 0), __ATOMIC_RELAXED, __HIP_MEMORY_SCOPE_AGENT);
            wv[q] = (e == NEXP) ? 1.f : (in ? lw : 0.f); }
#pragma unroll
        for (int ai = 0; ai < 2; ++ai)
#pragma unroll
            for (int m = 0; m < 4; ++m) {
                const int rl = 128 * ai + 64 * wr + 16 * m + fr; const float w = wv[4 * ai + m];
#pragma unroll
                for (int bj = 0; bj < 2; ++bj) {
                    const f32x4 gt = acc[ai][bj][m][0], up = acc[ai][bj][m][1]; float r[4];
#pragma unroll
                    for (int j = 0; j < 4; ++j) r[j] = gt[j] * __builtin_amdgcn_rcpf(1.f + __expf(-gt[j])) * up[j] * w;
                    u32x2 o; o.x = pk2(r[0], r[1]); o.y = pk2(r[2], r[3]);
                    *(u32x2*)(act + ((size_t)u.sbase + rl) * 256 + 16 * (8 * u.pn + 4 * bj + wc) + 4 * fq) = o;
                }
            }
    }
};
struct EpiG2 {
    static constexpr bool PERM = true, WIDE = true;
    bf16_t* slab; int sbase0;
    __device__ __forceinline__ void operator()(AccRef acc, const Unit& u, int wr, int wc, int fr, int fq) const {
        const bool lo = fr < 8; const int col = 256 * u.pn + 64 * wc + 8 * fq + (lo ? 0 : 32);
#pragma unroll
        for (int ai = 0; ai < 2; ++ai)
#pragma unroll
            for (int m = 0; m < 4; ++m) { const size_t row = (size_t)(u.sbase - sbase0) + 128 * ai + 64 * wr + 16 * m + (fr & 7);
                u32x4 x0, x1;
                { const f32x4 v0 = acc[ai][0][m][0], v1 = acc[ai][0][m][1]; x0.x = pk2(v0[0], v0[1]); x0.y = pk2(v0[2], v0[3]); x0.z = pk2(v1[0], v1[1]); x0.w = pk2(v1[2], v1[3]); }
                { const f32x4 v0 = acc[ai][1][m][0], v1 = acc[ai][1][m][1]; x1.x = pk2(v0[0], v0[1]); x1.y = pk2(v0[2], v0[3]); x1.z = pk2(v1[0], v1[1]); x1.w = pk2(v1[2], v1[3]); }
                u32x4 rc;
#pragma unroll
                for (int q = 0; q < 4; ++q) rc[q] = (unsigned)__shfl_xor((int)(lo ? x1[q] : x0[q]), 8);
                const u32x4 da = lo ? x0 : rc, db = lo ? rc : x1;
                __builtin_nontemporal_store(da, (u32x4*)(slab + row * 1024 + col)); __builtin_nontemporal_store(db, (u32x4*)(slab + (row + 8) * 1024 + col)); }
    }
};
}

struct AU {
    const bf16_t* qptr;
    bf16_t* optr;
    const bf16_t* kbase; unsigned kpitch;
    const bf16_t* vbase; unsigned vpitch;
    const bf16_t* k2base; unsigned k2pitch;
    int row_ctx, row_lat;
    int nt;
    int j0;
    int qoff;
    int start;
    float m0, l0;
};
constexpr int ATT_RPB = 122880;
constexpr float THR = 8.f;
__device__ __forceinline__ void glds16(const void* gsrc, unsigned lds_dst) { unsigned keep;
    asm volatile("s_mov_b32 %0, m0\n\ts_mov_b32 m0, %2\n\ts_nop 0\n\tglobal_load_lds_dwordx4 %1, off\n\ts_mov_b32 m0, %0" : "=&s"(keep) : "v"(gsrc), "s"(lds_dst) : "memory"); }
__device__ __forceinline__ float max3f(float a, float b, float c) { float r; asm("v_max3_f32 %0, %1, %2, %3" : "=v"(r) : "v"(a), "v"(b), "v"(c)); return r; }
__device__ __forceinline__ float max2f(float a, float b) { float r; asm("v_max_f32_e32 %0, %1, %2" : "=v"(r) : "v"(a), "v"(b)); return r; }

template <int MODE  , int DQ  >
__device__ __forceinline__ void attn_unit(LAS unsigned char* lds, const AU& a) {
    constexpr int NS = DQ / 16;
    constexpr int BUFB = (DQ == 96) ? 20480 : 16384;
    const int tid = ltid(), lane = tid & 63, wid = __builtin_amdgcn_readfirstlane(tid >> 6), r32 = lane & 31, hi = lane >> 5;
    const bool upper = wid >= 4;
    const int kr = tid >> 3, cp = tid & 7;
    const int ksrc = (cp ^ ((kr >> 1) & 7)) * 8, vsrc = (cp ^ (((kr >> 1) & 1) << 2)) * 8;
    const int kr2 = 16 * wid + (lane >> 2), k2src = ((lane & 3) ^ ((kr2 >> 2) & 3)) * 8;
    unsigned koff[NS];
#pragma unroll
    for (int s = 0; s < NS; ++s) koff[s] = (s < 4) ? (unsigned)(r32 * 128 + (((2 * s + hi) ^ ((r32 >> 1) & 7)) << 4))
                                                   : (unsigned)(16384 + r32 * 64 + (((2 * (s - 4) + hi) ^ ((r32 >> 2) & 3)) << 4));
    const int vg = (lane >> 4) & 1, vq = (lane & 15) >> 2, vp = lane & 3, vsw = (vq >> 1) & 1;
    const unsigned voff0 = (unsigned)(8192 + (4 * hi + vq) * 128 + 64 * vsw + 32 * vg + 8 * vp);
    const unsigned voff1 = (unsigned)(8192 + (4 * hi + vq) * 128 + 64 * (1 - vsw) + 32 * vg + 8 * vp);
    bf16x8 qf[NS];
#pragma unroll
    for (int s = 0; s < NS; ++s) qf[s] = *(const bf16x8*)(a.qptr + 16 * s + 8 * hi);
    f32x16 o0, o1, negm, p0, p1;
    float m = a.m0, l = a.l0;
#pragma unroll
    for (int r = 0; r < 16; ++r) { o0[r] = 0.f; o1[r] = 0.f; negm[r] = -m; p0[r] = 0.f; p1[r] = 0.f; }
    const int nt = a.nt;
    auto krow = [&](int t, int r) -> int {
        if (MODE == 0) return a.row_ctx + 64 * t + r;
        if (t < 4) return a.row_ctx + 64 * t + r;
        if (MODE == 1) return a.row_lat + a.start - 128 + 64 * (a.j0 + t - 4) + r;
        return a.row_lat + 64 * (a.j0 + t - 4) + r;
    };
    const unsigned lds0 = (unsigned)(uintptr_t)lds + (unsigned)wid * 1024u;
    auto dma = [&](int t, int boff) {
        const size_t r = (size_t)krow(t, kr);
        glds16(a.kbase + r * a.kpitch + ksrc, (unsigned)__builtin_amdgcn_readfirstlane((int)(lds0 + boff)));
        glds16(a.vbase + r * a.vpitch + vsrc, (unsigned)__builtin_amdgcn_readfirstlane((int)(lds0 + boff + 8192)));
        if (DQ == 96) { if (!upper) { const size_t r2 = (size_t)krow(t, kr2);
            glds16(a.k2base + r2 * a.k2pitch + k2src, (unsigned)__builtin_amdgcn_readfirstlane((int)(lds0 + boff + 16384))); } }
    };
    auto tile_active = [&](int t) -> bool {
        if (MODE != 2 || t < 4) return true;
        const int qrow = a.qoff >> 6; int rs = qrow - 4; rs = rs < 0 ? 0 : (rs > 24 ? 24 : rs); const int kgr = a.j0 + t - 4;
        return __builtin_amdgcn_readfirstlane((int)((kgr >= rs) && (kgr < rs + 8))) != 0;
    };
    auto QK = [&](int t, int boff) {
        const LAS unsigned char* Bb = lds + boff;
        bf16x8 kf[2 * NS];
#pragma unroll
        for (int s = 0; s < NS; ++s) { kf[2 * s] = *(const LAS bf16x8*)(Bb + koff[s]); kf[2 * s + 1] = *(const LAS bf16x8*)(Bb + koff[s] + (s < 4 ? 4096 : 2048)); }
#pragma unroll
        for (int s = 0; s < NS; ++s) {
            if (s == 0) { p0 = __builtin_amdgcn_mfma_f32_32x32x16_bf16(kf[0], qf[0], negm, 0, 0, 0); p1 = __builtin_amdgcn_mfma_f32_32x32x16_bf16(kf[1], qf[0], negm, 0, 0, 0); }
            else { p0 = __builtin_amdgcn_mfma_f32_32x32x16_bf16(kf[2 * s], qf[s], p0, 0, 0, 0); p1 = __builtin_amdgcn_mfma_f32_32x32x16_bf16(kf[2 * s + 1], qf[s], p1, 0, 0, 0); }
        }
        __builtin_amdgcn_sched_group_barrier(0x100, 2 * NS, 0);
        __builtin_amdgcn_sched_group_barrier(0x008, 2 * NS, 0);
        if (MODE == 1 && t >= 4) {
            const int j = a.j0 + t - 4;
            if (j == 0 || j == 4) {
                const int dbase = -128 + 64 * j - a.qoff + 4 * hi;
#pragma unroll
                for (int r = 0; r < 16; ++r) { const int d = dbase + (r & 3) + 8 * (r >> 2);
                    if ((unsigned)(d + 128) > 256u) p0[r] = -1e30f; if ((unsigned)(d + 32 + 128) > 256u) p1[r] = -1e30f; }
            }
        }
        if (MODE == 2 && t >= 4) {
            const int qrow = a.qoff >> 6, qcol = a.qoff & 63; int cs = qcol - 8; cs = cs < 0 ? 0 : (cs > 48 ? 48 : cs);
            const int krel = a.j0 + t - 4 - qrow + 7;
            const LAS float* bt = (const LAS float*)(lds + ATT_RPB) + krel * 128 + (63 - qcol) + 4 * hi;
            const int cb = 4 * hi - cs;
#pragma unroll
            for (int r = 0; r < 16; ++r) { const int kc = (r & 3) + 8 * (r >> 2);
                const float b0 = bt[kc], b1 = bt[kc + 32];
                p0[r] = ((unsigned)(cb + kc) < 16u) ? p0[r] + b0 : -1e30f;
                p1[r] = ((unsigned)(cb + kc + 32) < 16u) ? p1[r] + b1 : -1e30f; }
        }
    };
    bf16x8 pf0, pf1, pf2, pf3;
    auto SM = [&](bool first) {
        asm volatile("s_nop 15\n\ts_nop 7" : "+v"(p0), "+v"(p1));
        float ra = max3f(p0[0], p0[1], p1[0]), rb = max3f(p0[2], p0[3], p1[1]); ra = max3f(ra, p1[2], p1[3]);
#pragma unroll
        for (int r = 4; r < 16; r += 4) { ra = max3f(ra, p0[r], p0[r + 1]); rb = max3f(rb, p0[r + 2], p0[r + 3]); ra = max3f(ra, p1[r], p1[r + 1]); rb = max3f(rb, p1[r + 2], p1[r + 3]); }
        float rm = max2f(ra, rb);
        { auto rr = __builtin_amdgcn_permlane32_swap(__float_as_uint(rm), __float_as_uint(rm), false, false); rm = max2f(__uint_as_float(rr[0]), __uint_as_float(rr[1])); }
        if (first || __any(rm > THR)) {
            const float dl = first ? rm : fmaxf(rm, 0.f);
            m += dl; const float f = __builtin_amdgcn_exp2f(-dl); l *= f;
#pragma unroll
            for (int r = 0; r < 16; ++r) { p0[r] -= dl; p1[r] -= dl; o0[r] *= f; o1[r] *= f; negm[r] = -m; }
        }
        float ls = 0.f;
#pragma unroll
        for (int r = 0; r < 16; ++r) { p0[r] = __builtin_amdgcn_exp2f(p0[r]); p1[r] = __builtin_amdgcn_exp2f(p1[r]); ls += p0[r] + p1[r]; }
        l += ls;
        u32x4 w;
        w.x = pk2(p0[0], p0[1]); w.y = pk2(p0[2], p0[3]); w.z = pk2(p0[4], p0[5]); w.w = pk2(p0[6], p0[7]); pf0 = __builtin_bit_cast(bf16x8, w);
        w.x = pk2(p0[8], p0[9]); w.y = pk2(p0[10], p0[11]); w.z = pk2(p0[12], p0[13]); w.w = pk2(p0[14], p0[15]); pf1 = __builtin_bit_cast(bf16x8, w);
        w.x = pk2(p1[0], p1[1]); w.y = pk2(p1[2], p1[3]); w.z = pk2(p1[4], p1[5]); w.w = pk2(p1[6], p1[7]); pf2 = __builtin_bit_cast(bf16x8, w);
        w.x = pk2(p1[8], p1[9]); w.y = pk2(p1[10], p1[11]); w.z = pk2(p1[12], p1[13]); w.w = pk2(p1[14], p1[15]); pf3 = __builtin_bit_cast(bf16x8, w);
    };
    auto PV = [&](int boff) {
        const LAS unsigned char* Bb = lds + boff;
        s16x4 va0[4], va1[4], vc0[4], vc1[4];
#pragma unroll
        for (int kk = 0; kk < 4; ++kk) {
            const LAS unsigned char* vb = Bb + kk * 2048;
            va0[kk] = __builtin_bit_cast(s16x4, __builtin_amdgcn_ds_read_tr16_b64_v4i16((LAS s16x4*)(vb + voff0)));
            va1[kk] = __builtin_bit_cast(s16x4, __builtin_amdgcn_ds_read_tr16_b64_v4i16((LAS s16x4*)(vb + voff0 + 1024)));
            vc0[kk] = __builtin_bit_cast(s16x4, __builtin_amdgcn_ds_read_tr16_b64_v4i16((LAS s16x4*)(vb + voff1)));
            vc1[kk] = __builtin_bit_cast(s16x4, __builtin_amdgcn_ds_read_tr16_b64_v4i16((LAS s16x4*)(vb + voff1 + 1024)));
        }
#pragma unroll
        for (int kk = 0; kk < 4; ++kk) {
            const bf16x8 va = (bf16x8){va0[kk][0], va0[kk][1], va0[kk][2], va0[kk][3], va1[kk][0], va1[kk][1], va1[kk][2], va1[kk][3]};
            const bf16x8 vc = (bf16x8){vc0[kk][0], vc0[kk][1], vc0[kk][2], vc0[kk][3], vc1[kk][0], vc1[kk][1], vc1[kk][2], vc1[kk][3]};
            const bf16x8 pk = kk == 0 ? pf0 : (kk == 1 ? pf1 : (kk == 2 ? pf2 : pf3));
            o0 = __builtin_amdgcn_mfma_f32_32x32x16_bf16(va, pk, o0, 0, 0, 0);
            o1 = __builtin_amdgcn_mfma_f32_32x32x16_bf16(vc, pk, o1, 0, 0, 0);
        }
        __builtin_amdgcn_sched_group_barrier(0x100, 16, 0);
        __builtin_amdgcn_sched_group_barrier(0x008, 8, 0);
    };
#define ATT_WAIT_BAR(N) do { asm volatile("s_waitcnt vmcnt(" #N ") lgkmcnt(0)" ::: "memory"); __builtin_amdgcn_s_barrier(); asm volatile("" ::: "memory"); } while (0)
    constexpr int RING = 6, DIST = RING - 1;
    auto wait_bar = [&](int ntiles) {
        if (DQ == 96 && !upper) { switch (ntiles) { case 4: ATT_WAIT_BAR(12); break; case 3: ATT_WAIT_BAR(9); break; case 2: ATT_WAIT_BAR(6); break; case 1: ATT_WAIT_BAR(3); break; default: ATT_WAIT_BAR(0); } }
        else { switch (ntiles) { case 4: ATT_WAIT_BAR(8); break; case 3: ATT_WAIT_BAR(6); break; case 2: ATT_WAIT_BAR(4); break; case 1: ATT_WAIT_BAR(2); break; default: ATT_WAIT_BAR(0); } } };
    if (upper) __builtin_amdgcn_s_setprio(1);
    int issued = 0;
    for (; issued < DIST && issued < nt; ++issued) dma(issued, issued * BUFB);
    wait_bar(issued - 1);
    int b_cur = 0, b_iss = (DIST % RING) * BUFB;
    for (int t = 0; t < nt; ++t) {
        if (issued < nt) { dma(issued, b_iss); ++issued; b_iss += BUFB; if (b_iss == RING * BUFB) b_iss = 0; }
        if (tile_active(t)) { QK(t, b_cur); SM(t == 0); PV(b_cur); }
        { const int infl = issued - t - 2; wait_bar(infl < 0 ? 0 : infl); }
        b_cur += BUFB; if (b_cur == RING * BUFB) b_cur = 0;
    }
#undef ATT_WAIT_BAR
    if (upper) __builtin_amdgcn_s_setprio(0);
    { auto rr = __builtin_amdgcn_permlane32_swap(__float_as_uint(l), __float_as_uint(l), false, false); l = __uint_as_float(rr[0]) + __uint_as_float(rr[1]); }
    const float inv = 1.f / l;
#pragma unroll
    for (int ig = 0; ig < 4; ++ig) {
        u32x2 w0, w1;
        w0.x = pk2(o0[4 * ig] * inv, o0[4 * ig + 1] * inv); w0.y = pk2(o0[4 * ig + 2] * inv, o0[4 * ig + 3] * inv);
        w1.x = pk2(o1[4 * ig] * inv, o1[4 * ig + 1] * inv); w1.y = pk2(o1[4 * ig + 2] * inv, o1[4 * ig + 3] * inv);
        *(u32x2*)(a.optr + 8 * ig + 4 * hi) = w0;
        *(u32x2*)(a.optr + 32 + 8 * ig + 4 * hi) = w1;
    }
}

struct AU2 {
    const bf16_t* qptr; unsigned qpitch;
    bf16_t* optr;
    const bf16_t* kbase; unsigned kpitch; const bf16_t* vbase; unsigned vpitch; const bf16_t* k2base; unsigned k2pitch;
    int row_ctx, nt;
};
template <int DQ  , bool NOMAX  >
__device__ __forceinline__ void attn_unit2(LAS unsigned char* lds, const AU2& a) {
    constexpr int NS = DQ / 16;
    constexpr int BUFB = (DQ == 96) ? 20480 : 16384;
    const int tid = ltid(), lane = tid & 63, wid = __builtin_amdgcn_readfirstlane(tid >> 6), r32 = lane & 31, hi = lane >> 5;
    const bool upper = wid >= 4;
    const int kr = tid >> 3, cp = tid & 7;
    const int ksrc = (cp ^ ((kr >> 1) & 7)) * 8, vsrc = (cp ^ (((kr >> 1) & 1) << 2)) * 8;
    const int kr2 = 16 * wid + (lane >> 2), k2src = ((lane & 3) ^ ((kr2 >> 2) & 3)) * 8;
    unsigned koff[NS];
#pragma unroll
    for (int s = 0; s < NS; ++s) koff[s] = (s < 4) ? (unsigned)(r32 * 128 + (((2 * s + hi) ^ ((r32 >> 1) & 7)) << 4))
                                                   : (unsigned)(16384 + r32 * 64 + (((2 * (s - 4) + hi) ^ ((r32 >> 2) & 3)) << 4));
    const int vg = (lane >> 4) & 1, vq = (lane & 15) >> 2, vp = lane & 3, vsw = (vq >> 1) & 1;
    const unsigned voff0 = (unsigned)(8192 + (4 * hi + vq) * 128 + 64 * vsw + 32 * vg + 8 * vp);
    const unsigned voff1 = (unsigned)(8192 + (4 * hi + vq) * 128 + 64 * (1 - vsw) + 32 * vg + 8 * vp);
    bf16x8 qA[NS], qB[NS];
#pragma unroll
    for (int s = 0; s < NS; ++s) { qA[s] = *(const bf16x8*)(a.qptr + 16 * s + 8 * hi); qB[s] = *(const bf16x8*)(a.qptr + (size_t)32 * a.qpitch + 16 * s + 8 * hi); }
    f32x16 oA0, oA1, oB0, oB1, pA0, pA1, pB0, pB1;
    float mA = 0.f, lA = 0.f, mB = 0.f, lB = 0.f;
#pragma unroll
    for (int r = 0; r < 16; ++r) { oA0[r] = 0.f; oA1[r] = 0.f; oB0[r] = 0.f; oB1[r] = 0.f; }
    const int nt = a.nt;
    const unsigned lds0 = (unsigned)(uintptr_t)lds + (unsigned)wid * 1024u;
    auto dma = [&](int t, int boff) {
        const size_t r = (size_t)(a.row_ctx + 64 * t + kr);
        glds16(a.kbase + r * a.kpitch + ksrc, (unsigned)__builtin_amdgcn_readfirstlane((int)(lds0 + boff)));
        glds16(a.vbase + r * a.vpitch + vsrc, (unsigned)__builtin_amdgcn_readfirstlane((int)(lds0 + boff + 8192)));
        if (DQ == 96) { if (!upper) { const size_t r2 = (size_t)(a.row_ctx + 64 * t + kr2);
            glds16(a.k2base + r2 * a.k2pitch + k2src, (unsigned)__builtin_amdgcn_readfirstlane((int)(lds0 + boff + 16384))); } }
    };
    const f32x16 zero16 = {0.f, 0.f, 0.f, 0.f, 0.f, 0.f, 0.f, 0.f, 0.f, 0.f, 0.f, 0.f, 0.f, 0.f, 0.f, 0.f};
    auto QK = [&](int boff) {
        const LAS unsigned char* Bb = lds + boff;
        bf16x8 kf[2 * NS];
#pragma unroll
        for (int s = 0; s < NS; ++s) { kf[2 * s] = *(const LAS bf16x8*)(Bb + koff[s]); kf[2 * s + 1] = *(const LAS bf16x8*)(Bb + koff[s] + (s < 4 ? 4096 : 2048)); }
#pragma unroll
        for (int s = 0; s < NS; ++s) {
            pA0 = __builtin_amdgcn_mfma_f32_32x32x16_bf16(kf[2 * s], qA[s], s == 0 ? zero16 : pA0, 0, 0, 0); pA1 = __builtin_amdgcn_mfma_f32_32x32x16_bf16(kf[2 * s + 1], qA[s], s == 0 ? zero16 : pA1, 0, 0, 0);
            pB0 = __builtin_amdgcn_mfma_f32_32x32x16_bf16(kf[2 * s], qB[s], s == 0 ? zero16 : pB0, 0, 0, 0); pB1 = __builtin_amdgcn_mfma_f32_32x32x16_bf16(kf[2 * s + 1], qB[s], s == 0 ? zero16 : pB1, 0, 0, 0);
        }
        __builtin_amdgcn_sched_group_barrier(0x100, 2 * NS, 0);
        __builtin_amdgcn_sched_group_barrier(0x008, 4 * NS, 0);
    };
    auto SM = [&](f32x16& p0, f32x16& p1, f32x16& o0, f32x16& o1, float& m, float& l, bool first, bf16x8 (&pf)[4]) {
        float ls = 0.f;
        if constexpr (NOMAX) {
#pragma unroll
            for (int r = 0; r < 16; ++r) { p0[r] = __builtin_amdgcn_exp2f(p0[r]); p1[r] = __builtin_amdgcn_exp2f(p1[r]); ls += p0[r] + p1[r]; }
        } else {
            asm volatile("s_nop 15\n\ts_nop 7" : "+v"(p0), "+v"(p1));
            float ra = max3f(p0[0], p0[1], p1[0]), rb = max3f(p0[2], p0[3], p1[1]); ra = max3f(ra, p1[2], p1[3]);
#pragma unroll
            for (int r = 4; r < 16; r += 4) { ra = max3f(ra, p0[r], p0[r + 1]); rb = max3f(rb, p0[r + 2], p0[r + 3]); ra = max3f(ra, p1[r], p1[r + 1]); rb = max3f(rb, p1[r + 2], p1[r + 3]); }
            float rm = max2f(ra, rb);
            { auto rr = __builtin_amdgcn_permlane32_swap(__float_as_uint(rm), __float_as_uint(rm), false, false); rm = max2f(__uint_as_float(rr[0]), __uint_as_float(rr[1])); }
            if (first) m = rm;
            else if (__any(rm - m > THR)) { const float mn = fmaxf(m, rm); const float f = __builtin_amdgcn_exp2f(m - mn); m = mn; l *= f;
#pragma unroll
                for (int r = 0; r < 16; ++r) { o0[r] *= f; o1[r] *= f; } }
#pragma unroll
            for (int r = 0; r < 16; ++r) { p0[r] = __builtin_amdgcn_exp2f(p0[r] - m); p1[r] = __builtin_amdgcn_exp2f(p1[r] - m); ls += p0[r] + p1[r]; }
        }
        l += ls;
        u32x4 w;
        w.x = pk2(p0[0], p0[1]); w.y = pk2(p0[2], p0[3]); w.z = pk2(p0[4], p0[5]); w.w = pk2(p0[6], p0[7]); pf[0] = __builtin_bit_cast(bf16x8, w);
        w.x = pk2(p0[8], p0[9]); w.y = pk2(p0[10], p0[11]); w.z = pk2(p0[12], p0[13]); w.w = pk2(p0[14], p0[15]); pf[1] = __builtin_bit_cast(bf16x8, w);
        w.x = pk2(p1[0], p1[1]); w.y = pk2(p1[2], p1[3]); w.z = pk2(p1[4], p1[5]); w.w = pk2(p1[6], p1[7]); pf[2] = __builtin_bit_cast(bf16x8, w);
        w.x = pk2(p1[8], p1[9]); w.y = pk2(p1[10], p1[11]); w.z = pk2(p1[12], p1[13]); w.w = pk2(p1[14], p1[15]); pf[3] = __builtin_bit_cast(bf16x8, w);
    };
    bf16x8 pfA[4], pfB[4];
    auto PV = [&](int boff) {
        const LAS unsigned char* Bb = lds + boff;
        s16x4 va0[4], va1[4], vc0[4], vc1[4];
#pragma unroll
        for (int kk = 0; kk < 4; ++kk) {
            const LAS unsigned char* vb = Bb + kk * 2048;
            va0[kk] = __builtin_bit_cast(s16x4, __builtin_amdgcn_ds_read_tr16_b64_v4i16((LAS s16x4*)(vb + voff0)));
            va1[kk] = __builtin_bit_cast(s16x4, __builtin_amdgcn_ds_read_tr16_b64_v4i16((LAS s16x4*)(vb + voff0 + 1024)));
            vc0[kk] = __builtin_bit_cast(s16x4, __builtin_amdgcn_ds_read_tr16_b64_v4i16((LAS s16x4*)(vb + voff1)));
            vc1[kk] = __builtin_bit_cast(s16x4, __builtin_amdgcn_ds_read_tr16_b64_v4i16((LAS s16x4*)(vb + voff1 + 1024)));
        }
#pragma unroll
        for (int kk = 0; kk < 4; ++kk) {
            const bf16x8 va = (bf16x8){va0[kk][0], va0[kk][1], va0[kk][2], va0[kk][3], va1[kk][0], va1[kk][1], va1[kk][2], va1[kk][3]};
            const bf16x8 vc = (bf16x8){vc0[kk][0], vc0[kk][1], vc0[kk][2], vc0[kk][3], vc1[kk][0], vc1[kk][1], vc1[kk][2], vc1[kk][3]};
            oA0 = __builtin_amdgcn_mfma_f32_32x32x16_bf16(va, pfA[kk], oA0, 0, 0, 0); oA1 = __builtin_amdgcn_mfma_f32_32x32x16_bf16(vc, pfA[kk], oA1, 0, 0, 0);
            oB0 = __builtin_amdgcn_mfma_f32_32x32x16_bf16(va, pfB[kk], oB0, 0, 0, 0); oB1 = __builtin_amdgcn_mfma_f32_32x32x16_bf16(vc, pfB[kk], oB1, 0, 0, 0);
        }
        __builtin_amdgcn_sched_group_barrier(0x100, 16, 0);
        __builtin_amdgcn_sched_group_barrier(0x008, 16, 0);
    };
#define ATT_WAIT_BAR(N) do { asm volatile("s_waitcnt vmcnt(" #N ") lgkmcnt(0)" ::: "memory"); __builtin_amdgcn_s_barrier(); asm volatile("" ::: "memory"); } while (0)
    constexpr int RING = 6, DIST = RING - 1;
    auto wait_bar = [&](int ntiles) {
        if (DQ == 96 && !upper) { switch (ntiles) { case 4: ATT_WAIT_BAR(12); break; case 3: ATT_WAIT_BAR(9); break; case 2: ATT_WAIT_BAR(6); break; case 1: ATT_WAIT_BAR(3); break; default: ATT_WAIT_BAR(0); } }
        else { switch (ntiles) { case 4: ATT_WAIT_BAR(8); break; case 3: ATT_WAIT_BAR(6); break; case 2: ATT_WAIT_BAR(4); break; case 1: ATT_WAIT_BAR(2); break; default: ATT_WAIT_BAR(0); } } };
    if (upper) __builtin_amdgcn_s_setprio(1);
    int issued = 0;
    for (; issued < DIST && issued < nt; ++issued) dma(issued, issued * BUFB);
    wait_bar(issued - 1);
    int b_cur = 0, b_iss = (DIST % RING) * BUFB;
    for (int t = 0; t < nt; ++t) {
        if (issued < nt) { dma(issued, b_iss); ++issued; b_iss += BUFB; if (b_iss == RING * BUFB) b_iss = 0; }
        QK(b_cur);
        SM(pA0, pA1, oA0, oA1, mA, lA, t == 0, pfA);
        SM(pB0, pB1, oB0, oB1, mB, lB, t == 0, pfB);
        PV(b_cur);
        { const int infl = issued - t - 2; wait_bar(infl < 0 ? 0 : infl); }
        b_cur += BUFB; if (b_cur == RING * BUFB) b_cur = 0;
    }
#undef ATT_WAIT_BAR
    if (upper) __builtin_amdgcn_s_setprio(0);
    { auto rr = __builtin_amdgcn_permlane32_swap(__float_as_uint(lA), __float_as_uint(lA), false, false); lA = __uint_as_float(rr[0]) + __uint_as_float(rr[1]); }
    { auto rr = __builtin_amdgcn_permlane32_swap(__float_as_uint(lB), __float_as_uint(lB), false, false); lB = __uint_as_float(rr[0]) + __uint_as_float(rr[1]); }
    const float invA = 1.f / lA, invB = 1.f / lB; bf16_t* oB = a.optr + (size_t)32 * 1024;
#pragma unroll
    for (int ig = 0; ig < 4; ++ig) {
        u32x2 w0, w1;
        w0.x = pk2(oA0[4 * ig] * invA, oA0[4 * ig + 1] * invA); w0.y = pk2(oA0[4 * ig + 2] * invA, oA0[4 * ig + 3] * invA);
        w1.x = pk2(oA1[4 * ig] * invA, oA1[4 * ig + 1] * invA); w1.y = pk2(oA1[4 * ig + 2] * invA, oA1[4 * ig + 3] * invA);
        *(u32x2*)(a.optr + 8 * ig + 4 * hi) = w0; *(u32x2*)(a.optr + 32 + 8 * ig + 4 * hi) = w1;
        w0.x = pk2(oB0[4 * ig] * invB, oB0[4 * ig + 1] * invB); w0.y = pk2(oB0[4 * ig + 2] * invB, oB0[4 * ig + 3] * invB);
        w1.x = pk2(oB1[4 * ig] * invB, oB1[4 * ig + 1] * invB); w1.y = pk2(oB1[4 * ig + 2] * invB, oB1[4 * ig + 3] * invB);
        *(u32x2*)(oB + 8 * ig + 4 * hi) = w0; *(u32x2*)(oB + 32 + 8 * ig + 4 * hi) = w1;
    }
}

struct Job { const float* src; bf16_t* dst; int K, N, ldd, nb; size_t sbs, dbs; int mode; const float* rscale; };

__device__ __forceinline__ int hperm64(int c) { const int base = c & ~63, cl = c & 63, p = cl >> 1, n = cl & 1, g = p >> 4, i = p & 15; return base + 32 * g + 16 * n + i; }
__device__ __forceinline__ int rowmap(int mode, int c) {
    switch (mode) {
        case 1: return c < 640 ? hperm64(c) : c;
        case 2: if ((c >= 384 && c < 896) || (c >= 1184 && c < 1312)) { const int b0 = (c >= 1184) ? 1184 : 384; return b0 + hperm64(c - b0); }
                if (c >= 1152 && c < 1184) { const int cl = c - 1152; return 1152 + 16 * (cl & 1) + (cl >> 1); }
                return c;
        case 3: { const int h = c / 96, cl = c % 96; if (cl < 64) return c; const int r = cl - 64; return h * 96 + 64 + 16 * (r & 1) + (r >> 1); }
        case 4: return 32 * (c >> 4) + (c & 15);
        case 5: return 32 * (c >> 4) + 16 + (c & 15);
        default: return c;
    }
}
__device__ __forceinline__ float colscale(int mode, int c) {
    if (mode == 1) return (c < 512 || (c >= 768 && c < 1280)) ? QS64 : 1.f;
    if (mode == 3) return QS96;
    return 1.f;
}
__device__ __forceinline__ bool get_job(PP P, int j, Job& J) {
    const int layer = j >= 9 ? 1 : 0, jj = layer ? j - 9 : j; const int ib = layer ? 20 : 4;
    bf16_t* W = (bf16_t*)(P->ws + (layer ? WS_W1 : WS_W0));
    J.nb = 1; J.sbs = 0; J.dbs = 0; J.rscale = nullptr; J.mode = 0; J.ldd = 1024; J.K = 1024;
    switch (jj) {
        case 0: J.src = P->in[ib + 3]; J.dst = W + WO_IN; J.N = layer ? 1440 : 2304; J.mode = layer ? 2 : 1; break;
        case 1: J.src = P->in[layer ? 30 : 10]; J.dst = W + WO_OUT; J.N = 1024; break;
        case 2: J.src = P->in[layer ? 32 : 12]; J.dst = W + WO_RT; J.N = 64; J.mode = 7; break;
        case 3: J.src = P->in[layer ? 34 : 14]; J.dst = W + WO_GU; J.N = 256; J.nb = 64; J.sbs = (size_t)1024 * 256; J.dbs = (size_t)512 * 1024; J.mode = 4; break;
        case 4: J.src = P->in[layer ? 35 : 15]; J.dst = W + WO_GU; J.N = 256; J.nb = 64; J.sbs = (size_t)1024 * 256; J.dbs = (size_t)512 * 1024; J.mode = 5; break;
        case 5: J.src = P->in[layer ? 36 : 16]; J.dst = W + WO_D; J.K = 256; J.N = 1024; J.ldd = 256; J.nb = 64; J.sbs = (size_t)256 * 1024; J.dbs = (size_t)1024 * 256; break;
        case 6: J.src = P->in[layer ? 37 : 17]; J.dst = W + WO_GU + (size_t)64 * 512 * 1024; J.N = 256; J.mode = 4; break;
        case 7: J.src = P->in[layer ? 38 : 18]; J.dst = W + WO_GU + (size_t)64 * 512 * 1024; J.N = 256; J.mode = 5; break;
        case 8: J.src = P->in[layer ? 39 : 19]; J.dst = W + WO_D + (size_t)64 * 1024 * 256; J.K = 256; J.N = 1024; J.ldd = 256; break;
        case 9: J.src = P->in[25]; J.dst = W + WO_UQ; J.K = 384; J.N = 768; J.ldd = 384; J.mode = 3; J.rscale = P->in[24]; break;
        case 10: J.src = P->in[27]; J.dst = W + WO_UKV; J.K = 256; J.N = 1024; J.ldd = 256; J.mode = 6; J.rscale = P->in[26]; break;
        default: return false;
    }
    return true;
}
constexpr int NJOBS = 20;
__device__ __forceinline__ int job_tiles(const Job& J) { return J.nb * (J.K >> 6) * ((J.N + 255) >> 8); }

__device__ __forceinline__ void conv_tile(const Job& J, int tile, LAS float* T) {
    const int tid = ltid(); const int ntn = (J.N + 255) >> 8, ntk = J.K >> 6;
    const int b = tile / (ntn * ntk), r = tile % (ntn * ntk), tk = r / ntn, tn = r % ntn;
    const float* src = J.src + (size_t)b * J.sbs; bf16_t* dst = J.dst + (size_t)b * J.dbs; const int k0 = tk * 64, n0 = tn * 256;
    { const int n4 = (tid & 63) * 4; const bool ok = (n0 + n4) < J.N;
      f32x4 v[8];
#pragma unroll
      for (int j = 0; j < 8; ++j) { const int k = (tid >> 6) + 8 * j; v[j] = ok ? *(const f32x4*)(src + (size_t)(k0 + k) * J.N + n0 + n4) : (f32x4){0.f, 0.f, 0.f, 0.f}; }
      f32x4 cs; cs[0] = colscale(J.mode, n0 + n4); cs[1] = colscale(J.mode, n0 + n4 + 1); cs[2] = colscale(J.mode, n0 + n4 + 2); cs[3] = colscale(J.mode, n0 + n4 + 3);
#pragma unroll
      for (int j = 0; j < 8; ++j) { const int k = (tid >> 6) + 8 * j; f32x4 x = v[j] * cs; if (J.rscale) x = x * J.rscale[k0 + k]; *(LAS f32x4*)(T + k * 260 + n4) = x; } }
    __syncthreads();
    { const int nn = tid >> 1, kh = (tid & 1) * 32;
      if (n0 + nn < J.N) { const int drow = rowmap(J.mode, n0 + nn); bf16_t* dp = dst + (size_t)drow * J.ldd + k0 + kh;
#pragma unroll
          for (int q = 0; q < 4; ++q) { float v[8];
#pragma unroll
              for (int j = 0; j < 8; ++j) v[j] = T[(kh + 8 * q + j) * 260 + nn];
              u32x4 w; w.x = pk2(v[0], v[1]); w.y = pk2(v[2], v[3]); w.z = pk2(v[4], v[5]); w.w = pk2(v[6], v[7]);
              *(u32x4*)(dp + 8 * q) = w;
              if (J.mode == 7) { u32x4 w2;
                  w2.x = pk2(v[0] - bflo(w.x), v[1] - bfhi(w.x)); w2.y = pk2(v[2] - bflo(w.y), v[3] - bfhi(w.y));
                  w2.z = pk2(v[4] - bflo(w.z), v[5] - bfhi(w.z)); w2.w = pk2(v[6] - bflo(w.w), v[7] - bfhi(w.w));
                  *(u32x4*)(dp + (size_t)64 * 1024 + 8 * q) = w2; } } } }
    __syncthreads();
}

__device__ __forceinline__ void ada_item(PP P, int item, LAS float* S) {
    const int tid = ltid(); const int layer = item / 96, chunk = item % 96;
    for (int idx = tid; idx < 33 * 1024; idx += 512) { const int r = idx >> 10, k = idx & 1023; const float x = (r < 32) ? P->in[1][r * 1024 + k] : P->in[3][k]; S[idx] = x / (1.f + expf(-x)); }
    __syncthreads();
    const int col = chunk * 64 + (tid & 63), kg = tid >> 6;
    float acc[33];
#pragma unroll
    for (int r = 0; r < 33; ++r) acc[r] = 0.f;
    const float* W = P->in[layer ? 20 : 4] + col;
    for (int k = kg * 128; k < kg * 128 + 128; ++k) { const float w = W[(size_t)k * 6144];
#pragma unroll
        for (int r = 0; r < 33; ++r) acc[r] += S[r * 1024 + k] * w; }
    __syncthreads();
#pragma unroll
    for (int r = 0; r < 33; ++r) S[(kg * 33 + r) * 64 + (tid & 63)] = acc[r];
    __syncthreads();
    float* ada = (float*)(P->ws + WS_ADA) + (size_t)layer * 33 * 6144; const float* bias = P->in[layer ? 21 : 5];
    for (int idx = tid; idx < 33 * 64; idx += 512) { const int r = idx >> 6, cc = idx & 63; float s = 0.f;
#pragma unroll
        for (int g = 0; g < 8; ++g) s += S[(g * 33 + r) * 64 + cc];
        ada[(size_t)r * 6144 + chunk * 64 + cc] = s + bias[chunk * 64 + cc]; }
    __syncthreads();
}

__device__ __forceinline__ void phase_prologue(PP P, LAS unsigned char* lds, int c, int G) {
    const int tid = ltid();
    for (int it = c; it < 192; it += G) ada_item(P, it, (LAS float*)lds);
    { float* rp = (float*)(P->ws + WS_ROPE); float* cosh_ = rp; float* sinh_ = rp + 2048 * 32; float* cosr_ = rp + 2 * 2048 * 32; float* sinr_ = cosr_ + 2048 * 16;
      for (int idx = c * 512 + tid; idx < 2048 * 48; idx += G * 512) {
          if (idx < 2048 * 32) { const int t = idx >> 5, p = idx & 31; const float pos = (p < 16) ? (float)(t >> 6) : (float)(t & 63); const int i = p & 15;
              const float inv = powf(10000.0f, -(float)i / 16.0f); const float ang = pos * inv; cosh_[idx] = cosf(ang); sinh_[idx] = sinf(ang); }
          else { const int k = idx - 2048 * 32; const int t = k >> 4, p = k & 15; const float pos = (p < 8) ? (float)(t >> 6) : (float)(t & 63); const int i = p & 7;
              const float inv = powf(10000.0f, -(float)i / 8.0f); const float ang = pos * inv; cosr_[k] = cosf(ang); sinr_[k] = sinf(ang); } } }
    { u32x4* z = (u32x4*)((bf16_t*)(P->ws + WS_W1) + WO_IN + (size_t)1440 * 1024); for (int idx = c * 512 + tid; idx < 96 * 1024 / 8; idx += G * 512) z[idx] = (u32x4){0u, 0u, 0u, 0u}; }
    { int base = 0; int tile = c;
      for (int j = 0; j < NJOBS; ++j) { Job J; get_job(P, j, J); const int n = job_tiles(J);
          while (tile < base + n) { conv_tile(J, tile - base, (LAS float*)lds); tile += G; }
          base += n; } }
}

__device__ __forceinline__ void phase_norm(PP P, int c, int G, const float* xlat, const float* xctx, const float* g, const float* ada  , int sh_off, int sc_off, bool latent_only, bf16_t* H, bf16_t* HLO,
                                           const bool resid = false, float* xlat_dst = nullptr, float* xctx_dst = nullptr) {
    const int tid_ = ltid(); const int lane = tid_ & 63, wv = c * 8 + (tid_ >> 6), nw = G * 8;
    for (int row = wv; row < MROWS; row += nw) {
        const int b = row / TOK, t = row % TOK; const bool ctx = t < CTX;
        if (ctx && latent_only) continue;
        const float* x = ctx ? xctx + ((size_t)b * CTX + t) * 1024 : xlat + ((size_t)b * SEQ + t - CTX) * 1024;
        const float* ap = ada + (size_t)(ctx ? 32 : b) * 6144;
        f32x4 v[4]; float ss = 0.f;
#pragma unroll
        for (int i = 0; i < 2; ++i) { v[2 * i] = *(const f32x4*)(x + 512 * i + 8 * lane); v[2 * i + 1] = *(const f32x4*)(x + 512 * i + 8 * lane + 4); }
        if (resid) {
            float* xd = ctx ? xctx_dst + ((size_t)b * CTX + t) * 1024 : xlat_dst + ((size_t)b * SEQ + t - CTX) * 1024;
#pragma unroll
            for (int i = 0; i < 2; ++i) { const u32x4 yw = *(const u32x4*)(HLO + (size_t)row * 1024 + 512 * i + 8 * lane);
                const f32x4 g0 = *(const f32x4*)(ap + 2048 + 512 * i + 8 * lane), g1 = *(const f32x4*)(ap + 2048 + 512 * i + 8 * lane + 4);
                v[2 * i][0] += g0[0] * bflo(yw.x); v[2 * i][1] += g0[1] * bfhi(yw.x); v[2 * i][2] += g0[2] * bflo(yw.y); v[2 * i][3] += g0[3] * bfhi(yw.y);
                v[2 * i + 1][0] += g1[0] * bflo(yw.z); v[2 * i + 1][1] += g1[1] * bfhi(yw.z); v[2 * i + 1][2] += g1[2] * bflo(yw.w); v[2 * i + 1][3] += g1[3] * bfhi(yw.w);
                *(f32x4*)(xd + 512 * i + 8 * lane) = v[2 * i]; *(f32x4*)(xd + 512 * i + 8 * lane + 4) = v[2 * i + 1]; }
        }
#pragma unroll
        for (int i = 0; i < 4; ++i) ss += v[i][0] * v[i][0] + v[i][1] * v[i][1] + v[i][2] * v[i][2] + v[i][3] * v[i][3];
        ss = wave_sum(ss); const float rstd = rsqrtf(ss * (1.f / 1024.f) + EPS);
#pragma unroll
        for (int i = 0; i < 2; ++i) { const int col = 512 * i + 8 * lane; float o[8];
#pragma unroll
            for (int h = 0; h < 2; ++h) { const f32x4 gg = *(const f32x4*)(g + col + 4 * h), sc = *(const f32x4*)(ap + sc_off + col + 4 * h), sh = *(const f32x4*)(ap + sh_off + col + 4 * h);
#pragma unroll
                for (int j = 0; j < 4; ++j) o[4 * h + j] = v[2 * i + h][j] * rstd * gg[j] * (1.f + sc[j]) + sh[j]; }
            u32x4 w; w.x = pk2(o[0], o[1]); w.y = pk2(o[2], o[3]); w.z = pk2(o[4], o[5]); w.w = pk2(o[6], o[7]);
            *(u32x4*)(H + (size_t)row * 1024 + col) = w;
            if (HLO) { u32x4 w2; w2.x = pk2(o[0] - bflo(w.x), o[1] - bfhi(w.x)); w2.y = pk2(o[2] - bflo(w.y), o[3] - bfhi(w.y)); w2.z = pk2(o[4] - bflo(w.z), o[5] - bfhi(w.z)); w2.w = pk2(o[6] - bflo(w.w), o[7] - bfhi(w.w));
                *(u32x4*)(HLO + (size_t)row * 1024 + col) = w2; } }
    }
}

__device__ __forceinline__ void phase_post1(PP P, int c, int G) {
    const int tid_ = ltid(); const int lane = tid_ & 63, wv = c * 8 + (tid_ >> 6), nw = G * 8;
    bf16_t* Pb = (bf16_t*)(P->ws + WS_BIG + BIG_P); float* RS = (float*)(P->ws + WS_RSTD);
    const float* rp = (const float*)(P->ws + WS_ROPE); const float* cosh_ = rp; const float* sinh_ = rp + 2048 * 32; const float* cosr_ = rp + 2 * 2048 * 32; const float* sinr_ = cosr_ + 2048 * 16;
    const float* gqn = P->in[28]; const float* gkn = P->in[29];
    for (int row = wv; row < MROWS; row += nw) {
        bf16_t* pr = Pb + (size_t)row * 1536; const int t = row % TOK; const bool lat = t >= CTX; const int tt = t - CTX;
        float s1 = 0.f, s2 = 0.f;
        if (lane < 48) { const u32x4 w = *(const u32x4*)(pr + 8 * lane); const float a0 = bflo(w.x), a1 = bfhi(w.x), a2 = bflo(w.y), a3 = bfhi(w.y), a4 = bflo(w.z), a5 = bfhi(w.z), a6 = bflo(w.w), a7 = bfhi(w.w);
            s1 = a0 * a0 + a1 * a1 + a2 * a2 + a3 * a3 + a4 * a4 + a5 * a5 + a6 * a6 + a7 * a7; }
        if (lane < 32) { const u32x4 w = *(const u32x4*)(pr + 896 + 8 * lane); const float a0 = bflo(w.x), a1 = bfhi(w.x), a2 = bflo(w.y), a3 = bfhi(w.y), a4 = bflo(w.z), a5 = bfhi(w.z), a6 = bflo(w.w), a7 = bfhi(w.w);
            s2 = a0 * a0 + a1 * a1 + a2 * a2 + a3 * a3 + a4 * a4 + a5 * a5 + a6 * a6 + a7 * a7; }
        s1 = wave_sum(s1); s2 = wave_sum(s2);
        if (lane == 0) { RS[(size_t)row * 2] = rsqrtf(s1 * (1.f / 384.f) + EPS); RS[(size_t)row * 2 + 1] = rsqrtf(s2 * (1.f / 256.f) + EPS); }
#pragma unroll
        for (int ps = 0; ps < 2; ++ps) {
            const int Gi = lane >> 2, qd = lane & 3; const bool on = (ps == 0) || (lane < 16);
            bf16_t* base = pr + (ps == 0 ? 384 : 1184) + 32 * Gi + 4 * qd;
            float x0[4] = {0.f, 0.f, 0.f, 0.f}, x1[4] = {0.f, 0.f, 0.f, 0.f};
            if (on) { const u32x2 w0 = *(const u32x2*)base, w1 = *(const u32x2*)(base + 16);
                x0[0] = bflo(w0.x); x0[1] = bfhi(w0.x); x0[2] = bflo(w0.y); x0[3] = bfhi(w0.y); x1[0] = bflo(w1.x); x1[1] = bfhi(w1.x); x1[2] = bflo(w1.y); x1[3] = bfhi(w1.y); }
            float ss = 0.f;
#pragma unroll
            for (int j = 0; j < 4; ++j) ss += x0[j] * x0[j] + x1[j] * x1[j];
            ss += __shfl_xor(ss, 1); ss += __shfl_xor(ss, 2); ss += __shfl_xor(ss, 4);
            const float rstd = rsqrtf(ss * (1.f / 64.f) + EPS);
            const int gsel = Gi & 1; const float* gn = ps == 0 ? gqn : gkn; const float qs = ps == 0 ? QS64 : 1.f;
            if (on) { float y0[4], y1[4];
#pragma unroll
                for (int j = 0; j < 4; ++j) { const int pidx = 16 * gsel + 4 * qd + j; y0[j] = x0[j] * rstd * gn[2 * pidx]; y1[j] = x1[j] * rstd * gn[2 * pidx + 1];
                    if (lat) { const float cs = cosh_[(size_t)tt * 32 + pidx], sn = sinh_[(size_t)tt * 32 + pidx]; const float a = y0[j] * cs - y1[j] * sn, bb = y0[j] * sn + y1[j] * cs; y0[j] = a; y1[j] = bb; }
                    y0[j] *= qs; y1[j] *= qs; }
                u32x2 w0, w1; w0.x = pk2(y0[0], y0[1]); w0.y = pk2(y0[2], y0[3]); w1.x = pk2(y1[0], y1[1]); w1.y = pk2(y1[2], y1[3]);
                *(u32x2*)base = w0; *(u32x2*)(base + 16) = w1; }
        }
        if (lat && lane < 4) { bf16_t* base = pr + 1152 + 4 * lane; const u32x2 w0 = *(const u32x2*)base, w1 = *(const u32x2*)(base + 16);
            float x0[4] = {bflo(w0.x), bfhi(w0.x), bflo(w0.y), bfhi(w0.y)}, x1[4] = {bflo(w1.x), bfhi(w1.x), bflo(w1.y), bfhi(w1.y)}; float y0[4], y1[4];
#pragma unroll
            for (int j = 0; j < 4; ++j) { const int pidx = 4 * lane + j; const float cs = cosr_[(size_t)tt * 16 + pidx], sn = sinr_[(size_t)tt * 16 + pidx]; y0[j] = x0[j] * cs - x1[j] * sn; y1[j] = x0[j] * sn + x1[j] * cs; }
            u32x2 o0, o1; o0.x = pk2(y0[0], y0[1]); o0.y = pk2(y0[2], y0[3]); o1.x = pk2(y1[0], y1[1]); o1.y = pk2(y1[2], y1[3]);
            *(u32x2*)base = o0; *(u32x2*)(base + 16) = o1; }
    }
}

__device__ __forceinline__ void phase_router(PP P, LAS unsigned char* lds, int c, int G, int layer) {
    const int tid = ltid(), lane = tid & 63, wid = tid >> 6, r32 = lane & 31, hi = lane >> 5;
    const bf16_t* H = (const bf16_t*)(P->ws + WS_H); const bf16_t* HLO = (const bf16_t*)(P->ws + WS_BIG + BIG_HLO);
    const bf16_t* W = (const bf16_t*)(P->ws + (layer ? WS_W1 : WS_W0)) + WO_RT; const bf16_t* WL = W + 64 * 1024;
    const float* brt = P->in[layer ? 33 : 13];
    int* cnt = (int*)(P->ws + WS_CTL + CTL_CNT) + layer * NG; int* srow = (int*)(P->ws + WS_SROW); float* sw = (float*)(P->ws + WS_SW); int* tslot = (int*)(P->ws + WS_TSLOT);
    LAS float* L = (LAS float*)lds + wid * (32 * 65);
    const int ngroups = MROWS / 32;
    for (int gidx = c * 8 + wid; gidx < ngroups; gidx += G * 8) {
        const int row0 = gidx * 32; const int t0 = row0 % TOK;
        if (layer == 1 && t0 < CTX) continue;
        f32x16 a0, a1;
#pragma unroll
        for (int r = 0; r < 16; ++r) { a0[r] = 0.f; a1[r] = 0.f; }
        const bf16_t* hp = H + (size_t)(row0 + r32) * 1024 + 8 * hi; const bf16_t* hl = HLO + (size_t)(row0 + r32) * 1024 + 8 * hi;
        const bf16_t* w0 = W + (size_t)r32 * 1024 + 8 * hi; const bf16_t* wl0 = WL + (size_t)r32 * 1024 + 8 * hi;
#pragma unroll 4
        for (int s = 0; s < 64; ++s) {
            const bf16x8 xh = *(const bf16x8*)(hp + 16 * s), xl = *(const bf16x8*)(hl + 16 * s);
            const bf16x8 wa = *(const bf16x8*)(w0 + 16 * s), wb = *(const bf16x8*)(w0 + 32 * 1024 + 16 * s);
            const bf16x8 la = *(const bf16x8*)(wl0 + 16 * s), lb = *(const bf16x8*)(wl0 + 32 * 1024 + 16 * s);
            a0 = __builtin_amdgcn_mfma_f32_32x32x16_bf16(wa, xh, a0, 0, 0, 0); a1 = __builtin_amdgcn_mfma_f32_32x32x16_bf16(wb, xh, a1, 0, 0, 0);
            a0 = __builtin_amdgcn_mfma_f32_32x32x16_bf16(wa, xl, a0, 0, 0, 0); a1 = __builtin_amdgcn_mfma_f32_32x32x16_bf16(wb, xl, a1, 0, 0, 0);
            a0 = __builtin_amdgcn_mfma_f32_32x32x16_bf16(la, xh, a0, 0, 0, 0); a1 = __builtin_amdgcn_mfma_f32_32x32x16_bf16(lb, xh, a1, 0, 0, 0);
        }
#pragma unroll
        for (int r = 0; r < 16; ++r) { const int e = (r & 3) + 8 * (r >> 2) + 4 * hi; L[r32 * 65 + e] = a0[r]; L[r32 * 65 + e + 32] = a1[r]; }
        __builtin_amdgcn_s_waitcnt(0xC07F);
        __builtin_amdgcn_wave_barrier();
        if (lane < 32) {
            const int row = row0 + lane; float bk[6], bs[6]; int bi[6];
#pragma unroll
            for (int k = 0; k < 6; ++k) { bk[k] = -1e30f; bs[k] = 0.f; bi[k] = 0; }
            for (int e = 0; e < 64; ++e) { const float x = L[lane * 65 + e]; const float sc = 1.f / (1.f + expf(-x)); float key = sc + brt[e]; float s = sc; int id = e;
#pragma unroll
                for (int k = 0; k < 6; ++k) { if (key > bk[k]) { const float tk = bk[k], ts = bs[k]; const int ti = bi[k]; bk[k] = key; bs[k] = s; bi[k] = id; key = tk; s = ts; id = ti; } } }
            float tot = 0.f;
#pragma unroll
            for (int k = 0; k < 6; ++k) tot += bs[k];
            const float sc = 2.5f / tot; const int ch = row / CHUNK_ROWS;
#pragma unroll
            for (int k = 0; k < 6; ++k) { const int e = bi[k]; const int pos = atomicAdd(cnt + ch * NGRP + e, 1);
                if (pos < CAP) { srow[(size_t)(ch * 64 + e) * CAP + pos] = row; sw[(size_t)(ch * 64 + e) * CAP + pos] = bs[k] * sc; }
                tslot[(size_t)row * 6 + k] = (e << 20) | pos; }
        }
        __builtin_amdgcn_wave_barrier();
    }
    if (c == 0 && tid < NCHUNK) cnt[tid * NGRP + NEXP] = layer ? CHUNK_B * SEQ : CHUNK_ROWS;
}

__device__ __forceinline__ void build_toff(LAS int* toff, const int* cnt) {
    const int tid = ltid();
    if (tid < 64) { int v[5], s = 0;
#pragma unroll
        for (int j = 0; j < 5; ++j) { const int g = tid * 5 + j; const int cv = (g < NG) ? ld_ctl(cnt + g) : 0; if (g < NG) toff[272 + g] = cv; v[j] = (cv + 255) >> 8; s += v[j]; }
        int inc = s;
#pragma unroll
        for (int o = 1; o < 64; o <<= 1) { const int t = __shfl_up(inc, o); if (tid >= o) inc += t; }
        int ex = inc - s;
#pragma unroll
        for (int j = 0; j < 5; ++j) { const int g = tid * 5 + j; if (g <= NG) toff[g] = ex; ex += v[j]; } }
    __syncthreads();
}

__device__ __forceinline__ void phase_combine(PP P, LAS unsigned char* lds, int c, int G, int layer, int ch) {
    const int tid_ = ltid(); const int lane = tid_ & 63, wv = c * 8 + (tid_ >> 6), nw = G * 8;
    LAS const int* toff = (LAS const int*)(lds + LDS_TAB);
    const bf16_t* slab = (const bf16_t*)(P->ws + WS_BIG + BIG_SLAB); const int* tslot = (const int*)(P->ws + WS_TSLOT);
    const float* ada = (const float*)(P->ws + WS_ADA) + (size_t)layer * 33 * 6144; const float* ada1 = (const float*)(P->ws + WS_ADA) + (size_t)33 * 6144;
    float* xc = (float*)(P->ws + WS_XC); bf16_t* H = (bf16_t*)(P->ws + WS_H);
    const int t0 = toff[ch * NGRP];
    for (int rr = wv; rr < CHUNK_ROWS; rr += nw) {
        const int row = ch * CHUNK_ROWS + rr; const int b = row / TOK, t = row % TOK; const bool ctx = t < CTX;
        if (ctx && layer == 1) continue;
        int sidx = 0;
        if (lane < 6) { const int v = __hip_atomic_load(tslot + (size_t)row * 6 + lane, __ATOMIC_RELAXED, __HIP_MEMORY_SCOPE_AGENT); sidx = (toff[ch * NGRP + (v >> 20)] - t0) * 256 + (v & 0xfffff); }
        if (lane == 6) { const int rank = layer ? ((b - ch * CHUNK_B) * SEQ + t - CTX) : rr; sidx = (toff[ch * NGRP + NEXP] - t0) * 256 + rank; }
        float* x = ctx ? xc + ((size_t)b * CTX + t) * 1024 : P->out + ((size_t)b * SEQ + t - CTX) * 1024;
        const float* ap = ada + (size_t)(ctx ? 32 : b) * 6144 + 5 * 1024;
        f32x4 xv[4];
#pragma unroll
        for (int i = 0; i < 4; ++i) xv[i] = *(const f32x4*)(x + 512 * (i >> 1) + 8 * lane + 4 * (i & 1));
        float acc[16];
#pragma unroll
        for (int j = 0; j < 16; ++j) acc[j] = 0.f;
#pragma unroll
        for (int k = 0; k < 7; ++k) { const int s = __shfl(sidx, k); const bf16_t* sp = slab + (size_t)s * 1024;
#pragma unroll
            for (int i = 0; i < 2; ++i) { const u32x4 w = __builtin_nontemporal_load((const u32x4*)(sp + 512 * i + 8 * lane));
                acc[8 * i + 0] += bflo(w.x); acc[8 * i + 1] += bfhi(w.x); acc[8 * i + 2] += bflo(w.y); acc[8 * i + 3] += bfhi(w.y);
                acc[8 * i + 4] += bflo(w.z); acc[8 * i + 5] += bfhi(w.z); acc[8 * i + 6] += bflo(w.w); acc[8 * i + 7] += bfhi(w.w); } }
        float v[16]; float ss = 0.f;
#pragma unroll
        for (int i = 0; i < 4; ++i) { const f32x4 gq = *(const f32x4*)(ap + 512 * (i >> 1) + 8 * lane + 4 * (i & 1));
#pragma unroll
            for (int j = 0; j < 4; ++j) { const float y = xv[i][j] + gq[j] * acc[4 * i + j]; v[4 * i + j] = y; ss += y * y; } }
        ss = wave_sum(ss); const float rstd = rsqrtf(ss * (1.f / 1024.f) + EPS);
        if (layer == 0) {
            const float* gm1 = P->in[22]; const float* a1 = ada1 + (size_t)(ctx ? 32 : b) * 6144; float o[16];
#pragma unroll
            for (int i = 0; i < 4; ++i) { const int col = 512 * (i >> 1) + 8 * lane + 4 * (i & 1);
                *(f32x4*)(x + col) = (f32x4){v[4 * i], v[4 * i + 1], v[4 * i + 2], v[4 * i + 3]};
                const f32x4 gg = *(const f32x4*)(gm1 + col), sc = *(const f32x4*)(a1 + 1024 + col), sh = *(const f32x4*)(a1 + col);
#pragma unroll
                for (int j = 0; j < 4; ++j) o[4 * i + j] = v[4 * i + j] * rstd * gg[j] * (1.f + sc[j]) + sh[j]; }
#pragma unroll
            for (int i = 0; i < 2; ++i) { u32x4 w; w.x = pk2(o[8 * i], o[8 * i + 1]); w.y = pk2(o[8 * i + 2], o[8 * i + 3]); w.z = pk2(o[8 * i + 4], o[8 * i + 5]); w.w = pk2(o[8 * i + 6], o[8 * i + 7]);
                *(u32x4*)(H + (size_t)row * 1024 + 512 * i + 8 * lane) = w; }
        } else {
            const float* gf = P->in[40];
#pragma unroll
            for (int i = 0; i < 4; ++i) { const int col = 512 * (i >> 1) + 8 * lane + 4 * (i & 1); const f32x4 gg = *(const f32x4*)(gf + col); f32x4 o;
#pragma unroll
                for (int j = 0; j < 4; ++j) o[j] = v[4 * i + j] * rstd * gg[j];
                *(f32x4*)(x + col) = o; }
        }
    }
}

__device__ __forceinline__ int remap64(int c, int i, int G) { return c + i * G; }
__device__ __forceinline__ int remap8(int c, int G) { return c; }
__device__ __forceinline__ void phase_attn0(PP P, LAS unsigned char* lds, int c, int G) {
    const int tid = ltid(), lane = tid & 63, wid = __builtin_amdgcn_readfirstlane(tid >> 6), r32 = lane & 31;
    const bf16_t* QKV = (const bf16_t*)(P->ws + WS_BIG + BIG_QKV); bf16_t* ATT = (bf16_t*)(P->ws + WS_H);
    const float* sink = P->in[8]; const float* rpb = P->in[9];
    for (int i = 0; c + i * G < 2048; ++i) {
        const int u = remap64(c, i, G); const int b = u >> 6, kvh = (u >> 5) & 1, blk = u & 31; const int g = wid & 3, ts = wid >> 2; const int head = kvh * 4 + g;
        AU a; const int tok = blk * 64 + 32 * ts + r32; const size_t qrow = (size_t)b * TOK + CTX + tok;
        a.qptr = QKV + qrow * 2304 + head * 64; a.optr = ATT + qrow * 1024 + head * 64;
        a.kbase = QKV + 512 + kvh * 64; a.kpitch = 2304; a.vbase = QKV + 640 + kvh * 64; a.vpitch = 2304; a.k2base = nullptr; a.k2pitch = 0;
        a.row_ctx = b * TOK; a.row_lat = b * TOK + CTX; a.start = blk * 64;
        const int jlo = blk >= 2 ? 0 : 2 - blk; int jhi = (2048 + 128 - blk * 64) / 64; jhi = jhi > 5 ? 5 : jhi;
        a.j0 = jlo; a.nt = 4 + (jhi - jlo); a.qoff = 32 * ts + r32; a.m0 = sink[head] * LOG2E; a.l0 = 1.f;
        attn_unit<1, 64>(lds, a);
    }
    for (int i = 0; c + i * G < 2048; ++i) {
        const int u = remap64(c, i, G); const int b = u >> 6, head = (u >> 3) & 7, uu = u & 7;
        { LAS float* bt = (LAS float*)(lds + ATT_RPB);
          for (int idx = tid; idx < 15 * 128; idx += 512) { const int dr = idx >> 7, dc = (idx & 127) - 48; bt[idx] = (dc >= 0 && dc <= 30) ? rpb[(head * 15 + dr) * 31 + dc] * LOG2E : 0.f; } }
        AU a; const int qr = 4 * uu + (wid >> 1), qc = 32 * (wid & 1) + r32; const int tok = qr * 64 + qc; const size_t qrow = (size_t)b * TOK + CTX + tok;
        a.qptr = QKV + qrow * 2304 + 768 + head * 64; a.optr = ATT + qrow * 1024 + 512 + head * 64;
        a.kbase = QKV + 1280 + head * 64; a.kpitch = 2304; a.vbase = QKV + 1792 + head * 64; a.vpitch = 2304; a.k2base = nullptr; a.k2pitch = 0;
        a.row_ctx = b * TOK; a.row_lat = b * TOK + CTX; a.start = 0;
        int rs0 = 4 * uu - 4; rs0 = rs0 < 0 ? 0 : (rs0 > 24 ? 24 : rs0); int rl = 4 * uu - 1; rl = rl < 0 ? 0 : (rl > 24 ? 24 : rl);
        a.j0 = rs0; a.nt = 4 + (rl + 8 - rs0); a.qoff = tok; a.m0 = 0.f; a.l0 = 0.f;
        attn_unit<2, 64>(lds, a);
    }
    for (int u0 = c; u0 < 256; u0 += G) {
        const int u = remap8(u0, G); const int b = u >> 3, kvh = (u >> 2) & 1, cb = u & 3; const int g = wid & 3, ts = wid >> 2; const int head = kvh * 4 + g;
        AU a; const int tok = cb * 64 + 32 * ts + r32; const size_t qrow = (size_t)b * TOK + tok;
        a.qptr = QKV + qrow * 2304 + head * 64; a.optr = ATT + qrow * 1024 + head * 64;
        a.kbase = QKV + 512 + kvh * 64; a.kpitch = 2304; a.vbase = QKV + 640 + kvh * 64; a.vpitch = 2304; a.k2base = nullptr; a.k2pitch = 0;
        a.row_ctx = b * TOK; a.row_lat = 0; a.start = 0; a.j0 = 0; a.nt = 4; a.qoff = 0; a.m0 = sink[head] * LOG2E; a.l0 = 1.f;
        attn_unit<0, 64>(lds, a);
    }
    for (int u0 = c; u0 < 256; u0 += G) {
        const int u = remap8(u0, G); const int b = u >> 3, head = u & 7;
        AU a; const int tok = 32 * wid + r32; const size_t qrow = (size_t)b * TOK + tok;
        a.qptr = QKV + qrow * 2304 + 768 + head * 64; a.optr = ATT + qrow * 1024 + 512 + head * 64;
        a.kbase = QKV + 1280 + head * 64; a.kpitch = 2304; a.vbase = QKV + 1792 + head * 64; a.vpitch = 2304; a.k2base = nullptr; a.k2pitch = 0;
        a.row_ctx = b * TOK; a.row_lat = 0; a.start = 0; a.j0 = 0; a.nt = 4; a.qoff = 0; a.m0 = 0.f; a.l0 = 0.f;
        attn_unit<0, 64>(lds, a);
    }
}
__device__ __forceinline__ void phase_attn1(PP P, LAS unsigned char* lds, int c, int G) {
    const int tid = ltid(), lane = tid & 63, wid = __builtin_amdgcn_readfirstlane(tid >> 6), r32 = lane & 31;
    const bf16_t* PB = (const bf16_t*)(P->ws + WS_BIG + BIG_P); const bf16_t* QM = (const bf16_t*)(P->ws + WS_BIG + BIG_QM); const bf16_t* KVX = (const bf16_t*)(P->ws + WS_BIG + BIG_KVX);
    bf16_t* ATT = (bf16_t*)(P->ws + WS_H);
    for (int u = c; u < 1024; u += G) {
        const int b = u >> 5, head = (u >> 2) & 7, qb = u & 3;
        AU2 a; const int tok = qb * 512 + 64 * wid + r32; const size_t qrow = (size_t)b * TOK + CTX + tok;
        a.qptr = QM + qrow * 768 + head * 96; a.qpitch = 768; a.optr = ATT + qrow * 1024 + head * 64;
        a.kbase = KVX + head * 128; a.kpitch = 1024; a.vbase = KVX + head * 128 + 64; a.vpitch = 1024; a.k2base = PB + 1152; a.k2pitch = 1536;
        a.row_ctx = b * TOK; a.nt = 36;
        attn_unit2<96, false>(lds, a);
    }
    float gq = fabsf(P->in[28][lane]), gk = fabsf(P->in[29][lane]);
#pragma unroll
    for (int o = 32; o > 0; o >>= 1) { gq = fmaxf(gq, __shfl_xor(gq, o)); gk = fmaxf(gk, __shfl_xor(gk, o)); }
    const bool bounded = __builtin_amdgcn_readfirstlane((int)(64.f * gq * gk * QS64 < 100.f)) != 0;
    for (int u = c; u < 1024; u += G) {
        const int b = u >> 5, kvh = (u >> 4) & 1, blk = u & 15;
        if (bounded) {
            const int g = wid & 3, hf = wid >> 2; const int head = kvh * 4 + g;
            AU2 a; const int tok = blk * 128 + 64 * hf + r32; const size_t qrow = (size_t)b * TOK + CTX + tok;
            a.qptr = PB + qrow * 1536 + 384 + head * 64; a.qpitch = 1536; a.optr = ATT + qrow * 1024 + 512 + head * 64;
            a.kbase = PB + 1184 + kvh * 64; a.kpitch = 1536; a.vbase = PB + 1312 + kvh * 64; a.vpitch = 1536; a.k2base = nullptr; a.k2pitch = 0;
            a.row_ctx = b * TOK; a.nt = 36;
            attn_unit2<64, true>(lds, a);
        } else {
            for (int hfb = 0; hfb < 2; ++hfb) { const int g = wid & 3, ts = wid >> 2; const int head = kvh * 4 + g;
                AU a; const int tok = blk * 128 + 64 * hfb + 32 * ts + r32; const size_t qrow = (size_t)b * TOK + CTX + tok;
                a.qptr = PB + qrow * 1536 + 384 + head * 64; a.optr = ATT + qrow * 1024 + 512 + head * 64;
                a.kbase = PB + 1184 + kvh * 64; a.kpitch = 1536; a.vbase = PB + 1312 + kvh * 64; a.vpitch = 1536; a.k2base = nullptr; a.k2pitch = 0;
                a.row_ctx = b * TOK; a.row_lat = 0; a.start = 0; a.j0 = 0; a.nt = 36; a.qoff = 0; a.m0 = 0.f; a.l0 = 0.f;
                attn_unit<0, 64>(lds, a); }
        }
    }
}

constexpr int PH_MOE0 = 7, PH_L1 = PH_MOE0 + 1 + 2 * NCHUNK, PH_MOE1 = PH_L1 + 7, NPH = PH_MOE1 + 1 + 2 * NCHUNK;
template <int PH>
__device__ __forceinline__ void run_phase(LAS unsigned char* lds, int c, int G) {
    const PP P = get_pp();
    const float* rp = (const float*)(P->ws + WS_ROPE);
    const float* ada0 = (const float*)(P->ws + WS_ADA); const float* ada1 = ada0 + (size_t)33 * 6144;
    bf16_t* W0 = (bf16_t*)(P->ws + WS_W0); bf16_t* W1 = (bf16_t*)(P->ws + WS_W1);
    bf16_t* H = (bf16_t*)(P->ws + WS_H); char* BIG = P->ws + WS_BIG; float* XC = (float*)(P->ws + WS_XC);
    if constexpr (PH == 0) { phase_prologue(P, lds, c, G); }
    else if constexpr (PH == 1) { phase_norm(P, c, G, P->in[0], P->in[2], P->in[6], ada0, 0, 1024, false, H, nullptr); }
    else if constexpr (PH == 2) {
        gm::DenseSched S; S.init(0, 9, G, c); gm::Desc d{(const char*)H, 2048u, (const char*)(W0 + WO_IN), 2048u, 1024};
        gm::EpiQKV0 E{(bf16_t*)(BIG + BIG_QKV), rp, rp + 2048 * 32}; gm::gemm_phase(lds, d, S, E); }
    else if constexpr (PH == 3) { phase_attn0(P, lds, ONE_LAUNCH ? (int)*(volatile LAS int*)(lds + LDS_BARW + 8) : c, G); }
    else if constexpr (PH == 4) {
        gm::DenseSched S; S.init(0, 4, G, c); gm::Desc d{(const char*)H, 2048u, (const char*)(W0 + WO_OUT), 2048u, 1024};
        gm::EpiP1 E{(bf16_t*)(BIG + BIG_HLO), 1024, nullptr, 0}; gm::gemm_phase(lds, d, S, E); }
    else if constexpr (PH == 5) { phase_norm(P, c, G, P->in[0], P->in[2], P->in[11], ada0, 3072, 4096, false, H, (bf16_t*)(BIG + BIG_HLO), true, P->out, XC); }
    else if constexpr (PH == 6) { phase_router(P, lds, c, G, 0); }
    else if constexpr (PH == PH_L1) {
        gm::DenseSched S; S.init(0, 6, G, c); gm::Desc d{(const char*)H, 2048u, (const char*)(W1 + WO_IN), 2048u, 1024};
        gm::EpiP1 E{(bf16_t*)(BIG + BIG_P), 1536, nullptr, 0}; gm::gemm_phase(lds, d, S, E); }
    else if constexpr (PH == PH_L1 + 1) { phase_post1(P, c, G); }
    else if constexpr (PH == PH_L1 + 2) {
        { gm::DenseSched S; S.init(1, 3, G, c); gm::Desc d{(const char*)(BIG + BIG_P), 3072u, (const char*)(W1 + WO_UQ), 768u, 384};
          gm::EpiUQ E{(bf16_t*)(BIG + BIG_QM), (const float*)(P->ws + WS_RSTD), rp + 2 * 2048 * 32, rp + 2 * 2048 * 32 + 2048 * 16}; gm::gemm_phase(lds, d, S, E); }
        { gm::DenseSched S; S.init(0, 4, G, c); gm::Desc d{(const char*)(BIG + BIG_P) + 896 * 2, 3072u, (const char*)(W1 + WO_UKV), 512u, 256};
          gm::EpiP1 E{(bf16_t*)(BIG + BIG_KVX), 1024, (const float*)(P->ws + WS_RSTD), 1}; gm::gemm_phase(lds, d, S, E); } }
    else if constexpr (PH == PH_L1 + 3) { phase_attn1(P, lds, ONE_LAUNCH ? (int)*(volatile LAS int*)(lds + LDS_BARW + 8) : c, G); }
    else if constexpr (PH == PH_L1 + 4) {
        gm::DenseSched S; S.init(1, 4, G, c); gm::Desc d{(const char*)H, 2048u, (const char*)(W1 + WO_OUT), 2048u, 1024};
        gm::EpiP1 E{(bf16_t*)(BIG + BIG_HLO), 1024, nullptr, 0}; gm::gemm_phase(lds, d, S, E); }
    else if constexpr (PH == PH_L1 + 5) { phase_norm(P, c, G, P->out, XC, P->in[31], ada1, 3072, 4096, true, H, (bf16_t*)(BIG + BIG_HLO), true, P->out, XC); }
    else if constexpr (PH == PH_L1 + 6) { phase_router(P, lds, c, G, 1); }
    else {
        constexpr int layer = PH >= PH_MOE1 ? 1 : 0; constexpr int rel = PH - (layer ? PH_MOE1 : PH_MOE0);
        const int* cnt = (const int*)(P->ws + WS_CTL + CTL_CNT) + layer * NG;
        LAS int* toff = (LAS int*)(lds + LDS_TAB);
        bf16_t* W = layer ? W1 : W0;
        build_toff(toff, cnt);
        if constexpr (rel == 0) {
            gm::MoeSched<1> S; S.toff = toff; S.slot_row = (const int*)(P->ws + WS_SROW); S.t_lo = 0; S.t_hi = toff[NG]; S.nN = 2; S.G = G; S.c = c; S.bN = 512; S.layer = layer;
            gm::Desc d{(const char*)H, 2048u, (const char*)(W + WO_GU), 2048u, 1024};
            gm::EpiG1 E{(bf16_t*)(BIG + BIG_ACT), (const float*)(P->ws + WS_SW)}; gm::gemm_phase(lds, d, S, E);
        } else if constexpr ((rel & 1) == 1) {
            constexpr int ch = (rel - 1) >> 1;
            gm::MoeSched<2> S; S.toff = toff; S.slot_row = nullptr; S.t_lo = toff[ch * NGRP]; S.t_hi = toff[(ch + 1) * NGRP]; S.nN = 4; S.G = G; S.c = c; S.bN = 1024; S.layer = layer;
            gm::Desc d{(const char*)(BIG + BIG_ACT), 512u, (const char*)(W + WO_D), 512u, 256};
            gm::EpiG2 E{(bf16_t*)(BIG + BIG_SLAB), toff[ch * NGRP] * 256};
            gm::gemm_phase(lds, d, S, E);
        } else {
            constexpr int ch = (rel - 2) >> 1;
            phase_combine(P, lds, c, G, layer, ch);
        }
    }
}

template <int PH> struct PhaseLoop {
    static __device__ __forceinline__ void run(LAS unsigned char* lds, const XcdBarrier& bar) {
        run_phase<PH>(lds, (int)blockIdx.x, (int)gridDim.x);
        if constexpr (PH + 1 < NPH) { xcd_barrier(bar); PhaseLoop<PH + 1>::run(lds, bar); }
    }
};

extern __shared__ __attribute__((aligned(16))) unsigned char smem_raw[];

#if ONE_LAUNCH
__global__ void __launch_bounds__(512, 2) mega_fwd(Params Pk) {
    LAS unsigned char* lds = (LAS unsigned char*)smem_raw;
    volatile LAS unsigned* st = (volatile LAS unsigned*)(lds + LDS_BARW);
    if (threadIdx.x == 0) { st[0] = 0u; st[1] = 0u; st[2] = 0u; st[3] = 0u; }
    __syncthreads();
    XcdBarrier bar = xcd_barrier_post((unsigned*)(Pk.ws + WS_CTL), st);
    int* xr = (int*)(Pk.ws + WS_CTL + CTL_XRANK);
    int myrank = 0; if (threadIdx.x == 0) myrank = atomicAdd(xr + 64 * (int)bar.x, 1);
    run_phase<0>(lds, (int)blockIdx.x, (int)gridDim.x);
    xcd_barrier(bar);
    if (threadIdx.x == 0) { int base = 0; for (int j = 0; j < (int)bar.x; ++j) base += ld_ctl(xr + 64 * j); st[2] = (unsigned)(base + myrank); }
    __syncthreads();
    PhaseLoop<1>::run(lds, bar);
}
#else
template <int PH> __global__ void __launch_bounds__(512, 2) phase_kernel(Params Pk) {
    LAS unsigned char* lds = (LAS unsigned char*)smem_raw;
    run_phase<PH>(lds, (int)blockIdx.x, (int)gridDim.x);
}
template <int PH> struct PhaseLaunch {
    static void run(const Params& P, int grid, hipStream_t s) {
        (void)hipFuncSetAttribute((const void*)phase_kernel<PH>, hipFuncAttributeMaxDynamicSharedMemorySize, LDS_BYTES);
        hipLaunchKernelGGL(phase_kernel<PH>, dim3(grid), dim3(512), LDS_BYTES, s, P);
        if constexpr (PH + 1 < NPH) PhaseLaunch<PH + 1>::run(P, grid, s);
    }
};
#endif

extern "C" void kernel_launch(void* const* d_in, const int* in_sizes, int n_in, void* d_out, int out_size, void* d_ws, size_t ws_size, hipStream_t stream) {
    static int grid = 0;
    if (n_in != 41 || ws_size < WS_END) { fprintf(stderr, "kernel_launch: need 41 inputs and %zu bytes of workspace (got %d, %zu)\n", (size_t)WS_END, n_in, ws_size); return; }
    if (!grid) {
        int dev = 0, cus = 0;
        (void)hipGetDevice(&dev); (void)hipDeviceGetAttribute(&cus, hipDeviceAttributeMultiprocessorCount, dev);
#if ONE_LAUNCH
        (void)hipFuncSetAttribute((const void*)mega_fwd, hipFuncAttributeMaxDynamicSharedMemorySize, LDS_BYTES);
        int per_cu = 0; (void)hipOccupancyMaxActiveBlocksPerMultiprocessor(&per_cu, (const void*)mega_fwd, 512, LDS_BYTES);
        if (per_cu < 1) fprintf(stderr, "kernel_launch: occupancy query says %d blocks per CU\n", per_cu);
#endif
        grid = cus > 0 ? cus : 256;
    }
    Params P{};
    for (int i = 0; i < 41; ++i) P.in[i] = (const float*)d_in[i];
    P.out = (float*)d_out; P.ws = (char*)d_ws;
    (void)hipMemsetAsync((char*)d_ws + WS_CTL, 0, CTL_BYTES, stream);
#if ONE_LAUNCH
    hipLaunchKernelGGL(mega_fwd, dim3(grid), dim3(512), LDS_BYTES, stream, P);
#else
    PhaseLaunch<0>::run(P, grid, stream);
#endif
}
```

```cpp
#include <hip/hip_runtime.h>
#include <stdint.h>
#include <stdio.h>

#ifndef ONE_LAUNCH
#define ONE_LAUNCH 1
#endif

#define LAS __attribute__((address_space(3)))
typedef unsigned short bf16_t;
typedef short bf16x8 __attribute__((ext_vector_type(8)));
typedef short s16x4 __attribute__((ext_vector_type(4)));
typedef float f32x4 __attribute__((ext_vector_type(4)));
typedef float f32x16 __attribute__((ext_vector_type(16)));
typedef unsigned u32x4 __attribute__((ext_vector_type(4)));
typedef unsigned u32x2 __attribute__((ext_vector_type(2)));

constexpr int NB = 32, SEQ = 2048, DM = 1024, CTX = 256, TOK = CTX + SEQ, MROWS = NB * TOK;
constexpr int NEXP = 64, NGRP = 65, NCHUNK = 4, NG = NCHUNK * NGRP;
constexpr int CAP = MROWS / NCHUNK;
constexpr int CHUNK_ROWS = MROWS / NCHUNK;
constexpr int CHUNK_B = NB / NCHUNK;
constexpr float LOG2E = 1.4426950408889634f;
constexpr float QS64 = 0.125f * LOG2E;
constexpr float QS96 = 0.10206207261596575f * LOG2E;
constexpr float EPS = 1e-6f;

constexpr size_t MiB = 1048576;
constexpr size_t WS_CTL = 0;
constexpr size_t CTL_BYTES = 65536;
constexpr size_t CTL_CNT = 16384;
constexpr size_t CTL_XRANK = 24576;
constexpr size_t WS_ADA = 65536;
constexpr size_t WS_ROPE = WS_ADA + 2 * MiB;
constexpr size_t WO_IN = 0, WO_OUT = WO_IN + 2304 * 1024, WO_RT = WO_OUT + 1024 * 1024, WO_UQ = WO_RT + 2 * 64 * 1024, WO_UKV = WO_UQ + 768 * 384,
                 WO_GU = WO_UKV + 1024 * 256, WO_D = WO_GU + (size_t)65 * 512 * 1024, W_ELEMS = WO_D + (size_t)65 * 1024 * 256;
constexpr size_t W_BYTES = ((W_ELEMS * 2 + 255) / 256) * 256;
constexpr size_t WS_W0 = WS_ROPE + 1 * MiB;
constexpr size_t WS_W1 = WS_W0 + W_BYTES;
constexpr size_t WS_XC = WS_W1 + W_BYTES;
constexpr size_t WS_H = WS_XC + 32 * MiB;
constexpr size_t WS_RSTD = WS_H + 144 * MiB;
constexpr size_t WS_SROW = WS_RSTD + 1 * MiB;
constexpr size_t WS_SW = WS_SROW + (size_t)NCHUNK * 64 * CAP * 4;
constexpr size_t WS_TSLOT = WS_SW + (size_t)NCHUNK * 64 * CAP * 4;
constexpr size_t WS_BIG = ((WS_TSLOT + (size_t)MROWS * 6 * 4 + 255) / 256) * 256;
constexpr size_t BIG_QKV = 0;
constexpr size_t BIG_P = 0;
constexpr size_t BIG_QM = BIG_P + (size_t)MROWS * 1536 * 2;
constexpr size_t BIG_KVX = BIG_QM + (size_t)MROWS * 768 * 2;
constexpr size_t BIG_HLO = 0;
constexpr size_t MAXSLOT = (size_t)MROWS * 7 + (size_t)NG * 256;
constexpr size_t BIG_ACT = 0;
constexpr size_t BIG_SLAB = BIG_ACT + MAXSLOT * 512;
constexpr size_t SLAB_SLOTS = (size_t)CHUNK_ROWS * 7 + (size_t)NGRP * 256;
constexpr size_t WS_END = WS_BIG + BIG_SLAB + SLAB_SLOTS * 2048;

constexpr int LDS_BYTES = 139264;
constexpr int LDS_TAB = 131072;
constexpr int LDS_BARW = LDS_BYTES - 16;

struct Params {
    const float* in[41];
    float* out;
    char* ws;
};
typedef const Params __attribute__((address_space(4)))* PP;
__device__ __forceinline__ PP get_pp() { PP p = (PP)__builtin_amdgcn_kernarg_segment_ptr(); asm volatile("" : "+s"(p)); return p; }
__device__ __forceinline__ int ltid() { int t = threadIdx.x; asm volatile("" : "+v"(t)); return t; }

__device__ __forceinline__ unsigned pk2(float lo, float hi) {
    typedef float f2 __attribute__((ext_vector_type(2))); typedef __bf16 b2 __attribute__((ext_vector_type(2)));
    f2 v = {lo, hi}; b2 b = __builtin_convertvector(v, b2); return __builtin_bit_cast(unsigned, b);
}
__device__ __forceinline__ float bflo(unsigned u) { return __uint_as_float(u << 16); }
__device__ __forceinline__ float bfhi(unsigned u) { return __uint_as_float(u & 0xffff0000u); }
__device__ __forceinline__ float wave_sum(float v) {
#pragma unroll
    for (int o = 32; o > 0; o >>= 1) v += __shfl_xor(v, o);
    return v;
}
__device__ __forceinline__ int ld_ctl(const int* p) { return __hip_atomic_load(p, __ATOMIC_RELAXED, __HIP_MEMORY_SCOPE_AGENT); }

#define XB_TMO      128
#define XB_XCNT(j)  (256  + 64 * (j))
#define XB_XSUB(j)  (1280 + 64 * (j))
#define XB_XGEN(j)  (2304 + 64 * (j))
#define XB_TOP      3328
#define XB_TOPGEN   3392
#define XCD_BAR_WORDS 3456
#define XB_SPIN_CAP (1u << 18)

__device__ __forceinline__ unsigned xb_ld(unsigned* p)              { return __hip_atomic_load(p, __ATOMIC_RELAXED, __HIP_MEMORY_SCOPE_AGENT); }
__device__ __forceinline__ unsigned xb_add(unsigned* p, unsigned v) { return __hip_atomic_fetch_add(p, v, __ATOMIC_RELAXED, __HIP_MEMORY_SCOPE_AGENT); }
__device__ __forceinline__ unsigned xb_xcc_id() { return (unsigned)__builtin_amdgcn_s_getreg((3 << 11) | 20) & 0xFu; }
#define XB_SPIN(cond, bar) do { unsigned _sp = 0; while (cond) { __builtin_amdgcn_s_sleep(1); \
    if ((++_sp & 255u) == 0u) { if (xb_ld(&(bar)[XB_TMO])) break; if (_sp > XB_SPIN_CAP) { atomicAdd(&(bar)[XB_TMO], 1u); break; } } } } while (0)

struct XcdBarrier { unsigned* bar; unsigned x; volatile LAS unsigned* st; };

__device__ __forceinline__ XcdBarrier xcd_barrier_post(unsigned* bar, volatile LAS unsigned* st) {
    XcdBarrier b; b.bar = bar; b.x = xb_xcc_id(); b.st = st;
    if (threadIdx.x == 0) (void)xb_add(&bar[XB_XCNT(b.x)], 1u);
    return b;
}
__device__ __forceinline__ void xcd_barrier_complete(unsigned* bar, unsigned x, unsigned& nloc, unsigned& nx) {
    const unsigned G = gridDim.x * gridDim.y * gridDim.z;
    unsigned sum, cnt, mine, sp = 0u;
    for (;;) {
        sum = 0u; cnt = 0u; mine = 0u;
#pragma unroll
        for (unsigned j = 0; j < 16; ++j) { const unsigned c = xb_ld(&bar[XB_XCNT(j)]); sum += c; cnt += (c > 0u) ? 1u : 0u; mine = (j == x) ? c : mine; }
        if (sum == G) break;
        __builtin_amdgcn_s_sleep(1);
        if ((++sp & 255u) == 0u) { if (xb_ld(&bar[XB_TMO])) break; if (sp > XB_SPIN_CAP) { atomicAdd(&bar[XB_TMO], 1u); break; } }
    }
    nloc = mine > 0u ? mine : 1u; nx = cnt > 0u ? cnt : 1u;
}
__device__ __forceinline__ void xcd_barrier(const XcdBarrier& b) {
    asm volatile("s_waitcnt vmcnt(0)" ::: "memory");
    __syncthreads();
    if (threadIdx.x == 0) {
        unsigned* bar = b.bar;
        __builtin_amdgcn_s_waitcnt(0);
        unsigned nloc = b.st[0], nx = b.st[1];
        if (nloc == 0u) { xcd_barrier_complete(bar, b.x, nloc, nx); b.st[0] = nloc; b.st[1] = nx; }
        const unsigned old = xb_add(&bar[XB_XSUB(b.x)], 1u);
        const unsigned gen = old / nloc;
        if (old + 1u == (gen + 1u) * nloc) {
            __builtin_amdgcn_fence(__ATOMIC_RELEASE, "agent");
            asm volatile("s_waitcnt vmcnt(0)" ::: "memory");
            const unsigned og = xb_add(&bar[XB_TOP], 1u);
            const unsigned tg = og / nx;
            if (og + 1u == (tg + 1u) * nx) xb_add(&bar[XB_TOPGEN], 1u);
            else XB_SPIN(xb_ld(&bar[XB_TOPGEN]) == tg, bar);
            __builtin_amdgcn_fence(__ATOMIC_ACQUIRE, "agent");
            xb_add(&bar[XB_XGEN(b.x)], 1u);
            asm volatile("s_waitcnt vmcnt(0)" ::: "memory");
        } else {
            XB_SPIN(xb_ld(&bar[XB_XGEN(b.x)]) == gen, bar);
            __builtin_amdgcn_fence(__ATOMIC_ACQUIRE, "agent");
            asm volatile("s_waitcnt vmcnt(0)" ::: "memory");
        }
    }
    __syncthreads();
}

namespace gm {
constexpr int BM = 256, BK = 64, HALF = 128, HTB = HALF * BK * 2, STAGE_BYTES = 8 * HTB, NXCD = 8, WGM = 8;
__device__ __forceinline__ int lds_byte(int r, int c) { const int st = (r >> 4) * 2 + (c >> 5), rr = r & 15, cc = c & 31, ob = rr * 64 + cc * 2; return st * 1024 + (ob ^ (((ob >> 9) & 1) << 5)); }
__device__ __forceinline__ void stage_rc(int b, int& R, int& C) { const int st = b / 1024, sb = b % 1024, swz = sb ^ (((sb >> 9) & 1) << 5); R = (st >> 1) * 16 + swz / 64; C = (st & 1) * 32 + (swz % 64) / 2; }
__device__ __forceinline__ int perm32(int rho) { const int n = rho >> 4, i = rho & 15; return 8 * (i >> 2) + 4 * n + (i & 3); }

struct Unit { int pm, pn, g, mt, cnt, sbase; };
struct Desc { const char* A; unsigned lda; const char* B; unsigned ldb; int K; };

struct DenseSched {
    int nMt, nN, nwg, G, c, mmode;
    __device__ __forceinline__ void init(int mmode_, int nN_, int G_, int c_) { mmode = mmode_; nMt = mmode_ ? 256 : 288; nN = nN_; nwg = nMt * nN_; G = G_; c = c_; }
    __device__ __forceinline__ bool next(int i, Unit& u) const {
        const long L = (long)i * G + c; if (L >= nwg) return false;
        int wgid = (int)L; { const int q = nwg / NXCD, r = nwg % NXCD, xcd = wgid % NXCD, off = wgid / NXCD; wgid = (xcd < r ? xcd * (q + 1) : r * (q + 1) + (xcd - r) * q) + off; }
        const int nig = WGM * nN, gid = wgid / nig, fm = gid * WGM, gsz = (nMt - fm) < WGM ? (nMt - fm) : WGM;
        const int pmi = fm + ((wgid % nig) % gsz); u.pn = (wgid % nig) / gsz;
        u.pm = mmode ? (pmi >> 3) * 9 + 1 + (pmi & 7) : pmi; u.g = 0; u.mt = 0; u.cnt = 256; u.sbase = 0; return true;
    }
    __device__ __forceinline__ int a_row(const Unit& u, int r) const { return u.pm * 256 + r; }
    __device__ __forceinline__ int b_row(const Unit& u) const { return u.pn * 256; }
};

template <int WHICH  >
struct MoeSched {
    LAS const int* toff; const int* slot_row; int nN, G, c, bN, layer, t_lo, t_hi, xq, xj;
    __device__ __forceinline__ bool next(int i, Unit& u) const {
        const int per = G >> 3, nt_ = t_hi - t_lo;
        const int xs = t_lo + (int)(((long)nt_ * xq) >> 3), xe = t_lo + (int)(((long)nt_ * (xq + 1)) >> 3);
        const int L = i * per + xj; if (L >= (xe - xs) * nN) return false;
        const int tau = L / nN; u.pn = L - tau * nN; const int T = xs + tau;
        int lo = 0, hi = NG;
        while (hi - lo > 1) { const int mid = (lo + hi) >> 1; if (toff[mid] <= T) lo = mid; else hi = mid; }
        u.g = lo; u.mt = T - toff[lo]; u.pm = T; u.sbase = T * 256; u.cnt = toff[272 + lo]; return true;
    }
    __device__ __forceinline__ int a_row(const Unit& u, int r) const {
        if (WHICH == 2) return u.sbase + r;
        const int e = u.g % NGRP, ch = u.g / NGRP, idx = u.mt * 256 + r;
        const bool in = (e < NEXP) && (idx < u.cnt);
        const int lrow = slot_row[(size_t)(ch * 64 + (e < NEXP ? e : 0)) * CAP + (in ? idx : 0)];
        const int b1 = ch * CHUNK_B + (idx >> 11);
        const int srow = (layer == 0) ? (ch * CHUNK_ROWS + idx) : (b1 * TOK + CTX + (idx & 2047));
        return (e == NEXP) ? srow : (in ? lrow : 0);
    }
    __device__ __forceinline__ int b_row(const Unit& u) const { return (u.g % NGRP) * bN + u.pn * 256; }
};

template <class Epi, class Sched>
__device__ __forceinline__ void gemm_phase(LAS unsigned char* lds, const Desc g, const Sched& S, const Epi& E) {
    const int tid = ltid(), wid = __builtin_amdgcn_readfirstlane(tid >> 6), lane = tid & 63, wr = wid >> 2, wc = wid & 3, fr = lane & 15, fq = lane >> 4;
    const int nt = g.K / BK;
    unsigned voffB[2][2];
#pragma unroll
    for (int i = 0; i < 2; ++i) { int R, C; stage_rc(tid * 16 + i * 8192, R, C); const int Rl = Epi::PERM ? perm32(R & 31) : (R & 31);
#pragma unroll
        for (int h = 0; h < 2; ++h) { const int Rb = Epi::WIDE ? (64 * (R >> 5) + 32 * h + Rl) : (128 * h + (R & ~31) + Rl);
            voffB[h][i] = (unsigned)Rb * g.ldb + (unsigned)C * 2u; } }
    const size_t kstep = (size_t)(BK * 2);
    const unsigned ldsw = (unsigned)wid * 1024u;
    const int aoff = lds_byte(wr * 64 + fr, fq * 8), boff = lds_byte(wc * 32 + fr, fq * 8);
#define GM_SA(b, h) (((b) * 2 + (h)) * HTB)
#define GM_SB(b, h) ((4 + (b) * 2 + (h)) * HTB)
#define GM_STAGE_A(bufoff, kb, va, h) do { _Pragma("unroll") for (int _i = 0; _i < 2; ++_i) \
        __builtin_amdgcn_global_load_lds((const unsigned*)(g.A + (kb) + (va)[h][_i]), (LAS unsigned*)(lds + (bufoff) + ldsw + _i * 8192), 16, 0, 0); } while (0)
#define GM_STAGE_B(bufoff, bp, h) do { _Pragma("unroll") for (int _i = 0; _i < 2; ++_i) \
        __builtin_amdgcn_global_load_lds((const unsigned*)((bp) + voffB[h][_i]), (LAS unsigned*)(lds + (bufoff) + ldsw + _i * 8192), 16, 0, 0); } while (0)
#define GM_LDA(dst, b, h) do { _Pragma("unroll") for (int m = 0; m < 4; ++m) _Pragma("unroll") for (int k = 0; k < 2; ++k) dst[m][k] = *(const LAS bf16x8*)(lds + GM_SA(b, h) + aoff + m * 2048 + k * 1024); } while (0)
#define GM_LDB(dst, b, h) do { _Pragma("unroll") for (int n = 0; n < 2; ++n) _Pragma("unroll") for (int k = 0; k < 2; ++k) dst[n][k] = *(const LAS bf16x8*)(lds + GM_SB(b, h) + boff + n * 2048 + k * 1024); } while (0)
#define GM_MMA(ai, bj, At, Bt) do { __builtin_amdgcn_s_setprio(1); _Pragma("unroll") for (int m = 0; m < 4; ++m) _Pragma("unroll") for (int n = 0; n < 2; ++n) _Pragma("unroll") for (int k = 0; k < 2; ++k) \
        acc[ai][bj][m][n] = __builtin_amdgcn_mfma_f32_16x16x32_bf16(Bt[n][k], At[m][k], acc[ai][bj][m][n], 0, 0, 0); __builtin_amdgcn_s_setprio(0); } while (0)
#define GM_WAIT_V(n) asm volatile("s_waitcnt vmcnt(" #n ")" ::: "memory")
#define GM_WAIT_L(n) asm volatile("s_waitcnt lgkmcnt(" #n ")" ::: "memory")
#define GM_BAR __builtin_amdgcn_s_barrier()
#define GM_SCHED __builtin_amdgcn_sched_barrier(0)
#define GM_CALC_VA(va, u) do { int _tz = tid; asm volatile("" : "+v"(_tz)); int _rw[2][2]; unsigned _cc[2]; \
        _Pragma("unroll") for (int _i = 0; _i < 2; ++_i) { int _R, _C; stage_rc(_tz * 16 + _i * 8192, _R, _C); _cc[_i] = (unsigned)_C * 2u; \
            _Pragma("unroll") for (int _h = 0; _h < 2; ++_h) _rw[_h][_i] = S.a_row((u), _h * HALF + _R); } \
        _Pragma("unroll") for (int _i = 0; _i < 2; ++_i) _Pragma("unroll") for (int _h = 0; _h < 2; ++_h) (va)[_h][_i] = (unsigned)_rw[_h][_i] * g.lda + _cc[_i]; } while (0)
    Unit cur, nxt; int ui = 0;
    if (!S.next(0, cur)) return;
    f32x4 acc[2][2][4][2];
#pragma unroll
    for (int a = 0; a < 2; ++a)
#pragma unroll
        for (int b = 0; b < 2; ++b)
#pragma unroll
            for (int m = 0; m < 4; ++m)
#pragma unroll
                for (int n = 0; n < 2; ++n) acc[a][b][m][n] = (f32x4){0.f, 0.f, 0.f, 0.f};
    bf16x8 At[4][2], B0[2][2], B1[2][2];
    unsigned vaC[2][2];
    GM_CALC_VA(vaC, cur);
    const char* cB = g.B + (size_t)S.b_row(cur) * g.ldb;
    GM_STAGE_B(GM_SB(0, 0), cB, 0); GM_STAGE_A(GM_SA(0, 0), (size_t)0, vaC, 0); GM_STAGE_B(GM_SB(0, 1), cB, 1); GM_STAGE_A(GM_SA(0, 1), (size_t)0, vaC, 1);
    if (wr == 1) GM_BAR;
    GM_WAIT_V(4); GM_BAR;
    GM_STAGE_B(GM_SB(1, 0), cB + kstep, 0); GM_STAGE_A(GM_SA(1, 0), kstep, vaC, 0); GM_STAGE_B(GM_SB(1, 1), cB + kstep, 1);
    GM_WAIT_V(6); GM_BAR;
    for (;;) {
        const bool has_next = S.next(ui + 1, nxt);
        const char* nB = cB;
        if (has_next) nB = g.B + (size_t)S.b_row(nxt) * g.ldb;
        unsigned va2[2][2];
#pragma clang loop unroll(disable)
        for (int t = 0; t < nt; t += 2) {
            const bool last = (t == nt - 2);
            const size_t k1 = (size_t)(t + 1) * kstep;
            const size_t k2 = last ? (size_t)0 : (size_t)(t + 2) * kstep, k3 = k2 + kstep;
            const char* b2 = last ? nB : cB + k2; const char* b3 = b2 + kstep;
#pragma unroll
            for (int _h = 0; _h < 2; ++_h)
#pragma unroll
                for (int _i = 0; _i < 2; ++_i) va2[_h][_i] = vaC[_h][_i];
            if (last && has_next) GM_CALC_VA(va2, nxt);
            GM_LDB(B0, 0, 0); GM_SCHED; GM_LDA(At, 0, 0); GM_STAGE_A(GM_SA(1, 1), k1, vaC, 1);
            GM_WAIT_L(8); GM_BAR; GM_WAIT_L(0); GM_MMA(0, 0, At, B0); GM_BAR; GM_SCHED;
            GM_LDB(B1, 0, 1); GM_STAGE_B(GM_SB(0, 0), b2, 0);
            GM_BAR; GM_WAIT_L(0); GM_MMA(0, 1, At, B1); GM_BAR;
            GM_LDA(At, 0, 1); GM_STAGE_A(GM_SA(0, 0), k2, va2, 0);
            GM_BAR; GM_WAIT_L(0); GM_MMA(1, 0, At, B0); GM_BAR; GM_SCHED;
            GM_STAGE_B(GM_SB(0, 1), b2, 1);
            GM_WAIT_V(6); GM_BAR; GM_MMA(1, 1, At, B1); GM_BAR;
            GM_LDB(B0, 1, 0); GM_SCHED; GM_LDA(At, 1, 0); GM_STAGE_A(GM_SA(0, 1), k2, va2, 1);
            GM_WAIT_L(8); GM_BAR; GM_WAIT_L(0); GM_MMA(0, 0, At, B0); GM_BAR; GM_SCHED;
            GM_LDB(B1, 1, 1); GM_STAGE_B(GM_SB(1, 0), b3, 0);
            GM_BAR; GM_WAIT_L(0); GM_MMA(0, 1, At, B1); GM_BAR;
            GM_LDA(At, 1, 1); GM_STAGE_A(GM_SA(1, 0), k3, va2, 0);
            GM_BAR; GM_WAIT_L(0); GM_MMA(1, 0, At, B0); GM_BAR; GM_SCHED;
            GM_STAGE_B(GM_SB(1, 1), b3, 1);
            GM_WAIT_V(6); GM_BAR; GM_MMA(1, 1, At, B1); GM_BAR;
        }
        { int tz = tid; asm volatile("" : "+v"(tz));
          const int wid2 = __builtin_amdgcn_readfirstlane(tz >> 6), ln2 = tz & 63; E(acc, cur, wid2 >> 2, wid2 & 3, ln2 & 15, ln2 >> 4); }
        if (!has_next) break;
#pragma unroll
        for (int a = 0; a < 2; ++a)
#pragma unroll
            for (int b = 0; b < 2; ++b)
#pragma unroll
                for (int m = 0; m < 4; ++m)
#pragma unroll
                    for (int n = 0; n < 2; ++n) acc[a][b][m][n] = (f32x4){0.f, 0.f, 0.f, 0.f};
        cur = nxt; cB = nB; ++ui;
#pragma unroll
        for (int _h = 0; _h < 2; ++_h)
#pragma unroll
            for (int _i = 0; _i < 2; ++_i) vaC[_h][_i] = va2[_h][_i];
    }
    GM_WAIT_V(0);
    if (wr == 0) GM_BAR;
    GM_BAR;
#undef GM_SA
#undef GM_SB
#undef GM_STAGE_A
#undef GM_STAGE_B
#undef GM_LDA
#undef GM_LDB
#undef GM_MMA
#undef GM_WAIT_V
#undef GM_WAIT_L
#undef GM_BAR
#undef GM_SCHED
#undef GM_CALC_VA
}

typedef const f32x4 (&AccRef)[2][2][4][2];

struct EpiQKV0 {
    static constexpr bool PERM = false; static constexpr int WIDE = 0;
    bf16_t* O; const float* cosT; const float* sinT;
    __device__ __forceinline__ void operator()(AccRef acc, const Unit& u, int wr, int wc, int fr, int fq) const {
        const int tq = u.pm % 9; const bool ctx = (tq == 0); const int tbase = tq * 256 - 256;
        const int colg0 = 256 * u.pn + 32 * wc; const bool rope0 = (colg0 < 640) && !ctx, rope1 = (colg0 + 128 < 640) && !ctx; const int gi = 16 * (wc & 1) + 4 * fq;
        f32x4 cs[8], sn[8];
        if (rope0) {
#pragma unroll
            for (int q = 0; q < 8; ++q) { const int rl = 128 * (q >> 2) + 64 * wr + 16 * (q & 3) + fr; cs[q] = *(const f32x4*)(cosT + (size_t)(tbase + rl) * 32 + gi); sn[q] = *(const f32x4*)(sinT + (size_t)(tbase + rl) * 32 + gi); }
        }
#pragma unroll
        for (int bj = 0; bj < 2; ++bj) {
            const int colg = colg0 + 128 * bj; const bool rope = bj ? rope1 : rope0;
#pragma unroll
            for (int ai = 0; ai < 2; ++ai)
#pragma unroll
                for (int m = 0; m < 4; ++m) {
                    const int rl = 128 * ai + 64 * wr + 16 * m + fr; const size_t row = (size_t)u.pm * 256 + rl;
                    f32x4 v0 = acc[ai][bj][m][0], v1 = acc[ai][bj][m][1];
                    if (rope) { const f32x4 c4 = cs[4 * ai + m], s4 = sn[4 * ai + m]; const f32x4 x0 = v0 * c4 - v1 * s4, x1 = v0 * s4 + v1 * c4; v0 = x0; v1 = x1; }
                    bf16_t* p = O + row * 2304 + colg + 4 * fq;
                    u32x2 w0, w1; w0.x = pk2(v0[0], v0[1]); w0.y = pk2(v0[2], v0[3]); w1.x = pk2(v1[0], v1[1]); w1.y = pk2(v1[2], v1[3]);
                    *(u32x2*)p = w0; *(u32x2*)(p + 16) = w1;
                }
        }
    }
};
struct EpiP1 {
    static constexpr bool PERM = true; static constexpr int WIDE = 1;
    bf16_t* O; int ldc; const float* rs; int rsel;
    __device__ __forceinline__ void operator()(AccRef acc, const Unit& u, int wr, int wc, int fr, int fq) const {
        float scv[8];
#pragma unroll
        for (int q = 0; q < 8; ++q) { const size_t row = (size_t)u.pm * 256 + 128 * (q >> 2) + 64 * wr + 16 * (q & 3) + fr; scv[q] = rs ? rs[row * 2 + rsel] : 1.f; }
        const bool lo = fr < 8; const int col = 256 * u.pn + 64 * wc + 8 * fq + (lo ? 0 : 32);
#pragma unroll
        for (int ai = 0; ai < 2; ++ai)
#pragma unroll
            for (int m = 0; m < 4; ++m) { const size_t row = (size_t)u.pm * 256 + 128 * ai + 64 * wr + 16 * m + (fr & 7); const float sc = scv[4 * ai + m];
                u32x4 x0, x1;
                { const f32x4 v0 = acc[ai][0][m][0] * sc, v1 = acc[ai][0][m][1] * sc; x0.x = pk2(v0[0], v0[1]); x0.y = pk2(v0[2], v0[3]); x0.z = pk2(v1[0], v1[1]); x0.w = pk2(v1[2], v1[3]); }
                { const f32x4 v0 = acc[ai][1][m][0] * sc, v1 = acc[ai][1][m][1] * sc; x1.x = pk2(v0[0], v0[1]); x1.y = pk2(v0[2], v0[3]); x1.z = pk2(v1[0], v1[1]); x1.w = pk2(v1[2], v1[3]); }
                u32x4 rc;
#pragma unroll
                for (int q = 0; q < 4; ++q) rc[q] = (unsigned)__shfl_xor((int)(lo ? x1[q] : x0[q]), 8);
                const u32x4 da = lo ? x0 : rc, db = lo ? rc : x1;
                *(u32x4*)(O + row * ldc + col) = da; *(u32x4*)(O + (row + 8) * ldc + col) = db; }
    }
};
struct EpiUQ {
    static constexpr bool PERM = false; static constexpr int WIDE = 0;
    bf16_t* O; const float* rs; const float* cosT; const float* sinT;
    __device__ __forceinline__ void operator()(AccRef acc, const Unit& u, int wr, int wc, int fr, int fq) const {
        const int tq = u.pm % 9; const bool ctx = (tq == 0); const int tbase = tq * 256 - 256;
        const int colg0 = 256 * u.pn + 32 * wc, colg1 = colg0 + 128;
        const bool rope0 = ((colg0 >> 5) % 3 == 2) && !ctx, rope1 = ((colg1 >> 5) % 3 == 2) && !ctx;
        float scv[8]; f32x4 cs[8], sn[8];
#pragma unroll
        for (int q = 0; q < 8; ++q) { const int rl = 128 * (q >> 2) + 64 * wr + 16 * (q & 3) + fr; scv[q] = rs[((size_t)u.pm * 256 + rl) * 2]; }
        if (rope0 || rope1) {
#pragma unroll
            for (int q = 0; q < 8; ++q) { const int rl = 128 * (q >> 2) + 64 * wr + 16 * (q & 3) + fr; cs[q] = *(const f32x4*)(cosT + (size_t)(tbase + rl) * 16 + 4 * fq); sn[q] = *(const f32x4*)(sinT + (size_t)(tbase + rl) * 16 + 4 * fq); }
        }
#pragma unroll
        for (int ai = 0; ai < 2; ++ai)
#pragma unroll
            for (int m = 0; m < 4; ++m) {
                const int rl = 128 * ai + 64 * wr + 16 * m + fr; const size_t row = (size_t)u.pm * 256 + rl; const float sc = scv[4 * ai + m];
#pragma unroll
                for (int bj = 0; bj < 2; ++bj) {
                    f32x4 v0 = acc[ai][bj][m][0] * sc, v1 = acc[ai][bj][m][1] * sc;
                    if (bj ? rope1 : rope0) { const f32x4 c4 = cs[4 * ai + m], s4 = sn[4 * ai + m]; const f32x4 x0 = v0 * c4 - v1 * s4, x1 = v0 * s4 + v1 * c4; v0 = x0; v1 = x1; }
                    bf16_t* p = O + row * 768 + (bj ? colg1 : colg0) + 4 * fq;
                    u32x2 w0, w1; w0.x = pk2(v0[0], v0[1]); w0.y = pk2(v0[2], v0[3]); w1.x = pk2(v1[0], v1[1]); w1.y = pk2(v1[2], v1[3]);
                    *(u32x2*)p = w0; *(u32x2*)(p + 16) = w1;
                }
            }
    }
};
struct EpiG1 {
    static constexpr bool PERM = false; static constexpr int WIDE = 0;
    bf16_t* act; const float* slot_w;
    __device__ __forceinline__ void operator()(AccRef acc, const Unit& u, int wr, int wc, int fr, int fq) const {
        const int e = u.g % NGRP, ch = u.g / NGRP;
        float wv[8];
        const float* wp = slot_w + (size_t)(ch * 64 + (e < NEXP ? e : NEXP - 1)) * CAP;
#pragma unroll
        for (int q = 0; q < 8; ++q) { const int idx = u.mt * 256 + 128 * (q >> 2) + 64 * wr + 16 * (q & 3) + fr; const bool in = idx < u.cnt;
            const float lw = __hip_atomic_load(wp + (in ? idx : 0), __ATOMIC_RELAXED, __HIP_MEMORY_SCOPE_AGENT);
            wv[q] = (e == NEXP) ? 1.f : (in ? lw : 0.f); }
#pragma unroll
        for (int ai = 0; ai < 2; ++ai)
#pragma unroll
            for (int m = 0; m < 4; ++m) {
                const int rl = 128 * ai + 64 * wr + 16 * m + fr; const float w = wv[4 * ai + m];
#pragma unroll
                for (int bj = 0; bj < 2; ++bj) {
                    const f32x4 gt = acc[ai][bj][m][0], up = acc[ai][bj][m][1]; float r[4];
#pragma unroll
                    for (int j = 0; j < 4; ++j) r[j] = gt[j] * __builtin_amdgcn_rcpf(1.f + __expf(-gt[j])) * up[j] * w;
                    u32x2 o; o.x = pk2(r[0], r[1]); o.y = pk2(r[2], r[3]);
                    *(u32x2*)(act + ((size_t)u.sbase + rl) * 256 + 16 * (8 * u.pn + 4 * bj + wc) + 4 * fq) = o;
                }
            }
    }
};
struct EpiG2 {
    static constexpr bool PERM = true, WIDE = true;
    bf16_t* slab; int sbase0;
    __device__ __forceinline__ void operator()(AccRef acc, const Unit& u, int wr, int wc, int fr, int fq) const {
        const bool lo = fr < 8; const int col = 256 * u.pn + 64 * wc + 8 * fq + (lo ? 0 : 32);
#pragma unroll
        for (int ai = 0; ai < 2; ++ai)
#pragma unroll
            for (int m = 0; m < 4; ++m) { const size_t row = (size_t)(u.sbase - sbase0) + 128 * ai + 64 * wr + 16 * m + (fr & 7);
                u32x4 x0, x1;
                { const f32x4 v0 = acc[ai][0][m][0], v1 = acc[ai][0][m][1]; x0.x = pk2(v0[0], v0[1]); x0.y = pk2(v0[2], v0[3]); x0.z = pk2(v1[0], v1[1]); x0.w = pk2(v1[2], v1[3]); }
                { const f32x4 v0 = acc[ai][1][m][0], v1 = acc[ai][1][m][1]; x1.x = pk2(v0[0], v0[1]); x1.y = pk2(v0[2], v0[3]); x1.z = pk2(v1[0], v1[1]); x1.w = pk2(v1[2], v1[3]); }
                u32x4 rc;
#pragma unroll
                for (int q = 0; q < 4; ++q) rc[q] = (unsigned)__shfl_xor((int)(lo ? x1[q] : x0[q]), 8);
                const u32x4 da = lo ? x0 : rc, db = lo ? rc : x1;
                __builtin_nontemporal_store(da, (u32x4*)(slab + row * 1024 + col)); __builtin_nontemporal_store(db, (u32x4*)(slab + (row + 8) * 1024 + col)); }
    }
};
}

struct AU {
    const bf16_t* qptr;
    bf16_t* optr;
    const bf16_t* kbase; unsigned kpitch;
    const bf16_t* vbase; unsigned vpitch;
    const bf16_t* k2base; unsigned k2pitch;
    int row_ctx, row_lat;
    int nt;
    int j0;
    int qoff;
    int start;
    float m0, l0;
};
constexpr int ATT_RPB = 122880;
constexpr float THR = 8.f;
__device__ __forceinline__ void glds16(const void* gsrc, unsigned lds_dst) { unsigned keep;
    asm volatile("s_mov_b32 %0, m0\n\ts_mov_b32 m0, %2\n\ts_nop 0\n\tglobal_load_lds_dwordx4 %1, off\n\ts_mov_b32 m0, %0" : "=&s"(keep) : "v"(gsrc), "s"(lds_dst) : "memory"); }
__device__ __forceinline__ float max3f(float a, float b, float c) { float r; asm("v_max3_f32 %0, %1, %2, %3" : "=v"(r) : "v"(a), "v"(b), "v"(c)); return r; }
__device__ __forceinline__ float max2f(float a, float b) { float r; asm("v_max_f32_e32 %0, %1, %2" : "=v"(r) : "v"(a), "v"(b)); return r; }

template <int MODE  , int DQ  >
__device__ __forceinline__ void attn_unit(LAS unsigned char* lds, const AU& a) {
    constexpr int NS = DQ / 16;
    constexpr int BUFB = (DQ == 96) ? 20480 : 16384;
    const int tid = ltid(), lane = tid & 63, wid = __builtin_amdgcn_readfirstlane(tid >> 6), r32 = lane & 31, hi = lane >> 5;
    const bool upper = wid >= 4;
    const int kr = tid >> 3, cp = tid & 7;
    const int ksrc = (cp ^ ((kr >> 1) & 7)) * 8, vsrc = (cp ^ (((kr >> 1) & 1) << 2)) * 8;
    const int kr2 = 16 * wid + (lane >> 2), k2src = ((lane & 3) ^ ((kr2 >> 2) & 3)) * 8;
    unsigned koff[NS];
#pragma unroll
    for (int s = 0; s < NS; ++s) koff[s] = (s < 4) ? (unsigned)(r32 * 128 + (((2 * s + hi) ^ ((r32 >> 1) & 7)) << 4))
                                                   : (unsigned)(16384 + r32 * 64 + (((2 * (s - 4) + hi) ^ ((r32 >> 2) & 3)) << 4));
    const int vg = (lane >> 4) & 1, vq = (lane & 15) >> 2, vp = lane & 3, vsw = (vq >> 1) & 1;
    const unsigned voff0 = (unsigned)(8192 + (4 * hi + vq) * 128 + 64 * vsw + 32 * vg + 8 * vp);
    const unsigned voff1 = (unsigned)(8192 + (4 * hi + vq) * 128 + 64 * (1 - vsw) + 32 * vg + 8 * vp);
    bf16x8 qf[NS];
#pragma unroll
    for (int s = 0; s < NS; ++s) qf[s] = *(const bf16x8*)(a.qptr + 16 * s + 8 * hi);
    f32x16 o0, o1, negm, p0, p1;
    float m = a.m0, l = a.l0;
#pragma unroll
    for (int r = 0; r < 16; ++r) { o0[r] = 0.f; o1[r] = 0.f; negm[r] = -m; p0[r] = 0.f; p1[r] = 0.f; }
    const int nt = a.nt;
    auto krow = [&](int t, int r) -> int {
        if (MODE == 0) return a.row_ctx + 64 * t + r;
        if (t < 4) return a.row_ctx + 64 * t + r;
        if (MODE == 1) return a.row_lat + a.start - 128 + 64 * (a.j0 + t - 4) + r;
        return a.row_lat + 64 * (a.j0 + t - 4) + r;
    };
    const unsigned lds0 = (unsigned)(uintptr_t)lds + (unsigned)wid * 1024u;
    auto dma = [&](int t, int boff) {
        const size_t r = (size_t)krow(t, kr);
        glds16(a.kbase + r * a.kpitch + ksrc, (unsigned)__builtin_amdgcn_readfirstlane((int)(lds0 + boff)));
        glds16(a.vbase + r * a.vpitch + vsrc, (unsigned)__builtin_amdgcn_readfirstlane((int)(lds0 + boff + 8192)));
        if (DQ == 96) { if (!upper) { const size_t r2 = (size_t)krow(t, kr2);
            glds16(a.k2base + r2 * a.k2pitch + k2src, (unsigned)__builtin_amdgcn_readfirstlane((int)(lds0 + boff + 16384))); } }
    };
    auto tile_active = [&](int t) -> bool {
        if (MODE != 2 || t < 4) return true;
        const int qrow = a.qoff >> 6; int rs = qrow - 4; rs = rs < 0 ? 0 : (rs > 24 ? 24 : rs); const int kgr = a.j0 + t - 4;
        return __builtin_amdgcn_readfirstlane((int)((kgr >= rs) && (kgr < rs + 8))) != 0;
    };
    auto QK = [&](int t, int boff) {
        const LAS unsigned char* Bb = lds + boff;
        bf16x8 kf[2 * NS];
#pragma unroll
        for (int s = 0; s < NS; ++s) { kf[2 * s] = *(const LAS bf16x8*)(Bb + koff[s]); kf[2 * s + 1] = *(const LAS bf16x8*)(Bb + koff[s] + (s < 4 ? 4096 : 2048)); }
#pragma unroll
        for (int s = 0; s < NS; ++s) {
            if (s == 0) { p0 = __builtin_amdgcn_mfma_f32_32x32x16_bf16(kf[0], qf[0], negm, 0, 0, 0); p1 = __builtin_amdgcn_mfma_f32_32x32x16_bf16(kf[1], qf[0], negm, 0, 0, 0); }
            else { p0 = __builtin_amdgcn_mfma_f32_32x32x16_bf16(kf[2 * s], qf[s], p0, 0, 0, 0); p1 = __builtin_amdgcn_mfma_f32_32x32x16_bf16(kf[2 * s + 1], qf[s], p1, 0, 0, 0); }
        }
        __builtin_amdgcn_sched_group_barrier(0x100, 2 * NS, 0);
        __builtin_amdgcn_sched_group_barrier(0x008, 2 * NS, 0);
        if (MODE == 1 && t >= 4) {
            const int j = a.j0 + t - 4;
            if (j == 0 || j == 4) {
                const int dbase = -128 + 64 * j - a.qoff + 4 * hi;
#pragma unroll
                for (int r = 0; r < 16; ++r) { const int d = dbase + (r & 3) + 8 * (r >> 2);
                    if ((unsigned)(d + 128) > 256u) p0[r] = -1e30f; if ((unsigned)(d + 32 + 128) > 256u) p1[r] = -1e30f; }
            }
        }
        if (MODE == 2 && t >= 4) {
            const int qrow = a.qoff >> 6, qcol = a.qoff & 63; int cs = qcol - 8; cs = cs < 0 ? 0 : (cs > 48 ? 48 : cs);
            const int krel = a.j0 + t - 4 - qrow + 7;
            const LAS float* bt = (const LAS float*)(lds + ATT_RPB) + krel * 128 + (63 - qcol) + 4 * hi;
            const int cb = 4 * hi - cs;
#pragma unroll
            for (int r = 0; r < 16; ++r) { const int kc = (r & 3) + 8 * (r >> 2);
                const float b0 = bt[kc], b1 = bt[kc + 32];
                p0[r] = ((unsigned)(cb + kc) < 16u) ? p0[r] + b0 : -1e30f;
                p1[r] = ((unsigned)(cb + kc + 32) < 16u) ? p1[r] + b1 : -1e30f; }
        }
    };
    bf16x8 pf0, pf1, pf2, pf3;
    auto SM = [&](bool first) {
        asm volatile("s_nop 15\n\ts_nop 7" : "+v"(p0), "+v"(p1));
        float ra = max3f(p0[0], p0[1], p1[0]), rb = max3f(p0[2], p0[3], p1[1]); ra = max3f(ra, p1[2], p1[3]);
#pragma unroll
        for (int r = 4; r < 16; r += 4) { ra = max3f(ra, p0[r], p0[r + 1]); rb = max3f(rb, p0[r + 2], p0[r + 3]); ra = max3f(ra, p1[r], p1[r + 1]); rb = max3f(rb, p1[r + 2], p1[r + 3]); }
        float rm = max2f(ra, rb);
        { auto rr = __builtin_amdgcn_permlane32_swap(__float_as_uint(rm), __float_as_uint(rm), false, false); rm = max2f(__uint_as_float(rr[0]), __uint_as_float(rr[1])); }
        if (first || __any(rm > THR)) {
            const float dl = first ? rm : fmaxf(rm, 0.f);
            m += dl; const float f = __builtin_amdgcn_exp2f(-dl); l *= f;
#pragma unroll
            for (int r = 0; r < 16; ++r) { p0[r] -= dl; p1[r] -= dl; o0[r] *= f; o1[r] *= f; negm[r] = -m; }
        }
        float ls = 0.f;
#pragma unroll
        for (int r = 0; r < 16; ++r) { p0[r] = __builtin_amdgcn_exp2f(p0[r]); p1[r] = __builtin_amdgcn_exp2f(p1[r]); ls += p0[r] + p1[r]; }
        l += ls;
        u32x4 w;
        w.x = pk2(p0[0], p0[1]); w.y = pk2(p0[2], p0[3]); w.z = pk2(p0[4], p0[5]); w.w = pk2(p0[6], p0[7]); pf0 = __builtin_bit_cast(bf16x8, w);
        w.x = pk2(p0[8], p0[9]); w.y = pk2(p0[10], p0[11]); w.z = pk2(p0[12], p0[13]); w.w = pk2(p0[14], p0[15]); pf1 = __builtin_bit_cast(bf16x8, w);
        w.x = pk2(p1[0], p1[1]); w.y = pk2(p1[2], p1[3]); w.z = pk2(p1[4], p1[5]); w.w = pk2(p1[6], p1[7]); pf2 = __builtin_bit_cast(bf16x8, w);
        w.x = pk2(p1[8], p1[9]); w.y = pk2(p1[10], p1[11]); w.z = pk2(p1[12], p1[13]); w.w = pk2(p1[14], p1[15]); pf3 = __builtin_bit_cast(bf16x8, w);
    };
    auto PV = [&](int boff) {
        const LAS unsigned char* Bb = lds + boff;
        s16x4 va0[4], va1[4], vc0[4], vc1[4];
#pragma unroll
        for (int kk = 0; kk < 4; ++kk) {
            const LAS unsigned char* vb = Bb + kk * 2048;
            va0[kk] = __builtin_bit_cast(s16x4, __builtin_amdgcn_ds_read_tr16_b64_v4i16((LAS s16x4*)(vb + voff0)));
            va1[kk] = __builtin_bit_cast(s16x4, __builtin_amdgcn_ds_read_tr16_b64_v4i16((LAS s16x4*)(vb + voff0 + 1024)));
            vc0[kk] = __builtin_bit_cast(s16x4, __builtin_amdgcn_ds_read_tr16_b64_v4i16((LAS s16x4*)(vb + voff1)));
            vc1[kk] = __builtin_bit_cast(s16x4, __builtin_amdgcn_ds_read_tr16_b64_v4i16((LAS s16x4*)(vb + voff1 + 1024)));
        }
#pragma unroll
        for (int kk = 0; kk < 4; ++kk) {
            const bf16x8 va = (bf16x8){va0[kk][0], va0[kk][1], va0[kk][2], va0[kk][3], va1[kk][0], va1[kk][1], va1[kk][2], va1[kk][3]};
            const bf16x8 vc = (bf16x8){vc0[kk][0], vc0[kk][1], vc0[kk][2], vc0[kk][3], vc1[kk][0], vc1[kk][1], vc1[kk][2], vc1[kk][3]};
            const bf16x8 pk = kk == 0 ? pf0 : (kk == 1 ? pf1 : (kk == 2 ? pf2 : pf3));
            o0 = __builtin_amdgcn_mfma_f32_32x32x16_bf16(va, pk, o0, 0, 0, 0);
            o1 = __builtin_amdgcn_mfma_f32_32x32x16_bf16(vc, pk, o1, 0, 0, 0);
        }
        __builtin_amdgcn_sched_group_barrier(0x100, 16, 0);
        __builtin_amdgcn_sched_group_barrier(0x008, 8, 0);
    };
#define ATT_WAIT_BAR(N) do { asm volatile("s_waitcnt vmcnt(" #N ") lgkmcnt(0)" ::: "memory"); __builtin_amdgcn_s_barrier(); asm volatile("" ::: "memory"); } while (0)
    constexpr int RING = 6, DIST = RING - 1;
    auto wait_bar = [&](int ntiles) {
        if (DQ == 96 && !upper) { switch (ntiles) { case 4: ATT_WAIT_BAR(12); break; case 3: ATT_WAIT_BAR(9); break; case 2: ATT_WAIT_BAR(6); break; case 1: ATT_WAIT_BAR(3); break; default: ATT_WAIT_BAR(0); } }
        else { switch (ntiles) { case 4: ATT_WAIT_BAR(8); break; case 3: ATT_WAIT_BAR(6); break; case 2: ATT_WAIT_BAR(4); break; case 1: ATT_WAIT_BAR(2); break; default: ATT_WAIT_BAR(0); } } };
    if (upper) __builtin_amdgcn_s_setprio(1);
    int issued = 0;
    for (; issued < DIST && issued < nt; ++issued) dma(issued, issued * BUFB);
    wait_bar(issued - 1);
    int b_cur = 0, b_iss = (DIST % RING) * BUFB;
    for (int t = 0; t < nt; ++t) {
        if (issued < nt) { dma(issued, b_iss); ++issued; b_iss += BUFB; if (b_iss == RING * BUFB) b_iss = 0; }
        if (tile_active(t)) { QK(t, b_cur); SM(t == 0); PV(b_cur); }
        { const int infl = issued - t - 2; wait_bar(infl < 0 ? 0 : infl); }
        b_cur += BUFB; if (b_cur == RING * BUFB) b_cur = 0;
    }
#undef ATT_WAIT_BAR
    if (upper) __builtin_amdgcn_s_setprio(0);
    { auto rr = __builtin_amdgcn_permlane32_swap(__float_as_uint(l), __float_as_uint(l), false, false); l = __uint_as_float(rr[0]) + __uint_as_float(rr[1]); }
    const float inv = 1.f / l;
#pragma unroll
    for (int ig = 0; ig < 4; ++ig) {
        u32x2 w0, w1;
        w0.x = pk2(o0[4 * ig] * inv, o0[4 * ig + 1] * inv); w0.y = pk2(o0[4 * ig + 2] * inv, o0[4 * ig + 3] * inv);
        w1.x = pk2(o1[4 * ig] * inv, o1[4 * ig + 1] * inv); w1.y = pk2(o1[4 * ig + 2] * inv, o1[4 * ig + 3] * inv);
        *(u32x2*)(a.optr + 8 * ig + 4 * hi) = w0;
        *(u32x2*)(a.optr + 32 + 8 * ig + 4 * hi) = w1;
    }
}

struct AU2 {
    const bf16_t* qptr; unsigned qpitch;
    bf16_t* optr;
    const bf16_t* kbase; unsigned kpitch; const bf16_t* vbase; unsigned vpitch; const bf16_t* k2base; unsigned k2pitch;
    int row_ctx, nt;
};
template <int DQ  , bool NOMAX  >
__device__ __forceinline__ void attn_unit2(LAS unsigned char* lds, const AU2& a) {
    constexpr int NS = DQ / 16;
    constexpr int BUFB = (DQ == 96) ? 20480 : 16384;
    const int tid = ltid(), lane = tid & 63, wid = __builtin_amdgcn_readfirstlane(tid >> 6), r32 = lane & 31, hi = lane >> 5;
    const bool upper = wid >= 4;
    const int kr = tid >> 3, cp = tid & 7;
    const int ksrc = (cp ^ ((kr >> 1) & 7)) * 8, vsrc = (cp ^ (((kr >> 1) & 1) << 2)) * 8;
    const int kr2 = 16 * wid + (lane >> 2), k2src = ((lane & 3) ^ ((kr2 >> 2) & 3)) * 8;
    unsigned koff[NS];
#pragma unroll
    for (int s = 0; s < NS; ++s) koff[s] = (s < 4) ? (unsigned)(r32 * 128 + (((2 * s + hi) ^ ((r32 >> 1) & 7)) << 4))
                                                   : (unsigned)(16384 + r32 * 64 + (((2 * (s - 4) + hi) ^ ((r32 >> 2) & 3)) << 4));
    const int vg = (lane >> 4) & 1, vq = (lane & 15) >> 2, vp = lane & 3, vsw = (vq >> 1) & 1;
    const unsigned voff0 = (unsigned)(8192 + (4 * hi + vq) * 128 + 64 * vsw + 32 * vg + 8 * vp);
    const unsigned voff1 = (unsigned)(8192 + (4 * hi + vq) * 128 + 64 * (1 - vsw) + 32 * vg + 8 * vp);
    bf16x8 qA[NS], qB[NS];
#pragma unroll
    for (int s = 0; s < NS; ++s) { qA[s] = *(const bf16x8*)(a.qptr + 16 * s + 8 * hi); qB[s] = *(const bf16x8*)(a.qptr + (size_t)32 * a.qpitch + 16 * s + 8 * hi); }
    f32x16 oA0, oA1, oB0, oB1, pA0, pA1, pB0, pB1;
    float mA = 0.f, lA = 0.f, mB = 0.f, lB = 0.f;
#pragma unroll
    for (int r = 0; r < 16; ++r) { oA0[r] = 0.f; oA1[r] = 0.f; oB0[r] = 0.f; oB1[r] = 0.f; }
    const int nt = a.nt;
    const unsigned lds0 = (unsigned)(uintptr_t)lds + (unsigned)wid * 1024u;
    auto dma = [&](int t, int boff) {
        const size_t r = (size_t)(a.row_ctx + 64 * t + kr);
        glds16(a.kbase + r * a.kpitch + ksrc, (unsigned)__builtin_amdgcn_readfirstlane((int)(lds0 + boff)));
        glds16(a.vbase + r * a.vpitch + vsrc, (unsigned)__builtin_amdgcn_readfirstlane((int)(lds0 + boff + 8192)));
        if (DQ == 96) { if (!upper) { const size_t r2 = (size_t)(a.row_ctx + 64 * t + kr2);
            glds16(a.k2base + r2 * a.k2pitch + k2src, (unsigned)__builtin_amdgcn_readfirstlane((int)(lds0 + boff + 16384))); } }
    };
    const f32x16 zero16 = {0.f, 0.f, 0.f, 0.f, 0.f, 0.f, 0.f, 0.f, 0.f, 0.f, 0.f, 0.f, 0.f, 0.f, 0.f, 0.f};
    auto QK = [&](int boff) {
        const LAS unsigned char* Bb = lds + boff;
        bf16x8 kf[2 * NS];
#pragma unroll
        for (int s = 0; s < NS; ++s) { kf[2 * s] = *(const LAS bf16x8*)(Bb + koff[s]); kf[2 * s + 1] = *(const LAS bf16x8*)(Bb + koff[s] + (s < 4 ? 4096 : 2048)); }
#pragma unroll
        for (int s = 0; s < NS; ++s) {
            pA0 = __builtin_amdgcn_mfma_f32_32x32x16_bf16(kf[2 * s], qA[s], s == 0 ? zero16 : pA0, 0, 0, 0); pA1 = __builtin_amdgcn_mfma_f32_32x32x16_bf16(kf[2 * s + 1], qA[s], s == 0 ? zero16 : pA1, 0, 0, 0);
            pB0 = __builtin_amdgcn_mfma_f32_32x32x16_bf16(kf[2 * s], qB[s], s == 0 ? zero16 : pB0, 0, 0, 0); pB1 = __builtin_amdgcn_mfma_f32_32x32x16_bf16(kf[2 * s + 1], qB[s], s == 0 ? zero16 : pB1, 0, 0, 0);
        }
        __builtin_amdgcn_sched_group_barrier(0x100, 2 * NS, 0);
        __builtin_amdgcn_sched_group_barrier(0x008, 4 * NS, 0);
    };
    auto SM = [&](f32x16& p0, f32x16& p1, f32x16& o0, f32x16& o1, float& m, float& l, bool first, bf16x8 (&pf)[4]) {
        float ls = 0.f;
        if constexpr (NOMAX) {
#pragma unroll
            for (int r = 0; r < 16; ++r) { p0[r] = __builtin_amdgcn_exp2f(p0[r]); p1[r] = __builtin_amdgcn_exp2f(p1[r]); ls += p0[r] + p1[r]; }
        } else {
            asm volatile("s_nop 15\n\ts_nop 7" : "+v"(p0), "+v"(p1));
            float ra = max3f(p0[0], p0[1], p1[0]), rb = max3f(p0[2], p0[3], p1[1]); ra = max3f(ra, p1[2], p1[3]);
#pragma unroll
            for (int r = 4; r < 16; r += 4) { ra = max3f(ra, p0[r], p0[r + 1]); rb = max3f(rb, p0[r + 2], p0[r + 3]); ra = max3f(ra, p1[r], p1[r + 1]); rb = max3f(rb, p1[r + 2], p1[r + 3]); }
            float rm = max2f(ra, rb);
            { auto rr = __builtin_amdgcn_permlane32_swap(__float_as_uint(rm), __float_as_uint(rm), false, false); rm = max2f(__uint_as_float(rr[0]), __uint_as_float(rr[1])); }
            if (first) m = rm;
            else if (__any(rm - m > THR)) { const float mn = fmaxf(m, rm); const float f = __builtin_amdgcn_exp2f(m - mn); m = mn; l *= f;
#pragma unroll
                for (int r = 0; r < 16; ++r) { o0[r] *= f; o1[r] *= f; } }
#pragma unroll
            for (int r = 0; r < 16; ++r) { p0[r] = __builtin_amdgcn_exp2f(p0[r] - m); p1[r] = __builtin_amdgcn_exp2f(p1[r] - m); ls += p0[r] + p1[r]; }
        }
        l += ls;
        u32x4 w;
        w.x = pk2(p0[0], p0[1]); w.y = pk2(p0[2], p0[3]); w.z = pk2(p0[4], p0[5]); w.w = pk2(p0[6], p0[7]); pf[0] = __builtin_bit_cast(bf16x8, w);
        w.x = pk2(p0[8], p0[9]); w.y = pk2(p0[10], p0[11]); w.z = pk2(p0[12], p0[13]); w.w = pk2(p0[14], p0[15]); pf[1] = __builtin_bit_cast(bf16x8, w);
        w.x = pk2(p1[0], p1[1]); w.y = pk2(p1[2], p1[3]); w.z = pk2(p1[4], p1[5]); w.w = pk2(p1[6], p1[7]); pf[2] = __builtin_bit_cast(bf16x8, w);
        w.x = pk2(p1[8], p1[9]); w.y = pk2(p1[10], p1[11]); w.z = pk2(p1[12], p1[13]); w.w = pk2(p1[14], p1[15]); pf[3] = __builtin_bit_cast(bf16x8, w);
    };
    bf16x8 pfA[4], pfB[4];
    auto PV = [&](int boff) {
        const LAS unsigned char* Bb = lds + boff;
        s16x4 va0[4], va1[4], vc0[4], vc1[4];
#pragma unroll
        for (int kk = 0; kk < 4; ++kk) {
            const LAS unsigned char* vb = Bb + kk * 2048;
            va0[kk] = __builtin_bit_cast(s16x4, __builtin_amdgcn_ds_read_tr16_b64_v4i16((LAS s16x4*)(vb + voff0)));
            va1[kk] = __builtin_bit_cast(s16x4, __builtin_amdgcn_ds_read_tr16_b64_v4i16((LAS s16x4*)(vb + voff0 + 1024)));
            vc0[kk] = __builtin_bit_cast(s16x4, __builtin_amdgcn_ds_read_tr16_b64_v4i16((LAS s16x4*)(vb + voff1)));
            vc1[kk] = __builtin_bit_cast(s16x4, __builtin_amdgcn_ds_read_tr16_b64_v4i16((LAS s16x4*)(vb + voff1 + 1024)));
        }
#pragma unroll
        for (int kk = 0; kk < 4; ++kk) {
            const bf16x8 va = (bf16x8){va0[kk][0], va0[kk][1], va0[kk][2], va0[kk][3], va1[kk][0], va1[kk][1], va1[kk][2], va1[kk][3]};
            const bf16x8 vc = (bf16x8){vc0[kk][0], vc0[kk][1], vc0[kk][2], vc0[kk][3], vc1[kk][0], vc1[kk][1], vc1[kk][2], vc1[kk][3]};
            oA0 = __builtin_amdgcn_mfma_f32_32x32x16_bf16(va, pfA[kk], oA0, 0, 0, 0); oA1 = __builtin_amdgcn_mfma_f32_32x32x16_bf16(vc, pfA[kk], oA1, 0, 0, 0);
            oB0 = __builtin_amdgcn_mfma_f32_32x32x16_bf16(va, pfB[kk], oB0, 0, 0, 0); oB1 = __builtin_amdgcn_mfma_f32_32x32x16_bf16(vc, pfB[kk], oB1, 0, 0, 0);
        }
        __builtin_amdgcn_sched_group_barrier(0x100, 16, 0);
        __builtin_amdgcn_sched_group_barrier(0x008, 16, 0);
    };
#define ATT_WAIT_BAR(N) do { asm volatile("s_waitcnt vmcnt(" #N ") lgkmcnt(0)" ::: "memory"); __builtin_amdgcn_s_barrier(); asm volatile("" ::: "memory"); } while (0)
    constexpr int RING = 6, DIST = RING - 1;
    auto wait_bar = [&](int ntiles) {
        if (DQ == 96 && !upper) { switch (ntiles) { case 4: ATT_WAIT_BAR(12); break; case 3: ATT_WAIT_BAR(9); break; case 2: ATT_WAIT_BAR(6); break; case 1: ATT_WAIT_BAR(3); break; default: ATT_WAIT_BAR(0); } }
        else { switch (ntiles) { case 4: ATT_WAIT_BAR(8); break; case 3: ATT_WAIT_BAR(6); break; case 2: ATT_WAIT_BAR(4); break; case 1: ATT_WAIT_BAR(2); break; default: ATT_WAIT_BAR(0); } } };
    if (upper) __builtin_amdgcn_s_setprio(1);
    int issued = 0;
    for (; issued < DIST && issued < nt; ++issued) dma(issued, issued * BUFB);
    wait_bar(issued - 1);
    int b_cur = 0, b_iss = (DIST % RING) * BUFB;
    for (int t = 0; t < nt; ++t) {
        if (issued < nt) { dma(issued, b_iss); ++issued; b_iss += BUFB; if (b_iss == RING * BUFB) b_iss = 0; }
        QK(b_cur);
        SM(pA0, pA1, oA0, oA1, mA, lA, t == 0, pfA);
        SM(pB0, pB1, oB0, oB1, mB, lB, t == 0, pfB);
        PV(b_cur);
        { const int infl = issued - t - 2; wait_bar(infl < 0 ? 0 : infl); }
        b_cur += BUFB; if (b_cur == RING * BUFB) b_cur = 0;
    }
#undef ATT_WAIT_BAR
    if (upper) __builtin_amdgcn_s_setprio(0);
    { auto rr = __builtin_amdgcn_permlane32_swap(__float_as_uint(lA), __float_as_uint(lA), false, false); lA = __uint_as_float(rr[0]) + __uint_as_float(rr[1]); }
    { auto rr = __builtin_amdgcn_permlane32_swap(__float_as_uint(lB), __float_as_uint(lB), false, false); lB = __uint_as_float(rr[0]) + __uint_as_float(rr[1]); }
    const float invA = 1.f / lA, invB = 1.f / lB; bf16_t* oB = a.optr + (size_t)32 * 1024;
#pragma unroll
    for (int ig = 0; ig < 4; ++ig) {
        u32x2 w0, w1;
        w0.x = pk2(oA0[4 * ig] * invA, oA0[4 * ig + 1] * invA); w0.y = pk2(oA0[4 * ig + 2] * invA, oA0[4 * ig + 3] * invA);
        w1.x = pk2(oA1[4 * ig] * invA, oA1[4 * ig + 1] * invA); w1.y = pk2(oA1[4 * ig + 2] * invA, oA1[4 * ig + 3] * invA);
        *(u32x2*)(a.optr + 8 * ig + 4 * hi) = w0; *(u32x2*)(a.optr + 32 + 8 * ig + 4 * hi) = w1;
        w0.x = pk2(oB0[4 * ig] * invB, oB0[4 * ig + 1] * invB); w0.y = pk2(oB0[4 * ig + 2] * invB, oB0[4 * ig + 3] * invB);
        w1.x = pk2(oB1[4 * ig] * invB, oB1[4 * ig + 1] * invB); w1.y = pk2(oB1[4 * ig + 2] * invB, oB1[4 * ig + 3] * invB);
        *(u32x2*)(oB + 8 * ig + 4 * hi) = w0; *(u32x2*)(oB + 32 + 8 * ig + 4 * hi) = w1;
    }
}

struct Job { const float* src; bf16_t* dst; int K, N, ldd, nb; size_t sbs, dbs; int mode; const float* rscale; };

__device__ __forceinline__ int hperm64(int c) { const int base = c & ~63, cl = c & 63, p = cl >> 1, n = cl & 1, g = p >> 4, i = p & 15; return base + 32 * g + 16 * n + i; }
__device__ __forceinline__ int rowmap(int mode, int c) {
    switch (mode) {
        case 1: return c < 640 ? hperm64(c) : c;
        case 2: if ((c >= 384 && c < 896) || (c >= 1184 && c < 1312)) { const int b0 = (c >= 1184) ? 1184 : 384; return b0 + hperm64(c - b0); }
                if (c >= 1152 && c < 1184) { const int cl = c - 1152; return 1152 + 16 * (cl & 1) + (cl >> 1); }
                return c;
        case 3: { const int h = c / 96, cl = c % 96; if (cl < 64) return c; const int r = cl - 64; return h * 96 + 64 + 16 * (r & 1) + (r >> 1); }
        case 4: return 32 * (c >> 4) + (c & 15);
        case 5: return 32 * (c >> 4) + 16 + (c & 15);
        default: return c;
    }
}
__device__ __forceinline__ float colscale(int mode, int c) {
    if (mode == 1) return (c < 512 || (c >= 768 && c < 1280)) ? QS64 : 1.f;
    if (mode == 3) return QS96;
    return 1.f;
}
__device__ __forceinline__ bool get_job(PP P, int j, Job& J) {
    const int layer = j >= 9 ? 1 : 0, jj = layer ? j - 9 : j; const int ib = layer ? 20 : 4;
    bf16_t* W = (bf16_t*)(P->ws + (layer ? WS_W1 : WS_W0));
    J.nb = 1; J.sbs = 0; J.dbs = 0; J.rscale = nullptr; J.mode = 0; J.ldd = 1024; J.K = 1024;
    switch (jj) {
        case 0: J.src = P->in[ib + 3]; J.dst = W + WO_IN; J.N = layer ? 1440 : 2304; J.mode = layer ? 2 : 1; break;
        case 1: J.src = P->in[layer ? 30 : 10]; J.dst = W + WO_OUT; J.N = 1024; break;
        case 2: J.src = P->in[layer ? 32 : 12]; J.dst = W + WO_RT; J.N = 64; J.mode = 7; break;
        case 3: J.src = P->in[layer ? 34 : 14]; J.dst = W + WO_GU; J.N = 256; J.nb = 64; J.sbs = (size_t)1024 * 256; J.dbs = (size_t)512 * 1024; J.mode = 4; break;
        case 4: J.src = P->in[layer ? 35 : 15]; J.dst = W + WO_GU; J.N = 256; J.nb = 64; J.sbs = (size_t)1024 * 256; J.dbs = (size_t)512 * 1024; J.mode = 5; break;
        case 5: J.src = P->in[layer ? 36 : 16]; J.dst = W + WO_D; J.K = 256; J.N = 1024; J.ldd = 256; J.nb = 64; J.sbs = (size_t)256 * 1024; J.dbs = (size_t)1024 * 256; break;
        case 6: J.src = P->in[layer ? 37 : 17]; J.dst = W + WO_GU + (size_t)64 * 512 * 1024; J.N = 256; J.mode = 4; break;
        case 7: J.src = P->in[layer ? 38 : 18]; J.dst = W + WO_GU + (size_t)64 * 512 * 1024; J.N = 256; J.mode = 5; break;
        case 8: J.src = P->in[layer ? 39 : 19]; J.dst = W + WO_D + (size_t)64 * 1024 * 256; J.K = 256; J.N = 1024; J.ldd = 256; break;
        case 9: J.src = P->in[25]; J.dst = W + WO_UQ; J.K = 384; J.N = 768; J.ldd = 384; J.mode = 3; J.rscale = P->in[24]; break;
        case 10: J.src = P->in[27]; J.dst = W + WO_UKV; J.K = 256; J.N = 1024; J.ldd = 256; J.mode = 6; J.rscale = P->in[26]; break;
        default: return false;
    }
    return true;
}
constexpr int NJOBS = 20;
__device__ __forceinline__ int job_tiles(const Job& J) { return J.nb * (J.K >> 6) * ((J.N + 255) >> 8); }

__device__ __forceinline__ void conv_tile(const Job& J, int tile, LAS float* T) {
    const int tid = ltid(); const int ntn = (J.N + 255) >> 8, ntk = J.K >> 6;
    const int b = tile / (ntn * ntk), r = tile % (ntn * ntk), tk = r / ntn, tn = r % ntn;
    const float* src = J.src + (size_t)b * J.sbs; bf16_t* dst = J.dst + (size_t)b * J.dbs; const int k0 = tk * 64, n0 = tn * 256;
    { const int n4 = (tid & 63) * 4; const bool ok = (n0 + n4) < J.N;
      f32x4 v[8];
#pragma unroll
      for (int j = 0; j < 8; ++j) { const int k = (tid >> 6) + 8 * j; v[j] = ok ? *(const f32x4*)(src + (size_t)(k0 + k) * J.N + n0 + n4) : (f32x4){0.f, 0.f, 0.f, 0.f}; }
      f32x4 cs; cs[0] = colscale(J.mode, n0 + n4); cs[1] = colscale(J.mode, n0 + n4 + 1); cs[2] = colscale(J.mode, n0 + n4 + 2); cs[3] = colscale(J.mode, n0 + n4 + 3);
#pragma unroll
      for (int j = 0; j < 8; ++j) { const int k = (tid >> 6) + 8 * j; f32x4 x = v[j] * cs; if (J.rscale) x = x * J.rscale[k0 + k]; *(LAS f32x4*)(T + k * 260 + n4) = x; } }
    __syncthreads();
    { const int nn = tid >> 1, kh = (tid & 1) * 32;
      if (n0 + nn < J.N) { const int drow = rowmap(J.mode, n0 + nn); bf16_t* dp = dst + (size_t)drow * J.ldd + k0 + kh;
#pragma unroll
          for (int q = 0; q < 4; ++q) { float v[8];
#pragma unroll
              for (int j = 0; j < 8; ++j) v[j] = T[(kh + 8 * q + j) * 260 + nn];
              u32x4 w; w.x = pk2(v[0], v[1]); w.y = pk2(v[2], v[3]); w.z = pk2(v[4], v[5]); w.w = pk2(v[6], v[7]);
              *(u32x4*)(dp + 8 * q) = w;
              if (J.mode == 7) { u32x4 w2;
                  w2.x = pk2(v[0] - bflo(w.x), v[1] - bfhi(w.x)); w2.y = pk2(v[2] - bflo(w.y), v[3] - bfhi(w.y));
                  w2.z = pk2(v[4] - bflo(w.z), v[5] - bfhi(w.z)); w2.w = pk2(v[6] - bflo(w.w), v[7] - bfhi(w.w));
                  *(u32x4*)(dp + (size_t)64 * 1024 + 8 * q) = w2; } } } }
    __syncthreads();
}

__device__ __forceinline__ void ada_item(PP P, int item, LAS float* S) {
    const int tid = ltid(); const int layer = item / 96, chunk = item % 96;
    for (int idx = tid; idx < 33 * 1024; idx += 512) { const int r = idx >> 10, k = idx & 1023; const float x = (r < 32) ? P->in[1][r * 1024 + k] : P->in[3][k]; S[idx] = x / (1.f + expf(-x)); }
    __syncthreads();
    const int col = chunk * 64 + (tid & 63), kg = tid >> 6;
    float acc[33];
#pragma unroll
    for (int r = 0; r < 33; ++r) acc[r] = 0.f;
    const float* W = P->in[layer ? 20 : 4] + col;
    for (int k = kg * 128; k < kg * 128 + 128; ++k) { const float w = W[(size_t)k * 6144];
#pragma unroll
        for (int r = 0; r < 33; ++r) acc[r] += S[r * 1024 + k] * w; }
    __syncthreads();
#pragma unroll
    for (int r = 0; r < 33; ++r) S[(kg * 33 + r) * 64 + (tid & 63)] = acc[r];
    __syncthreads();
    float* ada = (float*)(P->ws + WS_ADA) + (size_t)layer * 33 * 6144; const float* bias = P->in[layer ? 21 : 5];
    for (int idx = tid; idx < 33 * 64; idx += 512) { const int r = idx >> 6, cc = idx & 63; float s = 0.f;
#pragma unroll
        for (int g = 0; g < 8; ++g) s += S[(g * 33 + r) * 64 + cc];
        ada[(size_t)r * 6144 + chunk * 64 + cc] = s + bias[chunk * 64 + cc]; }
    __syncthreads();
}

__device__ __forceinline__ void phase_prologue(PP P, LAS unsigned char* lds, int c, int G) {
    const int tid = ltid();
    for (int it = c; it < 192; it += G) ada_item(P, it, (LAS float*)lds);
    { float* rp = (float*)(P->ws + WS_ROPE); float* cosh_ = rp; float* sinh_ = rp + 2048 * 32; float* cosr_ = rp + 2 * 2048 * 32; float* sinr_ = cosr_ + 2048 * 16;
      for (int idx = c * 512 + tid; idx < 2048 * 48; idx += G * 512) {
          if (idx < 2048 * 32) { const int t = idx >> 5, p = idx & 31; const float pos = (p < 16) ? (float)(t >> 6) : (float)(t & 63); const int i = p & 15;
              const float inv = powf(10000.0f, -(float)i / 16.0f); const float ang = pos * inv; cosh_[idx] = cosf(ang); sinh_[idx] = sinf(ang); }
          else { const int k = idx - 2048 * 32; const int t = k >> 4, p = k & 15; const float pos = (p < 8) ? (float)(t >> 6) : (float)(t & 63); const int i = p & 7;
              const float inv = powf(10000.0f, -(float)i / 8.0f); const float ang = pos * inv; cosr_[k] = cosf(ang); sinr_[k] = sinf(ang); } } }
    { u32x4* z = (u32x4*)((bf16_t*)(P->ws + WS_W1) + WO_IN + (size_t)1440 * 1024); for (int idx = c * 512 + tid; idx < 96 * 1024 / 8; idx += G * 512) z[idx] = (u32x4){0u, 0u, 0u, 0u}; }
    { int base = 0; int tile = c;
      for (int j = 0; j < NJOBS; ++j) { Job J; get_job(P, j, J); const int n = job_tiles(J);
          while (tile < base + n) { conv_tile(J, tile - base, (LAS float*)lds); tile += G; }
          base += n; } }
}

__device__ __forceinline__ void phase_norm(PP P, int c, int G, const float* xlat, const float* xctx, const float* g, const float* ada  , int sh_off, int sc_off, bool latent_only, bf16_t* H, bf16_t* HLO,
                                           const bool resid = false, float* xlat_dst = nullptr, float* xctx_dst = nullptr) {
    const int tid_ = ltid(); const int lane = tid_ & 63, wv = c * 8 + (tid_ >> 6), nw = G * 8;
    for (int row = wv; row < MROWS; row += nw) {
        const int b = row / TOK, t = row % TOK; const bool ctx = t < CTX;
        if (ctx && latent_only) continue;
        const float* x = ctx ? xctx + ((size_t)b * CTX + t) * 1024 : xlat + ((size_t)b * SEQ + t - CTX) * 1024;
        const float* ap = ada + (size_t)(ctx ? 32 : b) * 6144;
        f32x4 v[4]; float ss = 0.f;
#pragma unroll
        for (int i = 0; i < 2; ++i) { v[2 * i] = *(const f32x4*)(x + 512 * i + 8 * lane); v[2 * i + 1] = *(const f32x4*)(x + 512 * i + 8 * lane + 4); }
        if (resid) {
            float* xd = ctx ? xctx_dst + ((size_t)b * CTX + t) * 1024 : xlat_dst + ((size_t)b * SEQ + t - CTX) * 1024;
#pragma unroll
            for (int i = 0; i < 2; ++i) { const u32x4 yw = *(const u32x4*)(HLO + (size_t)row * 1024 + 512 * i + 8 * lane);
                const f32x4 g0 = *(const f32x4*)(ap + 2048 + 512 * i + 8 * lane), g1 = *(const f32x4*)(ap + 2048 + 512 * i + 8 * lane + 4);
                v[2 * i][0] += g0[0] * bflo(yw.x); v[2 * i][1] += g0[1] * bfhi(yw.x); v[2 * i][2] += g0[2] * bflo(yw.y); v[2 * i][3] += g0[3] * bfhi(yw.y);
                v[2 * i + 1][0] += g1[0] * bflo(yw.z); v[2 * i + 1][1] += g1[1] * bfhi(yw.z); v[2 * i + 1][2] += g1[2] * bflo(yw.w); v[2 * i + 1][3] += g1[3] * bfhi(yw.w);
                *(f32x4*)(xd + 512 * i + 8 * lane) = v[2 * i]; *(f32x4*)(xd + 512 * i + 8 * lane + 4) = v[2 * i + 1]; }
        }
#pragma unroll
        for (int i = 0; i < 4; ++i) ss += v[i][0] * v[i][0] + v[i][1] * v[i][1] + v[i][2] * v[i][2] + v[i][3] * v[i][3];
        ss = wave_sum(ss); const float rstd = rsqrtf(ss * (1.f / 1024.f) + EPS);
#pragma unroll
        for (int i = 0; i < 2; ++i) { const int col = 512 * i + 8 * lane; float o[8];
#pragma unroll
            for (int h = 0; h < 2; ++h) { const f32x4 gg = *(const f32x4*)(g + col + 4 * h), sc = *(const f32x4*)(ap + sc_off + col + 4 * h), sh = *(const f32x4*)(ap + sh_off + col + 4 * h);
#pragma unroll
                for (int j = 0; j < 4; ++j) o[4 * h + j] = v[2 * i + h][j] * rstd * gg[j] * (1.f + sc[j]) + sh[j]; }
            u32x4 w; w.x = pk2(o[0], o[1]); w.y = pk2(o[2], o[3]); w.z = pk2(o[4], o[5]); w.w = pk2(o[6], o[7]);
            *(u32x4*)(H + (size_t)row * 1024 + col) = w;
            if (HLO) { u32x4 w2; w2.x = pk2(o[0] - bflo(w.x), o[1] - bfhi(w.x)); w2.y = pk2(o[2] - bflo(w.y), o[3] - bfhi(w.y)); w2.z = pk2(o[4] - bflo(w.z), o[5] - bfhi(w.z)); w2.w = pk2(o[6] - bflo(w.w), o[7] - bfhi(w.w));
                *(u32x4*)(HLO + (size_t)row * 1024 + col) = w2; } }
    }
}

__device__ __forceinline__ void phase_post1(PP P, int c, int G) {
    const int tid_ = ltid(); const int lane = tid_ & 63, wv = c * 8 + (tid_ >> 6), nw = G * 8;
    bf16_t* Pb = (bf16_t*)(P->ws + WS_BIG + BIG_P); float* RS = (float*)(P->ws + WS_RSTD);
    const float* rp = (const float*)(P->ws + WS_ROPE); const float* cosh_ = rp; const float* sinh_ = rp + 2048 * 32; const float* cosr_ = rp + 2 * 2048 * 32; const float* sinr_ = cosr_ + 2048 * 16;
    const float* gqn = P->in[28]; const float* gkn = P->in[29];
    for (int row = wv; row < MROWS; row += nw) {
        bf16_t* pr = Pb + (size_t)row * 1536; const int t = row % TOK; const bool lat = t >= CTX; const int tt = t - CTX;
        float s1 = 0.f, s2 = 0.f;
        if (lane < 48) { const u32x4 w = *(const u32x4*)(pr + 8 * lane); const float a0 = bflo(w.x), a1 = bfhi(w.x), a2 = bflo(w.y), a3 = bfhi(w.y), a4 = bflo(w.z), a5 = bfhi(w.z), a6 = bflo(w.w), a7 = bfhi(w.w);
            s1 = a0 * a0 + a1 * a1 + a2 * a2 + a3 * a3 + a4 * a4 + a5 * a5 + a6 * a6 + a7 * a7; }
        if (lane < 32) { const u32x4 w = *(const u32x4*)(pr + 896 + 8 * lane); const float a0 = bflo(w.x), a1 = bfhi(w.x), a2 = bflo(w.y), a3 = bfhi(w.y), a4 = bflo(w.z), a5 = bfhi(w.z), a6 = bflo(w.w), a7 = bfhi(w.w);
            s2 = a0 * a0 + a1 * a1 + a2 * a2 + a3 * a3 + a4 * a4 + a5 * a5 + a6 * a6 + a7 * a7; }
        s1 = wave_sum(s1); s2 = wave_sum(s2);
        if (lane == 0) { RS[(size_t)row * 2] = rsqrtf(s1 * (1.f / 384.f) + EPS); RS[(size_t)row * 2 + 1] = rsqrtf(s2 * (1.f / 256.f) + EPS); }
#pragma unroll
        for (int ps = 0; ps < 2; ++ps) {
            const int Gi = lane >> 2, qd = lane & 3; const bool on = (ps == 0) || (lane < 16);
            bf16_t* base = pr + (ps == 0 ? 384 : 1184) + 32 * Gi + 4 * qd;
            float x0[4] = {0.f, 0.f, 0.f, 0.f}, x1[4] = {0.f, 0.f, 0.f, 0.f};
            if (on) { const u32x2 w0 = *(const u32x2*)base, w1 = *(const u32x2*)(base + 16);
                x0[0] = bflo(w0.x); x0[1] = bfhi(w0.x); x0[2] = bflo(w0.y); x0[3] = bfhi(w0.y); x1[0] = bflo(w1.x); x1[1] = bfhi(w1.x); x1[2] = bflo(w1.y); x1[3] = bfhi(w1.y); }
            float ss = 0.f;
#pragma unroll
            for (int j = 0; j < 4; ++j) ss += x0[j] * x0[j] + x1[j] * x1[j];
            ss += __shfl_xor(ss, 1); ss += __shfl_xor(ss, 2); ss += __shfl_xor(ss, 4);
            const float rstd = rsqrtf(ss * (1.f / 64.f) + EPS);
            const int gsel = Gi & 1; const float* gn = ps == 0 ? gqn : gkn; const float qs = ps == 0 ? QS64 : 1.f;
            if (on) { float y0[4], y1[4];
#pragma unroll
                for (int j = 0; j < 4; ++j) { const int pidx = 16 * gsel + 4 * qd + j; y0[j] = x0[j] * rstd * gn[2 * pidx]; y1[j] = x1[j] * rstd * gn[2 * pidx + 1];
                    if (lat) { const float cs = cosh_[(size_t)tt * 32 + pidx], sn = sinh_[(size_t)tt * 32 + pidx]; const float a = y0[j] * cs - y1[j] * sn, bb = y0[j] * sn + y1[j] * cs; y0[j] = a; y1[j] = bb; }
                    y0[j] *= qs; y1[j] *= qs; }
                u32x2 w0, w1; w0.x = pk2(y0[0], y0[1]); w0.y = pk2(y0[2], y0[3]); w1.x = pk2(y1[0], y1[1]); w1.y = pk2(y1[2], y1[3]);
                *(u32x2*)base = w0; *(u32x2*)(base + 16) = w1; }
        }
        if (lat && lane < 4) { bf16_t* base = pr + 1152 + 4 * lane; const u32x2 w0 = *(const u32x2*)base, w1 = *(const u32x2*)(base + 16);
            float x0[4] = {bflo(w0.x), bfhi(w0.x), bflo(w0.y), bfhi(w0.y)}, x1[4] = {bflo(w1.x), bfhi(w1.x), bflo(w1.y), bfhi(w1.y)}; float y0[4], y1[4];
#pragma unroll
            for (int j = 0; j < 4; ++j) { const int pidx = 4 * lane + j; const float cs = cosr_[(size_t)tt * 16 + pidx], sn = sinr_[(size_t)tt * 16 + pidx]; y0[j] = x0[j] * cs - x1[j] * sn; y1[j] = x0[j] * sn + x1[j] * cs; }
            u32x2 o0, o1; o0.x = pk2(y0[0], y0[1]); o0.y = pk2(y0[2], y0[3]); o1.x = pk2(y1[0], y1[1]); o1.y = pk2(y1[2], y1[3]);
            *(u32x2*)base = o0; *(u32x2*)(base + 16) = o1; }
    }
}

__device__ __forceinline__ void phase_router(PP P, LAS unsigned char* lds, int c, int G, int layer) {
    const int tid = ltid(), lane = tid & 63, wid = tid >> 6, r32 = lane & 31, hi = lane >> 5;
    const bf16_t* H = (const bf16_t*)(P->ws + WS_H); const bf16_t* HLO = (const bf16_t*)(P->ws + WS_BIG + BIG_HLO);
    const bf16_t* W = (const bf16_t*)(P->ws + (layer ? WS_W1 : WS_W0)) + WO_RT; const bf16_t* WL = W + 64 * 1024;
    const float* brt = P->in[layer ? 33 : 13];
    int* cnt = (int*)(P->ws + WS_CTL + CTL_CNT) + layer * NG; int* srow = (int*)(P->ws + WS_SROW); float* sw = (float*)(P->ws + WS_SW); int* tslot = (int*)(P->ws + WS_TSLOT);
    LAS float* L = (LAS float*)lds + wid * (32 * 65);
    const int ngroups = MROWS / 32;
    for (int gidx = c * 8 + wid; gidx < ngroups; gidx += G * 8) {
        const int row0 = gidx * 32; const int t0 = row0 % TOK;
        if (layer == 1 && t0 < CTX) continue;
        f32x16 a0, a1;
#pragma unroll
        for (int r = 0; r < 16; ++r) { a0[r] = 0.f; a1[r] = 0.f; }
        const bf16_t* hp = H + (size_t)(row0 + r32) * 1024 + 8 * hi; const bf16_t* hl = HLO + (size_t)(row0 + r32) * 1024 + 8 * hi;
        const bf16_t* w0 = W + (size_t)r32 * 1024 + 8 * hi; const bf16_t* wl0 = WL + (size_t)r32 * 1024 + 8 * hi;
#pragma unroll 4
        for (int s = 0; s < 64; ++s) {
            const bf16x8 xh = *(const bf16x8*)(hp + 16 * s), xl = *(const bf16x8*)(hl + 16 * s);
            const bf16x8 wa = *(const bf16x8*)(w0 + 16 * s), wb = *(const bf16x8*)(w0 + 32 * 1024 + 16 * s);
            const bf16x8 la = *(const bf16x8*)(wl0 + 16 * s), lb = *(const bf16x8*)(wl0 + 32 * 1024 + 16 * s);
            a0 = __builtin_amdgcn_mfma_f32_32x32x16_bf16(wa, xh, a0, 0, 0, 0); a1 = __builtin_amdgcn_mfma_f32_32x32x16_bf16(wb, xh, a1, 0, 0, 0);
            a0 = __builtin_amdgcn_mfma_f32_32x32x16_bf16(wa, xl, a0, 0, 0, 0); a1 = __builtin_amdgcn_mfma_f32_32x32x16_bf16(wb, xl, a1, 0, 0, 0);
            a0 = __builtin_amdgcn_mfma_f32_32x32x16_bf16(la, xh, a0, 0, 0, 0); a1 = __builtin_amdgcn_mfma_f32_32x32x16_bf16(lb, xh, a1, 0, 0, 0);
        }
#pragma unroll
        for (int r = 0; r < 16; ++r) { const int e = (r & 3) + 8 * (r >> 2) + 4 * hi; L[r32 * 65 + e] = a0[r]; L[r32 * 65 + e + 32] = a1[r]; }
        __builtin_amdgcn_s_waitcnt(0xC07F);
        __builtin_amdgcn_wave_barrier();
        if (lane < 32) {
            const int row = row0 + lane; float bk[6], bs[6]; int bi[6];
#pragma unroll
            for (int k = 0; k < 6; ++k) { bk[k] = -1e30f; bs[k] = 0.f; bi[k] = 0; }
            for (int e = 0; e < 64; ++e) { const float x = L[lane * 65 + e]; const float sc = 1.f / (1.f + expf(-x)); float key = sc + brt[e]; float s = sc; int id = e;
#pragma unroll
                for (int k = 0; k < 6; ++k) { if (key > bk[k]) { const float tk = bk[k], ts = bs[k]; const int ti = bi[k]; bk[k] = key; bs[k] = s; bi[k] = id; key = tk; s = ts; id = ti; } } }
            float tot = 0.f;
#pragma unroll
            for (int k = 0; k < 6; ++k) tot += bs[k];
            const float sc = 2.5f / tot; const int ch = row / CHUNK_ROWS;
#pragma unroll
            for (int k = 0; k < 6; ++k) { const int e = bi[k]; const int pos = atomicAdd(cnt + ch * NGRP + e, 1);
                if (pos < CAP) { srow[(size_t)(ch * 64 + e) * CAP + pos] = row; sw[(size_t)(ch * 64 + e) * CAP + pos] = bs[k] * sc; }
                tslot[(size_t)row * 6 + k] = (e << 20) | pos; }
        }
        __builtin_amdgcn_wave_barrier();
    }
    if (c == 0 && tid < NCHUNK) cnt[tid * NGRP + NEXP] = layer ? CHUNK_B * SEQ : CHUNK_ROWS;
}

__device__ __forceinline__ void build_toff(LAS int* toff, const int* cnt) {
    const int tid = ltid();
    if (tid < 64) { int v[5], s = 0;
#pragma unroll
        for (int j = 0; j < 5; ++j) { const int g = tid * 5 + j; const int cv = (g < NG) ? ld_ctl(cnt + g) : 0; if (g < NG) toff[272 + g] = cv; v[j] = (cv + 255) >> 8; s += v[j]; }
        int inc = s;
#pragma unroll
        for (int o = 1; o < 64; o <<= 1) { const int t = __shfl_up(inc, o); if (tid >= o) inc += t; }
        int ex = inc - s;
#pragma unroll
        for (int j = 0; j < 5; ++j) { const int g = tid * 5 + j; if (g <= NG) toff[g] = ex; ex += v[j]; } }
    __syncthreads();
}

__device__ __forceinline__ void phase_combine(PP P, LAS unsigned char* lds, int c, int G, int layer, int ch) {
    const int tid_ = ltid(); const int lane = tid_ & 63, wv = c * 8 + (tid_ >> 6), nw = G * 8;
    LAS const int* toff = (LAS const int*)(lds + LDS_TAB);
    const bf16_t* slab = (const bf16_t*)(P->ws + WS_BIG + BIG_SLAB); const int* tslot = (const int*)(P->ws + WS_TSLOT);
    const float* ada = (const float*)(P->ws + WS_ADA) + (size_t)layer * 33 * 6144; const float* ada1 = (const float*)(P->ws + WS_ADA) + (size_t)33 * 6144;
    float* xc = (float*)(P->ws + WS_XC); bf16_t* H = (bf16_t*)(P->ws + WS_H);
    const int t0 = toff[ch * NGRP];
    for (int rr = wv; rr < CHUNK_ROWS; rr += nw) {
        const int row = ch * CHUNK_ROWS + rr; const int b = row / TOK, t = row % TOK; const bool ctx = t < CTX;
        if (ctx && layer == 1) continue;
        int sidx = 0;
        if (lane < 6) { const int v = __hip_atomic_load(tslot + (size_t)row * 6 + lane, __ATOMIC_RELAXED, __HIP_MEMORY_SCOPE_AGENT); sidx = (toff[ch * NGRP + (v >> 20)] - t0) * 256 + (v & 0xfffff); }
        if (lane == 6) { const int rank = layer ? ((b - ch * CHUNK_B) * SEQ + t - CTX) : rr; sidx = (toff[ch * NGRP + NEXP] - t0) * 256 + rank; }
        float* x = ctx ? xc + ((size_t)b * CTX + t) * 1024 : P->out + ((size_t)b * SEQ + t - CTX) * 1024;
        const float* ap = ada + (size_t)(ctx ? 32 : b) * 6144 + 5 * 1024;
        f32x4 xv[4];
#pragma unroll
        for (int i = 0; i < 4; ++i) xv[i] = *(const f32x4*)(x + 512 * (i >> 1) + 8 * lane + 4 * (i & 1));
        float acc[16];
#pragma unroll
        for (int j = 0; j < 16; ++j) acc[j] = 0.f;
#pragma unroll
        for (int k = 0; k < 7; ++k) { const int s = __shfl(sidx, k); const bf16_t* sp = slab + (size_t)s * 1024;
#pragma unroll
            for (int i = 0; i < 2; ++i) { const u32x4 w = __builtin_nontemporal_load((const u32x4*)(sp + 512 * i + 8 * lane));
                acc[8 * i + 0] += bflo(w.x); acc[8 * i + 1] += bfhi(w.x); acc[8 * i + 2] += bflo(w.y); acc[8 * i + 3] += bfhi(w.y);
                acc[8 * i + 4] += bflo(w.z); acc[8 * i + 5] += bfhi(w.z); acc[8 * i + 6] += bflo(w.w); acc[8 * i + 7] += bfhi(w.w); } }
        float v[16]; float ss = 0.f;
#pragma unroll
        for (int i = 0; i < 4; ++i) { const f32x4 gq = *(const f32x4*)(ap + 512 * (i >> 1) + 8 * lane + 4 * (i & 1));
#pragma unroll
            for (int j = 0; j < 4; ++j) { const float y = xv[i][j] + gq[j] * acc[4 * i + j]; v[4 * i + j] = y; ss += y * y; } }
        ss = wave_sum(ss); const float rstd = rsqrtf(ss * (1.f / 1024.f) + EPS);
        if (layer == 0) {
            const float* gm1 = P->in[22]; const float* a1 = ada1 + (size_t)(ctx ? 32 : b) * 6144; float o[16];
#pragma unroll
            for (int i = 0; i < 4; ++i) { const int col = 512 * (i >> 1) + 8 * lane + 4 * (i & 1);
                *(f32x4*)(x + col) = (f32x4){v[4 * i], v[4 * i + 1], v[4 * i + 2], v[4 * i + 3]};
                const f32x4 gg = *(const f32x4*)(gm1 + col), sc = *(const f32x4*)(a1 + 1024 + col), sh = *(const f32x4*)(a1 + col);
#pragma unroll
                for (int j = 0; j < 4; ++j) o[4 * i + j] = v[4 * i + j] * rstd * gg[j] * (1.f + sc[j]) + sh[j]; }
#pragma unroll
            for (int i = 0; i < 2; ++i) { u32x4 w; w.x = pk2(o[8 * i], o[8 * i + 1]); w.y = pk2(o[8 * i + 2], o[8 * i + 3]); w.z = pk2(o[8 * i + 4], o[8 * i + 5]); w.w = pk2(o[8 * i + 6], o[8 * i + 7]);
                *(u32x4*)(H + (size_t)row * 1024 + 512 * i + 8 * lane) = w; }
        } else {
            const float* gf = P->in[40];
#pragma unroll
            for (int i = 0; i < 4; ++i) { const int col = 512 * (i >> 1) + 8 * lane + 4 * (i & 1); const f32x4 gg = *(const f32x4*)(gf + col); f32x4 o;
#pragma unroll
                for (int j = 0; j < 4; ++j) o[j] = v[4 * i + j] * rstd * gg[j];
                *(f32x4*)(x + col) = o; }
        }
    }
}

__device__ __forceinline__ int remap64(int c, int i, int G) { return c + i * G; }
__device__ __forceinline__ int remap8(int c, int G) { return c; }
__device__ __forceinline__ void phase_attn0(PP P, LAS unsigned char* lds, int c, int G) {
    const int tid = ltid(), lane = tid & 63, wid = __builtin_amdgcn_readfirstlane(tid >> 6), r32 = lane & 31;
    const bf16_t* QKV = (const bf16_t*)(P->ws + WS_BIG + BIG_QKV); bf16_t* ATT = (bf16_t*)(P->ws + WS_H);
    const float* sink = P->in[8]; const float* rpb = P->in[9];
    for (int i = 0; c + i * G < 2048; ++i) {
        const int u = remap64(c, i, G); const int b = u >> 6, kvh = (u >> 5) & 1, blk = u & 31; const int g = wid & 3, ts = wid >> 2; const int head = kvh * 4 + g;
        AU a; const int tok = blk * 64 + 32 * ts + r32; const size_t qrow = (size_t)b * TOK + CTX + tok;
        a.qptr = QKV + qrow * 2304 + head * 64; a.optr = ATT + qrow * 1024 + head * 64;
        a.kbase = QKV + 512 + kvh * 64; a.kpitch = 2304; a.vbase = QKV + 640 + kvh * 64; a.vpitch = 2304; a.k2base = nullptr; a.k2pitch = 0;
        a.row_ctx = b * TOK; a.row_lat = b * TOK + CTX; a.start = blk * 64;
        const int jlo = blk >= 2 ? 0 : 2 - blk; int jhi = (2048 + 128 - blk * 64) / 64; jhi = jhi > 5 ? 5 : jhi;
        a.j0 = jlo; a.nt = 4 + (jhi - jlo); a.qoff = 32 * ts + r32; a.m0 = sink[head] * LOG2E; a.l0 = 1.f;
        attn_unit<1, 64>(lds, a);
    }
    for (int i = 0; c + i * G < 2048; ++i) {
        const int u = remap64(c, i, G); const int b = u >> 6, head = (u >> 3) & 7, uu = u & 7;
        { LAS float* bt = (LAS float*)(lds + ATT_RPB);
          for (int idx = tid; idx < 15 * 128; idx += 512) { const int dr = idx >> 7, dc = (idx & 127) - 48; bt[idx] = (dc >= 0 && dc <= 30) ? rpb[(head * 15 + dr) * 31 + dc] * LOG2E : 0.f; } }
        AU a; const int qr = 4 * uu + (wid >> 1), qc = 32 * (wid & 1) + r32; const int tok = qr * 64 + qc; const size_t qrow = (size_t)b * TOK + CTX + tok;
        a.qptr = QKV + qrow * 2304 + 768 + head * 64; a.optr = ATT + qrow * 1024 + 512 + head * 64;
        a.kbase = QKV + 1280 + head * 64; a.kpitch = 2304; a.vbase = QKV + 1792 + head * 64; a.vpitch = 2304; a.k2base = nullptr; a.k2pitch = 0;
        a.row_ctx = b * TOK; a.row_lat = b * TOK + CTX; a.start = 0;
        int rs0 = 4 * uu - 4; rs0 = rs0 < 0 ? 0 : (rs0 > 24 ? 24 : rs0); int rl = 4 * uu - 1; rl = rl < 0 ? 0 : (rl > 24 ? 24 : rl);
        a.j0 = rs0; a.nt = 4 + (rl + 8 - rs0); a.qoff = tok; a.m0 = 0.f; a.l0 = 0.f;
        attn_unit<2, 64>(lds, a);
    }
    for (int u0 = c; u0 < 256; u0 += G) {
        const int u = remap8(u0, G); const int b = u >> 3, kvh = (u >> 2) & 1, cb = u & 3; const int g = wid & 3, ts = wid >> 2; const int head = kvh * 4 + g;
        AU a; const int tok = cb * 64 + 32 * ts + r32; const size_t qrow = (size_t)b * TOK + tok;
        a.qptr = QKV + qrow * 2304 + head * 64; a.optr = ATT + qrow * 1024 + head * 64;
        a.kbase = QKV + 512 + kvh * 64; a.kpitch = 2304; a.vbase = QKV + 640 + kvh * 64; a.vpitch = 2304; a.k2base = nullptr; a.k2pitch = 0;
        a.row_ctx = b * TOK; a.row_lat = 0; a.start = 0; a.j0 = 0; a.nt = 4; a.qoff = 0; a.m0 = sink[head] * LOG2E; a.l0 = 1.f;
        attn_unit<0, 64>(lds, a);
    }
    for (int u0 = c; u0 < 256; u0 += G) {
        const int u = remap8(u0, G); const int b = u >> 3, head = u & 7;
        AU a; const int tok = 32 * wid + r32; const size_t qrow = (size_t)b * TOK + tok;
        a.qptr = QKV + qrow * 2304 + 768 + head * 64; a.optr = ATT + qrow * 1024 + 512 + head * 64;
        a.kbase = QKV + 1280 + head * 64; a.kpitch = 2304; a.vbase = QKV + 1792 + head * 64; a.vpitch = 2304; a.k2base = nullptr; a.k2pitch = 0;
        a.row_ctx = b * TOK; a.row_lat = 0; a.start = 0; a.j0 = 0; a.nt = 4; a.qoff = 0; a.m0 = 0.f; a.l0 = 0.f;
        attn_unit<0, 64>(lds, a);
    }
}
__device__ __forceinline__ void phase_attn1(PP P, LAS unsigned char* lds, int c, int G) {
    const int tid = ltid(), lane = tid & 63, wid = __builtin_amdgcn_readfirstlane(tid >> 6), r32 = lane & 31;
    const bf16_t* PB = (const bf16_t*)(P->ws + WS_BIG + BIG_P); const bf16_t* QM = (const bf16_t*)(P->ws + WS_BIG + BIG_QM); const bf16_t* KVX = (const bf16_t*)(P->ws + WS_BIG + BIG_KVX);
    bf16_t* ATT = (bf16_t*)(P->ws + WS_H);
    for (int u = c; u < 1024; u += G) {
        const int b = u >> 5, head = (u >> 2) & 7, qb = u & 3;
        AU2 a; const int tok = qb * 512 + 64 * wid + r32; const size_t qrow = (size_t)b * TOK + CTX + tok;
        a.qptr = QM + qrow * 768 + head * 96; a.qpitch = 768; a.optr = ATT + qrow * 1024 + head * 64;
        a.kbase = KVX + head * 128; a.kpitch = 1024; a.vbase = KVX + head * 128 + 64; a.vpitch = 1024; a.k2base = PB + 1152; a.k2pitch = 1536;
        a.row_ctx = b * TOK; a.nt = 36;
        attn_unit2<96, false>(lds, a);
    }
    float gq = fabsf(P->in[28][lane]), gk = fabsf(P->in[29][lane]);
#pragma unroll
    for (int o = 32; o > 0; o >>= 1) { gq = fmaxf(gq, __shfl_xor(gq, o)); gk = fmaxf(gk, __shfl_xor(gk, o)); }
    const bool bounded = __builtin_amdgcn_readfirstlane((int)(64.f * gq * gk * QS64 < 100.f)) != 0;
    for (int u = c; u < 1024; u += G) {
        const int b = u >> 5, kvh = (u >> 4) & 1, blk = u & 15;
        if (bounded) {
            const int g = wid & 3, hf = wid >> 2; const int head = kvh * 4 + g;
            AU2 a; const int tok = blk * 128 + 64 * hf + r32; const size_t qrow = (size_t)b * TOK + CTX + tok;
            a.qptr = PB + qrow * 1536 + 384 + head * 64; a.qpitch = 1536; a.optr = ATT + qrow * 1024 + 512 + head * 64;
            a.kbase = PB + 1184 + kvh * 64; a.kpitch = 1536; a.vbase = PB + 1312 + kvh * 64; a.vpitch = 1536; a.k2base = nullptr; a.k2pitch = 0;
            a.row_ctx = b * TOK; a.nt = 36;
            attn_unit2<64, true>(lds, a);
        } else {
            for (int hfb = 0; hfb < 2; ++hfb) { const int g = wid & 3, ts = wid >> 2; const int head = kvh * 4 + g;
                AU a; const int tok = blk * 128 + 64 * hfb + 32 * ts + r32; const size_t qrow = (size_t)b * TOK + CTX + tok;
                a.qptr = PB + qrow * 1536 + 384 + head * 64; a.optr = ATT + qrow * 1024 + 512 + head * 64;
                a.kbase = PB + 1184 + kvh * 64; a.kpitch = 1536; a.vbase = PB + 1312 + kvh * 64; a.vpitch = 1536; a.k2base = nullptr; a.k2pitch = 0;
                a.row_ctx = b * TOK; a.row_lat = 0; a.start = 0; a.j0 = 0; a.nt = 36; a.qoff = 0; a.m0 = 0.f; a.l0 = 0.f;
                attn_unit<0, 64>(lds, a); }
        }
    }
}

constexpr int PH_MOE0 = 7, PH_L1 = PH_MOE0 + 1 + 2 * NCHUNK, PH_MOE1 = PH_L1 + 7, NPH = PH_MOE1 + 1 + 2 * NCHUNK;
template <int PH>
__device__ __forceinline__ void run_phase(LAS unsigned char* lds, int c, int G) {
    const PP P = get_pp();
    const float* rp = (const float*)(P->ws + WS_ROPE);
    const float* ada0 = (const float*)(P->ws + WS_ADA); const float* ada1 = ada0 + (size_t)33 * 6144;
    bf16_t* W0 = (bf16_t*)(P->ws + WS_W0); bf16_t* W1 = (bf16_t*)(P->ws + WS_W1);
    bf16_t* H = (bf16_t*)(P->ws + WS_H); char* BIG = P->ws + WS_BIG; float* XC = (float*)(P->ws + WS_XC);
    if constexpr (PH == 0) { phase_prologue(P, lds, c, G); }
    else if constexpr (PH == 1) { phase_norm(P, c, G, P->in[0], P->in[2], P->in[6], ada0, 0, 1024, false, H, nullptr); }
    else if constexpr (PH == 2) {
        gm::DenseSched S; S.init(0, 9, G, c); gm::Desc d{(const char*)H, 2048u, (const char*)(W0 + WO_IN), 2048u, 1024};
        gm::EpiQKV0 E{(bf16_t*)(BIG + BIG_QKV), rp, rp + 2048 * 32}; gm::gemm_phase(lds, d, S, E); }
    else if constexpr (PH == 3) { phase_attn0(P, lds, ONE_LAUNCH ? (int)*(volatile LAS int*)(lds + LDS_BARW + 8) : c, G); }
    else if constexpr (PH == 4) {
        gm::DenseSched S; S.init(0, 4, G, c); gm::Desc d{(const char*)H, 2048u, (const char*)(W0 + WO_OUT), 2048u, 1024};
        gm::EpiP1 E{(bf16_t*)(BIG + BIG_HLO), 1024, nullptr, 0}; gm::gemm_phase(lds, d, S, E); }
    else if constexpr (PH == 5) { phase_norm(P, c, G, P->in[0], P->in[2], P->in[11], ada0, 3072, 4096, false, H, (bf16_t*)(BIG + BIG_HLO), true, P->out, XC); }
    else if constexpr (PH == 6) { phase_router(P, lds, c, G, 0); }
    else if constexpr (PH == PH_L1) {
        gm::DenseSched S; S.init(0, 6, G, c); gm::Desc d{(const char*)H, 2048u, (const char*)(W1 + WO_IN), 2048u, 1024};
        gm::EpiP1 E{(bf16_t*)(BIG + BIG_P), 1536, nullptr, 0}; gm::gemm_phase(lds, d, S, E); }
    else if constexpr (PH == PH_L1 + 1) { phase_post1(P, c, G); }
    else if constexpr (PH == PH_L1 + 2) {
        { gm::DenseSched S; S.init(1, 3, G, c); gm::Desc d{(const char*)(BIG + BIG_P), 3072u, (const char*)(W1 + WO_UQ), 768u, 384};
          gm::EpiUQ E{(bf16_t*)(BIG + BIG_QM), (const float*)(P->ws + WS_RSTD), rp + 2 * 2048 * 32, rp + 2 * 2048 * 32 + 2048 * 16}; gm::gemm_phase(lds, d, S, E); }
        { gm::DenseSched S; S.init(0, 4, G, c); gm::Desc d{(const char*)(BIG + BIG_P) + 896 * 2, 3072u, (const char*)(W1 + WO_UKV), 512u, 256};
          gm::EpiP1 E{(bf16_t*)(BIG + BIG_KVX), 1024, (const float*)(P->ws + WS_RSTD), 1}; gm::gemm_phase(lds, d, S, E); } }
    else if constexpr (PH == PH_L1 + 3) { phase_attn1(P, lds, ONE_LAUNCH ? (int)*(volatile LAS int*)(lds + LDS_BARW + 8) : c, G); }
    else if constexpr (PH == PH_L1 + 4) {
        gm::DenseSched S; S.init(1, 4, G, c); gm::Desc d{(const char*)H, 2048u, (const char*)(W1 + WO_OUT), 2048u, 1024};
        gm::EpiP1 E{(bf16_t*)(BIG + BIG_HLO), 1024, nullptr, 0}; gm::gemm_phase(lds, d, S, E); }
    else if constexpr (PH == PH_L1 + 5) { phase_norm(P, c, G, P->out, XC, P->in[31], ada1, 3072, 4096, true, H, (bf16_t*)(BIG + BIG_HLO), true, P->out, XC); }
    else if constexpr (PH == PH_L1 + 6) { phase_router(P, lds, c, G, 1); }
    else {
        constexpr int layer = PH >= PH_MOE1 ? 1 : 0; constexpr int rel = PH - (layer ? PH_MOE1 : PH_MOE0);
        const int* cnt = (const int*)(P->ws + WS_CTL + CTL_CNT) + layer * NG;
        LAS int* toff = (LAS int*)(lds + LDS_TAB);
        bf16_t* W = layer ? W1 : W0;
        build_toff(toff, cnt);
        const int pidx = ONE_LAUNCH ? (int)*(volatile LAS int*)(lds + LDS_BARW + 8) : c;
        const int mxq = ONE_LAUNCH ? pidx / (G >> 3) : (c & 7), mxj = ONE_LAUNCH ? pidx % (G >> 3) : (c >> 3);
        if constexpr (rel == 0) {
            gm::MoeSched<1> S; S.toff = toff; S.slot_row = (const int*)(P->ws + WS_SROW); S.t_lo = 0; S.t_hi = toff[NG]; S.nN = 2; S.G = G; S.c = c; S.bN = 512; S.layer = layer; S.xq = mxq; S.xj = mxj;
            gm::Desc d{(const char*)H, 2048u, (const char*)(W + WO_GU), 2048u, 1024};
            gm::EpiG1 E{(bf16_t*)(BIG + BIG_ACT), (const float*)(P->ws + WS_SW)}; gm::gemm_phase(lds, d, S, E);
        } else if constexpr ((rel & 1) == 1) {
            constexpr int ch = (rel - 1) >> 1;
            gm::MoeSched<2> S; S.toff = toff; S.slot_row = nullptr; S.t_lo = toff[ch * NGRP]; S.t_hi = toff[(ch + 1) * NGRP]; S.nN = 4; S.G = G; S.c = c; S.bN = 1024; S.layer = layer; S.xq = mxq; S.xj = mxj;
            gm::Desc d{(const char*)(BIG + BIG_ACT), 512u, (const char*)(W + WO_D), 512u, 256};
            gm::EpiG2 E{(bf16_t*)(BIG + BIG_SLAB), toff[ch * NGRP] * 256};
            gm::gemm_phase(lds, d, S, E);
        } else {
            constexpr int ch = (rel - 2) >> 1;
            phase_combine(P, lds, c, G, layer, ch);
        }
    }
}

template <int PH> struct PhaseLoop {
    static __device__ __forceinline__ void run(LAS unsigned char* lds, const XcdBarrier& bar) {
        run_phase<PH>(lds, (int)blockIdx.x, (int)gridDim.x);
        if constexpr (PH + 1 < NPH) { xcd_barrier(bar); PhaseLoop<PH + 1>::run(lds, bar); }
    }
};

extern __shared__ __attribute__((aligned(16))) unsigned char smem_raw[];

#if ONE_LAUNCH
__global__ void __launch_bounds__(512, 2) mega_fwd(Params Pk) {
    LAS unsigned char* lds = (LAS unsigned char*)smem_raw;
    volatile LAS unsigned* st = (volatile LAS unsigned*)(lds + LDS_BARW);
    if (threadIdx.x == 0) { st[0] = 0u; st[1] = 0u; st[2] = 0u; st[3] = 0u; }
    __syncthreads();
    XcdBarrier bar = xcd_barrier_post((unsigned*)(Pk.ws + WS_CTL), st);
    int* xr = (int*)(Pk.ws + WS_CTL + CTL_XRANK);
    int myrank = 0; if (threadIdx.x == 0) myrank = atomicAdd(xr + 64 * (int)bar.x, 1);
    run_phase<0>(lds, (int)blockIdx.x, (int)gridDim.x);
    xcd_barrier(bar);
    if (threadIdx.x == 0) { int base = 0; for (int j = 0; j < (int)bar.x; ++j) base += ld_ctl(xr + 64 * j); st[2] = (unsigned)(base + myrank); }
    __syncthreads();
    PhaseLoop<1>::run(lds, bar);
}
#else
template <int PH> __global__ void __launch_bounds__(512, 2) phase_kernel(Params Pk) {
    LAS unsigned char* lds = (LAS unsigned char*)smem_raw;
    run_phase<PH>(lds, (int)blockIdx.x, (int)gridDim.x);
}
template <int PH> struct PhaseLaunch {
    static void run(const Params& P, int grid, hipStream_t s) {
        (void)hipFuncSetAttribute((const void*)phase_kernel<PH>, hipFuncAttributeMaxDynamicSharedMemorySize, LDS_BYTES);
        hipLaunchKernelGGL(phase_kernel<PH>, dim3(grid), dim3(512), LDS_BYTES, s, P);
        if constexpr (PH + 1 < NPH) PhaseLaunch<PH + 1>::run(P, grid, s);
    }
};
#endif

extern "C" void kernel_launch(void* const* d_in, const int* in_sizes, int n_in, void* d_out, int out_size, void* d_ws, size_t ws_size, hipStream_t stream) {
    static int grid = 0;
    if (n_in != 41 || ws_size < WS_END) { fprintf(stderr, "kernel_launch: need 41 inputs and %zu bytes of workspace (got %d, %zu)\n", (size_t)WS_END, n_in, ws_size); return; }
    if (!grid) {
        int dev = 0, cus = 0;
        (void)hipGetDevice(&dev); (void)hipDeviceGetAttribute(&cus, hipDeviceAttributeMultiprocessorCount, dev);
#if ONE_LAUNCH
        (void)hipFuncSetAttribute((const void*)mega_fwd, hipFuncAttributeMaxDynamicSharedMemorySize, LDS_BYTES);
        int per_cu = 0; (void)hipOccupancyMaxActiveBlocksPerMultiprocessor(&per_cu, (const void*)mega_fwd, 512, LDS_BYTES);
        if (per_cu < 1) fprintf(stderr, "kernel_launch: occupancy query says %d blocks per CU\n", per_cu);
#endif
        grid = cus > 0 ? cus : 256;
    }
    Params P{};
    for (int i = 0; i < 41; ++i) P.in[i] = (const float*)d_in[i];
    P.out = (float*)d_out; P.ws = (char*)d_ws;
    (void)hipMemsetAsync((char*)d_ws + WS_CTL, 0, CTL_BYTES, stream);
#if ONE_LAUNCH
    hipLaunchKernelGGL(mega_fwd, dim3(grid), dim3(512), LDS_BYTES, stream, P);
#else
    PhaseLaunch<0>::run(P, grid, stream);
#endif
}
```

```cpp
#include <hip/hip_runtime.h>
#include <stdint.h>
#include <stdio.h>

#ifndef ONE_LAUNCH
#define ONE_LAUNCH 1
#endif

#define LAS __attribute__((address_space(3)))
typedef unsigned short bf16_t;
typedef short bf16x8 __attribute__((ext_vector_type(8)));
typedef short s16x4 __attribute__((ext_vector_type(4)));
typedef float f32x4 __attribute__((ext_vector_type(4)));
typedef float f32x16 __attribute__((ext_vector_type(16)));
typedef unsigned u32x4 __attribute__((ext_vector_type(4)));
typedef unsigned u32x2 __attribute__((ext_vector_type(2)));

constexpr int NB = 32, SEQ = 2048, DM = 1024, CTX = 256, TOK = CTX + SEQ, MROWS = NB * TOK;
constexpr int NEXP = 64, NGRP = 65, NCHUNK = 4, NG = NCHUNK * NGRP;
constexpr int CAP = MROWS / NCHUNK;
constexpr int CHUNK_ROWS = MROWS / NCHUNK;
constexpr int CHUNK_B = NB / NCHUNK;
constexpr float LOG2E = 1.4426950408889634f;
constexpr float QS64 = 0.125f * LOG2E;
constexpr float QS96 = 0.10206207261596575f * LOG2E;
constexpr float EPS = 1e-6f;

constexpr size_t MiB = 1048576;
constexpr size_t WS_CTL = 0;
constexpr size_t CTL_BYTES = 65536;
constexpr size_t CTL_CNT = 16384;
constexpr size_t CTL_XRANK = 24576;
constexpr size_t WS_ADA = 65536;
constexpr size_t WS_ROPE = WS_ADA + 2 * MiB;
constexpr size_t WO_IN = 0, WO_OUT = WO_IN + 2304 * 1024, WO_RT = WO_OUT + 1024 * 1024, WO_UQ = WO_RT + 2 * 64 * 1024, WO_UKV = WO_UQ + 768 * 384,
                 WO_GU = WO_UKV + 1024 * 256, WO_D = WO_GU + (size_t)65 * 512 * 1024, W_ELEMS = WO_D + (size_t)65 * 1024 * 256;
constexpr size_t W_BYTES = ((W_ELEMS * 2 + 255) / 256) * 256;
constexpr size_t WS_W0 = WS_ROPE + 1 * MiB;
constexpr size_t WS_W1 = WS_W0 + W_BYTES;
constexpr size_t WS_XC = WS_W1 + W_BYTES;
constexpr size_t WS_H = WS_XC + 32 * MiB;
constexpr size_t WS_RSTD = WS_H + 144 * MiB;
constexpr size_t WS_SROW = WS_RSTD + 1 * MiB;
constexpr size_t WS_SW = WS_SROW + (size_t)NCHUNK * 64 * CAP * 4;
constexpr size_t WS_TSLOT = WS_SW + (size_t)NCHUNK * 64 * CAP * 4;
constexpr size_t WS_BIG = ((WS_TSLOT + (size_t)MROWS * 6 * 4 + 255) / 256) * 256;
constexpr size_t BIG_QKV = 0;
constexpr size_t BIG_P = 0;
constexpr size_t BIG_QM = BIG_P + (size_t)MROWS * 1536 * 2;
constexpr size_t BIG_KVX = BIG_QM + (size_t)MROWS * 768 * 2;
constexpr size_t BIG_HLO = 0;
constexpr size_t MAXSLOT = (size_t)MROWS * 7 + (size_t)NG * 256;
constexpr size_t BIG_ACT = 0;
constexpr size_t BIG_SLAB = BIG_ACT + MAXSLOT * 512;
constexpr size_t SLAB_SLOTS = (size_t)CHUNK_ROWS * 7 + (size_t)NGRP * 256;
constexpr size_t WS_END = WS_BIG + BIG_SLAB + SLAB_SLOTS * 2048;

constexpr int LDS_BYTES = 139264;
constexpr int LDS_TAB = 131072;
constexpr int LDS_BARW = LDS_BYTES - 16;

struct Params {
    const float* in[41];
    float* out;
    char* ws;
};
typedef const Params __attribute__((address_space(4)))* PP;
__device__ __forceinline__ PP get_pp() { PP p = (PP)__builtin_amdgcn_kernarg_segment_ptr(); asm volatile("" : "+s"(p)); return p; }
__device__ __forceinline__ int ltid() { int t = threadIdx.x; asm volatile("" : "+v"(t)); return t; }

__device__ __forceinline__ unsigned pk2(float lo, float hi) {
    typedef float f2 __attribute__((ext_vector_type(2))); typedef __bf16 b2 __attribute__((ext_vector_type(2)));
    f2 v = {lo, hi}; b2 b = __builtin_convertvector(v, b2); return __builtin_bit_cast(unsigned, b);
}
__device__ __forceinline__ float bflo(unsigned u) { return __uint_as_float(u << 16); }
__device__ __forceinline__ float bfhi(unsigned u) { return __uint_as_float(u & 0xffff0000u); }
__device__ __forceinline__ float wave_sum(float v) {
#pragma unroll
    for (int o = 32; o > 0; o >>= 1) v += __shfl_xor(v, o);
    return v;
}
__device__ __forceinline__ int ld_ctl(const int* p) { return __hip_atomic_load(p, __ATOMIC_RELAXED, __HIP_MEMORY_SCOPE_AGENT); }

#define XB_TMO      128
#define XB_XCNT(j)  (256  + 64 * (j))
#define XB_XSUB(j)  (1280 + 64 * (j))
#define XB_XGEN(j)  (2304 + 64 * (j))
#define XB_TOP      3328
#define XB_TOPGEN   3392
#define XCD_BAR_WORDS 3456
#define XB_SPIN_CAP (1u << 18)

__device__ __forceinline__ unsigned xb_ld(unsigned* p)              { return __hip_atomic_load(p, __ATOMIC_RELAXED, __HIP_MEMORY_SCOPE_AGENT); }
__device__ __forceinline__ unsigned xb_add(unsigned* p, unsigned v) { return __hip_atomic_fetch_add(p, v, __ATOMIC_RELAXED, __HIP_MEMORY_SCOPE_AGENT); }
__device__ __forceinline__ unsigned xb_xcc_id() { return (unsigned)__builtin_amdgcn_s_getreg((3 << 11) | 20) & 0xFu; }
#define XB_SPIN(cond, bar) do { unsigned _sp = 0; while (cond) { __builtin_amdgcn_s_sleep(1); \
    if ((++_sp & 255u) == 0u) { if (xb_ld(&(bar)[XB_TMO])) break; if (_sp > XB_SPIN_CAP) { atomicAdd(&(bar)[XB_TMO], 1u); break; } } } } while (0)

struct XcdBarrier { unsigned* bar; unsigned x; volatile LAS unsigned* st; };

__device__ __forceinline__ XcdBarrier xcd_barrier_post(unsigned* bar, volatile LAS unsigned* st) {
    XcdBarrier b; b.bar = bar; b.x = xb_xcc_id(); b.st = st;
    if (threadIdx.x == 0) (void)xb_add(&bar[XB_XCNT(b.x)], 1u);
    return b;
}
__device__ __forceinline__ void xcd_barrier_complete(unsigned* bar, unsigned x, unsigned& nloc, unsigned& nx) {
    const unsigned G = gridDim.x * gridDim.y * gridDim.z;
    unsigned sum, cnt, mine, sp = 0u;
    for (;;) {
        sum = 0u; cnt = 0u; mine = 0u;
#pragma unroll
        for (unsigned j = 0; j < 16; ++j) { const unsigned c = xb_ld(&bar[XB_XCNT(j)]); sum += c; cnt += (c > 0u) ? 1u : 0u; mine = (j == x) ? c : mine; }
        if (sum == G) break;
        __builtin_amdgcn_s_sleep(1);
        if ((++sp & 255u) == 0u) { if (xb_ld(&bar[XB_TMO])) break; if (sp > XB_SPIN_CAP) { atomicAdd(&bar[XB_TMO], 1u); break; } }
    }
    nloc = mine > 0u ? mine : 1u; nx = cnt > 0u ? cnt : 1u;
}
__device__ __forceinline__ void xcd_barrier(const XcdBarrier& b) {
    asm volatile("s_waitcnt vmcnt(0)" ::: "memory");
    __syncthreads();
    if (threadIdx.x == 0) {
        unsigned* bar = b.bar;
        __builtin_amdgcn_s_waitcnt(0);
        unsigned nloc = b.st[0], nx = b.st[1];
        if (nloc == 0u) { xcd_barrier_complete(bar, b.x, nloc, nx); b.st[0] = nloc; b.st[1] = nx; }
        const unsigned old = xb_add(&bar[XB_XSUB(b.x)], 1u);
        const unsigned gen = old / nloc;
        if (old + 1u == (gen + 1u) * nloc) {
            __builtin_amdgcn_fence(__ATOMIC_RELEASE, "agent");
            asm volatile("s_waitcnt vmcnt(0)" ::: "memory");
            const unsigned og = xb_add(&bar[XB_TOP], 1u);
            const unsigned tg = og / nx;
            if (og + 1u == (tg + 1u) * nx) xb_add(&bar[XB_TOPGEN], 1u);
            else XB_SPIN(xb_ld(&bar[XB_TOPGEN]) == tg, bar);
            __builtin_amdgcn_fence(__ATOMIC_ACQUIRE, "agent");
            xb_add(&bar[XB_XGEN(b.x)], 1u);
            asm volatile("s_waitcnt vmcnt(0)" ::: "memory");
        } else {
            XB_SPIN(xb_ld(&bar[XB_XGEN(b.x)]) == gen, bar);
            __builtin_amdgcn_fence(__ATOMIC_ACQUIRE, "agent");
            asm volatile("s_waitcnt vmcnt(0)" ::: "memory");
        }
    }
    __syncthreads();
}

namespace gm {
constexpr int BM = 256, BK = 64, HALF = 128, HTB = HALF * BK * 2, STAGE_BYTES = 8 * HTB, NXCD = 8, WGM = 8;
__device__ __forceinline__ int lds_byte(int r, int c) { const int st = (r >> 4) * 2 + (c >> 5), rr = r & 15, cc = c & 31, ob = rr * 64 + cc * 2; return st * 1024 + (ob ^ (((ob >> 9) & 1) << 5)); }
__device__ __forceinline__ void stage_rc(int b, int& R, int& C) { const int st = b / 1024, sb = b % 1024, swz = sb ^ (((sb >> 9) & 1) << 5); R = (st >> 1) * 16 + swz / 64; C = (st & 1) * 32 + (swz % 64) / 2; }
__device__ __forceinline__ int perm32(int rho) { const int n = rho >> 4, i = rho & 15; return 8 * (i >> 2) + 4 * n + (i & 3); }

struct Unit { int pm, pn, g, mt, cnt, sbase; };
struct Desc { const char* A; unsigned lda; const char* B; unsigned ldb; int K; };

struct DenseSched {
    int nMt, nN, nwg, G, c, mmode;
    __device__ __forceinline__ void init(int mmode_, int nN_, int G_, int c_) { mmode = mmode_; nMt = mmode_ ? 256 : 288; nN = nN_; nwg = nMt * nN_; G = G_; c = c_; }
    __device__ __forceinline__ bool next(int i, Unit& u) const {
        const long L = (long)i * G + c; if (L >= nwg) return false;
        int wgid = (int)L; { const int q = nwg / NXCD, r = nwg % NXCD, xcd = wgid % NXCD, off = wgid / NXCD; wgid = (xcd < r ? xcd * (q + 1) : r * (q + 1) + (xcd - r) * q) + off; }
        const int nig = WGM * nN, gid = wgid / nig, fm = gid * WGM, gsz = (nMt - fm) < WGM ? (nMt - fm) : WGM;
        const int pmi = fm + ((wgid % nig) % gsz); u.pn = (wgid % nig) / gsz;
        u.pm = mmode ? (pmi >> 3) * 9 + 1 + (pmi & 7) : pmi; u.g = 0; u.mt = 0; u.cnt = 256; u.sbase = 0; return true;
    }
    __device__ __forceinline__ int a_row(const Unit& u, int r) const { return u.pm * 256 + r; }
    __device__ __forceinline__ int b_row(const Unit& u) const { return u.pn * 256; }
};

template <int WHICH  >
struct MoeSched {
    LAS const int* toff; const int* slot_row; int nN, G, c, bN, layer, t_lo, t_hi, xq, xj;
    __device__ __forceinline__ bool next(int i, Unit& u) const {
        const int per = G >> 3, nt_ = t_hi - t_lo;
        const int xs = t_lo + (int)(((long)nt_ * xq) >> 3), xe = t_lo + (int)(((long)nt_ * (xq + 1)) >> 3);
        const int L = i * per + xj; if (L >= (xe - xs) * nN) return false;
        const int tau = L / nN; u.pn = L - tau * nN; const int T = xs + tau;
        int lo = 0, hi = NG;
        while (hi - lo > 1) { const int mid = (lo + hi) >> 1; if (toff[mid] <= T) lo = mid; else hi = mid; }
        u.g = lo; u.mt = T - toff[lo]; u.pm = T; u.sbase = T * 256; u.cnt = toff[272 + lo]; return true;
    }
    __device__ __forceinline__ int a_row(const Unit& u, int r) const {
        if (WHICH == 2) return u.sbase + r;
        const int e = u.g % NGRP, ch = u.g / NGRP, idx = u.mt * 256 + r;
        const bool in = (e < NEXP) && (idx < u.cnt);
        const int lrow = slot_row[(size_t)(ch * 64 + (e < NEXP ? e : 0)) * CAP + (in ? idx : 0)];
        const int b1 = ch * CHUNK_B + (idx >> 11);
        const int srow = (layer == 0) ? (ch * CHUNK_ROWS + idx) : (b1 * TOK + CTX + (idx & 2047));
        return (e == NEXP) ? srow : (in ? lrow : 0);
    }
    __device__ __forceinline__ int b_row(const Unit& u) const { return (u.g % NGRP) * bN + u.pn * 256; }
};

template <class Epi, class Sched>
__device__ __forceinline__ void gemm_phase(LAS unsigned char* lds, const Desc g, const Sched& S, const Epi& E) {
    const int tid = ltid(), wid = __builtin_amdgcn_readfirstlane(tid >> 6), lane = tid & 63, wr = wid >> 2, wc = wid & 3, fr = lane & 15, fq = lane >> 4;
    const int nt = g.K / BK;
    unsigned voffB[2][2];
#pragma unroll
    for (int i = 0; i < 2; ++i) { int R, C; stage_rc(tid * 16 + i * 8192, R, C); const int Rl = Epi::PERM ? perm32(R & 31) : (R & 31);
#pragma unroll
        for (int h = 0; h < 2; ++h) { const int Rb = Epi::WIDE ? (64 * (R >> 5) + 32 * h + Rl) : (128 * h + (R & ~31) + Rl);
            voffB[h][i] = (unsigned)Rb * g.ldb + (unsigned)C * 2u; } }
    const size_t kstep = (size_t)(BK * 2);
    const unsigned ldsw = (unsigned)wid * 1024u;
    const int aoff = lds_byte(wr * 64 + fr, fq * 8), boff = lds_byte(wc * 32 + fr, fq * 8);
#define GM_SA(b, h) (((b) * 2 + (h)) * HTB)
#define GM_SB(b, h) ((4 + (b) * 2 + (h)) * HTB)
#define GM_STAGE_A(bufoff, kb, va, h) do { _Pragma("unroll") for (int _i = 0; _i < 2; ++_i) \
        __builtin_amdgcn_global_load_lds((const unsigned*)(g.A + (kb) + (va)[h][_i]), (LAS unsigned*)(lds + (bufoff) + ldsw + _i * 8192), 16, 0, 0); } while (0)
#define GM_STAGE_B(bufoff, bp, h) do { _Pragma("unroll") for (int _i = 0; _i < 2; ++_i) \
        __builtin_amdgcn_global_load_lds((const unsigned*)((bp) + voffB[h][_i]), (LAS unsigned*)(lds + (bufoff) + ldsw + _i * 8192), 16, 0, 0); } while (0)
#define GM_LDA(dst, b, h) do { _Pragma("unroll") for (int m = 0; m < 4; ++m) _Pragma("unroll") for (int k = 0; k < 2; ++k) dst[m][k] = *(const LAS bf16x8*)(lds + GM_SA(b, h) + aoff + m * 2048 + k * 1024); } while (0)
#define GM_LDB(dst, b, h) do { _Pragma("unroll") for (int n = 0; n < 2; ++n) _Pragma("unroll") for (int k = 0; k < 2; ++k) dst[n][k] = *(const LAS bf16x8*)(lds + GM_SB(b, h) + boff + n * 2048 + k * 1024); } while (0)
#define GM_MMA(ai, bj, At, Bt) do { __builtin_amdgcn_s_setprio(1); _Pragma("unroll") for (int m = 0; m < 4; ++m) _Pragma("unroll") for (int n = 0; n < 2; ++n) _Pragma("unroll") for (int k = 0; k < 2; ++k) \
        acc[ai][bj][m][n] = __builtin_amdgcn_mfma_f32_16x16x32_bf16(Bt[n][k], At[m][k], acc[ai][bj][m][n], 0, 0, 0); __builtin_amdgcn_s_setprio(0); } while (0)
#define GM_WAIT_V(n) asm volatile("s_waitcnt vmcnt(" #n ")" ::: "memory")
#define GM_WAIT_L(n) asm volatile("s_waitcnt lgkmcnt(" #n ")" ::: "memory")
#define GM_BAR __builtin_amdgcn_s_barrier()
#define GM_SCHED __builtin_amdgcn_sched_barrier(0)
#define GM_CALC_VA(va, u) do { int _tz = tid; asm volatile("" : "+v"(_tz)); int _rw[2][2]; unsigned _cc[2]; \
        _Pragma("unroll") for (int _i = 0; _i < 2; ++_i) { int _R, _C; stage_rc(_tz * 16 + _i * 8192, _R, _C); _cc[_i] = (unsigned)_C * 2u; \
            _Pragma("unroll") for (int _h = 0; _h < 2; ++_h) _rw[_h][_i] = S.a_row((u), _h * HALF + _R); } \
        _Pragma("unroll") for (int _i = 0; _i < 2; ++_i) _Pragma("unroll") for (int _h = 0; _h < 2; ++_h) (va)[_h][_i] = (unsigned)_rw[_h][_i] * g.lda + _cc[_i]; } while (0)
    Unit cur, nxt; int ui = 0;
    if (!S.next(0, cur)) return;
    f32x4 acc[2][2][4][2];
#pragma unroll
    for (int a = 0; a < 2; ++a)
#pragma unroll
        for (int b = 0; b < 2; ++b)
#pragma unroll
            for (int m = 0; m < 4; ++m)
#pragma unroll
                for (int n = 0; n < 2; ++n) acc[a][b][m][n] = (f32x4){0.f, 0.f, 0.f, 0.f};
    bf16x8 At[4][2], B0[2][2], B1[2][2];
    unsigned vaC[2][2];
    GM_CALC_VA(vaC, cur);
    const char* cB = g.B + (size_t)S.b_row(cur) * g.ldb;
    GM_STAGE_B(GM_SB(0, 0), cB, 0); GM_STAGE_A(GM_SA(0, 0), (size_t)0, vaC, 0); GM_STAGE_B(GM_SB(0, 1), cB, 1); GM_STAGE_A(GM_SA(0, 1), (size_t)0, vaC, 1);
    if (wr == 1) GM_BAR;
    GM_WAIT_V(4); GM_BAR;
    GM_STAGE_B(GM_SB(1, 0), cB + kstep, 0); GM_STAGE_A(GM_SA(1, 0), kstep, vaC, 0); GM_STAGE_B(GM_SB(1, 1), cB + kstep, 1);
    GM_WAIT_V(6); GM_BAR;
    for (;;) {
        const bool has_next = S.next(ui + 1, nxt);
        const char* nB = cB;
        if (has_next) nB = g.B + (size_t)S.b_row(nxt) * g.ldb;
        unsigned va2[2][2];
#pragma clang loop unroll(disable)
        for (int t = 0; t < nt; t += 2) {
            const bool last = (t == nt - 2);
            const size_t k1 = (size_t)(t + 1) * kstep;
            const size_t k2 = last ? (size_t)0 : (size_t)(t + 2) * kstep, k3 = k2 + kstep;
            const char* b2 = last ? nB : cB + k2; const char* b3 = b2 + kstep;
#pragma unroll
            for (int _h = 0; _h < 2; ++_h)
#pragma unroll
                for (int _i = 0; _i < 2; ++_i) va2[_h][_i] = vaC[_h][_i];
            if (last && has_next) GM_CALC_VA(va2, nxt);
            GM_LDB(B0, 0, 0); GM_SCHED; GM_LDA(At, 0, 0); GM_STAGE_A(GM_SA(1, 1), k1, vaC, 1);
            GM_WAIT_L(8); GM_BAR; GM_WAIT_L(0); GM_MMA(0, 0, At, B0); GM_BAR; GM_SCHED;
            GM_LDB(B1, 0, 1); GM_STAGE_B(GM_SB(0, 0), b2, 0);
            GM_BAR; GM_WAIT_L(0); GM_MMA(0, 1, At, B1); GM_BAR;
            GM_LDA(At, 0, 1); GM_STAGE_A(GM_SA(0, 0), k2, va2, 0);
            GM_BAR; GM_WAIT_L(0); GM_MMA(1, 0, At, B0); GM_BAR; GM_SCHED;
            GM_STAGE_B(GM_SB(0, 1), b2, 1);
            GM_WAIT_V(6); GM_BAR; GM_MMA(1, 1, At, B1); GM_BAR;
            GM_LDB(B0, 1, 0); GM_SCHED; GM_LDA(At, 1, 0); GM_STAGE_A(GM_SA(0, 1), k2, va2, 1);
            GM_WAIT_L(8); GM_BAR; GM_WAIT_L(0); GM_MMA(0, 0, At, B0); GM_BAR; GM_SCHED;
            GM_LDB(B1, 1, 1); GM_STAGE_B(GM_SB(1, 0), b3, 0);
            GM_BAR; GM_WAIT_L(0); GM_MMA(0, 1, At, B1); GM_BAR;
            GM_LDA(At, 1, 1); GM_STAGE_A(GM_SA(1, 0), k3, va2, 0);
            GM_BAR; GM_WAIT_L(0); GM_MMA(1, 0, At, B0); GM_BAR; GM_SCHED;
            GM_STAGE_B(GM_SB(1, 1), b3, 1);
            GM_WAIT_V(6); GM_BAR; GM_MMA(1, 1, At, B1); GM_BAR;
        }
        { int tz = tid; asm volatile("" : "+v"(tz));
          const int wid2 = __builtin_amdgcn_readfirstlane(tz >> 6), ln2 = tz & 63; E(acc, cur, wid2 >> 2, wid2 & 3, ln2 & 15, ln2 >> 4); }
        if (!has_next) break;
#pragma unroll
        for (int a = 0; a < 2; ++a)
#pragma unroll
            for (int b = 0; b < 2; ++b)
#pragma unroll
                for (int m = 0; m < 4; ++m)
#pragma unroll
                    for (int n = 0; n < 2; ++n) acc[a][b][m][n] = (f32x4){0.f, 0.f, 0.f, 0.f};
        cur = nxt; cB = nB; ++ui;
#pragma unroll
        for (int _h = 0; _h < 2; ++_h)
#pragma unroll
            for (int _i = 0; _i < 2; ++_i) vaC[_h][_i] = va2[_h][_i];
    }
    GM_WAIT_V(0);
    if (wr == 0) GM_BAR;
    GM_BAR;
#undef GM_SA
#undef GM_SB
#undef GM_STAGE_A
#undef GM_STAGE_B
#undef GM_LDA
#undef GM_LDB
#undef GM_MMA
#undef GM_WAIT_V
#undef GM_WAIT_L
#undef GM_BAR
#undef GM_SCHED
#undef GM_CALC_VA
}

typedef const f32x4 (&AccRef)[2][2][4][2];

struct EpiQKV0 {
    static constexpr bool PERM = false; static constexpr int WIDE = 0;
    bf16_t* O; const float* cosT; const float* sinT;
    __device__ __forceinline__ void operator()(AccRef acc, const Unit& u, int wr, int wc, int fr, int fq) const {
        const int tq = u.pm % 9; const bool ctx = (tq == 0); const int tbase = tq * 256 - 256;
        const int colg0 = 256 * u.pn + 32 * wc; const bool rope0 = (colg0 < 640) && !ctx, rope1 = (colg0 + 128 < 640) && !ctx; const int gi = 16 * (wc & 1) + 4 * fq;
        f32x4 cs[8], sn[8];
        if (rope0) {
#pragma unroll
            for (int q = 0; q < 8; ++q) { const int rl = 128 * (q >> 2) + 64 * wr + 16 * (q & 3) + fr; cs[q] = *(const f32x4*)(cosT + (size_t)(tbase + rl) * 32 + gi); sn[q] = *(const f32x4*)(sinT + (size_t)(tbase + rl) * 32 + gi); }
        }
#pragma unroll
        for (int bj = 0; bj < 2; ++bj) {
            const int colg = colg0 + 128 * bj; const bool rope = bj ? rope1 : rope0;
#pragma unroll
            for (int ai = 0; ai < 2; ++ai)
#pragma unroll
                for (int m = 0; m < 4; ++m) {
                    const int rl = 128 * ai + 64 * wr + 16 * m + fr; const size_t row = (size_t)u.pm * 256 + rl;
                    f32x4 v0 = acc[ai][bj][m][0], v1 = acc[ai][bj][m][1];
                    if (rope) { const f32x4 c4 = cs[4 * ai + m], s4 = sn[4 * ai + m]; const f32x4 x0 = v0 * c4 - v1 * s4, x1 = v0 * s4 + v1 * c4; v0 = x0; v1 = x1; }
                    bf16_t* p = O + row * 2304 + colg + 4 * fq;
                    u32x2 w0, w1; w0.x = pk2(v0[0], v0[1]); w0.y = pk2(v0[2], v0[3]); w1.x = pk2(v1[0], v1[1]); w1.y = pk2(v1[2], v1[3]);
                    *(u32x2*)p = w0; *(u32x2*)(p + 16) = w1;
                }
        }
    }
};
struct EpiP1 {
    static constexpr bool PERM = true; static constexpr int WIDE = 1;
    bf16_t* O; int ldc; const float* rs; int rsel;
    __device__ __forceinline__ void operator()(AccRef acc, const Unit& u, int wr, int wc, int fr, int fq) const {
        float scv[8];
#pragma unroll
        for (int q = 0; q < 8; ++q) { const size_t row = (size_t)u.pm * 256 + 128 * (q >> 2) + 64 * wr + 16 * (q & 3) + fr; scv[q] = rs ? rs[row * 2 + rsel] : 1.f; }
        const bool lo = fr < 8; const int col = 256 * u.pn + 64 * wc + 8 * fq + (lo ? 0 : 32);
#pragma unroll
        for (int ai = 0; ai < 2; ++ai)
#pragma unroll
            for (int m = 0; m < 4; ++m) { const size_t row = (size_t)u.pm * 256 + 128 * ai + 64 * wr + 16 * m + (fr & 7); const float sc = scv[4 * ai + m];
                u32x4 x0, x1;
                { const f32x4 v0 = acc[ai][0][m][0] * sc, v1 = acc[ai][0][m][1] * sc; x0.x = pk2(v0[0], v0[1]); x0.y = pk2(v0[2], v0[3]); x0.z = pk2(v1[0], v1[1]); x0.w = pk2(v1[2], v1[3]); }
                { const f32x4 v0 = acc[ai][1][m][0] * sc, v1 = acc[ai][1][m][1] * sc; x1.x = pk2(v0[0], v0[1]); x1.y = pk2(v0[2], v0[3]); x1.z = pk2(v1[0], v1[1]); x1.w = pk2(v1[2], v1[3]); }
                u32x4 rc;
#pragma unroll
                for (int q = 0; q < 4; ++q) rc[q] = (unsigned)__shfl_xor((int)(lo ? x1[q] : x0[q]), 8);
                const u32x4 da = lo ? x0 : rc, db = lo ? rc : x1;
                *(u32x4*)(O + row * ldc + col) = da; *(u32x4*)(O + (row + 8) * ldc + col) = db; }
    }
};
struct EpiUQ {
    static constexpr bool PERM = false; static constexpr int WIDE = 0;
    bf16_t* O; const float* rs; const float* cosT; const float* sinT;
    __device__ __forceinline__ void operator()(AccRef acc, const Unit& u, int wr, int wc, int fr, int fq) const {
        const int tq = u.pm % 9; const bool ctx = (tq == 0); const int tbase = tq * 256 - 256;
        const int colg0 = 256 * u.pn + 32 * wc, colg1 = colg0 + 128;
        const bool rope0 = ((colg0 >> 5) % 3 == 2) && !ctx, rope1 = ((colg1 >> 5) % 3 == 2) && !ctx;
        float scv[8]; f32x4 cs[8], sn[8];
#pragma unroll
        for (int q = 0; q < 8; ++q) { const int rl = 128 * (q >> 2) + 64 * wr + 16 * (q & 3) + fr; scv[q] = rs[((size_t)u.pm * 256 + rl) * 2]; }
        if (rope0 || rope1) {
#pragma unroll
            for (int q = 0; q < 8; ++q) { const int rl = 128 * (q >> 2) + 64 * wr + 16 * (q & 3) + fr; cs[q] = *(const f32x4*)(cosT + (size_t)(tbase + rl) * 16 + 4 * fq); sn[q] = *(const f32x4*)(sinT + (size_t)(tbase + rl) * 16 + 4 * fq); }
        }
#pragma unroll
        for (int ai = 0; ai < 2; ++ai)
#pragma unroll
            for (int m = 0; m < 4; ++m) {
                const int rl = 128 * ai + 64 * wr + 16 * m + fr; const size_t row = (size_t)u.pm * 256 + rl; const float sc = scv[4 * ai + m];
#pragma unroll
                for (int bj = 0; bj < 2; ++bj) {
                    f32x4 v0 = acc[ai][bj][m][0] * sc, v1 = acc[ai][bj][m][1] * sc;
                    if (bj ? rope1 : rope0) { const f32x4 c4 = cs[4 * ai + m], s4 = sn[4 * ai + m]; const f32x4 x0 = v0 * c4 - v1 * s4, x1 = v0 * s4 + v1 * c4; v0 = x0; v1 = x1; }
                    bf16_t* p = O + row * 768 + (bj ? colg1 : colg0) + 4 * fq;
                    u32x2 w0, w1; w0.x = pk2(v0[0], v0[1]); w0.y = pk2(v0[2], v0[3]); w1.x = pk2(v1[0], v1[1]); w1.y = pk2(v1[2], v1[3]);
                    *(u32x2*)p = w0; *(u32x2*)(p + 16) = w1;
                }
            }
    }
};
struct EpiG1 {
    static constexpr bool PERM = false; static constexpr int WIDE = 0;
    bf16_t* act;
    __device__ __forceinline__ void operator()(AccRef acc, const Unit& u, int wr, int wc, int fr, int fq) const {
#pragma unroll
        for (int ai = 0; ai < 2; ++ai)
#pragma unroll
            for (int m = 0; m < 4; ++m) {
                const int rl = 128 * ai + 64 * wr + 16 * m + fr;
#pragma unroll
                for (int bj = 0; bj < 2; ++bj) {
                    const f32x4 gt = acc[ai][bj][m][0], up = acc[ai][bj][m][1]; float r[4];
#pragma unroll
                    for (int j = 0; j < 4; ++j) r[j] = gt[j] * __builtin_amdgcn_rcpf(1.f + __expf(-gt[j])) * up[j];
                    u32x2 o; o.x = pk2(r[0], r[1]); o.y = pk2(r[2], r[3]);
                    *(u32x2*)(act + ((size_t)u.sbase + rl) * 256 + 16 * (8 * u.pn + 4 * bj + wc) + 4 * fq) = o;
                }
            }
    }
};
struct EpiG2 {
    static constexpr bool PERM = true, WIDE = true;
    bf16_t* slab; int sbase0;
    __device__ __forceinline__ void operator()(AccRef acc, const Unit& u, int wr, int wc, int fr, int fq) const {
        const bool lo = fr < 8; const int col = 256 * u.pn + 64 * wc + 8 * fq + (lo ? 0 : 32);
#pragma unroll
        for (int ai = 0; ai < 2; ++ai)
#pragma unroll
            for (int m = 0; m < 4; ++m) { const size_t row = (size_t)(u.sbase - sbase0) + 128 * ai + 64 * wr + 16 * m + (fr & 7);
                u32x4 x0, x1;
                { const f32x4 v0 = acc[ai][0][m][0], v1 = acc[ai][0][m][1]; x0.x = pk2(v0[0], v0[1]); x0.y = pk2(v0[2], v0[3]); x0.z = pk2(v1[0], v1[1]); x0.w = pk2(v1[2], v1[3]); }
                { const f32x4 v0 = acc[ai][1][m][0], v1 = acc[ai][1][m][1]; x1.x = pk2(v0[0], v0[1]); x1.y = pk2(v0[2], v0[3]); x1.z = pk2(v1[0], v1[1]); x1.w = pk2(v1[2], v1[3]); }
                u32x4 rc;
#pragma unroll
                for (int q = 0; q < 4; ++q) rc[q] = (unsigned)__shfl_xor((int)(lo ? x1[q] : x0[q]), 8);
                const u32x4 da = lo ? x0 : rc, db = lo ? rc : x1;
                __builtin_nontemporal_store(da, (u32x4*)(slab + row * 1024 + col)); __builtin_nontemporal_store(db, (u32x4*)(slab + (row + 8) * 1024 + col)); }
    }
};
}

struct AU {
    const bf16_t* qptr;
    bf16_t* optr;
    const bf16_t* kbase; unsigned kpitch;
    const bf16_t* vbase; unsigned vpitch;
    const bf16_t* k2base; unsigned k2pitch;
    int row_ctx, row_lat;
    int nt;
    int j0;
    int qoff;
    int start;
    float m0, l0;
};
constexpr int ATT_RPB = 122880;
constexpr float THR = 8.f;
__device__ __forceinline__ void glds16(const void* gsrc, unsigned lds_dst) { unsigned keep;
    asm volatile("s_mov_b32 %0, m0\n\ts_mov_b32 m0, %2\n\ts_nop 0\n\tglobal_load_lds_dwordx4 %1, off\n\ts_mov_b32 m0, %0" : "=&s"(keep) : "v"(gsrc), "s"(lds_dst) : "memory"); }
__device__ __forceinline__ float max3f(float a, float b, float c) { float r; asm("v_max3_f32 %0, %1, %2, %3" : "=v"(r) : "v"(a), "v"(b), "v"(c)); return r; }
__device__ __forceinline__ float max2f(float a, float b) { float r; asm("v_max_f32_e32 %0, %1, %2" : "=v"(r) : "v"(a), "v"(b)); return r; }

template <int MODE  , int DQ  >
__device__ __forceinline__ void attn_unit(LAS unsigned char* lds, const AU& a) {
    constexpr int NS = DQ / 16;
    constexpr int BUFB = (DQ == 96) ? 20480 : 16384;
    const int tid = ltid(), lane = tid & 63, wid = __builtin_amdgcn_readfirstlane(tid >> 6), r32 = lane & 31, hi = lane >> 5;
    const bool upper = wid >= 4;
    const int kr = tid >> 3, cp = tid & 7;
    const int ksrc = (cp ^ ((kr >> 1) & 7)) * 8, vsrc = (cp ^ (((kr >> 1) & 1) << 2)) * 8;
    const int kr2 = 16 * wid + (lane >> 2), k2src = ((lane & 3) ^ ((kr2 >> 2) & 3)) * 8;
    unsigned koff[NS];
#pragma unroll
    for (int s = 0; s < NS; ++s) koff[s] = (s < 4) ? (unsigned)(r32 * 128 + (((2 * s + hi) ^ ((r32 >> 1) & 7)) << 4))
                                                   : (unsigned)(16384 + r32 * 64 + (((2 * (s - 4) + hi) ^ ((r32 >> 2) & 3)) << 4));
    const int vg = (lane >> 4) & 1, vq = (lane & 15) >> 2, vp = lane & 3, vsw = (vq >> 1) & 1;
    const unsigned voff0 = (unsigned)(8192 + (4 * hi + vq) * 128 + 64 * vsw + 32 * vg + 8 * vp);
    const unsigned voff1 = (unsigned)(8192 + (4 * hi + vq) * 128 + 64 * (1 - vsw) + 32 * vg + 8 * vp);
    bf16x8 qf[NS];
#pragma unroll
    for (int s = 0; s < NS; ++s) qf[s] = *(const bf16x8*)(a.qptr + 16 * s + 8 * hi);
    f32x16 o0, o1, negm, p0, p1;
    float m = a.m0, l = a.l0;
#pragma unroll
    for (int r = 0; r < 16; ++r) { o0[r] = 0.f; o1[r] = 0.f; negm[r] = -m; p0[r] = 0.f; p1[r] = 0.f; }
    const int nt = a.nt;
    auto krow = [&](int t, int r) -> int {
        if (MODE == 0) return a.row_ctx + 64 * t + r;
        if (t < 4) return a.row_ctx + 64 * t + r;
        if (MODE == 1) return a.row_lat + a.start - 128 + 64 * (a.j0 + t - 4) + r;
        return a.row_lat + 64 * (a.j0 + t - 4) + r;
    };
    const unsigned lds0 = (unsigned)(uintptr_t)lds + (unsigned)wid * 1024u;
    auto dma = [&](int t, int boff) {
        const size_t r = (size_t)krow(t, kr);
        glds16(a.kbase + r * a.kpitch + ksrc, (unsigned)__builtin_amdgcn_readfirstlane((int)(lds0 + boff)));
        glds16(a.vbase + r * a.vpitch + vsrc, (unsigned)__builtin_amdgcn_readfirstlane((int)(lds0 + boff + 8192)));
        if (DQ == 96) { if (!upper) { const size_t r2 = (size_t)krow(t, kr2);
            glds16(a.k2base + r2 * a.k2pitch + k2src, (unsigned)__builtin_amdgcn_readfirstlane((int)(lds0 + boff + 16384))); } }
    };
    auto tile_active = [&](int t) -> bool {
        if (MODE != 2 || t < 4) return true;
        const int qrow = a.qoff >> 6; int rs = qrow - 4; rs = rs < 0 ? 0 : (rs > 24 ? 24 : rs); const int kgr = a.j0 + t - 4;
        return __builtin_amdgcn_readfirstlane((int)((kgr >= rs) && (kgr < rs + 8))) != 0;
    };
    auto QK = [&](int t, int boff) {
        const LAS unsigned char* Bb = lds + boff;
        bf16x8 kf[2 * NS];
#pragma unroll
        for (int s = 0; s < NS; ++s) { kf[2 * s] = *(const LAS bf16x8*)(Bb + koff[s]); kf[2 * s + 1] = *(const LAS bf16x8*)(Bb + koff[s] + (s < 4 ? 4096 : 2048)); }
#pragma unroll
        for (int s = 0; s < NS; ++s) {
            if (s == 0) { p0 = __builtin_amdgcn_mfma_f32_32x32x16_bf16(kf[0], qf[0], negm, 0, 0, 0); p1 = __builtin_amdgcn_mfma_f32_32x32x16_bf16(kf[1], qf[0], negm, 0, 0, 0); }
            else { p0 = __builtin_amdgcn_mfma_f32_32x32x16_bf16(kf[2 * s], qf[s], p0, 0, 0, 0); p1 = __builtin_amdgcn_mfma_f32_32x32x16_bf16(kf[2 * s + 1], qf[s], p1, 0, 0, 0); }
        }
        __builtin_amdgcn_sched_group_barrier(0x100, 2 * NS, 0);
        __builtin_amdgcn_sched_group_barrier(0x008, 2 * NS, 0);
        if (MODE == 1 && t >= 4) {
            const int j = a.j0 + t - 4;
            if (j == 0 || j == 4) {
                const int dbase = -128 + 64 * j - a.qoff + 4 * hi;
#pragma unroll
                for (int r = 0; r < 16; ++r) { const int d = dbase + (r & 3) + 8 * (r >> 2);
                    if ((unsigned)(d + 128) > 256u) p0[r] = -1e30f; if ((unsigned)(d + 32 + 128) > 256u) p1[r] = -1e30f; }
            }
        }
        if (MODE == 2 && t >= 4) {
            const int qrow = a.qoff >> 6, qcol = a.qoff & 63; int cs = qcol - 8; cs = cs < 0 ? 0 : (cs > 48 ? 48 : cs);
            const int krel = a.j0 + t - 4 - qrow + 7;
            const LAS float* bt = (const LAS float*)(lds + ATT_RPB) + krel * 128 + (63 - qcol) + 4 * hi;
            const int cb = 4 * hi - cs;
#pragma unroll
            for (int r = 0; r < 16; ++r) { const int kc = (r & 3) + 8 * (r >> 2);
                const float b0 = bt[kc], b1 = bt[kc + 32];
                p0[r] = ((unsigned)(cb + kc) < 16u) ? p0[r] + b0 : -1e30f;
                p1[r] = ((unsigned)(cb + kc + 32) < 16u) ? p1[r] + b1 : -1e30f; }
        }
    };
    bf16x8 pf0, pf1, pf2, pf3;
    auto SM = [&](bool first) {
        asm volatile("s_nop 15\n\ts_nop 7" : "+v"(p0), "+v"(p1));
        float ra = max3f(p0[0], p0[1], p1[0]), rb = max3f(p0[2], p0[3], p1[1]); ra = max3f(ra, p1[2], p1[3]);
#pragma unroll
        for (int r = 4; r < 16; r += 4) { ra = max3f(ra, p0[r], p0[r + 1]); rb = max3f(rb, p0[r + 2], p0[r + 3]); ra = max3f(ra, p1[r], p1[r + 1]); rb = max3f(rb, p1[r + 2], p1[r + 3]); }
        float rm = max2f(ra, rb);
        { auto rr = __builtin_amdgcn_permlane32_swap(__float_as_uint(rm), __float_as_uint(rm), false, false); rm = max2f(__uint_as_float(rr[0]), __uint_as_float(rr[1])); }
        if (first || __any(rm > THR)) {
            const float dl = first ? rm : fmaxf(rm, 0.f);
            m += dl; const float f = __builtin_amdgcn_exp2f(-dl); l *= f;
#pragma unroll
            for (int r = 0; r < 16; ++r) { p0[r] -= dl; p1[r] -= dl; o0[r] *= f; o1[r] *= f; negm[r] = -m; }
        }
        float ls = 0.f;
#pragma unroll
        for (int r = 0; r < 16; ++r) { p0[r] = __builtin_amdgcn_exp2f(p0[r]); p1[r] = __builtin_amdgcn_exp2f(p1[r]); ls += p0[r] + p1[r]; }
        l += ls;
        u32x4 w;
        w.x = pk2(p0[0], p0[1]); w.y = pk2(p0[2], p0[3]); w.z = pk2(p0[4], p0[5]); w.w = pk2(p0[6], p0[7]); pf0 = __builtin_bit_cast(bf16x8, w);
        w.x = pk2(p0[8], p0[9]); w.y = pk2(p0[10], p0[11]); w.z = pk2(p0[12], p0[13]); w.w = pk2(p0[14], p0[15]); pf1 = __builtin_bit_cast(bf16x8, w);
        w.x = pk2(p1[0], p1[1]); w.y = pk2(p1[2], p1[3]); w.z = pk2(p1[4], p1[5]); w.w = pk2(p1[6], p1[7]); pf2 = __builtin_bit_cast(bf16x8, w);
        w.x = pk2(p1[8], p1[9]); w.y = pk2(p1[10], p1[11]); w.z = pk2(p1[12], p1[13]); w.w = pk2(p1[14], p1[15]); pf3 = __builtin_bit_cast(bf16x8, w);
    };
    auto PV = [&](int boff) {
        const LAS unsigned char* Bb = lds + boff;
        s16x4 va0[4], va1[4], vc0[4], vc1[4];
#pragma unroll
        for (int kk = 0; kk < 4; ++kk) {
            const LAS unsigned char* vb = Bb + kk * 2048;
            va0[kk] = __builtin_bit_cast(s16x4, __builtin_amdgcn_ds_read_tr16_b64_v4i16((LAS s16x4*)(vb + voff0)));
            va1[kk] = __builtin_bit_cast(s16x4, __builtin_amdgcn_ds_read_tr16_b64_v4i16((LAS s16x4*)(vb + voff0 + 1024)));
            vc0[kk] = __builtin_bit_cast(s16x4, __builtin_amdgcn_ds_read_tr16_b64_v4i16((LAS s16x4*)(vb + voff1)));
            vc1[kk] = __builtin_bit_cast(s16x4, __builtin_amdgcn_ds_read_tr16_b64_v4i16((LAS s16x4*)(vb + voff1 + 1024)));
        }
#pragma unroll
        for (int kk = 0; kk < 4; ++kk) {
            const bf16x8 va = (bf16x8){va0[kk][0], va0[kk][1], va0[kk][2], va0[kk][3], va1[kk][0], va1[kk][1], va1[kk][2], va1[kk][3]};
            const bf16x8 vc = (bf16x8){vc0[kk][0], vc0[kk][1], vc0[kk][2], vc0[kk][3], vc1[kk][0], vc1[kk][1], vc1[kk][2], vc1[kk][3]};
            const bf16x8 pk = kk == 0 ? pf0 : (kk == 1 ? pf1 : (kk == 2 ? pf2 : pf3));
            o0 = __builtin_amdgcn_mfma_f32_32x32x16_bf16(va, pk, o0, 0, 0, 0);
            o1 = __builtin_amdgcn_mfma_f32_32x32x16_bf16(vc, pk, o1, 0, 0, 0);
        }
        __builtin_amdgcn_sched_group_barrier(0x100, 16, 0);
        __builtin_amdgcn_sched_group_barrier(0x008, 8, 0);
    };
#define ATT_WAIT_BAR(N) do { asm volatile("s_waitcnt vmcnt(" #N ") lgkmcnt(0)" ::: "memory"); __builtin_amdgcn_s_barrier(); asm volatile("" ::: "memory"); } while (0)
    constexpr int RING = 6, DIST = RING - 1;
    auto wait_bar = [&](int ntiles) {
        if (DQ == 96 && !upper) { switch (ntiles) { case 4: ATT_WAIT_BAR(12); break; case 3: ATT_WAIT_BAR(9); break; case 2: ATT_WAIT_BAR(6); break; case 1: ATT_WAIT_BAR(3); break; default: ATT_WAIT_BAR(0); } }
        else { switch (ntiles) { case 4: ATT_WAIT_BAR(8); break; case 3: ATT_WAIT_BAR(6); break; case 2: ATT_WAIT_BAR(4); break; case 1: ATT_WAIT_BAR(2); break; default: ATT_WAIT_BAR(0); } } };
    if (upper) __builtin_amdgcn_s_setprio(1);
    int issued = 0;
    for (; issued < DIST && issued < nt; ++issued) dma(issued, issued * BUFB);
    wait_bar(issued - 1);
    int b_cur = 0, b_iss = (DIST % RING) * BUFB;
    for (int t = 0; t < nt; ++t) {
        if (issued < nt) { dma(issued, b_iss); ++issued; b_iss += BUFB; if (b_iss == RING * BUFB) b_iss = 0; }
        if (tile_active(t)) { QK(t, b_cur); SM(t == 0); PV(b_cur); }
        { const int infl = issued - t - 2; wait_bar(infl < 0 ? 0 : infl); }
        b_cur += BUFB; if (b_cur == RING * BUFB) b_cur = 0;
    }
#undef ATT_WAIT_BAR
    if (upper) __builtin_amdgcn_s_setprio(0);
    { auto rr = __builtin_amdgcn_permlane32_swap(__float_as_uint(l), __float_as_uint(l), false, false); l = __uint_as_float(rr[0]) + __uint_as_float(rr[1]); }
    const float inv = 1.f / l;
#pragma unroll
    for (int ig = 0; ig < 4; ++ig) {
        u32x2 w0, w1;
        w0.x = pk2(o0[4 * ig] * inv, o0[4 * ig + 1] * inv); w0.y = pk2(o0[4 * ig + 2] * inv, o0[4 * ig + 3] * inv);
        w1.x = pk2(o1[4 * ig] * inv, o1[4 * ig + 1] * inv); w1.y = pk2(o1[4 * ig + 2] * inv, o1[4 * ig + 3] * inv);
        *(u32x2*)(a.optr + 8 * ig + 4 * hi) = w0;
        *(u32x2*)(a.optr + 32 + 8 * ig + 4 * hi) = w1;
    }
}

struct AU2 {
    const bf16_t* qptr; unsigned qpitch;
    bf16_t* optr;
    const bf16_t* kbase; unsigned kpitch; const bf16_t* vbase; unsigned vpitch; const bf16_t* k2base; unsigned k2pitch;
    int row_ctx, nt;
};
template <int DQ  , bool NOMAX  >
__device__ __forceinline__ void attn_unit2(LAS unsigned char* lds, const AU2& a) {
    constexpr int NS = DQ / 16;
    constexpr int BUFB = (DQ == 96) ? 20480 : 16384;
    const int tid = ltid(), lane = tid & 63, wid = __builtin_amdgcn_readfirstlane(tid >> 6), r32 = lane & 31, hi = lane >> 5;
    const bool upper = wid >= 4;
    const int kr = tid >> 3, cp = tid & 7;
    const int ksrc = (cp ^ ((kr >> 1) & 7)) * 8, vsrc = (cp ^ (((kr >> 1) & 1) << 2)) * 8;
    const int kr2 = 16 * wid + (lane >> 2), k2src = ((lane & 3) ^ ((kr2 >> 2) & 3)) * 8;
    unsigned koff[NS];
#pragma unroll
    for (int s = 0; s < NS; ++s) koff[s] = (s < 4) ? (unsigned)(r32 * 128 + (((2 * s + hi) ^ ((r32 >> 1) & 7)) << 4))
                                                   : (unsigned)(16384 + r32 * 64 + (((2 * (s - 4) + hi) ^ ((r32 >> 2) & 3)) << 4));
    const int vg = (lane >> 4) & 1, vq = (lane & 15) >> 2, vp = lane & 3, vsw = (vq >> 1) & 1;
    const unsigned voff0 = (unsigned)(8192 + (4 * hi + vq) * 128 + 64 * vsw + 32 * vg + 8 * vp);
    const unsigned voff1 = (unsigned)(8192 + (4 * hi + vq) * 128 + 64 * (1 - vsw) + 32 * vg + 8 * vp);
    bf16x8 qA[NS], qB[NS];
#pragma unroll
    for (int s = 0; s < NS; ++s) { qA[s] = *(const bf16x8*)(a.qptr + 16 * s + 8 * hi); qB[s] = *(const bf16x8*)(a.qptr + (size_t)32 * a.qpitch + 16 * s + 8 * hi); }
    f32x16 oA0, oA1, oB0, oB1, pA0, pA1, pB0, pB1;
    float mA = 0.f, lA = 0.f, mB = 0.f, lB = 0.f;
#pragma unroll
    for (int r = 0; r < 16; ++r) { oA0[r] = 0.f; oA1[r] = 0.f; oB0[r] = 0.f; oB1[r] = 0.f; }
    const int nt = a.nt;
    const unsigned lds0 = (unsigned)(uintptr_t)lds + (unsigned)wid * 1024u;
    auto dma = [&](int t, int boff) {
        const size_t r = (size_t)(a.row_ctx + 64 * t + kr);
        glds16(a.kbase + r * a.kpitch + ksrc, (unsigned)__builtin_amdgcn_readfirstlane((int)(lds0 + boff)));
        glds16(a.vbase + r * a.vpitch + vsrc, (unsigned)__builtin_amdgcn_readfirstlane((int)(lds0 + boff + 8192)));
        if (DQ == 96) { if (!upper) { const size_t r2 = (size_t)(a.row_ctx + 64 * t + kr2);
            glds16(a.k2base + r2 * a.k2pitch + k2src, (unsigned)__builtin_amdgcn_readfirstlane((int)(lds0 + boff + 16384))); } }
    };
    const f32x16 zero16 = {0.f, 0.f, 0.f, 0.f, 0.f, 0.f, 0.f, 0.f, 0.f, 0.f, 0.f, 0.f, 0.f, 0.f, 0.f, 0.f};
    auto QK = [&](int boff) {
        const LAS unsigned char* Bb = lds + boff;
        bf16x8 kf[2 * NS];
#pragma unroll
        for (int s = 0; s < NS; ++s) { kf[2 * s] = *(const LAS bf16x8*)(Bb + koff[s]); kf[2 * s + 1] = *(const LAS bf16x8*)(Bb + koff[s] + (s < 4 ? 4096 : 2048)); }
#pragma unroll
        for (int s = 0; s < NS; ++s) {
            pA0 = __builtin_amdgcn_mfma_f32_32x32x16_bf16(kf[2 * s], qA[s], s == 0 ? zero16 : pA0, 0, 0, 0); pA1 = __builtin_amdgcn_mfma_f32_32x32x16_bf16(kf[2 * s + 1], qA[s], s == 0 ? zero16 : pA1, 0, 0, 0);
            pB0 = __builtin_amdgcn_mfma_f32_32x32x16_bf16(kf[2 * s], qB[s], s == 0 ? zero16 : pB0, 0, 0, 0); pB1 = __builtin_amdgcn_mfma_f32_32x32x16_bf16(kf[2 * s + 1], qB[s], s == 0 ? zero16 : pB1, 0, 0, 0);
        }
        __builtin_amdgcn_sched_group_barrier(0x100, 2 * NS, 0);
        __builtin_amdgcn_sched_group_barrier(0x008, 4 * NS, 0);
    };
    auto SM = [&](f32x16& p0, f32x16& p1, f32x16& o0, f32x16& o1, float& m, float& l, bool first, bf16x8 (&pf)[4]) {
        float ls = 0.f;
        if constexpr (NOMAX) {
#pragma unroll
            for (int r = 0; r < 16; ++r) { p0[r] = __builtin_amdgcn_exp2f(p0[r]); p1[r] = __builtin_amdgcn_exp2f(p1[r]); ls += p0[r] + p1[r]; }
        } else {
            asm volatile("s_nop 15\n\ts_nop 7" : "+v"(p0), "+v"(p1));
            float ra = max3f(p0[0], p0[1], p1[0]), rb = max3f(p0[2], p0[3], p1[1]); ra = max3f(ra, p1[2], p1[3]);
#pragma unroll
            for (int r = 4; r < 16; r += 4) { ra = max3f(ra, p0[r], p0[r + 1]); rb = max3f(rb, p0[r + 2], p0[r + 3]); ra = max3f(ra, p1[r], p1[r + 1]); rb = max3f(rb, p1[r + 2], p1[r + 3]); }
            float rm = max2f(ra, rb);
            { auto rr = __builtin_amdgcn_permlane32_swap(__float_as_uint(rm), __float_as_uint(rm), false, false); rm = max2f(__uint_as_float(rr[0]), __uint_as_float(rr[1])); }
            if (first) m = rm;
            else if (__any(rm - m > THR)) { const float mn = fmaxf(m, rm); const float f = __builtin_amdgcn_exp2f(m - mn); m = mn; l *= f;
#pragma unroll
                for (int r = 0; r < 16; ++r) { o0[r] *= f; o1[r] *= f; } }
#pragma unroll
            for (int r = 0; r < 16; ++r) { p0[r] = __builtin_amdgcn_exp2f(p0[r] - m); p1[r] = __builtin_amdgcn_exp2f(p1[r] - m); ls += p0[r] + p1[r]; }
        }
        l += ls;
        u32x4 w;
        w.x = pk2(p0[0], p0[1]); w.y = pk2(p0[2], p0[3]); w.z = pk2(p0[4], p0[5]); w.w = pk2(p0[6], p0[7]); pf[0] = __builtin_bit_cast(bf16x8, w);
        w.x = pk2(p0[8], p0[9]); w.y = pk2(p0[10], p0[11]); w.z = pk2(p0[12], p0[13]); w.w = pk2(p0[14], p0[15]); pf[1] = __builtin_bit_cast(bf16x8, w);
        w.x = pk2(p1[0], p1[1]); w.y = pk2(p1[2], p1[3]); w.z = pk2(p1[4], p1[5]); w.w = pk2(p1[6], p1[7]); pf[2] = __builtin_bit_cast(bf16x8, w);
        w.x = pk2(p1[8], p1[9]); w.y = pk2(p1[10], p1[11]); w.z = pk2(p1[12], p1[13]); w.w = pk2(p1[14], p1[15]); pf[3] = __builtin_bit_cast(bf16x8, w);
    };
    bf16x8 pfA[4], pfB[4];
    auto PV = [&](int boff) {
        const LAS unsigned char* Bb = lds + boff;
        s16x4 va0[4], va1[4], vc0[4], vc1[4];
#pragma unroll
        for (int kk = 0; kk < 4; ++kk) {
            const LAS unsigned char* vb = Bb + kk * 2048;
            va0[kk] = __builtin_bit_cast(s16x4, __builtin_amdgcn_ds_read_tr16_b64_v4i16((LAS s16x4*)(vb + voff0)));
            va1[kk] = __builtin_bit_cast(s16x4, __builtin_amdgcn_ds_read_tr16_b64_v4i16((LAS s16x4*)(vb + voff0 + 1024)));
            vc0[kk] = __builtin_bit_cast(s16x4, __builtin_amdgcn_ds_read_tr16_b64_v4i16((LAS s16x4*)(vb + voff1)));
            vc1[kk] = __builtin_bit_cast(s16x4, __builtin_amdgcn_ds_read_tr16_b64_v4i16((LAS s16x4*)(vb + voff1 + 1024)));
        }
#pragma unroll
        for (int kk = 0; kk < 4; ++kk) {
            const bf16x8 va = (bf16x8){va0[kk][0], va0[kk][1], va0[kk][2], va0[kk][3], va1[kk][0], va1[kk][1], va1[kk][2], va1[kk][3]};
            const bf16x8 vc = (bf16x8){vc0[kk][0], vc0[kk][1], vc0[kk][2], vc0[kk][3], vc1[kk][0], vc1[kk][1], vc1[kk][2], vc1[kk][3]};
            oA0 = __builtin_amdgcn_mfma_f32_32x32x16_bf16(va, pfA[kk], oA0, 0, 0, 0); oA1 = __builtin_amdgcn_mfma_f32_32x32x16_bf16(vc, pfA[kk], oA1, 0, 0, 0);
            oB0 = __builtin_amdgcn_mfma_f32_32x32x16_bf16(va, pfB[kk], oB0, 0, 0, 0); oB1 = __builtin_amdgcn_mfma_f32_32x32x16_bf16(vc, pfB[kk], oB1, 0, 0, 0);
        }
        __builtin_amdgcn_sched_group_barrier(0x100, 16, 0);
        __builtin_amdgcn_sched_group_barrier(0x008, 16, 0);
    };
#define ATT_WAIT_BAR(N) do { asm volatile("s_waitcnt vmcnt(" #N ") lgkmcnt(0)" ::: "memory"); __builtin_amdgcn_s_barrier(); asm volatile("" ::: "memory"); } while (0)
    constexpr int RING = 6, DIST = RING - 1;
    auto wait_bar = [&](int ntiles) {
        if (DQ == 96 && !upper) { switch (ntiles) { case 4: ATT_WAIT_BAR(12); break; case 3: ATT_WAIT_BAR(9); break; case 2: ATT_WAIT_BAR(6); break; case 1: ATT_WAIT_BAR(3); break; default: ATT_WAIT_BAR(0); } }
        else { switch (ntiles) { case 4: ATT_WAIT_BAR(8); break; case 3: ATT_WAIT_BAR(6); break; case 2: ATT_WAIT_BAR(4); break; case 1: ATT_WAIT_BAR(2); break; default: ATT_WAIT_BAR(0); } } };
    if (upper) __builtin_amdgcn_s_setprio(1);
    int issued = 0;
    for (; issued < DIST && issued < nt; ++issued) dma(issued, issued * BUFB);
    wait_bar(issued - 1);
    int b_cur = 0, b_iss = (DIST % RING) * BUFB;
    for (int t = 0; t < nt; ++t) {
        if (issued < nt) { dma(issued, b_iss); ++issued; b_iss += BUFB; if (b_iss == RING * BUFB) b_iss = 0; }
        QK(b_cur);
        SM(pA0, pA1, oA0, oA1, mA, lA, t == 0, pfA);
        SM(pB0, pB1, oB0, oB1, mB, lB, t == 0, pfB);
        PV(b_cur);
        { const int infl = issued - t - 2; wait_bar(infl < 0 ? 0 : infl); }
        b_cur += BUFB; if (b_cur == RING * BUFB) b_cur = 0;
    }
#undef ATT_WAIT_BAR
    if (upper) __builtin_amdgcn_s_setprio(0);
    { auto rr = __builtin_amdgcn_permlane32_swap(__float_as_uint(lA), __float_as_uint(lA), false, false); lA = __uint_as_float(rr[0]) + __uint_as_float(rr[1]); }
    { auto rr = __builtin_amdgcn_permlane32_swap(__float_as_uint(lB), __float_as_uint(lB), false, false); lB = __uint_as_float(rr[0]) + __uint_as_float(rr[1]); }
    const float invA = 1.f / lA, invB = 1.f / lB; bf16_t* oB = a.optr + (size_t)32 * 1024;
#pragma unroll
    for (int ig = 0; ig < 4; ++ig) {
        u32x2 w0, w1;
        w0.x = pk2(oA0[4 * ig] * invA, oA0[4 * ig + 1] * invA); w0.y = pk2(oA0[4 * ig + 2] * invA, oA0[4 * ig + 3] * invA);
        w1.x = pk2(oA1[4 * ig] * invA, oA1[4 * ig + 1] * invA); w1.y = pk2(oA1[4 * ig + 2] * invA, oA1[4 * ig + 3] * invA);
        *(u32x2*)(a.optr + 8 * ig + 4 * hi) = w0; *(u32x2*)(a.optr + 32 + 8 * ig + 4 * hi) = w1;
        w0.x = pk2(oB0[4 * ig] * invB, oB0[4 * ig + 1] * invB); w0.y = pk2(oB0[4 * ig + 2] * invB, oB0[4 * ig + 3] * invB);
        w1.x = pk2(oB1[4 * ig] * invB, oB1[4 * ig + 1] * invB); w1.y = pk2(oB1[4 * ig + 2] * invB, oB1[4 * ig + 3] * invB);
        *(u32x2*)(oB + 8 * ig + 4 * hi) = w0; *(u32x2*)(oB + 32 + 8 * ig + 4 * hi) = w1;
    }
}

struct Job { const float* src; bf16_t* dst; int K, N, ldd, nb; size_t sbs, dbs; int mode; const float* rscale; };

__device__ __forceinline__ int hperm64(int c) { const int base = c & ~63, cl = c & 63, p = cl >> 1, n = cl & 1, g = p >> 4, i = p & 15; return base + 32 * g + 16 * n + i; }
__device__ __forceinline__ int rowmap(int mode, int c) {
    switch (mode) {
        case 1: return c < 640 ? hperm64(c) : c;
        case 2: if ((c >= 384 && c < 896) || (c >= 1184 && c < 1312)) { const int b0 = (c >= 1184) ? 1184 : 384; return b0 + hperm64(c - b0); }
                if (c >= 1152 && c < 1184) { const int cl = c - 1152; return 1152 + 16 * (cl & 1) + (cl >> 1); }
                return c;
        case 3: { const int h = c / 96, cl = c % 96; if (cl < 64) return c; const int r = cl - 64; return h * 96 + 64 + 16 * (r & 1) + (r >> 1); }
        case 4: return 32 * (c >> 4) + (c & 15);
        case 5: return 32 * (c >> 4) + 16 + (c & 15);
        default: return c;
    }
}
__device__ __forceinline__ float colscale(int mode, int c) {
    if (mode == 1) return (c < 512 || (c >= 768 && c < 1280)) ? QS64 : 1.f;
    if (mode == 3) return QS96;
    return 1.f;
}
__device__ __forceinline__ bool get_job(PP P, int j, Job& J) {
    const int layer = j >= 9 ? 1 : 0, jj = layer ? j - 9 : j; const int ib = layer ? 20 : 4;
    bf16_t* W = (bf16_t*)(P->ws + (layer ? WS_W1 : WS_W0));
    J.nb = 1; J.sbs = 0; J.dbs = 0; J.rscale = nullptr; J.mode = 0; J.ldd = 1024; J.K = 1024;
    switch (jj) {
        case 0: J.src = P->in[ib + 3]; J.dst = W + WO_IN; J.N = layer ? 1440 : 2304; J.mode = layer ? 2 : 1; break;
        case 1: J.src = P->in[layer ? 30 : 10]; J.dst = W + WO_OUT; J.N = 1024; break;
        case 2: J.src = P->in[layer ? 32 : 12]; J.dst = W + WO_RT; J.N = 64; J.mode = 7; break;
        case 3: J.src = P->in[layer ? 34 : 14]; J.dst = W + WO_GU; J.N = 256; J.nb = 64; J.sbs = (size_t)1024 * 256; J.dbs = (size_t)512 * 1024; J.mode = 4; break;
        case 4: J.src = P->in[layer ? 35 : 15]; J.dst = W + WO_GU; J.N = 256; J.nb = 64; J.sbs = (size_t)1024 * 256; J.dbs = (size_t)512 * 1024; J.mode = 5; break;
        case 5: J.src = P->in[layer ? 36 : 16]; J.dst = W + WO_D; J.K = 256; J.N = 1024; J.ldd = 256; J.nb = 64; J.sbs = (size_t)256 * 1024; J.dbs = (size_t)1024 * 256; break;
        case 6: J.src = P->in[layer ? 37 : 17]; J.dst = W + WO_GU + (size_t)64 * 512 * 1024; J.N = 256; J.mode = 4; break;
        case 7: J.src = P->in[layer ? 38 : 18]; J.dst = W + WO_GU + (size_t)64 * 512 * 1024; J.N = 256; J.mode = 5; break;
        case 8: J.src = P->in[layer ? 39 : 19]; J.dst = W + WO_D + (size_t)64 * 1024 * 256; J.K = 256; J.N = 1024; J.ldd = 256; break;
        case 9: J.src = P->in[25]; J.dst = W + WO_UQ; J.K = 384; J.N = 768; J.ldd = 384; J.mode = 3; J.rscale = P->in[24]; break;
        case 10: J.src = P->in[27]; J.dst = W + WO_UKV; J.K = 256; J.N = 1024; J.ldd = 256; J.mode = 6; J.rscale = P->in[26]; break;
        default: return false;
    }
    return true;
}
constexpr int NJOBS = 20;
__device__ __forceinline__ int job_tiles(const Job& J) { return J.nb * (J.K >> 6) * ((J.N + 255) >> 8); }

__device__ __forceinline__ void conv_tile(const Job& J, int tile, LAS float* T) {
    const int tid = ltid(); const int ntn = (J.N + 255) >> 8, ntk = J.K >> 6;
    const int b = tile / (ntn * ntk), r = tile % (ntn * ntk), tk = r / ntn, tn = r % ntn;
    const float* src = J.src + (size_t)b * J.sbs; bf16_t* dst = J.dst + (size_t)b * J.dbs; const int k0 = tk * 64, n0 = tn * 256;
    { const int n4 = (tid & 63) * 4; const bool ok = (n0 + n4) < J.N;
      f32x4 v[8];
#pragma unroll
      for (int j = 0; j < 8; ++j) { const int k = (tid >> 6) + 8 * j; v[j] = ok ? *(const f32x4*)(src + (size_t)(k0 + k) * J.N + n0 + n4) : (f32x4){0.f, 0.f, 0.f, 0.f}; }
      f32x4 cs; cs[0] = colscale(J.mode, n0 + n4); cs[1] = colscale(J.mode, n0 + n4 + 1); cs[2] = colscale(J.mode, n0 + n4 + 2); cs[3] = colscale(J.mode, n0 + n4 + 3);
#pragma unroll
      for (int j = 0; j < 8; ++j) { const int k = (tid >> 6) + 8 * j; f32x4 x = v[j] * cs; if (J.rscale) x = x * J.rscale[k0 + k]; *(LAS f32x4*)(T + k * 260 + n4) = x; } }
    __syncthreads();
    { const int nn = tid >> 1, kh = (tid & 1) * 32;
      if (n0 + nn < J.N) { const int drow = rowmap(J.mode, n0 + nn); bf16_t* dp = dst + (size_t)drow * J.ldd + k0 + kh;
#pragma unroll
          for (int q = 0; q < 4; ++q) { float v[8];
#pragma unroll
              for (int j = 0; j < 8; ++j) v[j] = T[(kh + 8 * q + j) * 260 + nn];
              u32x4 w; w.x = pk2(v[0], v[1]); w.y = pk2(v[2], v[3]); w.z = pk2(v[4], v[5]); w.w = pk2(v[6], v[7]);
              *(u32x4*)(dp + 8 * q) = w;
              if (J.mode == 7) { u32x4 w2;
                  w2.x = pk2(v[0] - bflo(w.x), v[1] - bfhi(w.x)); w2.y = pk2(v[2] - bflo(w.y), v[3] - bfhi(w.y));
                  w2.z = pk2(v[4] - bflo(w.z), v[5] - bfhi(w.z)); w2.w = pk2(v[6] - bflo(w.w), v[7] - bfhi(w.w));
                  *(u32x4*)(dp + (size_t)64 * 1024 + 8 * q) = w2; } } } }
    __syncthreads();
}

__device__ __forceinline__ void ada_item(PP P, int item, LAS float* S) {
    const int tid = ltid(); const int layer = item / 96, chunk = item % 96;
    for (int idx = tid; idx < 33 * 1024; idx += 512) { const int r = idx >> 10, k = idx & 1023; const float x = (r < 32) ? P->in[1][r * 1024 + k] : P->in[3][k]; S[idx] = x / (1.f + expf(-x)); }
    __syncthreads();
    const int col = chunk * 64 + (tid & 63), kg = tid >> 6;
    float acc[33];
#pragma unroll
    for (int r = 0; r < 33; ++r) acc[r] = 0.f;
    const float* W = P->in[layer ? 20 : 4] + col;
    for (int k = kg * 128; k < kg * 128 + 128; ++k) { const float w = W[(size_t)k * 6144];
#pragma unroll
        for (int r = 0; r < 33; ++r) acc[r] += S[r * 1024 + k] * w; }
    __syncthreads();
#pragma unroll
    for (int r = 0; r < 33; ++r) S[(kg * 33 + r) * 64 + (tid & 63)] = acc[r];
    __syncthreads();
    float* ada = (float*)(P->ws + WS_ADA) + (size_t)layer * 33 * 6144; const float* bias = P->in[layer ? 21 : 5];
    for (int idx = tid; idx < 33 * 64; idx += 512) { const int r = idx >> 6, cc = idx & 63; float s = 0.f;
#pragma unroll
        for (int g = 0; g < 8; ++g) s += S[(g * 33 + r) * 64 + cc];
        ada[(size_t)r * 6144 + chunk * 64 + cc] = s + bias[chunk * 64 + cc]; }
    __syncthreads();
}

__device__ __forceinline__ void phase_prologue(PP P, LAS unsigned char* lds, int c, int G) {
    const int tid = ltid();
    for (int it = c; it < 192; it += G) ada_item(P, it, (LAS float*)lds);
    { float* rp = (float*)(P->ws + WS_ROPE); float* cosh_ = rp; float* sinh_ = rp + 2048 * 32; float* cosr_ = rp + 2 * 2048 * 32; float* sinr_ = cosr_ + 2048 * 16;
      for (int idx = c * 512 + tid; idx < 2048 * 48; idx += G * 512) {
          if (idx < 2048 * 32) { const int t = idx >> 5, p = idx & 31; const float pos = (p < 16) ? (float)(t >> 6) : (float)(t & 63); const int i = p & 15;
              const float inv = powf(10000.0f, -(float)i / 16.0f); const float ang = pos * inv; cosh_[idx] = cosf(ang); sinh_[idx] = sinf(ang); }
          else { const int k = idx - 2048 * 32; const int t = k >> 4, p = k & 15; const float pos = (p < 8) ? (float)(t >> 6) : (float)(t & 63); const int i = p & 7;
              const float inv = powf(10000.0f, -(float)i / 8.0f); const float ang = pos * inv; cosr_[k] = cosf(ang); sinr_[k] = sinf(ang); } } }
    { u32x4* z = (u32x4*)((bf16_t*)(P->ws + WS_W1) + WO_IN + (size_t)1440 * 1024); for (int idx = c * 512 + tid; idx < 96 * 1024 / 8; idx += G * 512) z[idx] = (u32x4){0u, 0u, 0u, 0u}; }
    { int base = 0; int tile = c;
      for (int j = 0; j < NJOBS; ++j) { Job J; get_job(P, j, J); const int n = job_tiles(J);
          while (tile < base + n) { conv_tile(J, tile - base, (LAS float*)lds); tile += G; }
          base += n; } }
}

__device__ __forceinline__ void phase_norm(PP P, int c, int G, const float* xlat, const float* xctx, const float* g, const float* ada  , int sh_off, int sc_off, bool latent_only, bf16_t* H, bf16_t* HLO,
                                           const bool resid = false, float* xlat_dst = nullptr, float* xctx_dst = nullptr) {
    const int tid_ = ltid(); const int lane = tid_ & 63, wv = c * 8 + (tid_ >> 6), nw = G * 8;
    for (int row = wv; row < MROWS; row += nw) {
        const int b = row / TOK, t = row % TOK; const bool ctx = t < CTX;
        if (ctx && latent_only) continue;
        const float* x = ctx ? xctx + ((size_t)b * CTX + t) * 1024 : xlat + ((size_t)b * SEQ + t - CTX) * 1024;
        const float* ap = ada + (size_t)(ctx ? 32 : b) * 6144;
        f32x4 v[4]; float ss = 0.f;
#pragma unroll
        for (int i = 0; i < 2; ++i) { v[2 * i] = *(const f32x4*)(x + 512 * i + 8 * lane); v[2 * i + 1] = *(const f32x4*)(x + 512 * i + 8 * lane + 4); }
        if (resid) {
            float* xd = ctx ? xctx_dst + ((size_t)b * CTX + t) * 1024 : xlat_dst + ((size_t)b * SEQ + t - CTX) * 1024;
#pragma unroll
            for (int i = 0; i < 2; ++i) { const u32x4 yw = *(const u32x4*)(HLO + (size_t)row * 1024 + 512 * i + 8 * lane);
                const f32x4 g0 = *(const f32x4*)(ap + 2048 + 512 * i + 8 * lane), g1 = *(const f32x4*)(ap + 2048 + 512 * i + 8 * lane + 4);
                v[2 * i][0] += g0[0] * bflo(yw.x); v[2 * i][1] += g0[1] * bfhi(yw.x); v[2 * i][2] += g0[2] * bflo(yw.y); v[2 * i][3] += g0[3] * bfhi(yw.y);
                v[2 * i + 1][0] += g1[0] * bflo(yw.z); v[2 * i + 1][1] += g1[1] * bfhi(yw.z); v[2 * i + 1][2] += g1[2] * bflo(yw.w); v[2 * i + 1][3] += g1[3] * bfhi(yw.w);
                *(f32x4*)(xd + 512 * i + 8 * lane) = v[2 * i]; *(f32x4*)(xd + 512 * i + 8 * lane + 4) = v[2 * i + 1]; }
        }
#pragma unroll
        for (int i = 0; i < 4; ++i) ss += v[i][0] * v[i][0] + v[i][1] * v[i][1] + v[i][2] * v[i][2] + v[i][3] * v[i][3];
        ss = wave_sum(ss); const float rstd = rsqrtf(ss * (1.f / 1024.f) + EPS);
#pragma unroll
        for (int i = 0; i < 2; ++i) { const int col = 512 * i + 8 * lane; float o[8];
#pragma unroll
            for (int h = 0; h < 2; ++h) { const f32x4 gg = *(const f32x4*)(g + col + 4 * h), sc = *(const f32x4*)(ap + sc_off + col + 4 * h), sh = *(const f32x4*)(ap + sh_off + col + 4 * h);
#pragma unroll
                for (int j = 0; j < 4; ++j) o[4 * h + j] = v[2 * i + h][j] * rstd * gg[j] * (1.f + sc[j]) + sh[j]; }
            u32x4 w; w.x = pk2(o[0], o[1]); w.y = pk2(o[2], o[3]); w.z = pk2(o[4], o[5]); w.w = pk2(o[6], o[7]);
            *(u32x4*)(H + (size_t)row * 1024 + col) = w;
            if (HLO) { u32x4 w2; w2.x = pk2(o[0] - bflo(w.x), o[1] - bfhi(w.x)); w2.y = pk2(o[2] - bflo(w.y), o[3] - bfhi(w.y)); w2.z = pk2(o[4] - bflo(w.z), o[5] - bfhi(w.z)); w2.w = pk2(o[6] - bflo(w.w), o[7] - bfhi(w.w));
                *(u32x4*)(HLO + (size_t)row * 1024 + col) = w2; } }
    }
}

__device__ __forceinline__ void phase_post1(PP P, int c, int G) {
    const int tid_ = ltid(); const int lane = tid_ & 63, wv = c * 8 + (tid_ >> 6), nw = G * 8;
    bf16_t* Pb = (bf16_t*)(P->ws + WS_BIG + BIG_P); float* RS = (float*)(P->ws + WS_RSTD);
    const float* rp = (const float*)(P->ws + WS_ROPE); const float* cosh_ = rp; const float* sinh_ = rp + 2048 * 32; const float* cosr_ = rp + 2 * 2048 * 32; const float* sinr_ = cosr_ + 2048 * 16;
    const float* gqn = P->in[28]; const float* gkn = P->in[29];
    for (int row = wv; row < MROWS; row += nw) {
        bf16_t* pr = Pb + (size_t)row * 1536; const int t = row % TOK; const bool lat = t >= CTX; const int tt = t - CTX;
        float s1 = 0.f, s2 = 0.f;
        if (lane < 48) { const u32x4 w = *(const u32x4*)(pr + 8 * lane); const float a0 = bflo(w.x), a1 = bfhi(w.x), a2 = bflo(w.y), a3 = bfhi(w.y), a4 = bflo(w.z), a5 = bfhi(w.z), a6 = bflo(w.w), a7 = bfhi(w.w);
            s1 = a0 * a0 + a1 * a1 + a2 * a2 + a3 * a3 + a4 * a4 + a5 * a5 + a6 * a6 + a7 * a7; }
        if (lane < 32) { const u32x4 w = *(const u32x4*)(pr + 896 + 8 * lane); const float a0 = bflo(w.x), a1 = bfhi(w.x), a2 = bflo(w.y), a3 = bfhi(w.y), a4 = bflo(w.z), a5 = bfhi(w.z), a6 = bflo(w.w), a7 = bfhi(w.w);
            s2 = a0 * a0 + a1 * a1 + a2 * a2 + a3 * a3 + a4 * a4 + a5 * a5 + a6 * a6 + a7 * a7; }
        s1 = wave_sum(s1); s2 = wave_sum(s2);
        if (lane == 0) { RS[(size_t)row * 2] = rsqrtf(s1 * (1.f / 384.f) + EPS); RS[(size_t)row * 2 + 1] = rsqrtf(s2 * (1.f / 256.f) + EPS); }
#pragma unroll
        for (int ps = 0; ps < 2; ++ps) {
            const int Gi = lane >> 2, qd = lane & 3; const bool on = (ps == 0) || (lane < 16);
            bf16_t* base = pr + (ps == 0 ? 384 : 1184) + 32 * Gi + 4 * qd;
            float x0[4] = {0.f, 0.f, 0.f, 0.f}, x1[4] = {0.f, 0.f, 0.f, 0.f};
            if (on) { const u32x2 w0 = *(const u32x2*)base, w1 = *(const u32x2*)(base + 16);
                x0[0] = bflo(w0.x); x0[1] = bfhi(w0.x); x0[2] = bflo(w0.y); x0[3] = bfhi(w0.y); x1[0] = bflo(w1.x); x1[1] = bfhi(w1.x); x1[2] = bflo(w1.y); x1[3] = bfhi(w1.y); }
            float ss = 0.f;
#pragma unroll
            for (int j = 0; j < 4; ++j) ss += x0[j] * x0[j] + x1[j] * x1[j];
            ss += __shfl_xor(ss, 1); ss += __shfl_xor(ss, 2); ss += __shfl_xor(ss, 4);
            const float rstd = rsqrtf(ss * (1.f / 64.f) + EPS);
            const int gsel = Gi & 1; const float* gn = ps == 0 ? gqn : gkn; const float qs = ps == 0 ? QS64 : 1.f;
            if (on) { float y0[4], y1[4];
#pragma unroll
                for (int j = 0; j < 4; ++j) { const int pidx = 16 * gsel + 4 * qd + j; y0[j] = x0[j] * rstd * gn[2 * pidx]; y1[j] = x1[j] * rstd * gn[2 * pidx + 1];
                    if (lat) { const float cs = cosh_[(size_t)tt * 32 + pidx], sn = sinh_[(size_t)tt * 32 + pidx]; const float a = y0[j] * cs - y1[j] * sn, bb = y0[j] * sn + y1[j] * cs; y0[j] = a; y1[j] = bb; }
                    y0[j] *= qs; y1[j] *= qs; }
                u32x2 w0, w1; w0.x = pk2(y0[0], y0[1]); w0.y = pk2(y0[2], y0[3]); w1.x = pk2(y1[0], y1[1]); w1.y = pk2(y1[2], y1[3]);
                *(u32x2*)base = w0; *(u32x2*)(base + 16) = w1; }
        }
        if (lat && lane < 4) { bf16_t* base = pr + 1152 + 4 * lane; const u32x2 w0 = *(const u32x2*)base, w1 = *(const u32x2*)(base + 16);
            float x0[4] = {bflo(w0.x), bfhi(w0.x), bflo(w0.y), bfhi(w0.y)}, x1[4] = {bflo(w1.x), bfhi(w1.x), bflo(w1.y), bfhi(w1.y)}; float y0[4], y1[4];
#pragma unroll
            for (int j = 0; j < 4; ++j) { const int pidx = 4 * lane + j; const float cs = cosr_[(size_t)tt * 16 + pidx], sn = sinr_[(size_t)tt * 16 + pidx]; y0[j] = x0[j] * cs - x1[j] * sn; y1[j] = x0[j] * sn + x1[j] * cs; }
            u32x2 o0, o1; o0.x = pk2(y0[0], y0[1]); o0.y = pk2(y0[2], y0[3]); o1.x = pk2(y1[0], y1[1]); o1.y = pk2(y1[2], y1[3]);
            *(u32x2*)base = o0; *(u32x2*)(base + 16) = o1; }
    }
}

__device__ __forceinline__ void phase_router(PP P, LAS unsigned char* lds, int c, int G, int layer) {
    const int tid = ltid(), lane = tid & 63, wid = tid >> 6, r32 = lane & 31, hi = lane >> 5;
    const bf16_t* H = (const bf16_t*)(P->ws + WS_H); const bf16_t* HLO = (const bf16_t*)(P->ws + WS_BIG + BIG_HLO);
    const bf16_t* W = (const bf16_t*)(P->ws + (layer ? WS_W1 : WS_W0)) + WO_RT; const bf16_t* WL = W + 64 * 1024;
    const float* brt = P->in[layer ? 33 : 13];
    int* cnt = (int*)(P->ws + WS_CTL + CTL_CNT) + layer * NG; int* srow = (int*)(P->ws + WS_SROW); float* sw = (float*)(P->ws + WS_SW); int* tslot = (int*)(P->ws + WS_TSLOT);
    LAS float* L = (LAS float*)lds + wid * (32 * 65);
    const int ngroups = MROWS / 32;
    for (int gidx = c * 8 + wid; gidx < ngroups; gidx += G * 8) {
        const int row0 = gidx * 32; const int t0 = row0 % TOK;
        if (layer == 1 && t0 < CTX) continue;
        f32x16 a0, a1;
#pragma unroll
        for (int r = 0; r < 16; ++r) { a0[r] = 0.f; a1[r] = 0.f; }
        const bf16_t* hp = H + (size_t)(row0 + r32) * 1024 + 8 * hi; const bf16_t* hl = HLO + (size_t)(row0 + r32) * 1024 + 8 * hi;
        const bf16_t* w0 = W + (size_t)r32 * 1024 + 8 * hi; const bf16_t* wl0 = WL + (size_t)r32 * 1024 + 8 * hi;
#pragma unroll 4
        for (int s = 0; s < 64; ++s) {
            const bf16x8 xh = *(const bf16x8*)(hp + 16 * s), xl = *(const bf16x8*)(hl + 16 * s);
            const bf16x8 wa = *(const bf16x8*)(w0 + 16 * s), wb = *(const bf16x8*)(w0 + 32 * 1024 + 16 * s);
            const bf16x8 la = *(const bf16x8*)(wl0 + 16 * s), lb = *(const bf16x8*)(wl0 + 32 * 1024 + 16 * s);
            a0 = __builtin_amdgcn_mfma_f32_32x32x16_bf16(wa, xh, a0, 0, 0, 0); a1 = __builtin_amdgcn_mfma_f32_32x32x16_bf16(wb, xh, a1, 0, 0, 0);
            a0 = __builtin_amdgcn_mfma_f32_32x32x16_bf16(wa, xl, a0, 0, 0, 0); a1 = __builtin_amdgcn_mfma_f32_32x32x16_bf16(wb, xl, a1, 0, 0, 0);
            a0 = __builtin_amdgcn_mfma_f32_32x32x16_bf16(la, xh, a0, 0, 0, 0); a1 = __builtin_amdgcn_mfma_f32_32x32x16_bf16(lb, xh, a1, 0, 0, 0);
        }
#pragma unroll
        for (int r = 0; r < 16; ++r) { const int e = (r & 3) + 8 * (r >> 2) + 4 * hi; L[r32 * 65 + e] = a0[r]; L[r32 * 65 + e + 32] = a1[r]; }
        __builtin_amdgcn_s_waitcnt(0xC07F);
        __builtin_amdgcn_wave_barrier();
        if (lane < 32) {
            const int row = row0 + lane; float bk[6], bs[6]; int bi[6];
#pragma unroll
            for (int k = 0; k < 6; ++k) { bk[k] = -1e30f; bs[k] = 0.f; bi[k] = 0; }
            for (int e = 0; e < 64; ++e) { const float x = L[lane * 65 + e]; const float sc = 1.f / (1.f + expf(-x)); float key = sc + brt[e]; float s = sc; int id = e;
#pragma unroll
                for (int k = 0; k < 6; ++k) { if (key > bk[k]) { const float tk = bk[k], ts = bs[k]; const int ti = bi[k]; bk[k] = key; bs[k] = s; bi[k] = id; key = tk; s = ts; id = ti; } } }
            float tot = 0.f;
#pragma unroll
            for (int k = 0; k < 6; ++k) tot += bs[k];
            const float sc = 2.5f / tot; const int ch = row / CHUNK_ROWS;
#pragma unroll
            for (int k = 0; k < 6; ++k) { const int e = bi[k]; const int pos = atomicAdd(cnt + ch * NGRP + e, 1);
                if (pos < CAP) srow[(size_t)(ch * 64 + e) * CAP + pos] = row;
                sw[(size_t)row * 8 + k] = bs[k] * sc; tslot[(size_t)row * 6 + k] = (e << 20) | pos; }
        }
        __builtin_amdgcn_wave_barrier();
    }
    if (c == 0 && tid < NCHUNK) cnt[tid * NGRP + NEXP] = layer ? CHUNK_B * SEQ : CHUNK_ROWS;
}

__device__ __forceinline__ void build_toff(LAS int* toff, const int* cnt) {
    const int tid = ltid();
    if (tid < 64) { int v[5], s = 0;
#pragma unroll
        for (int j = 0; j < 5; ++j) { const int g = tid * 5 + j; const int cv = (g < NG) ? ld_ctl(cnt + g) : 0; if (g < NG) toff[272 + g] = cv; v[j] = (cv + 255) >> 8; s += v[j]; }
        int inc = s;
#pragma unroll
        for (int o = 1; o < 64; o <<= 1) { const int t = __shfl_up(inc, o); if (tid >= o) inc += t; }
        int ex = inc - s;
#pragma unroll
        for (int j = 0; j < 5; ++j) { const int g = tid * 5 + j; if (g <= NG) toff[g] = ex; ex += v[j]; } }
    __syncthreads();
}

__device__ __forceinline__ void phase_combine(PP P, LAS unsigned char* lds, int c, int G, int layer, int ch) {
    const int tid_ = ltid(); const int lane = tid_ & 63, wv = c * 8 + (tid_ >> 6), nw = G * 8;
    LAS const int* toff = (LAS const int*)(lds + LDS_TAB);
    const bf16_t* slab = (const bf16_t*)(P->ws + WS_BIG + BIG_SLAB); const int* tslot = (const int*)(P->ws + WS_TSLOT);
    const float* ada = (const float*)(P->ws + WS_ADA) + (size_t)layer * 33 * 6144; const float* ada1 = (const float*)(P->ws + WS_ADA) + (size_t)33 * 6144;
    float* xc = (float*)(P->ws + WS_XC); bf16_t* H = (bf16_t*)(P->ws + WS_H); const float* tokw = (const float*)(P->ws + WS_SW);
    const int t0 = toff[ch * NGRP];
    for (int rr = wv; rr < CHUNK_ROWS; rr += nw) {
        const int row = ch * CHUNK_ROWS + rr; const int b = row / TOK, t = row % TOK; const bool ctx = t < CTX;
        if (ctx && layer == 1) continue;
        int sidx = 0; float swt = 1.f;
        if (lane < 6) { const int v = __hip_atomic_load(tslot + (size_t)row * 6 + lane, __ATOMIC_RELAXED, __HIP_MEMORY_SCOPE_AGENT); sidx = (toff[ch * NGRP + (v >> 20)] - t0) * 256 + (v & 0xfffff);
            swt = __hip_atomic_load(tokw + (size_t)row * 8 + lane, __ATOMIC_RELAXED, __HIP_MEMORY_SCOPE_AGENT); }
        if (lane == 6) { const int rank = layer ? ((b - ch * CHUNK_B) * SEQ + t - CTX) : rr; sidx = (toff[ch * NGRP + NEXP] - t0) * 256 + rank; }
        float* x = ctx ? xc + ((size_t)b * CTX + t) * 1024 : P->out + ((size_t)b * SEQ + t - CTX) * 1024;
        const float* ap = ada + (size_t)(ctx ? 32 : b) * 6144 + 5 * 1024;
        f32x4 xv[4];
#pragma unroll
        for (int i = 0; i < 4; ++i) xv[i] = *(const f32x4*)(x + 512 * (i >> 1) + 8 * lane + 4 * (i & 1));
        float acc[16];
#pragma unroll
        for (int j = 0; j < 16; ++j) acc[j] = 0.f;
#pragma unroll
        for (int k = 0; k < 7; ++k) { const int s = __shfl(sidx, k); const float wk = __shfl(swt, k); const bf16_t* sp = slab + (size_t)s * 1024;
#pragma unroll
            for (int i = 0; i < 2; ++i) { const u32x4 w = __builtin_nontemporal_load((const u32x4*)(sp + 512 * i + 8 * lane));
                acc[8 * i + 0] += wk * bflo(w.x); acc[8 * i + 1] += wk * bfhi(w.x); acc[8 * i + 2] += wk * bflo(w.y); acc[8 * i + 3] += wk * bfhi(w.y);
                acc[8 * i + 4] += wk * bflo(w.z); acc[8 * i + 5] += wk * bfhi(w.z); acc[8 * i + 6] += wk * bflo(w.w); acc[8 * i + 7] += wk * bfhi(w.w); } }
        float v[16]; float ss = 0.f;
#pragma unroll
        for (int i = 0; i < 4; ++i) { const f32x4 gq = *(const f32x4*)(ap + 512 * (i >> 1) + 8 * lane + 4 * (i & 1));
#pragma unroll
            for (int j = 0; j < 4; ++j) { const float y = xv[i][j] + gq[j] * acc[4 * i + j]; v[4 * i + j] = y; ss += y * y; } }
        ss = wave_sum(ss); const float rstd = rsqrtf(ss * (1.f / 1024.f) + EPS);
        if (layer == 0) {
            const float* gm1 = P->in[22]; const float* a1 = ada1 + (size_t)(ctx ? 32 : b) * 6144; float o[16];
#pragma unroll
            for (int i = 0; i < 4; ++i) { const int col = 512 * (i >> 1) + 8 * lane + 4 * (i & 1);
                *(f32x4*)(x + col) = (f32x4){v[4 * i], v[4 * i + 1], v[4 * i + 2], v[4 * i + 3]};
                const f32x4 gg = *(const f32x4*)(gm1 + col), sc = *(const f32x4*)(a1 + 1024 + col), sh = *(const f32x4*)(a1 + col);
#pragma unroll
                for (int j = 0; j < 4; ++j) o[4 * i + j] = v[4 * i + j] * rstd * gg[j] * (1.f + sc[j]) + sh[j]; }
#pragma unroll
            for (int i = 0; i < 2; ++i) { u32x4 w; w.x = pk2(o[8 * i], o[8 * i + 1]); w.y = pk2(o[8 * i + 2], o[8 * i + 3]); w.z = pk2(o[8 * i + 4], o[8 * i + 5]); w.w = pk2(o[8 * i + 6], o[8 * i + 7]);
                *(u32x4*)(H + (size_t)row * 1024 + 512 * i + 8 * lane) = w; }
        } else {
            const float* gf = P->in[40];
#pragma unroll
            for (int i = 0; i < 4; ++i) { const int col = 512 * (i >> 1) + 8 * lane + 4 * (i & 1); const f32x4 gg = *(const f32x4*)(gf + col); f32x4 o;
#pragma unroll
                for (int j = 0; j < 4; ++j) o[j] = v[4 * i + j] * rstd * gg[j];
                *(f32x4*)(x + col) = o; }
        }
    }
}

__device__ __forceinline__ int remap64(int c, int i, int G) { return c + i * G; }
__device__ __forceinline__ int remap8(int c, int G) { return c; }
__device__ __forceinline__ void phase_attn0(PP P, LAS unsigned char* lds, int c, int G) {
    const int tid = ltid(), lane = tid & 63, wid = __builtin_amdgcn_readfirstlane(tid >> 6), r32 = lane & 31;
    const bf16_t* QKV = (const bf16_t*)(P->ws + WS_BIG + BIG_QKV); bf16_t* ATT = (bf16_t*)(P->ws + WS_H);
    const float* sink = P->in[8]; const float* rpb = P->in[9];
    for (int i = 0; c + i * G < 2048; ++i) {
        const int u = remap64(c, i, G); const int b = u >> 6, kvh = (u >> 5) & 1, blk = u & 31; const int g = wid & 3, ts = wid >> 2; const int head = kvh * 4 + g;
        AU a; const int tok = blk * 64 + 32 * ts + r32; const size_t qrow = (size_t)b * TOK + CTX + tok;
        a.qptr = QKV + qrow * 2304 + head * 64; a.optr = ATT + qrow * 1024 + head * 64;
        a.kbase = QKV + 512 + kvh * 64; a.kpitch = 2304; a.vbase = QKV + 640 + kvh * 64; a.vpitch = 2304; a.k2base = nullptr; a.k2pitch = 0;
        a.row_ctx = b * TOK; a.row_lat = b * TOK + CTX; a.start = blk * 64;
        const int jlo = blk >= 2 ? 0 : 2 - blk; int jhi = (2048 + 128 - blk * 64) / 64; jhi = jhi > 5 ? 5 : jhi;
        a.j0 = jlo; a.nt = 4 + (jhi - jlo); a.qoff = 32 * ts + r32; a.m0 = sink[head] * LOG2E; a.l0 = 1.f;
        attn_unit<1, 64>(lds, a);
    }
    for (int i = 0; c + i * G < 2048; ++i) {
        const int u = remap64(c, i, G); const int b = u >> 6, head = (u >> 3) & 7, uu = u & 7;
        { LAS float* bt = (LAS float*)(lds + ATT_RPB);
          for (int idx = tid; idx < 15 * 128; idx += 512) { const int dr = idx >> 7, dc = (idx & 127) - 48; bt[idx] = (dc >= 0 && dc <= 30) ? rpb[(head * 15 + dr) * 31 + dc] * LOG2E : 0.f; } }
        AU a; const int qr = 4 * uu + (wid >> 1), qc = 32 * (wid & 1) + r32; const int tok = qr * 64 + qc; const size_t qrow = (size_t)b * TOK + CTX + tok;
        a.qptr = QKV + qrow * 2304 + 768 + head * 64; a.optr = ATT + qrow * 1024 + 512 + head * 64;
        a.kbase = QKV + 1280 + head * 64; a.kpitch = 2304; a.vbase = QKV + 1792 + head * 64; a.vpitch = 2304; a.k2base = nullptr; a.k2pitch = 0;
        a.row_ctx = b * TOK; a.row_lat = b * TOK + CTX; a.start = 0;
        int rs0 = 4 * uu - 4; rs0 = rs0 < 0 ? 0 : (rs0 > 24 ? 24 : rs0); int rl = 4 * uu - 1; rl = rl < 0 ? 0 : (rl > 24 ? 24 : rl);
        a.j0 = rs0; a.nt = 4 + (rl + 8 - rs0); a.qoff = tok; a.m0 = 0.f; a.l0 = 0.f;
        attn_unit<2, 64>(lds, a);
    }
    for (int u0 = c; u0 < 256; u0 += G) {
        const int u = remap8(u0, G); const int b = u >> 3, kvh = (u >> 2) & 1, cb = u & 3; const int g = wid & 3, ts = wid >> 2; const int head = kvh * 4 + g;
        AU a; const int tok = cb * 64 + 32 * ts + r32; const size_t qrow = (size_t)b * TOK + tok;
        a.qptr = QKV + qrow * 2304 + head * 64; a.optr = ATT + qrow * 1024 + head * 64;
        a.kbase = QKV + 512 + kvh * 64; a.kpitch = 2304; a.vbase = QKV + 640 + kvh * 64; a.vpitch = 2304; a.k2base = nullptr; a.k2pitch = 0;
        a.row_ctx = b * TOK; a.row_lat = 0; a.start = 0; a.j0 = 0; a.nt = 4; a.qoff = 0; a.m0 = sink[head] * LOG2E; a.l0 = 1.f;
        attn_unit<0, 64>(lds, a);
    }
    for (int u0 = c; u0 < 256; u0 += G) {
        const int u = remap8(u0, G); const int b = u >> 3, head = u & 7;
        AU a; const int tok = 32 * wid + r32; const size_t qrow = (size_t)b * TOK + tok;
        a.qptr = QKV + qrow * 2304 + 768 + head * 64; a.optr = ATT + qrow * 1024 + 512 + head * 64;
        a.kbase = QKV + 1280 + head * 64; a.kpitch = 2304; a.vbase = QKV + 1792 + head * 64; a.vpitch = 2304; a.k2base = nullptr; a.k2pitch = 0;
        a.row_ctx = b * TOK; a.row_lat = 0; a.start = 0; a.j0 = 0; a.nt = 4; a.qoff = 0; a.m0 = 0.f; a.l0 = 0.f;
        attn_unit<0, 64>(lds, a);
    }
}
__device__ __forceinline__ void phase_attn1(PP P, LAS unsigned char* lds, int c, int G) {
    const int tid = ltid(), lane = tid & 63, wid = __builtin_amdgcn_readfirstlane(tid >> 6), r32 = lane & 31;
    const bf16_t* PB = (const bf16_t*)(P->ws + WS_BIG + BIG_P); const bf16_t* QM = (const bf16_t*)(P->ws + WS_BIG + BIG_QM); const bf16_t* KVX = (const bf16_t*)(P->ws + WS_BIG + BIG_KVX);
    bf16_t* ATT = (bf16_t*)(P->ws + WS_H);
    for (int u = c; u < 1024; u += G) {
        const int b = u >> 5, head = (u >> 2) & 7, qb = u & 3;
        AU2 a; const int tok = qb * 512 + 64 * wid + r32; const size_t qrow = (size_t)b * TOK + CTX + tok;
        a.qptr = QM + qrow * 768 + head * 96; a.qpitch = 768; a.optr = ATT + qrow * 1024 + head * 64;
        a.kbase = KVX + head * 128; a.kpitch = 1024; a.vbase = KVX + head * 128 + 64; a.vpitch = 1024; a.k2base = PB + 1152; a.k2pitch = 1536;
        a.row_ctx = b * TOK; a.nt = 36;
        attn_unit2<96, false>(lds, a);
    }
    float gq = fabsf(P->in[28][lane]), gk = fabsf(P->in[29][lane]);
#pragma unroll
    for (int o = 32; o > 0; o >>= 1) { gq = fmaxf(gq, __shfl_xor(gq, o)); gk = fmaxf(gk, __shfl_xor(gk, o)); }
    const bool bounded = __builtin_amdgcn_readfirstlane((int)(64.f * gq * gk * QS64 < 100.f)) != 0;
    for (int u = c; u < 1024; u += G) {
        const int b = u >> 5, kvh = (u >> 4) & 1, blk = u & 15;
        if (bounded) {
            const int g = wid & 3, hf = wid >> 2; const int head = kvh * 4 + g;
            AU2 a; const int tok = blk * 128 + 64 * hf + r32; const size_t qrow = (size_t)b * TOK + CTX + tok;
            a.qptr = PB + qrow * 1536 + 384 + head * 64; a.qpitch = 1536; a.optr = ATT + qrow * 1024 + 512 + head * 64;
            a.kbase = PB + 1184 + kvh * 64; a.kpitch = 1536; a.vbase = PB + 1312 + kvh * 64; a.vpitch = 1536; a.k2base = nullptr; a.k2pitch = 0;
            a.row_ctx = b * TOK; a.nt = 36;
            attn_unit2<64, true>(lds, a);
        } else {
            for (int hfb = 0; hfb < 2; ++hfb) { const int g = wid & 3, ts = wid >> 2; const int head = kvh * 4 + g;
                AU a; const int tok = blk * 128 + 64 * hfb + 32 * ts + r32; const size_t qrow = (size_t)b * TOK + CTX + tok;
                a.qptr = PB + qrow * 1536 + 384 + head * 64; a.optr = ATT + qrow * 1024 + 512 + head * 64;
                a.kbase = PB + 1184 + kvh * 64; a.kpitch = 1536; a.vbase = PB + 1312 + kvh * 64; a.vpitch = 1536; a.k2base = nullptr; a.k2pitch = 0;
                a.row_ctx = b * TOK; a.row_lat = 0; a.start = 0; a.j0 = 0; a.nt = 36; a.qoff = 0; a.m0 = 0.f; a.l0 = 0.f;
                attn_unit<0, 64>(lds, a); }
        }
    }
}

constexpr int PH_MOE0 = 7, PH_L1 = PH_MOE0 + 1 + 2 * NCHUNK, PH_MOE1 = PH_L1 + 7, NPH = PH_MOE1 + 1 + 2 * NCHUNK;
template <int PH>
__device__ __forceinline__ void run_phase(LAS unsigned char* lds, int c, int G) {
    const PP P = get_pp();
    const float* rp = (const float*)(P->ws + WS_ROPE);
    const float* ada0 = (const float*)(P->ws + WS_ADA); const float* ada1 = ada0 + (size_t)33 * 6144;
    bf16_t* W0 = (bf16_t*)(P->ws + WS_W0); bf16_t* W1 = (bf16_t*)(P->ws + WS_W1);
    bf16_t* H = (bf16_t*)(P->ws + WS_H); char* BIG = P->ws + WS_BIG; float* XC = (float*)(P->ws + WS_XC);
    if constexpr (PH == 0) { phase_prologue(P, lds, c, G); }
    else if constexpr (PH == 1) { phase_norm(P, c, G, P->in[0], P->in[2], P->in[6], ada0, 0, 1024, false, H, nullptr); }
    else if constexpr (PH == 2) {
        gm::DenseSched S; S.init(0, 9, G, c); gm::Desc d{(const char*)H, 2048u, (const char*)(W0 + WO_IN), 2048u, 1024};
        gm::EpiQKV0 E{(bf16_t*)(BIG + BIG_QKV), rp, rp + 2048 * 32}; gm::gemm_phase(lds, d, S, E); }
    else if constexpr (PH == 3) { phase_attn0(P, lds, ONE_LAUNCH ? (int)*(volatile LAS int*)(lds + LDS_BARW + 8) : c, G); }
    else if constexpr (PH == 4) {
        gm::DenseSched S; S.init(0, 4, G, c); gm::Desc d{(const char*)H, 2048u, (const char*)(W0 + WO_OUT), 2048u, 1024};
        gm::EpiP1 E{(bf16_t*)(BIG + BIG_HLO), 1024, nullptr, 0}; gm::gemm_phase(lds, d, S, E); }
    else if constexpr (PH == 5) { phase_norm(P, c, G, P->in[0], P->in[2], P->in[11], ada0, 3072, 4096, false, H, (bf16_t*)(BIG + BIG_HLO), true, P->out, XC); }
    else if constexpr (PH == 6) { phase_router(P, lds, c, G, 0); }
    else if constexpr (PH == PH_L1) {
        gm::DenseSched S; S.init(0, 6, G, c); gm::Desc d{(const char*)H, 2048u, (const char*)(W1 + WO_IN), 2048u, 1024};
        gm::EpiP1 E{(bf16_t*)(BIG + BIG_P), 1536, nullptr, 0}; gm::gemm_phase(lds, d, S, E); }
    else if constexpr (PH == PH_L1 + 1) { phase_post1(P, c, G); }
    else if constexpr (PH == PH_L1 + 2) {
        { gm::DenseSched S; S.init(1, 3, G, c); gm::Desc d{(const char*)(BIG + BIG_P), 3072u, (const char*)(W1 + WO_UQ), 768u, 384};
          gm::EpiUQ E{(bf16_t*)(BIG + BIG_QM), (const float*)(P->ws + WS_RSTD), rp + 2 * 2048 * 32, rp + 2 * 2048 * 32 + 2048 * 16}; gm::gemm_phase(lds, d, S, E); }
        { gm::DenseSched S; S.init(0, 4, G, c); gm::Desc d{(const char*)(BIG + BIG_P) + 896 * 2, 3072u, (const char*)(W1 + WO_UKV), 512u, 256};
          gm::EpiP1 E{(bf16_t*)(BIG + BIG_KVX), 1024, (const float*)(P->ws + WS_RSTD), 1}; gm::gemm_phase(lds, d, S, E); } }
    else if constexpr (PH == PH_L1 + 3) { phase_attn1(P, lds, ONE_LAUNCH ? (int)*(volatile LAS int*)(lds + LDS_BARW + 8) : c, G); }
    else if constexpr (PH == PH_L1 + 4) {
        gm::DenseSched S; S.init(1, 4, G, c); gm::Desc d{(const char*)H, 2048u, (const char*)(W1 + WO_OUT), 2048u, 1024};
        gm::EpiP1 E{(bf16_t*)(BIG + BIG_HLO), 1024, nullptr, 0}; gm::gemm_phase(lds, d, S, E); }
    else if constexpr (PH == PH_L1 + 5) { phase_norm(P, c, G, P->out, XC, P->in[31], ada1, 3072, 4096, true, H, (bf16_t*)(BIG + BIG_HLO), true, P->out, XC); }
    else if constexpr (PH == PH_L1 + 6) { phase_router(P, lds, c, G, 1); }
    else {
        constexpr int layer = PH >= PH_MOE1 ? 1 : 0; constexpr int rel = PH - (layer ? PH_MOE1 : PH_MOE0);
        const int* cnt = (const int*)(P->ws + WS_CTL + CTL_CNT) + layer * NG;
        LAS int* toff = (LAS int*)(lds + LDS_TAB);
        bf16_t* W = layer ? W1 : W0;
        build_toff(toff, cnt);
        const int pidx = ONE_LAUNCH ? (int)*(volatile LAS int*)(lds + LDS_BARW + 8) : c;
        const int mxq = ONE_LAUNCH ? pidx / (G >> 3) : (c & 7), mxj = ONE_LAUNCH ? pidx % (G >> 3) : (c >> 3);
        if constexpr (rel == 0) {
            gm::MoeSched<1> S; S.toff = toff; S.slot_row = (const int*)(P->ws + WS_SROW); S.t_lo = 0; S.t_hi = toff[NG]; S.nN = 2; S.G = G; S.c = c; S.bN = 512; S.layer = layer; S.xq = mxq; S.xj = mxj;
            gm::Desc d{(const char*)H, 2048u, (const char*)(W + WO_GU), 2048u, 1024};
            gm::EpiG1 E{(bf16_t*)(BIG + BIG_ACT)}; gm::gemm_phase(lds, d, S, E);
        } else if constexpr ((rel & 1) == 1) {
            constexpr int ch = (rel - 1) >> 1;
            gm::MoeSched<2> S; S.toff = toff; S.slot_row = nullptr; S.t_lo = toff[ch * NGRP]; S.t_hi = toff[(ch + 1) * NGRP]; S.nN = 4; S.G = G; S.c = c; S.bN = 1024; S.layer = layer; S.xq = mxq; S.xj = mxj;
            gm::Desc d{(const char*)(BIG + BIG_ACT), 512u, (const char*)(W + WO_D), 512u, 256};
            gm::EpiG2 E{(bf16_t*)(BIG + BIG_SLAB), toff[ch * NGRP] * 256};
            gm::gemm_phase(lds, d, S, E);
        } else {
            constexpr int ch = (rel - 2) >> 1;
            phase_combine(P, lds, c, G, layer, ch);
        }
    }
}

template <int PH> struct PhaseLoop {
    static __device__ __forceinline__ void run(LAS unsigned char* lds, const XcdBarrier& bar) {
        run_phase<PH>(lds, (int)blockIdx.x, (int)gridDim.x);
        if constexpr (PH + 1 < NPH) { xcd_barrier(bar); PhaseLoop<PH + 1>::run(lds, bar); }
    }
};

extern __shared__ __attribute__((aligned(16))) unsigned char smem_raw[];

#if ONE_LAUNCH
__global__ void __launch_bounds__(512, 2) mega_fwd(Params Pk) {
    LAS unsigned char* lds = (LAS unsigned char*)smem_raw;
    volatile LAS unsigned* st = (volatile LAS unsigned*)(lds + LDS_BARW);
    if (threadIdx.x == 0) { st[0] = 0u; st[1] = 0u; st[2] = 0u; st[3] = 0u; }
    __syncthreads();
    XcdBarrier bar = xcd_barrier_post((unsigned*)(Pk.ws + WS_CTL), st);
    int* xr = (int*)(Pk.ws + WS_CTL + CTL_XRANK);
    int myrank = 0; if (threadIdx.x == 0) myrank = atomicAdd(xr + 64 * (int)bar.x, 1);
    run_phase<0>(lds, (int)blockIdx.x, (int)gridDim.x);
    xcd_barrier(bar);
    if (threadIdx.x == 0) { int base = 0; for (int j = 0; j < (int)bar.x; ++j) base += ld_ctl(xr + 64 * j); st[2] = (unsigned)(base + myrank); }
    __syncthreads();
    PhaseLoop<1>::run(lds, bar);
}
#else
template <int PH> __global__ void __launch_bounds__(512, 2) phase_kernel(Params Pk) {
    LAS unsigned char* lds = (LAS unsigned char*)smem_raw;
    run_phase<PH>(lds, (int)blockIdx.x, (int)gridDim.x);
}
template <int PH> struct PhaseLaunch {
    static void run(const Params& P, int grid, hipStream_t s) {
        (void)hipFuncSetAttribute((const void*)phase_kernel<PH>, hipFuncAttributeMaxDynamicSharedMemorySize, LDS_BYTES);
        hipLaunchKernelGGL(phase_kernel<PH>, dim3(grid), dim3(512), LDS_BYTES, s, P);
        if constexpr (PH + 1 < NPH) PhaseLaunch<PH + 1>::run(P, grid, s);
    }
};
#endif

extern "C" void kernel_launch(void* const* d_in, const int* in_sizes, int n_in, void* d_out, int out_size, void* d_ws, size_t ws_size, hipStream_t stream) {
    static int grid = 0;
    if (n_in != 41 || ws_size < WS_END) { fprintf(stderr, "kernel_launch: need 41 inputs and %zu bytes of workspace (got %d, %zu)\n", (size_t)WS_END, n_in, ws_size); return; }
    if (!grid) {
        int dev = 0, cus = 0;
        (void)hipGetDevice(&dev); (void)hipDeviceGetAttribute(&cus, hipDeviceAttributeMultiprocessorCount, dev);
#if ONE_LAUNCH
        (void)hipFuncSetAttribute((const void*)mega_fwd, hipFuncAttributeMaxDynamicSharedMemorySize, LDS_BYTES);
        int per_cu = 0; (void)hipOccupancyMaxActiveBlocksPerMultiprocessor(&per_cu, (const void*)mega_fwd, 512, LDS_BYTES);
        if (per_cu < 1) fprintf(stderr, "kernel_launch: occupancy query says %d blocks per CU\n", per_cu);
#endif
        grid = cus > 0 ? cus : 256;
    }
    Params P{};
    for (int i = 0; i < 41; ++i) P.in[i] = (const float*)d_in[i];
    P.out = (float*)d_out; P.ws = (char*)d_ws;
    (void)hipMemsetAsync((char*)d_ws + WS_CTL, 0, CTL_BYTES, stream);
#if ONE_LAUNCH
    hipLaunchKernelGGL(mega_fwd, dim3(grid), dim3(512), LDS_BYTES, stream, P);
#else
    PhaseLaunch<0>::run(P, grid, stream);
#endif
}
```

```cpp
#include <hip/hip_runtime.h>
#include <stdint.h>
#include <stdio.h>

#ifndef ONE_LAUNCH
#define ONE_LAUNCH 1
#endif

#define LAS __attribute__((address_space(3)))
typedef unsigned short bf16_t;
typedef short bf16x8 __attribute__((ext_vector_type(8)));
typedef short s16x4 __attribute__((ext_vector_type(4)));
typedef float f32x4 __attribute__((ext_vector_type(4)));
typedef float f32x16 __attribute__((ext_vector_type(16)));
typedef unsigned u32x4 __attribute__((ext_vector_type(4)));
typedef unsigned u32x2 __attribute__((ext_vector_type(2)));

constexpr int NB = 32, SEQ = 2048, DM = 1024, CTX = 256, TOK = CTX + SEQ, MROWS = NB * TOK;
constexpr int NEXP = 64, NGRP = 65, NCHUNK = 4, NG = NCHUNK * NGRP;
constexpr int CAP = MROWS / NCHUNK;
constexpr int CHUNK_ROWS = MROWS / NCHUNK;
constexpr int CHUNK_B = NB / NCHUNK;
constexpr float LOG2E = 1.4426950408889634f;
constexpr float QS64 = 0.125f * LOG2E;
constexpr float QS96 = 0.10206207261596575f * LOG2E;
constexpr float EPS = 1e-6f;

constexpr size_t MiB = 1048576;
constexpr size_t WS_CTL = 0;
constexpr size_t CTL_BYTES = 65536;
constexpr size_t CTL_CNT = 16384;
constexpr size_t CTL_XRANK = 24576;
constexpr size_t WS_ADA = 65536;
constexpr size_t WS_ROPE = WS_ADA + 2 * MiB;
constexpr size_t WO_IN = 0, WO_OUT = WO_IN + 2304 * 1024, WO_RT = WO_OUT + 1024 * 1024, WO_UQ = WO_RT + 2 * 64 * 1024, WO_UKV = WO_UQ + 768 * 384,
                 WO_GU = WO_UKV + 1024 * 256, WO_D = WO_GU + (size_t)65 * 512 * 1024, W_ELEMS = WO_D + (size_t)65 * 1024 * 256;
constexpr size_t W_BYTES = ((W_ELEMS * 2 + 255) / 256) * 256;
constexpr size_t WS_W0 = WS_ROPE + 1 * MiB;
constexpr size_t WS_W1 = WS_W0 + W_BYTES;
constexpr size_t WS_XC = WS_W1 + W_BYTES;
constexpr size_t WS_H = WS_XC + 32 * MiB;
constexpr size_t WS_RSTD = WS_H + 144 * MiB;
constexpr size_t WS_SROW = WS_RSTD + 1 * MiB;
constexpr size_t WS_SW = WS_SROW + (size_t)NCHUNK * 64 * CAP * 4;
constexpr size_t WS_TSLOT = WS_SW + (size_t)NCHUNK * 64 * CAP * 4;
constexpr size_t WS_BIG = ((WS_TSLOT + (size_t)MROWS * 6 * 4 + 255) / 256) * 256;
constexpr size_t BIG_QKV = 0;
constexpr size_t BIG_P = 0;
constexpr size_t BIG_QM = BIG_P + (size_t)MROWS * 1536 * 2;
constexpr size_t BIG_KVX = BIG_QM + (size_t)MROWS * 768 * 2;
constexpr size_t BIG_HLO = 0;
constexpr size_t MAXSLOT = (size_t)MROWS * 7 + (size_t)NG * 256;
constexpr size_t BIG_ACT = 0;
constexpr size_t BIG_SLAB = BIG_ACT + MAXSLOT * 512;
constexpr size_t SLAB_SLOTS = (size_t)CHUNK_ROWS * 7 + (size_t)NGRP * 256;
constexpr size_t WS_END = WS_BIG + BIG_SLAB + SLAB_SLOTS * 2048;

constexpr int LDS_BYTES = 139264;
constexpr int LDS_TAB = 131072;
constexpr int LDS_BARW = LDS_BYTES - 16;

struct Params {
    const float* in[41];
    float* out;
    char* ws;
};
typedef const Params __attribute__((address_space(4)))* PP;
__device__ __forceinline__ PP get_pp() { PP p = (PP)__builtin_amdgcn_kernarg_segment_ptr(); asm volatile("" : "+s"(p)); return p; }
__device__ __forceinline__ int ltid() { int t = threadIdx.x; asm volatile("" : "+v"(t)); return t; }

__device__ __forceinline__ unsigned pk2(float lo, float hi) {
    typedef float f2 __attribute__((ext_vector_type(2))); typedef __bf16 b2 __attribute__((ext_vector_type(2)));
    f2 v = {lo, hi}; b2 b = __builtin_convertvector(v, b2); return __builtin_bit_cast(unsigned, b);
}
__device__ __forceinline__ float bflo(unsigned u) { return __uint_as_float(u << 16); }
__device__ __forceinline__ float bfhi(unsigned u) { return __uint_as_float(u & 0xffff0000u); }
__device__ __forceinline__ float wave_sum(float v) {
#pragma unroll
    for (int o = 32; o > 0; o >>= 1) v += __shfl_xor(v, o);
    return v;
}
__device__ __forceinline__ int ld_ctl(const int* p) { return __hip_atomic_load(p, __ATOMIC_RELAXED, __HIP_MEMORY_SCOPE_AGENT); }

#define XB_TMO      128
#define XB_XCNT(j)  (256  + 64 * (j))
#define XB_XSUB(j)  (1280 + 64 * (j))
#define XB_XGEN(j)  (2304 + 64 * (j))
#define XB_TOP      3328
#define XB_TOPGEN   3392
#define XCD_BAR_WORDS 3456
#define XB_SPIN_CAP (1u << 18)

__device__ __forceinline__ unsigned xb_ld(unsigned* p)              { return __hip_atomic_load(p, __ATOMIC_RELAXED, __HIP_MEMORY_SCOPE_AGENT); }
__device__ __forceinline__ unsigned xb_add(unsigned* p, unsigned v) { return __hip_atomic_fetch_add(p, v, __ATOMIC_RELAXED, __HIP_MEMORY_SCOPE_AGENT); }
__device__ __forceinline__ unsigned xb_xcc_id() { return (unsigned)__builtin_amdgcn_s_getreg((3 << 11) | 20) & 0xFu; }
#define XB_SPIN(cond, bar) do { unsigned _sp = 0; while (cond) { __builtin_amdgcn_s_sleep(1); \
    if ((++_sp & 255u) == 0u) { if (xb_ld(&(bar)[XB_TMO])) break; if (_sp > XB_SPIN_CAP) { atomicAdd(&(bar)[XB_TMO], 1u); break; } } } } while (0)

struct XcdBarrier { unsigned* bar; unsigned x; volatile LAS unsigned* st; };

__device__ __forceinline__ XcdBarrier xcd_barrier_post(unsigned* bar, volatile LAS unsigned* st) {
    XcdBarrier b; b.bar = bar; b.x = xb_xcc_id(); b.st = st;
    if (threadIdx.x == 0) (void)xb_add(&bar[XB_XCNT(b.x)], 1u);
    return b;
}
__device__ __forceinline__ void xcd_barrier_complete(unsigned* bar, unsigned x, unsigned& nloc, unsigned& nx) {
    const unsigned G = gridDim.x * gridDim.y * gridDim.z;
    unsigned sum, cnt, mine, sp = 0u;
    for (;;) {
        sum = 0u; cnt = 0u; mine = 0u;
#pragma unroll
        for (unsigned j = 0; j < 16; ++j) { const unsigned c = xb_ld(&bar[XB_XCNT(j)]); sum += c; cnt += (c > 0u) ? 1u : 0u; mine = (j == x) ? c : mine; }
        if (sum == G) break;
        __builtin_amdgcn_s_sleep(1);
        if ((++sp & 255u) == 0u) { if (xb_ld(&bar[XB_TMO])) break; if (sp > XB_SPIN_CAP) { atomicAdd(&bar[XB_TMO], 1u); break; } }
    }
    nloc = mine > 0u ? mine : 1u; nx = cnt > 0u ? cnt : 1u;
}
__device__ __forceinline__ void xcd_barrier(const XcdBarrier& b) {
    asm volatile("s_waitcnt vmcnt(0)" ::: "memory");
    __syncthreads();
    if (threadIdx.x == 0) {
        unsigned* bar = b.bar;
        __builtin_amdgcn_s_waitcnt(0);
        unsigned nloc = b.st[0], nx = b.st[1];
        if (nloc == 0u) { xcd_barrier_complete(bar, b.x, nloc, nx); b.st[0] = nloc; b.st[1] = nx; }
        const unsigned old = xb_add(&bar[XB_XSUB(b.x)], 1u);
        const unsigned gen = old / nloc;
        if (old + 1u == (gen + 1u) * nloc) {
            __builtin_amdgcn_fence(__ATOMIC_RELEASE, "agent");
            asm volatile("s_waitcnt vmcnt(0)" ::: "memory");
            const unsigned og = xb_add(&bar[XB_TOP], 1u);
            const unsigned tg = og / nx;
            if (og + 1u == (tg + 1u) * nx) xb_add(&bar[XB_TOPGEN], 1u);
            else XB_SPIN(xb_ld(&bar[XB_TOPGEN]) == tg, bar);
            __builtin_amdgcn_fence(__ATOMIC_ACQUIRE, "agent");
            xb_add(&bar[XB_XGEN(b.x)], 1u);
            asm volatile("s_waitcnt vmcnt(0)" ::: "memory");
        } else {
            XB_SPIN(xb_ld(&bar[XB_XGEN(b.x)]) == gen, bar);
            __builtin_amdgcn_fence(__ATOMIC_ACQUIRE, "agent");
            asm volatile("s_waitcnt vmcnt(0)" ::: "memory");
        }
    }
    __syncthreads();
}

namespace gm {
constexpr int BM = 256, BK = 64, HALF = 128, HTB = HALF * BK * 2, STAGE_BYTES = 8 * HTB, NXCD = 8, WGM = 8;
__device__ __forceinline__ int lds_byte(int r, int c) { const int st = (r >> 4) * 2 + (c >> 5), rr = r & 15, cc = c & 31, ob = rr * 64 + cc * 2; return st * 1024 + (ob ^ (((ob >> 9) & 1) << 5)); }
__device__ __forceinline__ void stage_rc(int b, int& R, int& C) { const int st = b / 1024, sb = b % 1024, swz = sb ^ (((sb >> 9) & 1) << 5); R = (st >> 1) * 16 + swz / 64; C = (st & 1) * 32 + (swz % 64) / 2; }
__device__ __forceinline__ int perm32(int rho) { const int n = rho >> 4, i = rho & 15; return 8 * (i >> 2) + 4 * n + (i & 3); }

struct Unit { int pm, pn, g, mt, cnt, sbase; };
struct Desc { const char* A; unsigned lda; const char* B; unsigned ldb; int K; };

struct DenseSched {
    int nMt, nN, nwg, G, c, mmode;
    __device__ __forceinline__ void init(int mmode_, int nN_, int G_, int c_) { mmode = mmode_; nMt = mmode_ ? 256 : 288; nN = nN_; nwg = nMt * nN_; G = G_; c = c_; }
    __device__ __forceinline__ bool next(int i, Unit& u) const {
        const long L = (long)i * G + c; if (L >= nwg) return false;
        int wgid = (int)L; { const int q = nwg / NXCD, r = nwg % NXCD, xcd = wgid % NXCD, off = wgid / NXCD; wgid = (xcd < r ? xcd * (q + 1) : r * (q + 1) + (xcd - r) * q) + off; }
        const int nig = WGM * nN, gid = wgid / nig, fm = gid * WGM, gsz = (nMt - fm) < WGM ? (nMt - fm) : WGM;
        const int pmi = fm + ((wgid % nig) % gsz); u.pn = (wgid % nig) / gsz;
        u.pm = mmode ? (pmi >> 3) * 9 + 1 + (pmi & 7) : pmi; u.g = 0; u.mt = 0; u.cnt = 256; u.sbase = 0; return true;
    }
    __device__ __forceinline__ int a_row(const Unit& u, int r) const { return u.pm * 256 + r; }
    __device__ __forceinline__ int a_raw(const Unit&, int) const { return 0; }
    __device__ __forceinline__ int a_fin(const Unit& u, int r, int) const { return u.pm * 256 + r; }
    __device__ __forceinline__ int b_row(const Unit& u) const { return u.pn * 256; }
};

template <int WHICH  >
struct MoeSched {
    LAS const int* toff; const int* slot_row; int nN, G, c, bN, layer, t_lo, t_hi, xq, xj;
    __device__ __forceinline__ bool next(int i, Unit& u) const {
        const int per = G >> 3, nt_ = t_hi - t_lo;
        const int xs = t_lo + (int)(((long)nt_ * xq) >> 3), xe = t_lo + (int)(((long)nt_ * (xq + 1)) >> 3);
        const int L = i * per + xj; if (L >= (xe - xs) * nN) return false;
        const int tau = L / nN; u.pn = L - tau * nN; const int T = xs + tau;
        int lo = 0, hi = NG;
        while (hi - lo > 1) { const int mid = (lo + hi) >> 1; if (toff[mid] <= T) lo = mid; else hi = mid; }
        u.g = lo; u.mt = T - toff[lo]; u.pm = T; u.sbase = T * 256; u.cnt = toff[272 + lo]; return true;
    }
    __device__ __forceinline__ int a_row(const Unit& u, int r) const {
        if (WHICH == 2) return u.sbase + r;
        const int e = u.g % NGRP, ch = u.g / NGRP, idx = u.mt * 256 + r;
        const bool in = (e < NEXP) && (idx < u.cnt);
        const int lrow = slot_row[(size_t)(ch * 64 + (e < NEXP ? e : 0)) * CAP + (in ? idx : 0)];
        const int b1 = ch * CHUNK_B + (idx >> 11);
        const int srow = (layer == 0) ? (ch * CHUNK_ROWS + idx) : (b1 * TOK + CTX + (idx & 2047));
        return (e == NEXP) ? srow : (in ? lrow : 0);
    }
    __device__ __forceinline__ int a_raw(const Unit& u, int r) const {
        if (WHICH == 2) return 0;
        const int e = u.g % NGRP, ch = u.g / NGRP, idx = u.mt * 256 + r; const bool in = (e < NEXP) && (idx < u.cnt);
        return slot_row[(size_t)(ch * 64 + (e < NEXP ? e : 0)) * CAP + (in ? idx : 0)];
    }
    __device__ __forceinline__ int a_fin(const Unit& u, int r, int raw) const {
        if (WHICH == 2) return u.sbase + r;
        const int e = u.g % NGRP, ch = u.g / NGRP, idx = u.mt * 256 + r; const bool in = (e < NEXP) && (idx < u.cnt);
        const int b1 = ch * CHUNK_B + (idx >> 11);
        const int srow = (layer == 0) ? (ch * CHUNK_ROWS + idx) : (b1 * TOK + CTX + (idx & 2047));
        return (e == NEXP) ? srow : (in ? raw : 0);
    }
    __device__ __forceinline__ int b_row(const Unit& u) const { return (u.g % NGRP) * bN + u.pn * 256; }
};

template <class Epi, class Sched>
__device__ __forceinline__ void gemm_phase(LAS unsigned char* lds, const Desc g, const Sched& S, const Epi& E) {
    const int tid = ltid(), wid = __builtin_amdgcn_readfirstlane(tid >> 6), lane = tid & 63, wr = wid >> 2, wc = wid & 3, fr = lane & 15, fq = lane >> 4;
    const int nt = g.K / BK;
    unsigned voffB[2][2];
#pragma unroll
    for (int i = 0; i < 2; ++i) { int R, C; stage_rc(tid * 16 + i * 8192, R, C); const int Rl = Epi::PERM ? perm32(R & 31) : (R & 31);
#pragma unroll
        for (int h = 0; h < 2; ++h) { const int Rb = Epi::WIDE ? (64 * (R >> 5) + 32 * h + Rl) : (128 * h + (R & ~31) + Rl);
            voffB[h][i] = (unsigned)Rb * g.ldb + (unsigned)C * 2u; } }
    const size_t kstep = (size_t)(BK * 2);
    const unsigned ldsw = (unsigned)wid * 1024u;
    const int aoff = lds_byte(wr * 64 + fr, fq * 8), boff = lds_byte(wc * 32 + fr, fq * 8);
#define GM_SA(b, h) (((b) * 2 + (h)) * HTB)
#define GM_SB(b, h) ((4 + (b) * 2 + (h)) * HTB)
#define GM_STAGE_A(bufoff, kb, va, h) do { _Pragma("unroll") for (int _i = 0; _i < 2; ++_i) \
        __builtin_amdgcn_global_load_lds((const unsigned*)(g.A + (kb) + (va)[h][_i]), (LAS unsigned*)(lds + (bufoff) + ldsw + _i * 8192), 16, 0, 0); } while (0)
#define GM_STAGE_B(bufoff, bp, h) do { _Pragma("unroll") for (int _i = 0; _i < 2; ++_i) \
        __builtin_amdgcn_global_load_lds((const unsigned*)((bp) + voffB[h][_i]), (LAS unsigned*)(lds + (bufoff) + ldsw + _i * 8192), 16, 0, 0); } while (0)
#define GM_LDA(dst, b, h) do { _Pragma("unroll") for (int m = 0; m < 4; ++m) _Pragma("unroll") for (int k = 0; k < 2; ++k) dst[m][k] = *(const LAS bf16x8*)(lds + GM_SA(b, h) + aoff + m * 2048 + k * 1024); } while (0)
#define GM_LDB(dst, b, h) do { _Pragma("unroll") for (int n = 0; n < 2; ++n) _Pragma("unroll") for (int k = 0; k < 2; ++k) dst[n][k] = *(const LAS bf16x8*)(lds + GM_SB(b, h) + boff + n * 2048 + k * 1024); } while (0)
#define GM_MMA(ai, bj, At, Bt) do { __builtin_amdgcn_s_setprio(1); _Pragma("unroll") for (int m = 0; m < 4; ++m) _Pragma("unroll") for (int n = 0; n < 2; ++n) _Pragma("unroll") for (int k = 0; k < 2; ++k) \
        acc[ai][bj][m][n] = __builtin_amdgcn_mfma_f32_16x16x32_bf16(Bt[n][k], At[m][k], acc[ai][bj][m][n], 0, 0, 0); __builtin_amdgcn_s_setprio(0); } while (0)
#define GM_WAIT_V(n) do { asm volatile("" ::: "memory"); __builtin_amdgcn_s_waitcnt(((n) & 15) | (((n) >> 4) << 14) | 0x0F70); asm volatile("" ::: "memory"); } while (0)
#define GM_WAIT_L(n) asm volatile("s_waitcnt lgkmcnt(" #n ")" ::: "memory")
#define GM_BAR __builtin_amdgcn_s_barrier()
#define GM_SCHED __builtin_amdgcn_sched_barrier(0)
#define GM_CALC_VA(va, u) do { int _tz = tid; asm volatile("" : "+v"(_tz)); int _rw[2][2]; unsigned _cc[2]; \
        _Pragma("unroll") for (int _i = 0; _i < 2; ++_i) { int _R, _C; stage_rc(_tz * 16 + _i * 8192, _R, _C); _cc[_i] = (unsigned)_C * 2u; \
            _Pragma("unroll") for (int _h = 0; _h < 2; ++_h) _rw[_h][_i] = S.a_row((u), _h * HALF + _R); } \
        _Pragma("unroll") for (int _i = 0; _i < 2; ++_i) _Pragma("unroll") for (int _h = 0; _h < 2; ++_h) (va)[_h][_i] = (unsigned)_rw[_h][_i] * g.lda + _cc[_i]; } while (0)
#define GM_LOAD_RAW(raw, u) do { int _tz = tid; asm volatile("" : "+v"(_tz)); \
        _Pragma("unroll") for (int _i = 0; _i < 2; ++_i) { int _R, _C; stage_rc(_tz * 16 + _i * 8192, _R, _C); \
            _Pragma("unroll") for (int _h = 0; _h < 2; ++_h) (raw)[_h][_i] = S.a_raw((u), _h * HALF + _R); } } while (0)
#define GM_FIN_VA(va, u, raw) do { int _tz = tid; asm volatile("" : "+v"(_tz)); \
        _Pragma("unroll") for (int _i = 0; _i < 2; ++_i) { int _R, _C; stage_rc(_tz * 16 + _i * 8192, _R, _C); \
            _Pragma("unroll") for (int _h = 0; _h < 2; ++_h) (va)[_h][_i] = (unsigned)S.a_fin((u), _h * HALF + _R, (raw)[_h][_i]) * g.lda + (unsigned)_C * 2u; } } while (0)
    Unit cur, nxt; int ui = 0;
    if (!S.next(0, cur)) return;
    f32x4 acc[2][2][4][2];
#pragma unroll
    for (int a = 0; a < 2; ++a)
#pragma unroll
        for (int b = 0; b < 2; ++b)
#pragma unroll
            for (int m = 0; m < 4; ++m)
#pragma unroll
                for (int n = 0; n < 2; ++n) acc[a][b][m][n] = (f32x4){0.f, 0.f, 0.f, 0.f};
    bf16x8 At[4][2], B0[2][2], B1[2][2];
    unsigned vaC[2][2];
    GM_CALC_VA(vaC, cur);
    const char* cB = g.B + (size_t)S.b_row(cur) * g.ldb;
    GM_STAGE_B(GM_SB(0, 0), cB, 0); GM_STAGE_A(GM_SA(0, 0), (size_t)0, vaC, 0); GM_STAGE_B(GM_SB(0, 1), cB, 1); GM_STAGE_A(GM_SA(0, 1), (size_t)0, vaC, 1);
    if (wr == 1) GM_BAR;
    GM_WAIT_V(4); GM_BAR;
    GM_STAGE_B(GM_SB(1, 0), cB + kstep, 0); GM_STAGE_A(GM_SA(1, 0), kstep, vaC, 0); GM_STAGE_B(GM_SB(1, 1), cB + kstep, 1);
    GM_WAIT_V(6); GM_BAR;
    for (;;) {
        const bool has_next = S.next(ui + 1, nxt);
        const char* nB = cB;
        if (has_next) nB = g.B + (size_t)S.b_row(nxt) * g.ldb;
        unsigned va2[2][2]; int rawN[2][2] = {{0, 0}, {0, 0}};
#pragma clang loop unroll(disable)
        for (int t = 0; t < nt; t += 2) {
            const bool last = (t == nt - 2);
            const size_t k1 = (size_t)(t + 1) * kstep;
            const size_t k2 = last ? (size_t)0 : (size_t)(t + 2) * kstep, k3 = k2 + kstep;
            const char* b2 = last ? nB : cB + k2; const char* b3 = b2 + kstep;
#pragma unroll
            for (int _h = 0; _h < 2; ++_h)
#pragma unroll
                for (int _i = 0; _i < 2; ++_i) va2[_h][_i] = vaC[_h][_i];
            if (last && has_next) { if (t == 0) GM_CALC_VA(va2, nxt); else GM_FIN_VA(va2, nxt, rawN); }
            if (t == 0 && !last && has_next) GM_LOAD_RAW(rawN, nxt);
            GM_LDB(B0, 0, 0); GM_SCHED; GM_LDA(At, 0, 0); GM_STAGE_A(GM_SA(1, 1), k1, vaC, 1);
            GM_WAIT_L(8); GM_BAR; GM_WAIT_L(0); GM_MMA(0, 0, At, B0); GM_BAR; GM_SCHED;
            GM_LDB(B1, 0, 1); GM_STAGE_B(GM_SB(0, 0), b2, 0);
            GM_BAR; GM_WAIT_L(0); GM_MMA(0, 1, At, B1); GM_BAR;
            GM_LDA(At, 0, 1); GM_STAGE_A(GM_SA(0, 0), k2, va2, 0);
            GM_BAR; GM_WAIT_L(0); GM_MMA(1, 0, At, B0); GM_BAR; GM_SCHED;
            GM_STAGE_B(GM_SB(0, 1), b2, 1);
            GM_WAIT_V(6); GM_BAR; GM_MMA(1, 1, At, B1); GM_BAR;
            GM_LDB(B0, 1, 0); GM_SCHED; GM_LDA(At, 1, 0); GM_STAGE_A(GM_SA(0, 1), k2, va2, 1);
            GM_WAIT_L(8); GM_BAR; GM_WAIT_L(0); GM_MMA(0, 0, At, B0); GM_BAR; GM_SCHED;
            GM_LDB(B1, 1, 1); GM_STAGE_B(GM_SB(1, 0), b3, 0);
            GM_BAR; GM_WAIT_L(0); GM_MMA(0, 1, At, B1); GM_BAR;
            GM_LDA(At, 1, 1); GM_STAGE_A(GM_SA(1, 0), k3, va2, 0);
            GM_BAR; GM_WAIT_L(0); GM_MMA(1, 0, At, B0); GM_BAR; GM_SCHED;
            GM_STAGE_B(GM_SB(1, 1), b3, 1);
            GM_WAIT_V(6); GM_BAR; GM_MMA(1, 1, At, B1); GM_BAR;
        }
        { int tz = tid; asm volatile("" : "+v"(tz));
          const int wid2 = __builtin_amdgcn_readfirstlane(tz >> 6), ln2 = tz & 63; E(acc, cur, wid2 >> 2, wid2 & 3, ln2 & 15, ln2 >> 4); }
        if (!has_next) break;
#pragma unroll
        for (int a = 0; a < 2; ++a)
#pragma unroll
            for (int b = 0; b < 2; ++b)
#pragma unroll
                for (int m = 0; m < 4; ++m)
#pragma unroll
                    for (int n = 0; n < 2; ++n) acc[a][b][m][n] = (f32x4){0.f, 0.f, 0.f, 0.f};
        cur = nxt; cB = nB; ++ui;
#pragma unroll
        for (int _h = 0; _h < 2; ++_h)
#pragma unroll
            for (int _i = 0; _i < 2; ++_i) vaC[_h][_i] = va2[_h][_i];
    }
    GM_WAIT_V(0);
    if (wr == 0) GM_BAR;
    GM_BAR;
#undef GM_SA
#undef GM_SB
#undef GM_STAGE_A
#undef GM_STAGE_B
#undef GM_LDA
#undef GM_LDB
#undef GM_MMA
#undef GM_WAIT_V
#undef GM_WAIT_L
#undef GM_BAR
#undef GM_SCHED
#undef GM_CALC_VA
#undef GM_LOAD_RAW
#undef GM_FIN_VA
}

typedef const f32x4 (&AccRef)[2][2][4][2];

struct EpiQKV0 {
    static constexpr bool PERM = false; static constexpr int WIDE = 0;
    bf16_t* O; const float* cosT; const float* sinT;
    __device__ __forceinline__ void operator()(AccRef acc, const Unit& u, int wr, int wc, int fr, int fq) const {
        const int tq = u.pm % 9; const bool ctx = (tq == 0); const int tbase = tq * 256 - 256;
        const int colg0 = 256 * u.pn + 32 * wc; const bool rope0 = (colg0 < 640) && !ctx, rope1 = (colg0 + 128 < 640) && !ctx; const int gi = 16 * (wc & 1) + 4 * fq;
        f32x4 cs[8], sn[8];
        if (rope0) {
#pragma unroll
            for (int q = 0; q < 8; ++q) { const int rl = 128 * (q >> 2) + 64 * wr + 16 * (q & 3) + fr; cs[q] = *(const f32x4*)(cosT + (size_t)(tbase + rl) * 32 + gi); sn[q] = *(const f32x4*)(sinT + (size_t)(tbase + rl) * 32 + gi); }
        }
#pragma unroll
        for (int bj = 0; bj < 2; ++bj) {
            const int colg = colg0 + 128 * bj; const bool rope = bj ? rope1 : rope0;
#pragma unroll
            for (int ai = 0; ai < 2; ++ai)
#pragma unroll
                for (int m = 0; m < 4; ++m) {
                    const int rl = 128 * ai + 64 * wr + 16 * m + fr; const size_t row = (size_t)u.pm * 256 + rl;
                    f32x4 v0 = acc[ai][bj][m][0], v1 = acc[ai][bj][m][1];
                    if (rope) { const f32x4 c4 = cs[4 * ai + m], s4 = sn[4 * ai + m]; const f32x4 x0 = v0 * c4 - v1 * s4, x1 = v0 * s4 + v1 * c4; v0 = x0; v1 = x1; }
                    bf16_t* p = O + row * 2304 + colg + 4 * fq;
                    u32x2 w0, w1; w0.x = pk2(v0[0], v0[1]); w0.y = pk2(v0[2], v0[3]); w1.x = pk2(v1[0], v1[1]); w1.y = pk2(v1[2], v1[3]);
                    *(u32x2*)p = w0; *(u32x2*)(p + 16) = w1;
                }
        }
    }
};
struct EpiP1 {
    static constexpr bool PERM = true; static constexpr int WIDE = 1;
    bf16_t* O; int ldc; const float* rs; int rsel;
    __device__ __forceinline__ void operator()(AccRef acc, const Unit& u, int wr, int wc, int fr, int fq) const {
        float scv[8];
#pragma unroll
        for (int q = 0; q < 8; ++q) { const size_t row = (size_t)u.pm * 256 + 128 * (q >> 2) + 64 * wr + 16 * (q & 3) + fr; scv[q] = rs ? rs[row * 2 + rsel] : 1.f; }
        const bool lo = fr < 8; const int col = 256 * u.pn + 64 * wc + 8 * fq + (lo ? 0 : 32);
#pragma unroll
        for (int ai = 0; ai < 2; ++ai)
#pragma unroll
            for (int m = 0; m < 4; ++m) { const size_t row = (size_t)u.pm * 256 + 128 * ai + 64 * wr + 16 * m + (fr & 7); const float sc = scv[4 * ai + m];
                u32x4 x0, x1;
                { const f32x4 v0 = acc[ai][0][m][0] * sc, v1 = acc[ai][0][m][1] * sc; x0.x = pk2(v0[0], v0[1]); x0.y = pk2(v0[2], v0[3]); x0.z = pk2(v1[0], v1[1]); x0.w = pk2(v1[2], v1[3]); }
                { const f32x4 v0 = acc[ai][1][m][0] * sc, v1 = acc[ai][1][m][1] * sc; x1.x = pk2(v0[0], v0[1]); x1.y = pk2(v0[2], v0[3]); x1.z = pk2(v1[0], v1[1]); x1.w = pk2(v1[2], v1[3]); }
                u32x4 rc;
#pragma unroll
                for (int q = 0; q < 4; ++q) rc[q] = (unsigned)__shfl_xor((int)(lo ? x1[q] : x0[q]), 8);
                const u32x4 da = lo ? x0 : rc, db = lo ? rc : x1;
                *(u32x4*)(O + row * ldc + col) = da; *(u32x4*)(O + (row + 8) * ldc + col) = db; }
    }
};
struct EpiUQ {
    static constexpr bool PERM = false; static constexpr int WIDE = 0;
    bf16_t* O; const float* rs; const float* cosT; const float* sinT;
    __device__ __forceinline__ void operator()(AccRef acc, const Unit& u, int wr, int wc, int fr, int fq) const {
        const int tq = u.pm % 9; const bool ctx = (tq == 0); const int tbase = tq * 256 - 256;
        const int colg0 = 256 * u.pn + 32 * wc, colg1 = colg0 + 128;
        const bool rope0 = ((colg0 >> 5) % 3 == 2) && !ctx, rope1 = ((colg1 >> 5) % 3 == 2) && !ctx;
        float scv[8]; f32x4 cs[8], sn[8];
#pragma unroll
        for (int q = 0; q < 8; ++q) { const int rl = 128 * (q >> 2) + 64 * wr + 16 * (q & 3) + fr; scv[q] = rs[((size_t)u.pm * 256 + rl) * 2]; }
        if (rope0 || rope1) {
#pragma unroll
            for (int q = 0; q < 8; ++q) { const int rl = 128 * (q >> 2) + 64 * wr + 16 * (q & 3) + fr; cs[q] = *(const f32x4*)(cosT + (size_t)(tbase + rl) * 16 + 4 * fq); sn[q] = *(const f32x4*)(sinT + (size_t)(tbase + rl) * 16 + 4 * fq); }
        }
#pragma unroll
        for (int ai = 0; ai < 2; ++ai)
#pragma unroll
            for (int m = 0; m < 4; ++m) {
                const int rl = 128 * ai + 64 * wr + 16 * m + fr; const size_t row = (size_t)u.pm * 256 + rl; const float sc = scv[4 * ai + m];
#pragma unroll
                for (int bj = 0; bj < 2; ++bj) {
                    f32x4 v0 = acc[ai][bj][m][0] * sc, v1 = acc[ai][bj][m][1] * sc;
                    if (bj ? rope1 : rope0) { const f32x4 c4 = cs[4 * ai + m], s4 = sn[4 * ai + m]; const f32x4 x0 = v0 * c4 - v1 * s4, x1 = v0 * s4 + v1 * c4; v0 = x0; v1 = x1; }
                    bf16_t* p = O + row * 768 + (bj ? colg1 : colg0) + 4 * fq;
                    u32x2 w0, w1; w0.x = pk2(v0[0], v0[1]); w0.y = pk2(v0[2], v0[3]); w1.x = pk2(v1[0], v1[1]); w1.y = pk2(v1[2], v1[3]);
                    *(u32x2*)p = w0; *(u32x2*)(p + 16) = w1;
                }
            }
    }
};
struct EpiG1 {
    static constexpr bool PERM = false; static constexpr int WIDE = 0;
    bf16_t* act;
    __device__ __forceinline__ void operator()(AccRef acc, const Unit& u, int wr, int wc, int fr, int fq) const {
#pragma unroll
        for (int ai = 0; ai < 2; ++ai)
#pragma unroll
            for (int m = 0; m < 4; ++m) {
                const int rl = 128 * ai + 64 * wr + 16 * m + fr;
#pragma unroll
                for (int bj = 0; bj < 2; ++bj) {
                    const f32x4 gt = acc[ai][bj][m][0], up = acc[ai][bj][m][1]; float r[4];
#pragma unroll
                    for (int j = 0; j < 4; ++j) r[j] = gt[j] * __builtin_amdgcn_rcpf(1.f + __expf(-gt[j])) * up[j];
                    u32x2 o; o.x = pk2(r[0], r[1]); o.y = pk2(r[2], r[3]);
                    *(u32x2*)(act + ((size_t)u.sbase + rl) * 256 + 16 * (8 * u.pn + 4 * bj + wc) + 4 * fq) = o;
                }
            }
    }
};
struct EpiG2 {
    static constexpr bool PERM = true, WIDE = true;
    bf16_t* slab; int sbase0;
    __device__ __forceinline__ void operator()(AccRef acc, const Unit& u, int wr, int wc, int fr, int fq) const {
        const bool lo = fr < 8; const int col = 256 * u.pn + 64 * wc + 8 * fq + (lo ? 0 : 32);
#pragma unroll
        for (int ai = 0; ai < 2; ++ai)
#pragma unroll
            for (int m = 0; m < 4; ++m) { const size_t row = (size_t)(u.sbase - sbase0) + 128 * ai + 64 * wr + 16 * m + (fr & 7);
                u32x4 x0, x1;
                { const f32x4 v0 = acc[ai][0][m][0], v1 = acc[ai][0][m][1]; x0.x = pk2(v0[0], v0[1]); x0.y = pk2(v0[2], v0[3]); x0.z = pk2(v1[0], v1[1]); x0.w = pk2(v1[2], v1[3]); }
                { const f32x4 v0 = acc[ai][1][m][0], v1 = acc[ai][1][m][1]; x1.x = pk2(v0[0], v0[1]); x1.y = pk2(v0[2], v0[3]); x1.z = pk2(v1[0], v1[1]); x1.w = pk2(v1[2], v1[3]); }
                u32x4 rc;
#pragma unroll
                for (int q = 0; q < 4; ++q) rc[q] = (unsigned)__shfl_xor((int)(lo ? x1[q] : x0[q]), 8);
                const u32x4 da = lo ? x0 : rc, db = lo ? rc : x1;
                __builtin_nontemporal_store(da, (u32x4*)(slab + row * 1024 + col)); __builtin_nontemporal_store(db, (u32x4*)(slab + (row + 8) * 1024 + col)); }
    }
};
}

struct AU {
    const bf16_t* qptr;
    bf16_t* optr;
    const bf16_t* kbase; unsigned kpitch;
    const bf16_t* vbase; unsigned vpitch;
    const bf16_t* k2base; unsigned k2pitch;
    int row_ctx, row_lat;
    int nt;
    int j0;
    int qoff;
    int start;
    float m0, l0;
};
constexpr int ATT_RPB = 122880;
constexpr float THR = 8.f;
__device__ __forceinline__ void glds16(const void* gsrc, unsigned lds_dst) { unsigned keep;
    asm volatile("s_mov_b32 %0, m0\n\ts_mov_b32 m0, %2\n\ts_nop 0\n\tglobal_load_lds_dwordx4 %1, off\n\ts_mov_b32 m0, %0" : "=&s"(keep) : "v"(gsrc), "s"(lds_dst) : "memory"); }
__device__ __forceinline__ float max3f(float a, float b, float c) { float r; asm("v_max3_f32 %0, %1, %2, %3" : "=v"(r) : "v"(a), "v"(b), "v"(c)); return r; }
__device__ __forceinline__ float max2f(float a, float b) { float r; asm("v_max_f32_e32 %0, %1, %2" : "=v"(r) : "v"(a), "v"(b)); return r; }

template <int MODE  , int DQ  >
__device__ __forceinline__ void attn_unit(LAS unsigned char* lds, const AU& a) {
    constexpr int NS = DQ / 16;
    constexpr int BUFB = (DQ == 96) ? 20480 : 16384;
    const int tid = ltid(), lane = tid & 63, wid = __builtin_amdgcn_readfirstlane(tid >> 6), r32 = lane & 31, hi = lane >> 5;
    const bool upper = wid >= 4;
    const int kr = tid >> 3, cp = tid & 7;
    const int ksrc = (cp ^ ((kr >> 1) & 7)) * 8, vsrc = (cp ^ (((kr >> 1) & 1) << 2)) * 8;
    const int kr2 = 16 * wid + (lane >> 2), k2src = ((lane & 3) ^ ((kr2 >> 2) & 3)) * 8;
    unsigned koff[NS];
#pragma unroll
    for (int s = 0; s < NS; ++s) koff[s] = (s < 4) ? (unsigned)(r32 * 128 + (((2 * s + hi) ^ ((r32 >> 1) & 7)) << 4))
                                                   : (unsigned)(16384 + r32 * 64 + (((2 * (s - 4) + hi) ^ ((r32 >> 2) & 3)) << 4));
    const int vg = (lane >> 4) & 1, vq = (lane & 15) >> 2, vp = lane & 3, vsw = (vq >> 1) & 1;
    const unsigned voff0 = (unsigned)(8192 + (4 * hi + vq) * 128 + 64 * vsw + 32 * vg + 8 * vp);
    const unsigned voff1 = (unsigned)(8192 + (4 * hi + vq) * 128 + 64 * (1 - vsw) + 32 * vg + 8 * vp);
    bf16x8 qf[NS];
#pragma unroll
    for (int s = 0; s < NS; ++s) qf[s] = *(const bf16x8*)(a.qptr + 16 * s + 8 * hi);
    f32x16 o0, o1, negm, p0, p1;
    float m = a.m0, l = a.l0;
#pragma unroll
    for (int r = 0; r < 16; ++r) { o0[r] = 0.f; o1[r] = 0.f; negm[r] = -m; p0[r] = 0.f; p1[r] = 0.f; }
    const int nt = a.nt;
    auto krow = [&](int t, int r) -> int {
        if (MODE == 0) return a.row_ctx + 64 * t + r;
        if (t < 4) return a.row_ctx + 64 * t + r;
        if (MODE == 1) return a.row_lat + a.start - 128 + 64 * (a.j0 + t - 4) + r;
        return a.row_lat + 64 * (a.j0 + t - 4) + r;
    };
    const unsigned lds0 = (unsigned)(uintptr_t)lds + (unsigned)wid * 1024u;
    auto dma = [&](int t, int boff) {
        const size_t r = (size_t)krow(t, kr);
        glds16(a.kbase + r * a.kpitch + ksrc, (unsigned)__builtin_amdgcn_readfirstlane((int)(lds0 + boff)));
        glds16(a.vbase + r * a.vpitch + vsrc, (unsigned)__builtin_amdgcn_readfirstlane((int)(lds0 + boff + 8192)));
        if (DQ == 96) { if (!upper) { const size_t r2 = (size_t)krow(t, kr2);
            glds16(a.k2base + r2 * a.k2pitch + k2src, (unsigned)__builtin_amdgcn_readfirstlane((int)(lds0 + boff + 16384))); } }
    };
    auto tile_active = [&](int t) -> bool {
        if (MODE != 2 || t < 4) return true;
        const int qrow = a.qoff >> 6; int rs = qrow - 4; rs = rs < 0 ? 0 : (rs > 24 ? 24 : rs); const int kgr = a.j0 + t - 4;
        return __builtin_amdgcn_readfirstlane((int)((kgr >= rs) && (kgr < rs + 8))) != 0;
    };
    auto QK = [&](int t, int boff) {
        const LAS unsigned char* Bb = lds + boff;
        bf16x8 kf[2 * NS];
#pragma unroll
        for (int s = 0; s < NS; ++s) { kf[2 * s] = *(const LAS bf16x8*)(Bb + koff[s]); kf[2 * s + 1] = *(const LAS bf16x8*)(Bb + koff[s] + (s < 4 ? 4096 : 2048)); }
#pragma unroll
        for (int s = 0; s < NS; ++s) {
            if (s == 0) { p0 = __builtin_amdgcn_mfma_f32_32x32x16_bf16(kf[0], qf[0], negm, 0, 0, 0); p1 = __builtin_amdgcn_mfma_f32_32x32x16_bf16(kf[1], qf[0], negm, 0, 0, 0); }
            else { p0 = __builtin_amdgcn_mfma_f32_32x32x16_bf16(kf[2 * s], qf[s], p0, 0, 0, 0); p1 = __builtin_amdgcn_mfma_f32_32x32x16_bf16(kf[2 * s + 1], qf[s], p1, 0, 0, 0); }
        }
        __builtin_amdgcn_sched_group_barrier(0x100, 2 * NS, 0);
        __builtin_amdgcn_sched_group_barrier(0x008, 2 * NS, 0);
        if (MODE == 1 && t >= 4) {
            const int j = a.j0 + t - 4;
            if (j == 0 || j == 4) {
                const int dbase = -128 + 64 * j - a.qoff + 4 * hi;
#pragma unroll
                for (int r = 0; r < 16; ++r) { const int d = dbase + (r & 3) + 8 * (r >> 2);
                    if ((unsigned)(d + 128) > 256u) p0[r] = -1e30f; if ((unsigned)(d + 32 + 128) > 256u) p1[r] = -1e30f; }
            }
        }
        if (MODE == 2 && t >= 4) {
            const int qrow = a.qoff >> 6, qcol = a.qoff & 63; int cs = qcol - 8; cs = cs < 0 ? 0 : (cs > 48 ? 48 : cs);
            const int krel = a.j0 + t - 4 - qrow + 7;
            const LAS float* bt = (const LAS float*)(lds + ATT_RPB) + krel * 128 + (63 - qcol) + 4 * hi;
            const int cb = 4 * hi - cs;
#pragma unroll
            for (int r = 0; r < 16; ++r) { const int kc = (r & 3) + 8 * (r >> 2);
                const float b0 = bt[kc], b1 = bt[kc + 32];
                p0[r] = ((unsigned)(cb + kc) < 16u) ? p0[r] + b0 : -1e30f;
                p1[r] = ((unsigned)(cb + kc + 32) < 16u) ? p1[r] + b1 : -1e30f; }
        }
    };
    bf16x8 pf0, pf1, pf2, pf3;
    auto SM = [&](bool first) {
        asm volatile("s_nop 15\n\ts_nop 7" : "+v"(p0), "+v"(p1));
        float ra = max3f(p0[0], p0[1], p1[0]), rb = max3f(p0[2], p0[3], p1[1]); ra = max3f(ra, p1[2], p1[3]);
#pragma unroll
        for (int r = 4; r < 16; r += 4) { ra = max3f(ra, p0[r], p0[r + 1]); rb = max3f(rb, p0[r + 2], p0[r + 3]); ra = max3f(ra, p1[r], p1[r + 1]); rb = max3f(rb, p1[r + 2], p1[r + 3]); }
        float rm = max2f(ra, rb);
        { auto rr = __builtin_amdgcn_permlane32_swap(__float_as_uint(rm), __float_as_uint(rm), false, false); rm = max2f(__uint_as_float(rr[0]), __uint_as_float(rr[1])); }
        if (first || __any(rm > THR)) {
            const float dl = first ? rm : fmaxf(rm, 0.f);
            m += dl; const float f = __builtin_amdgcn_exp2f(-dl); l *= f;
#pragma unroll
            for (int r = 0; r < 16; ++r) { p0[r] -= dl; p1[r] -= dl; o0[r] *= f; o1[r] *= f; negm[r] = -m; }
        }
        float ls = 0.f;
#pragma unroll
        for (int r = 0; r < 16; ++r) { p0[r] = __builtin_amdgcn_exp2f(p0[r]); p1[r] = __builtin_amdgcn_exp2f(p1[r]); ls += p0[r] + p1[r]; }
        l += ls;
        u32x4 w;
        w.x = pk2(p0[0], p0[1]); w.y = pk2(p0[2], p0[3]); w.z = pk2(p0[4], p0[5]); w.w = pk2(p0[6], p0[7]); pf0 = __builtin_bit_cast(bf16x8, w);
        w.x = pk2(p0[8], p0[9]); w.y = pk2(p0[10], p0[11]); w.z = pk2(p0[12], p0[13]); w.w = pk2(p0[14], p0[15]); pf1 = __builtin_bit_cast(bf16x8, w);
        w.x = pk2(p1[0], p1[1]); w.y = pk2(p1[2], p1[3]); w.z = pk2(p1[4], p1[5]); w.w = pk2(p1[6], p1[7]); pf2 = __builtin_bit_cast(bf16x8, w);
        w.x = pk2(p1[8], p1[9]); w.y = pk2(p1[10], p1[11]); w.z = pk2(p1[12], p1[13]); w.w = pk2(p1[14], p1[15]); pf3 = __builtin_bit_cast(bf16x8, w);
    };
    auto PV = [&](int boff) {
        const LAS unsigned char* Bb = lds + boff;
        s16x4 va0[4], va1[4], vc0[4], vc1[4];
#pragma unroll
        for (int kk = 0; kk < 4; ++kk) {
            const LAS unsigned char* vb = Bb + kk * 2048;
            va0[kk] = __builtin_bit_cast(s16x4, __builtin_amdgcn_ds_read_tr16_b64_v4i16((LAS s16x4*)(vb + voff0)));
            va1[kk] = __builtin_bit_cast(s16x4, __builtin_amdgcn_ds_read_tr16_b64_v4i16((LAS s16x4*)(vb + voff0 + 1024)));
            vc0[kk] = __builtin_bit_cast(s16x4, __builtin_amdgcn_ds_read_tr16_b64_v4i16((LAS s16x4*)(vb + voff1)));
            vc1[kk] = __builtin_bit_cast(s16x4, __builtin_amdgcn_ds_read_tr16_b64_v4i16((LAS s16x4*)(vb + voff1 + 1024)));
        }
#pragma unroll
        for (int kk = 0; kk < 4; ++kk) {
            const bf16x8 va = (bf16x8){va0[kk][0], va0[kk][1], va0[kk][2], va0[kk][3], va1[kk][0], va1[kk][1], va1[kk][2], va1[kk][3]};
            const bf16x8 vc = (bf16x8){vc0[kk][0], vc0[kk][1], vc0[kk][2], vc0[kk][3], vc1[kk][0], vc1[kk][1], vc1[kk][2], vc1[kk][3]};
            const bf16x8 pk = kk == 0 ? pf0 : (kk == 1 ? pf1 : (kk == 2 ? pf2 : pf3));
            o0 = __builtin_amdgcn_mfma_f32_32x32x16_bf16(va, pk, o0, 0, 0, 0);
            o1 = __builtin_amdgcn_mfma_f32_32x32x16_bf16(vc, pk, o1, 0, 0, 0);
        }
        __builtin_amdgcn_sched_group_barrier(0x100, 16, 0);
        __builtin_amdgcn_sched_group_barrier(0x008, 8, 0);
    };
#define ATT_WAIT_BAR(N) do { asm volatile("s_waitcnt vmcnt(" #N ") lgkmcnt(0)" ::: "memory"); __builtin_amdgcn_s_barrier(); asm volatile("" ::: "memory"); } while (0)
    constexpr int RING = 6, DIST = RING - 1;
    auto wait_bar = [&](int ntiles) {
        if (DQ == 96 && !upper) { switch (ntiles) { case 4: ATT_WAIT_BAR(12); break; case 3: ATT_WAIT_BAR(9); break; case 2: ATT_WAIT_BAR(6); break; case 1: ATT_WAIT_BAR(3); break; default: ATT_WAIT_BAR(0); } }
        else { switch (ntiles) { case 4: ATT_WAIT_BAR(8); break; case 3: ATT_WAIT_BAR(6); break; case 2: ATT_WAIT_BAR(4); break; case 1: ATT_WAIT_BAR(2); break; default: ATT_WAIT_BAR(0); } } };
    if (upper) __builtin_amdgcn_s_setprio(1);
    int issued = 0;
    for (; issued < DIST && issued < nt; ++issued) dma(issued, issued * BUFB);
    wait_bar(issued - 1);
    int b_cur = 0, b_iss = (DIST % RING) * BUFB;
    for (int t = 0; t < nt; ++t) {
        if (issued < nt) { dma(issued, b_iss); ++issued; b_iss += BUFB; if (b_iss == RING * BUFB) b_iss = 0; }
        if (tile_active(t)) { QK(t, b_cur); SM(t == 0); PV(b_cur); }
        { const int infl = issued - t - 2; wait_bar(infl < 0 ? 0 : infl); }
        b_cur += BUFB; if (b_cur == RING * BUFB) b_cur = 0;
    }
#undef ATT_WAIT_BAR
    if (upper) __builtin_amdgcn_s_setprio(0);
    { auto rr = __builtin_amdgcn_permlane32_swap(__float_as_uint(l), __float_as_uint(l), false, false); l = __uint_as_float(rr[0]) + __uint_as_float(rr[1]); }
    const float inv = 1.f / l;
#pragma unroll
    for (int ig = 0; ig < 4; ++ig) {
        u32x2 w0, w1;
        w0.x = pk2(o0[4 * ig] * inv, o0[4 * ig + 1] * inv); w0.y = pk2(o0[4 * ig + 2] * inv, o0[4 * ig + 3] * inv);
        w1.x = pk2(o1[4 * ig] * inv, o1[4 * ig + 1] * inv); w1.y = pk2(o1[4 * ig + 2] * inv, o1[4 * ig + 3] * inv);
        *(u32x2*)(a.optr + 8 * ig + 4 * hi) = w0;
        *(u32x2*)(a.optr + 32 + 8 * ig + 4 * hi) = w1;
    }
}

struct AU2 {
    const bf16_t* qptr; unsigned qpitch;
    bf16_t* optr;
    const bf16_t* kbase; unsigned kpitch; const bf16_t* vbase; unsigned vpitch; const bf16_t* k2base; unsigned k2pitch;
    int row_ctx, nt;
};
template <int DQ  , bool NOMAX  >
__device__ __forceinline__ void attn_unit2(LAS unsigned char* lds, const AU2& a) {
    constexpr int NS = DQ / 16;
    constexpr int BUFB = (DQ == 96) ? 20480 : 16384;
    const int tid = ltid(), lane = tid & 63, wid = __builtin_amdgcn_readfirstlane(tid >> 6), r32 = lane & 31, hi = lane >> 5;
    const bool upper = wid >= 4;
    const int kr = tid >> 3, cp = tid & 7;
    const int ksrc = (cp ^ ((kr >> 1) & 7)) * 8, vsrc = (cp ^ (((kr >> 1) & 1) << 2)) * 8;
    const int kr2 = 16 * wid + (lane >> 2), k2src = ((lane & 3) ^ ((kr2 >> 2) & 3)) * 8;
    unsigned koff[NS];
#pragma unroll
    for (int s = 0; s < NS; ++s) koff[s] = (s < 4) ? (unsigned)(r32 * 128 + (((2 * s + hi) ^ ((r32 >> 1) & 7)) << 4))
                                                   : (unsigned)(16384 + r32 * 64 + (((2 * (s - 4) + hi) ^ ((r32 >> 2) & 3)) << 4));
    const int vg = (lane >> 4) & 1, vq = (lane & 15) >> 2, vp = lane & 3, vsw = (vq >> 1) & 1;
    const unsigned voff0 = (unsigned)(8192 + (4 * hi + vq) * 128 + 64 * vsw + 32 * vg + 8 * vp);
    const unsigned voff1 = (unsigned)(8192 + (4 * hi + vq) * 128 + 64 * (1 - vsw) + 32 * vg + 8 * vp);
    bf16x8 qA[NS], qB[NS];
#pragma unroll
    for (int s = 0; s < NS; ++s) { qA[s] = *(const bf16x8*)(a.qptr + 16 * s + 8 * hi); qB[s] = *(const bf16x8*)(a.qptr + (size_t)32 * a.qpitch + 16 * s + 8 * hi); }
    f32x16 oA0, oA1, oB0, oB1, pA0, pA1, pB0, pB1;
    float mA = 0.f, lA = 0.f, mB = 0.f, lB = 0.f;
#pragma unroll
    for (int r = 0; r < 16; ++r) { oA0[r] = 0.f; oA1[r] = 0.f; oB0[r] = 0.f; oB1[r] = 0.f; }
    const int nt = a.nt;
    const unsigned lds0 = (unsigned)(uintptr_t)lds + (unsigned)wid * 1024u;
    auto dma = [&](int t, int boff) {
        const size_t r = (size_t)(a.row_ctx + 64 * t + kr);
        glds16(a.kbase + r * a.kpitch + ksrc, (unsigned)__builtin_amdgcn_readfirstlane((int)(lds0 + boff)));
        glds16(a.vbase + r * a.vpitch + vsrc, (unsigned)__builtin_amdgcn_readfirstlane((int)(lds0 + boff + 8192)));
        if (DQ == 96) { if (!upper) { const size_t r2 = (size_t)(a.row_ctx + 64 * t + kr2);
            glds16(a.k2base + r2 * a.k2pitch + k2src, (unsigned)__builtin_amdgcn_readfirstlane((int)(lds0 + boff + 16384))); } }
    };
    const f32x16 zero16 = {0.f, 0.f, 0.f, 0.f, 0.f, 0.f, 0.f, 0.f, 0.f, 0.f, 0.f, 0.f, 0.f, 0.f, 0.f, 0.f};
    auto QK = [&](int boff) {
        const LAS unsigned char* Bb = lds + boff;
        bf16x8 kf[2 * NS];
#pragma unroll
        for (int s = 0; s < NS; ++s) { kf[2 * s] = *(const LAS bf16x8*)(Bb + koff[s]); kf[2 * s + 1] = *(const LAS bf16x8*)(Bb + koff[s] + (s < 4 ? 4096 : 2048)); }
#pragma unroll
        for (int s = 0; s < NS; ++s) {
            pA0 = __builtin_amdgcn_mfma_f32_32x32x16_bf16(kf[2 * s], qA[s], s == 0 ? zero16 : pA0, 0, 0, 0); pA1 = __builtin_amdgcn_mfma_f32_32x32x16_bf16(kf[2 * s + 1], qA[s], s == 0 ? zero16 : pA1, 0, 0, 0);
            pB0 = __builtin_amdgcn_mfma_f32_32x32x16_bf16(kf[2 * s], qB[s], s == 0 ? zero16 : pB0, 0, 0, 0); pB1 = __builtin_amdgcn_mfma_f32_32x32x16_bf16(kf[2 * s + 1], qB[s], s == 0 ? zero16 : pB1, 0, 0, 0);
        }
        __builtin_amdgcn_sched_group_barrier(0x100, 2 * NS, 0);
        __builtin_amdgcn_sched_group_barrier(0x008, 4 * NS, 0);
    };
    auto SM = [&](f32x16& p0, f32x16& p1, f32x16& o0, f32x16& o1, float& m, float& l, bool first, bf16x8 (&pf)[4]) {
        float ls = 0.f;
        if constexpr (NOMAX) {
#pragma unroll
            for (int r = 0; r < 16; ++r) { p0[r] = __builtin_amdgcn_exp2f(p0[r]); p1[r] = __builtin_amdgcn_exp2f(p1[r]); ls += p0[r] + p1[r]; }
        } else {
            asm volatile("s_nop 15\n\ts_nop 7" : "+v"(p0), "+v"(p1));
            float ra = max3f(p0[0], p0[1], p1[0]), rb = max3f(p0[2], p0[3], p1[1]); ra = max3f(ra, p1[2], p1[3]);
#pragma unroll
            for (int r = 4; r < 16; r += 4) { ra = max3f(ra, p0[r], p0[r + 1]); rb = max3f(rb, p0[r + 2], p0[r + 3]); ra = max3f(ra, p1[r], p1[r + 1]); rb = max3f(rb, p1[r + 2], p1[r + 3]); }
            float rm = max2f(ra, rb);
            { auto rr = __builtin_amdgcn_permlane32_swap(__float_as_uint(rm), __float_as_uint(rm), false, false); rm = max2f(__uint_as_float(rr[0]), __uint_as_float(rr[1])); }
            if (first) m = rm;
            else if (__any(rm - m > THR)) { const float mn = fmaxf(m, rm); const float f = __builtin_amdgcn_exp2f(m - mn); m = mn; l *= f;
#pragma unroll
                for (int r = 0; r < 16; ++r) { o0[r] *= f; o1[r] *= f; } }
#pragma unroll
            for (int r = 0; r < 16; ++r) { p0[r] = __builtin_amdgcn_exp2f(p0[r] - m); p1[r] = __builtin_amdgcn_exp2f(p1[r] - m); ls += p0[r] + p1[r]; }
        }
        l += ls;
        u32x4 w;
        w.x = pk2(p0[0], p0[1]); w.y = pk2(p0[2], p0[3]); w.z = pk2(p0[4], p0[5]); w.w = pk2(p0[6], p0[7]); pf[0] = __builtin_bit_cast(bf16x8, w);
        w.x = pk2(p0[8], p0[9]); w.y = pk2(p0[10], p0[11]); w.z = pk2(p0[12], p0[13]); w.w = pk2(p0[14], p0[15]); pf[1] = __builtin_bit_cast(bf16x8, w);
        w.x = pk2(p1[0], p1[1]); w.y = pk2(p1[2], p1[3]); w.z = pk2(p1[4], p1[5]); w.w = pk2(p1[6], p1[7]); pf[2] = __builtin_bit_cast(bf16x8, w);
        w.x = pk2(p1[8], p1[9]); w.y = pk2(p1[10], p1[11]); w.z = pk2(p1[12], p1[13]); w.w = pk2(p1[14], p1[15]); pf[3] = __builtin_bit_cast(bf16x8, w);
    };
    bf16x8 pfA[4], pfB[4];
    auto PV = [&](int boff) {
        const LAS unsigned char* Bb = lds + boff;
        s16x4 va0[4], va1[4], vc0[4], vc1[4];
#pragma unroll
        for (int kk = 0; kk < 4; ++kk) {
            const LAS unsigned char* vb = Bb + kk * 2048;
            va0[kk] = __builtin_bit_cast(s16x4, __builtin_amdgcn_ds_read_tr16_b64_v4i16((LAS s16x4*)(vb + voff0)));
            va1[kk] = __builtin_bit_cast(s16x4, __builtin_amdgcn_ds_read_tr16_b64_v4i16((LAS s16x4*)(vb + voff0 + 1024)));
            vc0[kk] = __builtin_bit_cast(s16x4, __builtin_amdgcn_ds_read_tr16_b64_v4i16((LAS s16x4*)(vb + voff1)));
            vc1[kk] = __builtin_bit_cast(s16x4, __builtin_amdgcn_ds_read_tr16_b64_v4i16((LAS s16x4*)(vb + voff1 + 1024)));
        }
#pragma unroll
        for (int kk = 0; kk < 4; ++kk) {
            const bf16x8 va = (bf16x8){va0[kk][0], va0[kk][1], va0[kk][2], va0[kk][3], va1[kk][0], va1[kk][1], va1[kk][2], va1[kk][3]};
            const bf16x8 vc = (bf16x8){vc0[kk][0], vc0[kk][1], vc0[kk][2], vc0[kk][3], vc1[kk][0], vc1[kk][1], vc1[kk][2], vc1[kk][3]};
            oA0 = __builtin_amdgcn_mfma_f32_32x32x16_bf16(va, pfA[kk], oA0, 0, 0, 0); oA1 = __builtin_amdgcn_mfma_f32_32x32x16_bf16(vc, pfA[kk], oA1, 0, 0, 0);
            oB0 = __builtin_amdgcn_mfma_f32_32x32x16_bf16(va, pfB[kk], oB0, 0, 0, 0); oB1 = __builtin_amdgcn_mfma_f32_32x32x16_bf16(vc, pfB[kk], oB1, 0, 0, 0);
        }
        __builtin_amdgcn_sched_group_barrier(0x100, 16, 0);
        __builtin_amdgcn_sched_group_barrier(0x008, 16, 0);
    };
#define ATT_WAIT_BAR(N) do { asm volatile("s_waitcnt vmcnt(" #N ") lgkmcnt(0)" ::: "memory"); __builtin_amdgcn_s_barrier(); asm volatile("" ::: "memory"); } while (0)
    constexpr int RING = 6, DIST = RING - 1;
    auto wait_bar = [&](int ntiles) {
        if (DQ == 96 && !upper) { switch (ntiles) { case 4: ATT_WAIT_BAR(12); break; case 3: ATT_WAIT_BAR(9); break; case 2: ATT_WAIT_BAR(6); break; case 1: ATT_WAIT_BAR(3); break; default: ATT_WAIT_BAR(0); } }
        else { switch (ntiles) { case 4: ATT_WAIT_BAR(8); break; case 3: ATT_WAIT_BAR(6); break; case 2: ATT_WAIT_BAR(4); break; case 1: ATT_WAIT_BAR(2); break; default: ATT_WAIT_BAR(0); } } };
    if (upper) __builtin_amdgcn_s_setprio(1);
    int issued = 0;
    for (; issued < DIST && issued < nt; ++issued) dma(issued, issued * BUFB);
    wait_bar(issued - 1);
    int b_cur = 0, b_iss = (DIST % RING) * BUFB;
    for (int t = 0; t < nt; ++t) {
        if (issued < nt) { dma(issued, b_iss); ++issued; b_iss += BUFB; if (b_iss == RING * BUFB) b_iss = 0; }
        QK(b_cur);
        SM(pA0, pA1, oA0, oA1, mA, lA, t == 0, pfA);
        SM(pB0, pB1, oB0, oB1, mB, lB, t == 0, pfB);
        PV(b_cur);
        { const int infl = issued - t - 2; wait_bar(infl < 0 ? 0 : infl); }
        b_cur += BUFB; if (b_cur == RING * BUFB) b_cur = 0;
    }
#undef ATT_WAIT_BAR
    if (upper) __builtin_amdgcn_s_setprio(0);
    { auto rr = __builtin_amdgcn_permlane32_swap(__float_as_uint(lA), __float_as_uint(lA), false, false); lA = __uint_as_float(rr[0]) + __uint_as_float(rr[1]); }
    { auto rr = __builtin_amdgcn_permlane32_swap(__float_as_uint(lB), __float_as_uint(lB), false, false); lB = __uint_as_float(rr[0]) + __uint_as_float(rr[1]); }
    const float invA = 1.f / lA, invB = 1.f / lB; bf16_t* oB = a.optr + (size_t)32 * 1024;
#pragma unroll
    for (int ig = 0; ig < 4; ++ig) {
        u32x2 w0, w1;
        w0.x = pk2(oA0[4 * ig] * invA, oA0[4 * ig + 1] * invA); w0.y = pk2(oA0[4 * ig + 2] * invA, oA0[4 * ig + 3] * invA);
        w1.x = pk2(oA1[4 * ig] * invA, oA1[4 * ig + 1] * invA); w1.y = pk2(oA1[4 * ig + 2] * invA, oA1[4 * ig + 3] * invA);
        *(u32x2*)(a.optr + 8 * ig + 4 * hi) = w0; *(u32x2*)(a.optr + 32 + 8 * ig + 4 * hi) = w1;
        w0.x = pk2(oB0[4 * ig] * invB, oB0[4 * ig + 1] * invB); w0.y = pk2(oB0[4 * ig + 2] * invB, oB0[4 * ig + 3] * invB);
        w1.x = pk2(oB1[4 * ig] * invB, oB1[4 * ig + 1] * invB); w1.y = pk2(oB1[4 * ig + 2] * invB, oB1[4 * ig + 3] * invB);
        *(u32x2*)(oB + 8 * ig + 4 * hi) = w0; *(u32x2*)(oB + 32 + 8 * ig + 4 * hi) = w1;
    }
}

struct Job { const float* src; bf16_t* dst; int K, N, ldd, nb; size_t sbs, dbs; int mode; const float* rscale; };

__device__ __forceinline__ int hperm64(int c) { const int base = c & ~63, cl = c & 63, p = cl >> 1, n = cl & 1, g = p >> 4, i = p & 15; return base + 32 * g + 16 * n + i; }
__device__ __forceinline__ int rowmap(int mode, int c) {
    switch (mode) {
        case 1: return c < 640 ? hperm64(c) : c;
        case 2: if ((c >= 384 && c < 896) || (c >= 1184 && c < 1312)) { const int b0 = (c >= 1184) ? 1184 : 384; return b0 + hperm64(c - b0); }
                if (c >= 1152 && c < 1184) { const int cl = c - 1152; return 1152 + 16 * (cl & 1) + (cl >> 1); }
                return c;
        case 3: { const int h = c / 96, cl = c % 96; if (cl < 64) return c; const int r = cl - 64; return h * 96 + 64 + 16 * (r & 1) + (r >> 1); }
        case 4: return 32 * (c >> 4) + (c & 15);
        case 5: return 32 * (c >> 4) + 16 + (c & 15);
        default: return c;
    }
}
__device__ __forceinline__ float colscale(int mode, int c) {
    if (mode == 1) return (c < 512 || (c >= 768 && c < 1280)) ? QS64 : 1.f;
    if (mode == 3) return QS96;
    return 1.f;
}
__device__ __forceinline__ bool get_job(PP P, int j, Job& J) {
    const int layer = j >= 9 ? 1 : 0, jj = layer ? j - 9 : j; const int ib = layer ? 20 : 4;
    bf16_t* W = (bf16_t*)(P->ws + (layer ? WS_W1 : WS_W0));
    J.nb = 1; J.sbs = 0; J.dbs = 0; J.rscale = nullptr; J.mode = 0; J.ldd = 1024; J.K = 1024;
    switch (jj) {
        case 0: J.src = P->in[ib + 3]; J.dst = W + WO_IN; J.N = layer ? 1440 : 2304; J.mode = layer ? 2 : 1; break;
        case 1: J.src = P->in[layer ? 30 : 10]; J.dst = W + WO_OUT; J.N = 1024; break;
        case 2: J.src = P->in[layer ? 32 : 12]; J.dst = W + WO_RT; J.N = 64; J.mode = 7; break;
        case 3: J.src = P->in[layer ? 34 : 14]; J.dst = W + WO_GU; J.N = 256; J.nb = 64; J.sbs = (size_t)1024 * 256; J.dbs = (size_t)512 * 1024; J.mode = 4; break;
        case 4: J.src = P->in[layer ? 35 : 15]; J.dst = W + WO_GU; J.N = 256; J.nb = 64; J.sbs = (size_t)1024 * 256; J.dbs = (size_t)512 * 1024; J.mode = 5; break;
        case 5: J.src = P->in[layer ? 36 : 16]; J.dst = W + WO_D; J.K = 256; J.N = 1024; J.ldd = 256; J.nb = 64; J.sbs = (size_t)256 * 1024; J.dbs = (size_t)1024 * 256; break;
        case 6: J.src = P->in[layer ? 37 : 17]; J.dst = W + WO_GU + (size_t)64 * 512 * 1024; J.N = 256; J.mode = 4; break;
        case 7: J.src = P->in[layer ? 38 : 18]; J.dst = W + WO_GU + (size_t)64 * 512 * 1024; J.N = 256; J.mode = 5; break;
        case 8: J.src = P->in[layer ? 39 : 19]; J.dst = W + WO_D + (size_t)64 * 1024 * 256; J.K = 256; J.N = 1024; J.ldd = 256; break;
        case 9: J.src = P->in[25]; J.dst = W + WO_UQ; J.K = 384; J.N = 768; J.ldd = 384; J.mode = 3; J.rscale = P->in[24]; break;
        case 10: J.src = P->in[27]; J.dst = W + WO_UKV; J.K = 256; J.N = 1024; J.ldd = 256; J.mode = 6; J.rscale = P->in[26]; break;
        default: return false;
    }
    return true;
}
constexpr int NJOBS = 20;
__device__ __forceinline__ int job_tiles(const Job& J) { return J.nb * (J.K >> 6) * ((J.N + 255) >> 8); }

__device__ __forceinline__ void conv_tile(const Job& J, int tile, LAS float* T) {
    const int tid = ltid(); const int ntn = (J.N + 255) >> 8, ntk = J.K >> 6;
    const int b = tile / (ntn * ntk), r = tile % (ntn * ntk), tk = r / ntn, tn = r % ntn;
    const float* src = J.src + (size_t)b * J.sbs; bf16_t* dst = J.dst + (size_t)b * J.dbs; const int k0 = tk * 64, n0 = tn * 256;
    { const int n4 = (tid & 63) * 4; const bool ok = (n0 + n4) < J.N;
      f32x4 v[8];
#pragma unroll
      for (int j = 0; j < 8; ++j) { const int k = (tid >> 6) + 8 * j; v[j] = ok ? *(const f32x4*)(src + (size_t)(k0 + k) * J.N + n0 + n4) : (f32x4){0.f, 0.f, 0.f, 0.f}; }
      f32x4 cs; cs[0] = colscale(J.mode, n0 + n4); cs[1] = colscale(J.mode, n0 + n4 + 1); cs[2] = colscale(J.mode, n0 + n4 + 2); cs[3] = colscale(J.mode, n0 + n4 + 3);
#pragma unroll
      for (int j = 0; j < 8; ++j) { const int k = (tid >> 6) + 8 * j; f32x4 x = v[j] * cs; if (J.rscale) x = x * J.rscale[k0 + k]; *(LAS f32x4*)(T + k * 260 + n4) = x; } }
    __syncthreads();
    { const int nn = tid >> 1, kh = (tid & 1) * 32;
      if (n0 + nn < J.N) { const int drow = rowmap(J.mode, n0 + nn); bf16_t* dp = dst + (size_t)drow * J.ldd + k0 + kh;
#pragma unroll
          for (int q = 0; q < 4; ++q) { float v[8];
#pragma unroll
              for (int j = 0; j < 8; ++j) v[j] = T[(kh + 8 * q + j) * 260 + nn];
              u32x4 w; w.x = pk2(v[0], v[1]); w.y = pk2(v[2], v[3]); w.z = pk2(v[4], v[5]); w.w = pk2(v[6], v[7]);
              *(u32x4*)(dp + 8 * q) = w;
              if (J.mode == 7) { u32x4 w2;
                  w2.x = pk2(v[0] - bflo(w.x), v[1] - bfhi(w.x)); w2.y = pk2(v[2] - bflo(w.y), v[3] - bfhi(w.y));
                  w2.z = pk2(v[4] - bflo(w.z), v[5] - bfhi(w.z)); w2.w = pk2(v[6] - bflo(w.w), v[7] - bfhi(w.w));
                  *(u32x4*)(dp + (size_t)64 * 1024 + 8 * q) = w2; } } } }
    __syncthreads();
}

__device__ __forceinline__ void ada_item(PP P, int item, LAS float* S) {
    const int tid = ltid(); const int layer = item / 96, chunk = item % 96;
    for (int idx = tid; idx < 33 * 1024; idx += 512) { const int r = idx >> 10, k = idx & 1023; const float x = (r < 32) ? P->in[1][r * 1024 + k] : P->in[3][k]; S[idx] = x / (1.f + expf(-x)); }
    __syncthreads();
    const int col = chunk * 64 + (tid & 63), kg = tid >> 6;
    float acc[33];
#pragma unroll
    for (int r = 0; r < 33; ++r) acc[r] = 0.f;
    const float* W = P->in[layer ? 20 : 4] + col;
    for (int k = kg * 128; k < kg * 128 + 128; ++k) { const float w = W[(size_t)k * 6144];
#pragma unroll
        for (int r = 0; r < 33; ++r) acc[r] += S[r * 1024 + k] * w; }
    __syncthreads();
#pragma unroll
    for (int r = 0; r < 33; ++r) S[(kg * 33 + r) * 64 + (tid & 63)] = acc[r];
    __syncthreads();
    float* ada = (float*)(P->ws + WS_ADA) + (size_t)layer * 33 * 6144; const float* bias = P->in[layer ? 21 : 5];
    for (int idx = tid; idx < 33 * 64; idx += 512) { const int r = idx >> 6, cc = idx & 63; float s = 0.f;
#pragma unroll
        for (int g = 0; g < 8; ++g) s += S[(g * 33 + r) * 64 + cc];
        ada[(size_t)r * 6144 + chunk * 64 + cc] = s + bias[chunk * 64 + cc]; }
    __syncthreads();
}

__device__ __forceinline__ void phase_prologue(PP P, LAS unsigned char* lds, int c, int G) {
    const int tid = ltid();
    for (int it = c; it < 192; it += G) ada_item(P, it, (LAS float*)lds);
    { float* rp = (float*)(P->ws + WS_ROPE); float* cosh_ = rp; float* sinh_ = rp + 2048 * 32; float* cosr_ = rp + 2 * 2048 * 32; float* sinr_ = cosr_ + 2048 * 16;
      for (int idx = c * 512 + tid; idx < 2048 * 48; idx += G * 512) {
          if (idx < 2048 * 32) { const int t = idx >> 5, p = idx & 31; const float pos = (p < 16) ? (float)(t >> 6) : (float)(t & 63); const int i = p & 15;
              const float inv = powf(10000.0f, -(float)i / 16.0f); const float ang = pos * inv; cosh_[idx] = cosf(ang); sinh_[idx] = sinf(ang); }
          else { const int k = idx - 2048 * 32; const int t = k >> 4, p = k & 15; const float pos = (p < 8) ? (float)(t >> 6) : (float)(t & 63); const int i = p & 7;
              const float inv = powf(10000.0f, -(float)i / 8.0f); const float ang = pos * inv; cosr_[k] = cosf(ang); sinr_[k] = sinf(ang); } } }
    { u32x4* z = (u32x4*)((bf16_t*)(P->ws + WS_W1) + WO_IN + (size_t)1440 * 1024); for (int idx = c * 512 + tid; idx < 96 * 1024 / 8; idx += G * 512) z[idx] = (u32x4){0u, 0u, 0u, 0u}; }
    { int base = 0; int tile = c;
      for (int j = 0; j < NJOBS; ++j) { Job J; get_job(P, j, J); const int n = job_tiles(J);
          while (tile < base + n) { conv_tile(J, tile - base, (LAS float*)lds); tile += G; }
          base += n; } }
}

__device__ __forceinline__ void phase_norm(PP P, int c, int G, const float* xlat, const float* xctx, const float* g, const float* ada  , int sh_off, int sc_off, bool latent_only, bf16_t* H, bf16_t* HLO,
                                           const bool resid = false, float* xlat_dst = nullptr, float* xctx_dst = nullptr) {
    const int tid_ = ltid(); const int lane = tid_ & 63, wv = c * 8 + (tid_ >> 6), nw = G * 8;
    for (int row = wv; row < MROWS; row += nw) {
        const int b = row / TOK, t = row % TOK; const bool ctx = t < CTX;
        if (ctx && latent_only) continue;
        const float* x = ctx ? xctx + ((size_t)b * CTX + t) * 1024 : xlat + ((size_t)b * SEQ + t - CTX) * 1024;
        const float* ap = ada + (size_t)(ctx ? 32 : b) * 6144;
        f32x4 v[4]; float ss = 0.f;
#pragma unroll
        for (int i = 0; i < 2; ++i) { v[2 * i] = *(const f32x4*)(x + 512 * i + 8 * lane); v[2 * i + 1] = *(const f32x4*)(x + 512 * i + 8 * lane + 4); }
        if (resid) {
            float* xd = ctx ? xctx_dst + ((size_t)b * CTX + t) * 1024 : xlat_dst + ((size_t)b * SEQ + t - CTX) * 1024;
#pragma unroll
            for (int i = 0; i < 2; ++i) { const u32x4 yw = *(const u32x4*)(HLO + (size_t)row * 1024 + 512 * i + 8 * lane);
                const f32x4 g0 = *(const f32x4*)(ap + 2048 + 512 * i + 8 * lane), g1 = *(const f32x4*)(ap + 2048 + 512 * i + 8 * lane + 4);
                v[2 * i][0] += g0[0] * bflo(yw.x); v[2 * i][1] += g0[1] * bfhi(yw.x); v[2 * i][2] += g0[2] * bflo(yw.y); v[2 * i][3] += g0[3] * bfhi(yw.y);
                v[2 * i + 1][0] += g1[0] * bflo(yw.z); v[2 * i + 1][1] += g1[1] * bfhi(yw.z); v[2 * i + 1][2] += g1[2] * bflo(yw.w); v[2 * i + 1][3] += g1[3] * bfhi(yw.w);
                *(f32x4*)(xd + 512 * i + 8 * lane) = v[2 * i]; *(f32x4*)(xd + 512 * i + 8 * lane + 4) = v[2 * i + 1]; }
        }
#pragma unroll
        for (int i = 0; i < 4; ++i) ss += v[i][0] * v[i][0] + v[i][1] * v[i][1] + v[i][2] * v[i][2] + v[i][3] * v[i][3];
        ss = wave_sum(ss); const float rstd = rsqrtf(ss * (1.f / 1024.f) + EPS);
#pragma unroll
        for (int i = 0; i < 2; ++i) { const int col = 512 * i + 8 * lane; float o[8];
#pragma unroll
            for (int h = 0; h < 2; ++h) { const f32x4 gg = *(const f32x4*)(g + col + 4 * h), sc = *(const f32x4*)(ap + sc_off + col + 4 * h), sh = *(const f32x4*)(ap + sh_off + col + 4 * h);
#pragma unroll
                for (int j = 0; j < 4; ++j) o[4 * h + j] = v[2 * i + h][j] * rstd * gg[j] * (1.f + sc[j]) + sh[j]; }
            u32x4 w; w.x = pk2(o[0], o[1]); w.y = pk2(o[2], o[3]); w.z = pk2(o[4], o[5]); w.w = pk2(o[6], o[7]);
            *(u32x4*)(H + (size_t)row * 1024 + col) = w;
            if (HLO) { u32x4 w2; w2.x = pk2(o[0] - bflo(w.x), o[1] - bfhi(w.x)); w2.y = pk2(o[2] - bflo(w.y), o[3] - bfhi(w.y)); w2.z = pk2(o[4] - bflo(w.z), o[5] - bfhi(w.z)); w2.w = pk2(o[6] - bflo(w.w), o[7] - bfhi(w.w));
                *(u32x4*)(HLO + (size_t)row * 1024 + col) = w2; } }
    }
}

__device__ __forceinline__ void phase_post1(PP P, int c, int G) {
    const int tid_ = ltid(); const int lane = tid_ & 63, wv = c * 8 + (tid_ >> 6), nw = G * 8;
    bf16_t* Pb = (bf16_t*)(P->ws + WS_BIG + BIG_P); float* RS = (float*)(P->ws + WS_RSTD);
    const float* rp = (const float*)(P->ws + WS_ROPE); const float* cosh_ = rp; const float* sinh_ = rp + 2048 * 32; const float* cosr_ = rp + 2 * 2048 * 32; const float* sinr_ = cosr_ + 2048 * 16;
    const float* gqn = P->in[28]; const float* gkn = P->in[29];
    for (int row = wv; row < MROWS; row += nw) {
        bf16_t* pr = Pb + (size_t)row * 1536; const int t = row % TOK; const bool lat = t >= CTX; const int tt = t - CTX;
        float s1 = 0.f, s2 = 0.f;
        if (lane < 48) { const u32x4 w = *(const u32x4*)(pr + 8 * lane); const float a0 = bflo(w.x), a1 = bfhi(w.x), a2 = bflo(w.y), a3 = bfhi(w.y), a4 = bflo(w.z), a5 = bfhi(w.z), a6 = bflo(w.w), a7 = bfhi(w.w);
            s1 = a0 * a0 + a1 * a1 + a2 * a2 + a3 * a3 + a4 * a4 + a5 * a5 + a6 * a6 + a7 * a7; }
        if (lane < 32) { const u32x4 w = *(const u32x4*)(pr + 896 + 8 * lane); const float a0 = bflo(w.x), a1 = bfhi(w.x), a2 = bflo(w.y), a3 = bfhi(w.y), a4 = bflo(w.z), a5 = bfhi(w.z), a6 = bflo(w.w), a7 = bfhi(w.w);
            s2 = a0 * a0 + a1 * a1 + a2 * a2 + a3 * a3 + a4 * a4 + a5 * a5 + a6 * a6 + a7 * a7; }
        s1 = wave_sum(s1); s2 = wave_sum(s2);
        if (lane == 0) { RS[(size_t)row * 2] = rsqrtf(s1 * (1.f / 384.f) + EPS); RS[(size_t)row * 2 + 1] = rsqrtf(s2 * (1.f / 256.f) + EPS); }
#pragma unroll
        for (int ps = 0; ps < 2; ++ps) {
            const int Gi = lane >> 2, qd = lane & 3; const bool on = (ps == 0) || (lane < 16);
            bf16_t* base = pr + (ps == 0 ? 384 : 1184) + 32 * Gi + 4 * qd;
            float x0[4] = {0.f, 0.f, 0.f, 0.f}, x1[4] = {0.f, 0.f, 0.f, 0.f};
            if (on) { const u32x2 w0 = *(const u32x2*)base, w1 = *(const u32x2*)(base + 16);
                x0[0] = bflo(w0.x); x0[1] = bfhi(w0.x); x0[2] = bflo(w0.y); x0[3] = bfhi(w0.y); x1[0] = bflo(w1.x); x1[1] = bfhi(w1.x); x1[2] = bflo(w1.y); x1[3] = bfhi(w1.y); }
            float ss = 0.f;
#pragma unroll
            for (int j = 0; j < 4; ++j) ss += x0[j] * x0[j] + x1[j] * x1[j];
            ss += __shfl_xor(ss, 1); ss += __shfl_xor(ss, 2); ss += __shfl_xor(ss, 4);
            const float rstd = rsqrtf(ss * (1.f / 64.f) + EPS);
            const int gsel = Gi & 1; const float* gn = ps == 0 ? gqn : gkn; const float qs = ps == 0 ? QS64 : 1.f;
            if (on) { float y0[4], y1[4];
#pragma unroll
                for (int j = 0; j < 4; ++j) { const int pidx = 16 * gsel + 4 * qd + j; y0[j] = x0[j] * rstd * gn[2 * pidx]; y1[j] = x1[j] * rstd * gn[2 * pidx + 1];
                    if (lat) { const float cs = cosh_[(size_t)tt * 32 + pidx], sn = sinh_[(size_t)tt * 32 + pidx]; const float a = y0[j] * cs - y1[j] * sn, bb = y0[j] * sn + y1[j] * cs; y0[j] = a; y1[j] = bb; }
                    y0[j] *= qs; y1[j] *= qs; }
                u32x2 w0, w1; w0.x = pk2(y0[0], y0[1]); w0.y = pk2(y0[2], y0[3]); w1.x = pk2(y1[0], y1[1]); w1.y = pk2(y1[2], y1[3]);
                *(u32x2*)base = w0; *(u32x2*)(base + 16) = w1; }
        }
        if (lat && lane < 4) { bf16_t* base = pr + 1152 + 4 * lane; const u32x2 w0 = *(const u32x2*)base, w1 = *(const u32x2*)(base + 16);
            float x0[4] = {bflo(w0.x), bfhi(w0.x), bflo(w0.y), bfhi(w0.y)}, x1[4] = {bflo(w1.x), bfhi(w1.x), bflo(w1.y), bfhi(w1.y)}; float y0[4], y1[4];
#pragma unroll
            for (int j = 0; j < 4; ++j) { const int pidx = 4 * lane + j; const float cs = cosr_[(size_t)tt * 16 + pidx], sn = sinr_[(size_t)tt * 16 + pidx]; y0[j] = x0[j] * cs - x1[j] * sn; y1[j] = x0[j] * sn + x1[j] * cs; }
            u32x2 o0, o1; o0.x = pk2(y0[0], y0[1]); o0.y = pk2(y0[2], y0[3]); o1.x = pk2(y1[0], y1[1]); o1.y = pk2(y1[2], y1[3]);
            *(u32x2*)base = o0; *(u32x2*)(base + 16) = o1; }
    }
}

__device__ __forceinline__ void phase_router(PP P, LAS unsigned char* lds, int c, int G, int layer) {
    const int tid = ltid(), lane = tid & 63, wid = tid >> 6, r32 = lane & 31, hi = lane >> 5;
    const bf16_t* H = (const bf16_t*)(P->ws + WS_H); const bf16_t* HLO = (const bf16_t*)(P->ws + WS_BIG + BIG_HLO);
    const bf16_t* W = (const bf16_t*)(P->ws + (layer ? WS_W1 : WS_W0)) + WO_RT; const bf16_t* WL = W + 64 * 1024;
    const float* brt = P->in[layer ? 33 : 13];
    int* cnt = (int*)(P->ws + WS_CTL + CTL_CNT) + layer * NG; int* srow = (int*)(P->ws + WS_SROW); float* sw = (float*)(P->ws + WS_SW); int* tslot = (int*)(P->ws + WS_TSLOT);
    LAS float* L = (LAS float*)lds + wid * (32 * 65);
    const int ngroups = MROWS / 32;
    for (int gidx = c * 8 + wid; gidx < ngroups; gidx += G * 8) {
        const int row0 = gidx * 32; const int t0 = row0 % TOK;
        if (layer == 1 && t0 < CTX) continue;
        f32x16 a0, a1;
#pragma unroll
        for (int r = 0; r < 16; ++r) { a0[r] = 0.f; a1[r] = 0.f; }
        const bf16_t* hp = H + (size_t)(row0 + r32) * 1024 + 8 * hi; const bf16_t* hl = HLO + (size_t)(row0 + r32) * 1024 + 8 * hi;
        const bf16_t* w0 = W + (size_t)r32 * 1024 + 8 * hi; const bf16_t* wl0 = WL + (size_t)r32 * 1024 + 8 * hi;
#pragma unroll 4
        for (int s = 0; s < 64; ++s) {
            const bf16x8 xh = *(const bf16x8*)(hp + 16 * s), xl = *(const bf16x8*)(hl + 16 * s);
            const bf16x8 wa = *(const bf16x8*)(w0 + 16 * s), wb = *(const bf16x8*)(w0 + 32 * 1024 + 16 * s);
            const bf16x8 la = *(const bf16x8*)(wl0 + 16 * s), lb = *(const bf16x8*)(wl0 + 32 * 1024 + 16 * s);
            a0 = __builtin_amdgcn_mfma_f32_32x32x16_bf16(wa, xh, a0, 0, 0, 0); a1 = __builtin_amdgcn_mfma_f32_32x32x16_bf16(wb, xh, a1, 0, 0, 0);
            a0 = __builtin_amdgcn_mfma_f32_32x32x16_bf16(wa, xl, a0, 0, 0, 0); a1 = __builtin_amdgcn_mfma_f32_32x32x16_bf16(wb, xl, a1, 0, 0, 0);
            a0 = __builtin_amdgcn_mfma_f32_32x32x16_bf16(la, xh, a0, 0, 0, 0); a1 = __builtin_amdgcn_mfma_f32_32x32x16_bf16(lb, xh, a1, 0, 0, 0);
        }
#pragma unroll
        for (int r = 0; r < 16; ++r) { const int e = (r & 3) + 8 * (r >> 2) + 4 * hi; L[r32 * 65 + e] = a0[r]; L[r32 * 65 + e + 32] = a1[r]; }
        __builtin_amdgcn_s_waitcnt(0xC07F);
        __builtin_amdgcn_wave_barrier();
        if (lane < 32) {
            const int row = row0 + lane; float bk[6], bs[6]; int bi[6];
#pragma unroll
            for (int k = 0; k < 6; ++k) { bk[k] = -1e30f; bs[k] = 0.f; bi[k] = 0; }
            for (int e = 0; e < 64; ++e) { const float x = L[lane * 65 + e]; const float sc = 1.f / (1.f + expf(-x)); float key = sc + brt[e]; float s = sc; int id = e;
#pragma unroll
                for (int k = 0; k < 6; ++k) { if (key > bk[k]) { const float tk = bk[k], ts = bs[k]; const int ti = bi[k]; bk[k] = key; bs[k] = s; bi[k] = id; key = tk; s = ts; id = ti; } } }
            float tot = 0.f;
#pragma unroll
            for (int k = 0; k < 6; ++k) tot += bs[k];
            const float sc = 2.5f / tot; const int ch = row / CHUNK_ROWS;
#pragma unroll
            for (int k = 0; k < 6; ++k) { const int e = bi[k]; const int pos = atomicAdd(cnt + ch * NGRP + e, 1);
                if (pos < CAP) srow[(size_t)(ch * 64 + e) * CAP + pos] = row;
                sw[(size_t)row * 8 + k] = bs[k] * sc; tslot[(size_t)row * 6 + k] = (e << 20) | pos; }
        }
        __builtin_amdgcn_wave_barrier();
    }
    if (c == 0 && tid < NCHUNK) cnt[tid * NGRP + NEXP] = layer ? CHUNK_B * SEQ : CHUNK_ROWS;
}

__device__ __forceinline__ void build_toff(LAS int* toff, const int* cnt) {
    const int tid = ltid();
    if (tid < 64) { int v[5], s = 0;
#pragma unroll
        for (int j = 0; j < 5; ++j) { const int g = tid * 5 + j; const int cv = (g < NG) ? ld_ctl(cnt + g) : 0; if (g < NG) toff[272 + g] = cv; v[j] = (cv + 255) >> 8; s += v[j]; }
        int inc = s;
#pragma unroll
        for (int o = 1; o < 64; o <<= 1) { const int t = __shfl_up(inc, o); if (tid >= o) inc += t; }
        int ex = inc - s;
#pragma unroll
        for (int j = 0; j < 5; ++j) { const int g = tid * 5 + j; if (g <= NG) toff[g] = ex; ex += v[j]; } }
    __syncthreads();
}

__device__ __forceinline__ void phase_combine(PP P, LAS unsigned char* lds, int c, int G, int layer, int ch) {
    const int tid_ = ltid(); const int lane = tid_ & 63, wv = c * 8 + (tid_ >> 6), nw = G * 8;
    LAS const int* toff = (LAS const int*)(lds + LDS_TAB);
    const bf16_t* slab = (const bf16_t*)(P->ws + WS_BIG + BIG_SLAB); const int* tslot = (const int*)(P->ws + WS_TSLOT);
    const float* ada = (const float*)(P->ws + WS_ADA) + (size_t)layer * 33 * 6144; const float* ada1 = (const float*)(P->ws + WS_ADA) + (size_t)33 * 6144;
    float* xc = (float*)(P->ws + WS_XC); bf16_t* H = (bf16_t*)(P->ws + WS_H); const float* tokw = (const float*)(P->ws + WS_SW);
    const int t0 = toff[ch * NGRP];
    for (int rr = wv; rr < CHUNK_ROWS; rr += nw) {
        const int row = ch * CHUNK_ROWS + rr; const int b = row / TOK, t = row % TOK; const bool ctx = t < CTX;
        if (ctx && layer == 1) continue;
        int sidx = 0; float swt = 1.f;
        if (lane < 6) { const int v = __hip_atomic_load(tslot + (size_t)row * 6 + lane, __ATOMIC_RELAXED, __HIP_MEMORY_SCOPE_AGENT); sidx = (toff[ch * NGRP + (v >> 20)] - t0) * 256 + (v & 0xfffff);
            swt = __hip_atomic_load(tokw + (size_t)row * 8 + lane, __ATOMIC_RELAXED, __HIP_MEMORY_SCOPE_AGENT); }
        if (lane == 6) { const int rank = layer ? ((b - ch * CHUNK_B) * SEQ + t - CTX) : rr; sidx = (toff[ch * NGRP + NEXP] - t0) * 256 + rank; }
        float* x = ctx ? xc + ((size_t)b * CTX + t) * 1024 : P->out + ((size_t)b * SEQ + t - CTX) * 1024;
        const float* ap = ada + (size_t)(ctx ? 32 : b) * 6144 + 5 * 1024;
        f32x4 xv[4];
#pragma unroll
        for (int i = 0; i < 4; ++i) xv[i] = *(const f32x4*)(x + 512 * (i >> 1) + 8 * lane + 4 * (i & 1));
        float acc[16];
#pragma unroll
        for (int j = 0; j < 16; ++j) acc[j] = 0.f;
#pragma unroll
        for (int k = 0; k < 7; ++k) { const int s = __shfl(sidx, k); const float wk = __shfl(swt, k); const bf16_t* sp = slab + (size_t)s * 1024;
#pragma unroll
            for (int i = 0; i < 2; ++i) { const u32x4 w = __builtin_nontemporal_load((const u32x4*)(sp + 512 * i + 8 * lane));
                acc[8 * i + 0] += wk * bflo(w.x); acc[8 * i + 1] += wk * bfhi(w.x); acc[8 * i + 2] += wk * bflo(w.y); acc[8 * i + 3] += wk * bfhi(w.y);
                acc[8 * i + 4] += wk * bflo(w.z); acc[8 * i + 5] += wk * bfhi(w.z); acc[8 * i + 6] += wk * bflo(w.w); acc[8 * i + 7] += wk * bfhi(w.w); } }
        float v[16]; float ss = 0.f;
#pragma unroll
        for (int i = 0; i < 4; ++i) { const f32x4 gq = *(const f32x4*)(ap + 512 * (i >> 1) + 8 * lane + 4 * (i & 1));
#pragma unroll
            for (int j = 0; j < 4; ++j) { const float y = xv[i][j] + gq[j] * acc[4 * i + j]; v[4 * i + j] = y; ss += y * y; } }
        ss = wave_sum(ss); const float rstd = rsqrtf(ss * (1.f / 1024.f) + EPS);
        if (layer == 0) {
            const float* gm1 = P->in[22]; const float* a1 = ada1 + (size_t)(ctx ? 32 : b) * 6144; float o[16];
#pragma unroll
            for (int i = 0; i < 4; ++i) { const int col = 512 * (i >> 1) + 8 * lane + 4 * (i & 1);
                *(f32x4*)(x + col) = (f32x4){v[4 * i], v[4 * i + 1], v[4 * i + 2], v[4 * i + 3]};
                const f32x4 gg = *(const f32x4*)(gm1 + col), sc = *(const f32x4*)(a1 + 1024 + col), sh = *(const f32x4*)(a1 + col);
#pragma unroll
                for (int j = 0; j < 4; ++j) o[4 * i + j] = v[4 * i + j] * rstd * gg[j] * (1.f + sc[j]) + sh[j]; }
#pragma unroll
            for (int i = 0; i < 2; ++i) { u32x4 w; w.x = pk2(o[8 * i], o[8 * i + 1]); w.y = pk2(o[8 * i + 2], o[8 * i + 3]); w.z = pk2(o[8 * i + 4], o[8 * i + 5]); w.w = pk2(o[8 * i + 6], o[8 * i + 7]);
                *(u32x4*)(H + (size_t)row * 1024 + 512 * i + 8 * lane) = w; }
        } else {
            const float* gf = P->in[40];
#pragma unroll
            for (int i = 0; i < 4; ++i) { const int col = 512 * (i >> 1) + 8 * lane + 4 * (i & 1); const f32x4 gg = *(const f32x4*)(gf + col); f32x4 o;
#pragma unroll
                for (int j = 0; j < 4; ++j) o[j] = v[4 * i + j] * rstd * gg[j];
                *(f32x4*)(x + col) = o; }
        }
    }
}

__device__ __forceinline__ int remap64(int c, int i, int G) { return c + i * G; }
__device__ __forceinline__ int remap8(int c, int G) { return c; }
__device__ __forceinline__ void phase_attn0(PP P, LAS unsigned char* lds, int c, int G) {
    const int tid = ltid(), lane = tid & 63, wid = __builtin_amdgcn_readfirstlane(tid >> 6), r32 = lane & 31;
    const bf16_t* QKV = (const bf16_t*)(P->ws + WS_BIG + BIG_QKV); bf16_t* ATT = (bf16_t*)(P->ws + WS_H);
    const float* sink = P->in[8]; const float* rpb = P->in[9];
    for (int i = 0; c + i * G < 2048; ++i) {
        const int u = remap64(c, i, G); const int b = u >> 6, kvh = (u >> 5) & 1, blk = u & 31; const int g = wid & 3, ts = wid >> 2; const int head = kvh * 4 + g;
        AU a; const int tok = blk * 64 + 32 * ts + r32; const size_t qrow = (size_t)b * TOK + CTX + tok;
        a.qptr = QKV + qrow * 2304 + head * 64; a.optr = ATT + qrow * 1024 + head * 64;
        a.kbase = QKV + 512 + kvh * 64; a.kpitch = 2304; a.vbase = QKV + 640 + kvh * 64; a.vpitch = 2304; a.k2base = nullptr; a.k2pitch = 0;
        a.row_ctx = b * TOK; a.row_lat = b * TOK + CTX; a.start = blk * 64;
        const int jlo = blk >= 2 ? 0 : 2 - blk; int jhi = (2048 + 128 - blk * 64) / 64; jhi = jhi > 5 ? 5 : jhi;
        a.j0 = jlo; a.nt = 4 + (jhi - jlo); a.qoff = 32 * ts + r32; a.m0 = sink[head] * LOG2E; a.l0 = 1.f;
        attn_unit<1, 64>(lds, a);
    }
    for (int i = 0; c + i * G < 2048; ++i) {
        const int u = remap64(c, i, G); const int b = u >> 6, head = (u >> 3) & 7, uu = u & 7;
        { LAS float* bt = (LAS float*)(lds + ATT_RPB);
          for (int idx = tid; idx < 15 * 128; idx += 512) { const int dr = idx >> 7, dc = (idx & 127) - 48; bt[idx] = (dc >= 0 && dc <= 30) ? rpb[(head * 15 + dr) * 31 + dc] * LOG2E : 0.f; } }
        AU a; const int qr = 4 * uu + (wid >> 1), qc = 32 * (wid & 1) + r32; const int tok = qr * 64 + qc; const size_t qrow = (size_t)b * TOK + CTX + tok;
        a.qptr = QKV + qrow * 2304 + 768 + head * 64; a.optr = ATT + qrow * 1024 + 512 + head * 64;
        a.kbase = QKV + 1280 + head * 64; a.kpitch = 2304; a.vbase = QKV + 1792 + head * 64; a.vpitch = 2304; a.k2base = nullptr; a.k2pitch = 0;
        a.row_ctx = b * TOK; a.row_lat = b * TOK + CTX; a.start = 0;
        int rs0 = 4 * uu - 4; rs0 = rs0 < 0 ? 0 : (rs0 > 24 ? 24 : rs0); int rl = 4 * uu - 1; rl = rl < 0 ? 0 : (rl > 24 ? 24 : rl);
        a.j0 = rs0; a.nt = 4 + (rl + 8 - rs0); a.qoff = tok; a.m0 = 0.f; a.l0 = 0.f;
        attn_unit<2, 64>(lds, a);
    }
    for (int u0 = c; u0 < 256; u0 += G) {
        const int u = remap8(u0, G); const int b = u >> 3, kvh = (u >> 2) & 1, cb = u & 3; const int g = wid & 3, ts = wid >> 2; const int head = kvh * 4 + g;
        AU a; const int tok = cb * 64 + 32 * ts + r32; const size_t qrow = (size_t)b * TOK + tok;
        a.qptr = QKV + qrow * 2304 + head * 64; a.optr = ATT + qrow * 1024 + head * 64;
        a.kbase = QKV + 512 + kvh * 64; a.kpitch = 2304; a.vbase = QKV + 640 + kvh * 64; a.vpitch = 2304; a.k2base = nullptr; a.k2pitch = 0;
        a.row_ctx = b * TOK; a.row_lat = 0; a.start = 0; a.j0 = 0; a.nt = 4; a.qoff = 0; a.m0 = sink[head] * LOG2E; a.l0 = 1.f;
        attn_unit<0, 64>(lds, a);
    }
    for (int u0 = c; u0 < 256; u0 += G) {
        const int u = remap8(u0, G); const int b = u >> 3, head = u & 7;
        AU a; const int tok = 32 * wid + r32; const size_t qrow = (size_t)b * TOK + tok;
        a.qptr = QKV + qrow * 2304 + 768 + head * 64; a.optr = ATT + qrow * 1024 + 512 + head * 64;
        a.kbase = QKV + 1280 + head * 64; a.kpitch = 2304; a.vbase = QKV + 1792 + head * 64; a.vpitch = 2304; a.k2base = nullptr; a.k2pitch = 0;
        a.row_ctx = b * TOK; a.row_lat = 0; a.start = 0; a.j0 = 0; a.nt = 4; a.qoff = 0; a.m0 = 0.f; a.l0 = 0.f;
        attn_unit<0, 64>(lds, a);
    }
}
__device__ __forceinline__ void phase_attn1(PP P, LAS unsigned char* lds, int c, int G) {
    const int tid = ltid(), lane = tid & 63, wid = __builtin_amdgcn_readfirstlane(tid >> 6), r32 = lane & 31;
    const bf16_t* PB = (const bf16_t*)(P->ws + WS_BIG + BIG_P); const bf16_t* QM = (const bf16_t*)(P->ws + WS_BIG + BIG_QM); const bf16_t* KVX = (const bf16_t*)(P->ws + WS_BIG + BIG_KVX);
    bf16_t* ATT = (bf16_t*)(P->ws + WS_H);
    for (int u = c; u < 1024; u += G) {
        const int b = u >> 5, head = (u >> 2) & 7, qb = u & 3;
        AU2 a; const int tok = qb * 512 + 64 * wid + r32; const size_t qrow = (size_t)b * TOK + CTX + tok;
        a.qptr = QM + qrow * 768 + head * 96; a.qpitch = 768; a.optr = ATT + qrow * 1024 + head * 64;
        a.kbase = KVX + head * 128; a.kpitch = 1024; a.vbase = KVX + head * 128 + 64; a.vpitch = 1024; a.k2base = PB + 1152; a.k2pitch = 1536;
        a.row_ctx = b * TOK; a.nt = 36;
        attn_unit2<96, false>(lds, a);
    }
    float gq = fabsf(P->in[28][lane]), gk = fabsf(P->in[29][lane]);
#pragma unroll
    for (int o = 32; o > 0; o >>= 1) { gq = fmaxf(gq, __shfl_xor(gq, o)); gk = fmaxf(gk, __shfl_xor(gk, o)); }
    const bool bounded = __builtin_amdgcn_readfirstlane((int)(64.f * gq * gk * QS64 < 100.f)) != 0;
    for (int u = c; u < 1024; u += G) {
        const int b = u >> 5, kvh = (u >> 4) & 1, blk = u & 15;
        if (bounded) {
            const int g = wid & 3, hf = wid >> 2; const int head = kvh * 4 + g;
            AU2 a; const int tok = blk * 128 + 64 * hf + r32; const size_t qrow = (size_t)b * TOK + CTX + tok;
            a.qptr = PB + qrow * 1536 + 384 + head * 64; a.qpitch = 1536; a.optr = ATT + qrow * 1024 + 512 + head * 64;
            a.kbase = PB + 1184 + kvh * 64; a.kpitch = 1536; a.vbase = PB + 1312 + kvh * 64; a.vpitch = 1536; a.k2base = nullptr; a.k2pitch = 0;
            a.row_ctx = b * TOK; a.nt = 36;
            attn_unit2<64, true>(lds, a);
        } else {
            for (int hfb = 0; hfb < 2; ++hfb) { const int g = wid & 3, ts = wid >> 2; const int head = kvh * 4 + g;
                AU a; const int tok = blk * 128 + 64 * hfb + 32 * ts + r32; const size_t qrow = (size_t)b * TOK + CTX + tok;
                a.qptr = PB + qrow * 1536 + 384 + head * 64; a.optr = ATT + qrow * 1024 + 512 + head * 64;
                a.kbase = PB + 1184 + kvh * 64; a.kpitch = 1536; a.vbase = PB + 1312 + kvh * 64; a.vpitch = 1536; a.k2base = nullptr; a.k2pitch = 0;
                a.row_ctx = b * TOK; a.row_lat = 0; a.start = 0; a.j0 = 0; a.nt = 36; a.qoff = 0; a.m0 = 0.f; a.l0 = 0.f;
                attn_unit<0, 64>(lds, a); }
        }
    }
}

constexpr int PH_MOE0 = 7, PH_L1 = PH_MOE0 + 1 + 2 * NCHUNK, PH_MOE1 = PH_L1 + 7, NPH = PH_MOE1 + 1 + 2 * NCHUNK;
template <int PH>
__device__ __forceinline__ void run_phase(LAS unsigned char* lds, int c, int G) {
    const PP P = get_pp();
    const float* rp = (const float*)(P->ws + WS_ROPE);
    const float* ada0 = (const float*)(P->ws + WS_ADA); const float* ada1 = ada0 + (size_t)33 * 6144;
    bf16_t* W0 = (bf16_t*)(P->ws + WS_W0); bf16_t* W1 = (bf16_t*)(P->ws + WS_W1);
    bf16_t* H = (bf16_t*)(P->ws + WS_H); char* BIG = P->ws + WS_BIG; float* XC = (float*)(P->ws + WS_XC);
    if constexpr (PH == 0) { phase_prologue(P, lds, c, G); }
    else if constexpr (PH == 1) { phase_norm(P, c, G, P->in[0], P->in[2], P->in[6], ada0, 0, 1024, false, H, nullptr); }
    else if constexpr (PH == 2) {
        gm::DenseSched S; S.init(0, 9, G, c); gm::Desc d{(const char*)H, 2048u, (const char*)(W0 + WO_IN), 2048u, 1024};
        gm::EpiQKV0 E{(bf16_t*)(BIG + BIG_QKV), rp, rp + 2048 * 32}; gm::gemm_phase(lds, d, S, E); }
    else if constexpr (PH == 3) { phase_attn0(P, lds, ONE_LAUNCH ? (int)*(volatile LAS int*)(lds + LDS_BARW + 8) : c, G); }
    else if constexpr (PH == 4) {
        gm::DenseSched S; S.init(0, 4, G, c); gm::Desc d{(const char*)H, 2048u, (const char*)(W0 + WO_OUT), 2048u, 1024};
        gm::EpiP1 E{(bf16_t*)(BIG + BIG_HLO), 1024, nullptr, 0}; gm::gemm_phase(lds, d, S, E); }
    else if constexpr (PH == 5) { phase_norm(P, c, G, P->in[0], P->in[2], P->in[11], ada0, 3072, 4096, false, H, (bf16_t*)(BIG + BIG_HLO), true, P->out, XC); }
    else if constexpr (PH == 6) { phase_router(P, lds, c, G, 0); }
    else if constexpr (PH == PH_L1) {
        gm::DenseSched S; S.init(0, 6, G, c); gm::Desc d{(const char*)H, 2048u, (const char*)(W1 + WO_IN), 2048u, 1024};
        gm::EpiP1 E{(bf16_t*)(BIG + BIG_P), 1536, nullptr, 0}; gm::gemm_phase(lds, d, S, E); }
    else if constexpr (PH == PH_L1 + 1) { phase_post1(P, c, G); }
    else if constexpr (PH == PH_L1 + 2) {
        { gm::DenseSched S; S.init(1, 3, G, c); gm::Desc d{(const char*)(BIG + BIG_P), 3072u, (const char*)(W1 + WO_UQ), 768u, 384};
          gm::EpiUQ E{(bf16_t*)(BIG + BIG_QM), (const float*)(P->ws + WS_RSTD), rp + 2 * 2048 * 32, rp + 2 * 2048 * 32 + 2048 * 16}; gm::gemm_phase(lds, d, S, E); }
        { gm::DenseSched S; S.init(0, 4, G, c); gm::Desc d{(const char*)(BIG + BIG_P) + 896 * 2, 3072u, (const char*)(W1 + WO_UKV), 512u, 256};
          gm::EpiP1 E{(bf16_t*)(BIG + BIG_KVX), 1024, (const float*)(P->ws + WS_RSTD), 1}; gm::gemm_phase(lds, d, S, E); } }
    else if constexpr (PH == PH_L1 + 3) { phase_attn1(P, lds, ONE_LAUNCH ? (int)*(volatile LAS int*)(lds + LDS_BARW + 8) : c, G); }
    else if constexpr (PH == PH_L1 + 4) {
        gm::DenseSched S; S.init(1, 4, G, c); gm::Desc d{(const char*)H, 2048u, (const char*)(W1 + WO_OUT), 2048u, 1024};
        gm::EpiP1 E{(bf16_t*)(BIG + BIG_HLO), 1024, nullptr, 0}; gm::gemm_phase(lds, d, S, E); }
    else if constexpr (PH == PH_L1 + 5) { phase_norm(P, c, G, P->out, XC, P->in[31], ada1, 3072, 4096, true, H, (bf16_t*)(BIG + BIG_HLO), true, P->out, XC); }
    else if constexpr (PH == PH_L1 + 6) { phase_router(P, lds, c, G, 1); }
    else {
        constexpr int layer = PH >= PH_MOE1 ? 1 : 0; constexpr int rel = PH - (layer ? PH_MOE1 : PH_MOE0);
        const int* cnt = (const int*)(P->ws + WS_CTL + CTL_CNT) + layer * NG;
        LAS int* toff = (LAS int*)(lds + LDS_TAB);
        bf16_t* W = layer ? W1 : W0;
        build_toff(toff, cnt);
        const int pidx = ONE_LAUNCH ? (int)*(volatile LAS int*)(lds + LDS_BARW + 8) : c;
        const int mxq = ONE_LAUNCH ? pidx / (G >> 3) : (c & 7), mxj = ONE_LAUNCH ? pidx % (G >> 3) : (c >> 3);
        if constexpr (rel == 0) {
            gm::MoeSched<1> S; S.toff = toff; S.slot_row = (const int*)(P->ws + WS_SROW); S.t_lo = 0; S.t_hi = toff[NG]; S.nN = 2; S.G = G; S.c = c; S.bN = 512; S.layer = layer; S.xq = mxq; S.xj = mxj;
            gm::Desc d{(const char*)H, 2048u, (const char*)(W + WO_GU), 2048u, 1024};
            gm::EpiG1 E{(bf16_t*)(BIG + BIG_ACT)}; gm::gemm_phase(lds, d, S, E);
        } else if constexpr ((rel & 1) == 1) {
            constexpr int ch = (rel - 1) >> 1;
            gm::MoeSched<2> S; S.toff = toff; S.slot_row = nullptr; S.t_lo = toff[ch * NGRP]; S.t_hi = toff[(ch + 1) * NGRP]; S.nN = 4; S.G = G; S.c = c; S.bN = 1024; S.layer = layer; S.xq = mxq; S.xj = mxj;
            gm::Desc d{(const char*)(BIG + BIG_ACT), 512u, (const char*)(W + WO_D), 512u, 256};
            gm::EpiG2 E{(bf16_t*)(BIG + BIG_SLAB), toff[ch * NGRP] * 256};
            gm::gemm_phase(lds, d, S, E);
        } else {
            constexpr int ch = (rel - 2) >> 1;
            phase_combine(P, lds, c, G, layer, ch);
        }
    }
}

template <int PH> struct PhaseLoop {
    static __device__ __forceinline__ void run(LAS unsigned char* lds, const XcdBarrier& bar) {
        run_phase<PH>(lds, (int)blockIdx.x, (int)gridDim.x);
        if constexpr (PH + 1 < NPH) { xcd_barrier(bar); PhaseLoop<PH + 1>::run(lds, bar); }
    }
};

extern __shared__ __attribute__((aligned(16))) unsigned char smem_raw[];

#if ONE_LAUNCH
__global__ void __launch_bounds__(512, 2) mega_fwd(Params Pk) {
    LAS unsigned char* lds = (LAS unsigned char*)smem_raw;
    volatile LAS unsigned* st = (volatile LAS unsigned*)(lds + LDS_BARW);
    if (threadIdx.x == 0) { st[0] = 0u; st[1] = 0u; st[2] = 0u; st[3] = 0u; }
    __syncthreads();
    XcdBarrier bar = xcd_barrier_post((unsigned*)(Pk.ws + WS_CTL), st);
    int* xr = (int*)(Pk.ws + WS_CTL + CTL_XRANK);
    int myrank = 0; if (threadIdx.x == 0) myrank = atomicAdd(xr + 64 * (int)bar.x, 1);
    run_phase<0>(lds, (int)blockIdx.x, (int)gridDim.x);
    xcd_barrier(bar);
    if (threadIdx.x == 0) { int base = 0; for (int j = 0; j < (int)bar.x; ++j) base += ld_ctl(xr + 64 * j); st[2] = (unsigned)(base + myrank); }
    __syncthreads();
    PhaseLoop<1>::run(lds, bar);
}
#else
template <int PH> __global__ void __launch_bounds__(512, 2) phase_kernel(Params Pk) {
    LAS unsigned char* lds = (LAS unsigned char*)smem_raw;
    run_phase<PH>(lds, (int)blockIdx.x, (int)gridDim.x);
}
template <int PH> struct PhaseLaunch {
    static void run(const Params& P, int grid, hipStream_t s) {
        (void)hipFuncSetAttribute((const void*)phase_kernel<PH>, hipFuncAttributeMaxDynamicSharedMemorySize, LDS_BYTES);
        hipLaunchKernelGGL(phase_kernel<PH>, dim3(grid), dim3(512), LDS_BYTES, s, P);
        if constexpr (PH + 1 < NPH) PhaseLaunch<PH + 1>::run(P, grid, s);
    }
};
#endif

extern "C" void kernel_launch(void* const* d_in, const int* in_sizes, int n_in, void* d_out, int out_size, void* d_ws, size_t ws_size, hipStream_t stream) {
    static int grid = 0;
    if (n_in != 41 || ws_size < WS_END) { fprintf(stderr, "kernel_launch: need 41 inputs and %zu bytes of workspace (got %d, %zu)\n", (size_t)WS_END, n_in, ws_size); return; }
    if (!grid) {
        int dev = 0, cus = 0;
        (void)hipGetDevice(&dev); (void)hipDeviceGetAttribute(&cus, hipDeviceAttributeMultiprocessorCount, dev);
#if ONE_LAUNCH
        (void)hipFuncSetAttribute((const void*)mega_fwd, hipFuncAttributeMaxDynamicSharedMemorySize, LDS_BYTES);
        int per_cu = 0; (void)hipOccupancyMaxActiveBlocksPerMultiprocessor(&per_cu, (const void*)mega_fwd, 512, LDS_BYTES);
        if (per_cu < 1) fprintf(stderr, "kernel_launch: occupancy query says %d blocks per CU\n", per_cu);
#endif
        grid = cus > 0 ? cus : 256;
    }
    Params P{};
    for (int i = 0; i < 41; ++i) P.in[i] = (const float*)d_in[i];
    P.out = (float*)d_out; P.ws = (char*)d_ws;
    (void)hipMemsetAsync((char*)d_ws + WS_CTL, 0, CTL_BYTES, stream);
#if ONE_LAUNCH
    hipLaunchKernelGGL(mega_fwd, dim3(grid), dim3(512), LDS_BYTES, stream, P);
#else
    PhaseLaunch<0>::run(P, grid, stream);
#endif
}
```

```cpp
#include <hip/hip_runtime.h>
#include <stdint.h>
#include <stdio.h>

#ifndef ONE_LAUNCH
#define ONE_LAUNCH 1
#endif

#define LAS __attribute__((address_space(3)))
typedef unsigned short bf16_t;
typedef short bf16x8 __attribute__((ext_vector_type(8)));
typedef short s16x4 __attribute__((ext_vector_type(4)));
typedef float f32x4 __attribute__((ext_vector_type(4)));
typedef float f32x16 __attribute__((ext_vector_type(16)));
typedef unsigned u32x4 __attribute__((ext_vector_type(4)));
typedef unsigned u32x2 __attribute__((ext_vector_type(2)));

constexpr int NB = 32, SEQ = 2048, DM = 1024, CTX = 256, TOK = CTX + SEQ, MROWS = NB * TOK;
constexpr int NEXP = 64, NGRP = 65, NCHUNK = 4, NG = NCHUNK * NGRP;
constexpr int CAP = MROWS / NCHUNK;
constexpr int CHUNK_ROWS = MROWS / NCHUNK;
constexpr int CHUNK_B = NB / NCHUNK;
constexpr float LOG2E = 1.4426950408889634f;
constexpr float QS64 = 0.125f * LOG2E;
constexpr float QS96 = 0.10206207261596575f * LOG2E;
constexpr float EPS = 1e-6f;

constexpr size_t MiB = 1048576;
constexpr size_t WS_CTL = 0;
constexpr size_t CTL_BYTES = 65536;
constexpr size_t CTL_CNT = 16384;
constexpr size_t CTL_XRANK = 24576;
constexpr size_t WS_ADA = 65536;
constexpr size_t WS_ROPE = WS_ADA + 2 * MiB;
constexpr size_t WO_IN = 0, WO_OUT = WO_IN + 2304 * 1024, WO_RT = WO_OUT + 1024 * 1024, WO_UQ = WO_RT + 2 * 64 * 1024, WO_UKV = WO_UQ + 768 * 384,
                 WO_GU = WO_UKV + 1024 * 256, WO_D = WO_GU + (size_t)65 * 512 * 1024, W_ELEMS = WO_D + (size_t)65 * 1024 * 256;
constexpr size_t W_BYTES = ((W_ELEMS * 2 + 255) / 256) * 256;
constexpr size_t WS_W0 = WS_ROPE + 1 * MiB;
constexpr size_t WS_W1 = WS_W0 + W_BYTES;
constexpr size_t WS_XC = WS_W1 + W_BYTES;
constexpr size_t WS_H = WS_XC + 32 * MiB;
constexpr size_t WS_RSTD = WS_H + 144 * MiB;
constexpr size_t WS_SROW = WS_RSTD + 1 * MiB;
constexpr size_t WS_SW = WS_SROW + (size_t)NCHUNK * 64 * CAP * 4;
constexpr size_t WS_TSLOT = WS_SW + (size_t)NCHUNK * 64 * CAP * 4;
constexpr size_t WS_BIG = ((WS_TSLOT + (size_t)MROWS * 6 * 4 + 255) / 256) * 256;
constexpr size_t BIG_QKV = 0;
constexpr size_t BIG_P = 0;
constexpr size_t BIG_QM = BIG_P + (size_t)MROWS * 1536 * 2;
constexpr size_t BIG_KVX = BIG_QM + (size_t)MROWS * 768 * 2;
constexpr size_t BIG_HLO = 0;
constexpr size_t MAXSLOT = (size_t)MROWS * 7 + (size_t)NG * 256;
constexpr size_t BIG_ACT = 0;
constexpr size_t BIG_SLAB = BIG_ACT + MAXSLOT * 512;
constexpr size_t SLAB_SLOTS = (size_t)CHUNK_ROWS * 7 + (size_t)NGRP * 256;
constexpr size_t WS_END = WS_BIG + BIG_SLAB + SLAB_SLOTS * 2048;

constexpr int LDS_BYTES = 139264;
constexpr int LDS_TAB = 131072;
constexpr int LDS_BARW = LDS_BYTES - 16;

struct Params {
    const float* in[41];
    float* out;
    char* ws;
};
typedef const Params __attribute__((address_space(4)))* PP;
__device__ __forceinline__ PP get_pp() { PP p = (PP)__builtin_amdgcn_kernarg_segment_ptr(); asm volatile("" : "+s"(p)); return p; }
__device__ __forceinline__ int ltid() { int t = threadIdx.x; asm volatile("" : "+v"(t)); return t; }

__device__ __forceinline__ unsigned pk2(float lo, float hi) {
    typedef float f2 __attribute__((ext_vector_type(2))); typedef __bf16 b2 __attribute__((ext_vector_type(2)));
    f2 v = {lo, hi}; b2 b = __builtin_convertvector(v, b2); return __builtin_bit_cast(unsigned, b);
}
__device__ __forceinline__ float bflo(unsigned u) { return __uint_as_float(u << 16); }
__device__ __forceinline__ float bfhi(unsigned u) { return __uint_as_float(u & 0xffff0000u); }
__device__ __forceinline__ float wave_sum(float v) {
#pragma unroll
    for (int o = 32; o > 0; o >>= 1) v += __shfl_xor(v, o);
    return v;
}
__device__ __forceinline__ int ld_ctl(const int* p) { return __hip_atomic_load(p, __ATOMIC_RELAXED, __HIP_MEMORY_SCOPE_AGENT); }

#define XB_TMO      128
#define XB_XCNT(j)  (256  + 64 * (j))
#define XB_XSUB(j)  (1280 + 64 * (j))
#define XB_XGEN(j)  (2304 + 64 * (j))
#define XB_TOP      3328
#define XB_TOPGEN   3392
#define XCD_BAR_WORDS 3456
#define XB_SPIN_CAP (1u << 18)

__device__ __forceinline__ unsigned xb_ld(unsigned* p)              { return __hip_atomic_load(p, __ATOMIC_RELAXED, __HIP_MEMORY_SCOPE_AGENT); }
__device__ __forceinline__ unsigned xb_add(unsigned* p, unsigned v) { return __hip_atomic_fetch_add(p, v, __ATOMIC_RELAXED, __HIP_MEMORY_SCOPE_AGENT); }
__device__ __forceinline__ unsigned xb_xcc_id() { return (unsigned)__builtin_amdgcn_s_getreg((3 << 11) | 20) & 0xFu; }
#define XB_SPIN(cond, bar) do { unsigned _sp = 0; while (cond) { __builtin_amdgcn_s_sleep(1); \
    if ((++_sp & 255u) == 0u) { if (xb_ld(&(bar)[XB_TMO])) break; if (_sp > XB_SPIN_CAP) { atomicAdd(&(bar)[XB_TMO], 1u); break; } } } } while (0)

struct XcdBarrier { unsigned* bar; unsigned x; volatile LAS unsigned* st; };

__device__ __forceinline__ XcdBarrier xcd_barrier_post(unsigned* bar, volatile LAS unsigned* st) {
    XcdBarrier b; b.bar = bar; b.x = xb_xcc_id(); b.st = st;
    if (threadIdx.x == 0) (void)xb_add(&bar[XB_XCNT(b.x)], 1u);
    return b;
}
__device__ __forceinline__ void xcd_barrier_complete(unsigned* bar, unsigned x, unsigned& nloc, unsigned& nx) {
    const unsigned G = gridDim.x * gridDim.y * gridDim.z;
    unsigned sum, cnt, mine, sp = 0u;
    for (;;) {
        sum = 0u; cnt = 0u; mine = 0u;
#pragma unroll
        for (unsigned j = 0; j < 16; ++j) { const unsigned c = xb_ld(&bar[XB_XCNT(j)]); sum += c; cnt += (c > 0u) ? 1u : 0u; mine = (j == x) ? c : mine; }
        if (sum == G) break;
        __builtin_amdgcn_s_sleep(1);
        if ((++sp & 255u) == 0u) { if (xb_ld(&bar[XB_TMO])) break; if (sp > XB_SPIN_CAP) { atomicAdd(&bar[XB_TMO], 1u); break; } }
    }
    nloc = mine > 0u ? mine : 1u; nx = cnt > 0u ? cnt : 1u;
}
__device__ __forceinline__ void xcd_barrier(const XcdBarrier& b) {
    asm volatile("s_waitcnt vmcnt(0)" ::: "memory");
    __syncthreads();
    if (threadIdx.x == 0) {
        unsigned* bar = b.bar;
        __builtin_amdgcn_s_waitcnt(0);
        unsigned nloc = b.st[0], nx = b.st[1];
        if (nloc == 0u) { xcd_barrier_complete(bar, b.x, nloc, nx); b.st[0] = nloc; b.st[1] = nx; }
        const unsigned old = xb_add(&bar[XB_XSUB(b.x)], 1u);
        const unsigned gen = old / nloc;
        if (old + 1u == (gen + 1u) * nloc) {
            __builtin_amdgcn_fence(__ATOMIC_RELEASE, "agent");
            asm volatile("s_waitcnt vmcnt(0)" ::: "memory");
            const unsigned og = xb_add(&bar[XB_TOP], 1u);
            const unsigned tg = og / nx;
            if (og + 1u == (tg + 1u) * nx) xb_add(&bar[XB_TOPGEN], 1u);
            else XB_SPIN(xb_ld(&bar[XB_TOPGEN]) == tg, bar);
            __builtin_amdgcn_fence(__ATOMIC_ACQUIRE, "agent");
            xb_add(&bar[XB_XGEN(b.x)], 1u);
            asm volatile("s_waitcnt vmcnt(0)" ::: "memory");
        } else {
            XB_SPIN(xb_ld(&bar[XB_XGEN(b.x)]) == gen, bar);
            __builtin_amdgcn_fence(__ATOMIC_ACQUIRE, "agent");
            asm volatile("s_waitcnt vmcnt(0)" ::: "memory");
        }
    }
    __syncthreads();
}

namespace gm {
constexpr int BM = 256, BK = 64, HALF = 128, HTB = HALF * BK * 2, STAGE_BYTES = 8 * HTB, NXCD = 8, WGM = 8;
__device__ __forceinline__ int lds_byte(int r, int c) { const int st = (r >> 4) * 2 + (c >> 5), rr = r & 15, cc = c & 31, ob = rr * 64 + cc * 2; return st * 1024 + (ob ^ (((ob >> 9) & 1) << 5)); }
__device__ __forceinline__ void stage_rc(int b, int& R, int& C) { const int st = b / 1024, sb = b % 1024, swz = sb ^ (((sb >> 9) & 1) << 5); R = (st >> 1) * 16 + swz / 64; C = (st & 1) * 32 + (swz % 64) / 2; }
__device__ __forceinline__ int perm32(int rho) { const int n = rho >> 4, i = rho & 15; return 8 * (i >> 2) + 4 * n + (i & 3); }

struct Unit { int pm, pn, g, mt, cnt, sbase; };
struct Desc { const char* A; unsigned lda; const char* B; unsigned ldb; int K; };

struct DenseSched {
    int nMt, nN, nwg, G, c, mmode;
    __device__ __forceinline__ void init(int mmode_, int nN_, int G_, int c_) { mmode = mmode_; nMt = mmode_ ? 256 : 288; nN = nN_; nwg = nMt * nN_; G = G_; c = c_; }
    __device__ __forceinline__ bool next(int i, Unit& u) const {
        const long L = (long)i * G + c; if (L >= nwg) return false;
        int wgid = (int)L; { const int q = nwg / NXCD, r = nwg % NXCD, xcd = wgid % NXCD, off = wgid / NXCD; wgid = (xcd < r ? xcd * (q + 1) : r * (q + 1) + (xcd - r) * q) + off; }
        const int nig = WGM * nN, gid = wgid / nig, fm = gid * WGM, gsz = (nMt - fm) < WGM ? (nMt - fm) : WGM;
        const int pmi = fm + ((wgid % nig) % gsz); u.pn = (wgid % nig) / gsz;
        u.pm = mmode ? (pmi >> 3) * 9 + 1 + (pmi & 7) : pmi; u.g = 0; u.mt = 0; u.cnt = 256; u.sbase = 0; return true;
    }
    __device__ __forceinline__ int a_row(const Unit& u, int r) const { return u.pm * 256 + r; }
    __device__ __forceinline__ int a_raw(const Unit&, int) const { return 0; }
    __device__ __forceinline__ int a_fin(const Unit& u, int r, int) const { return u.pm * 256 + r; }
    __device__ __forceinline__ int b_row(const Unit& u) const { return u.pn * 256; }
};

template <int WHICH  >
struct MoeSched {
    LAS const int* toff; const int* slot_row; int nN, G, c, bN, layer, t_lo, t_hi, xq, xj;
    __device__ __forceinline__ bool next(int i, Unit& u) const {
        const int per = G >> 3, nt_ = t_hi - t_lo;
        const int xs = t_lo + (int)(((long)nt_ * xq) >> 3), xe = t_lo + (int)(((long)nt_ * (xq + 1)) >> 3);
        const int L = i * per + xj; if (L >= (xe - xs) * nN) return false;
        const int tau = L / nN; u.pn = L - tau * nN; const int T = xs + tau;
        int lo = 0, hi = NG;
        while (hi - lo > 1) { const int mid = (lo + hi) >> 1; if (toff[mid] <= T) lo = mid; else hi = mid; }
        u.g = lo; u.mt = T - toff[lo]; u.pm = T; u.sbase = T * 256; u.cnt = toff[272 + lo]; return true;
    }
    __device__ __forceinline__ int a_row(const Unit& u, int r) const {
        if (WHICH == 2) return u.sbase + r;
        const int e = u.g % NGRP, ch = u.g / NGRP, idx = u.mt * 256 + r;
        const bool in = (e < NEXP) && (idx < u.cnt);
        const int lrow = slot_row[(size_t)(ch * 64 + (e < NEXP ? e : 0)) * CAP + (in ? idx : 0)];
        const int b1 = ch * CHUNK_B + (idx >> 11);
        const int srow = (layer == 0) ? (ch * CHUNK_ROWS + idx) : (b1 * TOK + CTX + (idx & 2047));
        return (e == NEXP) ? srow : (in ? lrow : 0);
    }
    __device__ __forceinline__ int a_raw(const Unit& u, int r) const {
        if (WHICH == 2) return 0;
        const int e = u.g % NGRP, ch = u.g / NGRP, idx = u.mt * 256 + r; const bool in = (e < NEXP) && (idx < u.cnt);
        return slot_row[(size_t)(ch * 64 + (e < NEXP ? e : 0)) * CAP + (in ? idx : 0)];
    }
    __device__ __forceinline__ int a_fin(const Unit& u, int r, int raw) const {
        if (WHICH == 2) return u.sbase + r;
        const int e = u.g % NGRP, ch = u.g / NGRP, idx = u.mt * 256 + r; const bool in = (e < NEXP) && (idx < u.cnt);
        const int b1 = ch * CHUNK_B + (idx >> 11);
        const int srow = (layer == 0) ? (ch * CHUNK_ROWS + idx) : (b1 * TOK + CTX + (idx & 2047));
        return (e == NEXP) ? srow : (in ? raw : 0);
    }
    __device__ __forceinline__ int b_row(const Unit& u) const { return (u.g % NGRP) * bN + u.pn * 256; }
};

template <class Epi, class Sched>
__device__ __forceinline__ void gemm_phase(LAS unsigned char* lds, const Desc g, const Sched& S, const Epi& E) {
    const int tid = ltid(), wid = __builtin_amdgcn_readfirstlane(tid >> 6), lane = tid & 63, wr = wid >> 2, wc = wid & 3, fr = lane & 15, fq = lane >> 4;
    const int nt = g.K / BK;
    unsigned voffB[2][2];
#pragma unroll
    for (int i = 0; i < 2; ++i) { int R, C; stage_rc(tid * 16 + i * 8192, R, C); const int Rl = Epi::PERM ? perm32(R & 31) : (R & 31);
#pragma unroll
        for (int h = 0; h < 2; ++h) { const int Rb = Epi::WIDE ? (64 * (R >> 5) + 32 * h + Rl) : (128 * h + (R & ~31) + Rl);
            voffB[h][i] = (unsigned)Rb * g.ldb + (unsigned)C * 2u; } }
    const size_t kstep = (size_t)(BK * 2);
    const unsigned ldsw = (unsigned)wid * 1024u;
    const int aoff = lds_byte(wr * 64 + fr, fq * 8), boff = lds_byte(wc * 32 + fr, fq * 8);
#define GM_SA(b, h) (((b) * 2 + (h)) * HTB)
#define GM_SB(b, h) ((4 + (b) * 2 + (h)) * HTB)
#define GM_STAGE_A(bufoff, kb, va, h) do { _Pragma("unroll") for (int _i = 0; _i < 2; ++_i) \
        __builtin_amdgcn_global_load_lds((const unsigned*)(g.A + (kb) + (va)[h][_i]), (LAS unsigned*)(lds + (bufoff) + ldsw + _i * 8192), 16, 0, 0); } while (0)
#define GM_STAGE_B(bufoff, bp, h) do { _Pragma("unroll") for (int _i = 0; _i < 2; ++_i) \
        __builtin_amdgcn_global_load_lds((const unsigned*)((bp) + voffB[h][_i]), (LAS unsigned*)(lds + (bufoff) + ldsw + _i * 8192), 16, 0, 0); } while (0)
#define GM_LDA(dst, b, h) do { _Pragma("unroll") for (int m = 0; m < 4; ++m) _Pragma("unroll") for (int k = 0; k < 2; ++k) dst[m][k] = *(const LAS bf16x8*)(lds + GM_SA(b, h) + aoff + m * 2048 + k * 1024); } while (0)
#define GM_LDB(dst, b, h) do { _Pragma("unroll") for (int n = 0; n < 2; ++n) _Pragma("unroll") for (int k = 0; k < 2; ++k) dst[n][k] = *(const LAS bf16x8*)(lds + GM_SB(b, h) + boff + n * 2048 + k * 1024); } while (0)
#define GM_MMA(ai, bj, At, Bt) do { __builtin_amdgcn_s_setprio(1); _Pragma("unroll") for (int m = 0; m < 4; ++m) _Pragma("unroll") for (int n = 0; n < 2; ++n) _Pragma("unroll") for (int k = 0; k < 2; ++k) \
        acc[ai][bj][m][n] = __builtin_amdgcn_mfma_f32_16x16x32_bf16(Bt[n][k], At[m][k], acc[ai][bj][m][n], 0, 0, 0); __builtin_amdgcn_s_setprio(0); } while (0)
#define GM_WAIT_V(n) do { asm volatile("" ::: "memory"); __builtin_amdgcn_s_waitcnt(((n) & 15) | (((n) >> 4) << 14) | 0x0F70); asm volatile("" ::: "memory"); } while (0)
#define GM_WAIT_L(n) asm volatile("s_waitcnt lgkmcnt(" #n ")" ::: "memory")
#define GM_BAR __builtin_amdgcn_s_barrier()
#define GM_SCHED __builtin_amdgcn_sched_barrier(0)
#define GM_CALC_VA(va, u) do { int _tz = tid; asm volatile("" : "+v"(_tz)); int _rw[2][2]; unsigned _cc[2]; \
        _Pragma("unroll") for (int _i = 0; _i < 2; ++_i) { int _R, _C; stage_rc(_tz * 16 + _i * 8192, _R, _C); _cc[_i] = (unsigned)_C * 2u; \
            _Pragma("unroll") for (int _h = 0; _h < 2; ++_h) _rw[_h][_i] = S.a_row((u), _h * HALF + _R); } \
        _Pragma("unroll") for (int _i = 0; _i < 2; ++_i) _Pragma("unroll") for (int _h = 0; _h < 2; ++_h) (va)[_h][_i] = (unsigned)_rw[_h][_i] * g.lda + _cc[_i]; } while (0)
#define GM_LOAD_RAW(raw, u) do { int _tz = tid; asm volatile("" : "+v"(_tz)); \
        _Pragma("unroll") for (int _i = 0; _i < 2; ++_i) { int _R, _C; stage_rc(_tz * 16 + _i * 8192, _R, _C); \
            _Pragma("unroll") for (int _h = 0; _h < 2; ++_h) (raw)[_h][_i] = S.a_raw((u), _h * HALF + _R); } } while (0)
#define GM_FIN_VA(va, u, raw) do { int _tz = tid; asm volatile("" : "+v"(_tz)); \
        _Pragma("unroll") for (int _i = 0; _i < 2; ++_i) { int _R, _C; stage_rc(_tz * 16 + _i * 8192, _R, _C); \
            _Pragma("unroll") for (int _h = 0; _h < 2; ++_h) (va)[_h][_i] = (unsigned)S.a_fin((u), _h * HALF + _R, (raw)[_h][_i]) * g.lda + (unsigned)_C * 2u; } } while (0)
    Unit cur, nxt; int ui = 0;
    if (!S.next(0, cur)) return;
    f32x4 acc[2][2][4][2];
#pragma unroll
    for (int a = 0; a < 2; ++a)
#pragma unroll
        for (int b = 0; b < 2; ++b)
#pragma unroll
            for (int m = 0; m < 4; ++m)
#pragma unroll
                for (int n = 0; n < 2; ++n) acc[a][b][m][n] = (f32x4){0.f, 0.f, 0.f, 0.f};
    bf16x8 At[4][2], B0[2][2], B1[2][2];
    unsigned vaC[2][2];
    GM_CALC_VA(vaC, cur);
    const char* cB = g.B + (size_t)S.b_row(cur) * g.ldb;
    GM_STAGE_B(GM_SB(0, 0), cB, 0); GM_STAGE_A(GM_SA(0, 0), (size_t)0, vaC, 0); GM_STAGE_B(GM_SB(0, 1), cB, 1); GM_STAGE_A(GM_SA(0, 1), (size_t)0, vaC, 1);
    if (wr == 1) GM_BAR;
    GM_WAIT_V(4); GM_BAR;
    GM_STAGE_B(GM_SB(1, 0), cB + kstep, 0); GM_STAGE_A(GM_SA(1, 0), kstep, vaC, 0); GM_STAGE_B(GM_SB(1, 1), cB + kstep, 1);
    GM_WAIT_V(6); GM_BAR;
    for (;;) {
        const bool has_next = S.next(ui + 1, nxt);
        const char* nB = cB;
        if (has_next) nB = g.B + (size_t)S.b_row(nxt) * g.ldb;
        unsigned va2[2][2]; int rawN[2][2] = {{0, 0}, {0, 0}};
#pragma clang loop unroll(disable)
        for (int t = 0; t < nt; t += 2) {
            const bool last = (t == nt - 2);
            const size_t k1 = (size_t)(t + 1) * kstep;
            const size_t k2 = last ? (size_t)0 : (size_t)(t + 2) * kstep, k3 = k2 + kstep;
            const char* b2 = last ? nB : cB + k2; const char* b3 = b2 + kstep;
#pragma unroll
            for (int _h = 0; _h < 2; ++_h)
#pragma unroll
                for (int _i = 0; _i < 2; ++_i) va2[_h][_i] = vaC[_h][_i];
            if (last && has_next) { if (t == 0) GM_CALC_VA(va2, nxt); else GM_FIN_VA(va2, nxt, rawN); }
            if (t == 0 && !last && has_next) GM_LOAD_RAW(rawN, nxt);
            GM_LDB(B0, 0, 0); GM_SCHED; GM_LDA(At, 0, 0); GM_STAGE_A(GM_SA(1, 1), k1, vaC, 1);
            GM_WAIT_L(8); GM_BAR; GM_WAIT_L(0); GM_MMA(0, 0, At, B0); GM_BAR; GM_SCHED;
            GM_LDB(B1, 0, 1); GM_STAGE_B(GM_SB(0, 0), b2, 0);
            GM_BAR; GM_WAIT_L(0); GM_MMA(0, 1, At, B1); GM_BAR;
            GM_LDA(At, 0, 1); GM_STAGE_A(GM_SA(0, 0), k2, va2, 0);
            GM_BAR; GM_WAIT_L(0); GM_MMA(1, 0, At, B0); GM_BAR; GM_SCHED;
            GM_STAGE_B(GM_SB(0, 1), b2, 1);
            GM_WAIT_V(6); GM_BAR; GM_MMA(1, 1, At, B1); GM_BAR;
            GM_LDB(B0, 1, 0); GM_SCHED; GM_LDA(At, 1, 0); GM_STAGE_A(GM_SA(0, 1), k2, va2, 1);
            GM_WAIT_L(8); GM_BAR; GM_WAIT_L(0); GM_MMA(0, 0, At, B0); GM_BAR; GM_SCHED;
            GM_LDB(B1, 1, 1); GM_STAGE_B(GM_SB(1, 0), b3, 0);
            GM_BAR; GM_WAIT_L(0); GM_MMA(0, 1, At, B1); GM_BAR;
            GM_LDA(At, 1, 1); GM_STAGE_A(GM_SA(1, 0), k3, va2, 0);
            GM_BAR; GM_WAIT_L(0); GM_MMA(1, 0, At, B0); GM_BAR; GM_SCHED;
            GM_STAGE_B(GM_SB(1, 1), b3, 1);
            GM_WAIT_V(6); GM_BAR; GM_MMA(1, 1, At, B1); GM_BAR;
        }
        { int tz = tid; asm volatile("" : "+v"(tz));
          const int wid2 = __builtin_amdgcn_readfirstlane(tz >> 6), ln2 = tz & 63; E(acc, cur, wid2 >> 2, wid2 & 3, ln2 & 15, ln2 >> 4); }
        if (!has_next) break;
#pragma unroll
        for (int a = 0; a < 2; ++a)
#pragma unroll
            for (int b = 0; b < 2; ++b)
#pragma unroll
                for (int m = 0; m < 4; ++m)
#pragma unroll
                    for (int n = 0; n < 2; ++n) acc[a][b][m][n] = (f32x4){0.f, 0.f, 0.f, 0.f};
        cur = nxt; cB = nB; ++ui;
#pragma unroll
        for (int _h = 0; _h < 2; ++_h)
#pragma unroll
            for (int _i = 0; _i < 2; ++_i) vaC[_h][_i] = va2[_h][_i];
    }
    GM_WAIT_V(0);
    if (wr == 0) GM_BAR;
    GM_BAR;
#undef GM_SA
#undef GM_SB
#undef GM_STAGE_A
#undef GM_STAGE_B
#undef GM_LDA
#undef GM_LDB
#undef GM_MMA
#undef GM_WAIT_V
#undef GM_WAIT_L
#undef GM_BAR
#undef GM_SCHED
#undef GM_CALC_VA
#undef GM_LOAD_RAW
#undef GM_FIN_VA
}

typedef const f32x4 (&AccRef)[2][2][4][2];
__device__ __forceinline__ u32x4 pair16(u32x2 a, u32x2 b) {
    const auto r0 = __builtin_amdgcn_permlane16_swap(a.x, b.x, false, false); const auto r1 = __builtin_amdgcn_permlane16_swap(a.y, b.y, false, false);
    u32x4 w; w.x = r0[0]; w.y = r1[0]; w.z = r0[1]; w.w = r1[1]; return w;
}

struct EpiQKV0 {
    static constexpr bool PERM = false; static constexpr int WIDE = 0;
    bf16_t* O; const float* cosT; const float* sinT;
    __device__ __forceinline__ void operator()(AccRef acc, const Unit& u, int wr, int wc, int fr, int fq) const {
        const int tq = u.pm % 9; const bool ctx = (tq == 0); const int tbase = tq * 256 - 256;
        const int colg0 = 256 * u.pn + 32 * wc; const bool rope0 = (colg0 < 640) && !ctx, rope1 = (colg0 + 128 < 640) && !ctx; const int gi = 16 * (wc & 1) + 4 * fq;
        f32x4 cs[8], sn[8];
        if (rope0) {
#pragma unroll
            for (int q = 0; q < 8; ++q) { const int rl = 128 * (q >> 2) + 64 * wr + 16 * (q & 3) + fr; cs[q] = *(const f32x4*)(cosT + (size_t)(tbase + rl) * 32 + gi); sn[q] = *(const f32x4*)(sinT + (size_t)(tbase + rl) * 32 + gi); }
        }
#pragma unroll
        for (int bj = 0; bj < 2; ++bj) {
            const int colg = colg0 + 128 * bj; const bool rope = bj ? rope1 : rope0;
#pragma unroll
            for (int ai = 0; ai < 2; ++ai)
#pragma unroll
                for (int m = 0; m < 4; ++m) {
                    const int rl = 128 * ai + 64 * wr + 16 * m + fr; const size_t row = (size_t)u.pm * 256 + rl;
                    f32x4 v0 = acc[ai][bj][m][0], v1 = acc[ai][bj][m][1];
                    if (rope) { const f32x4 c4 = cs[4 * ai + m], s4 = sn[4 * ai + m]; const f32x4 x0 = v0 * c4 - v1 * s4, x1 = v0 * s4 + v1 * c4; v0 = x0; v1 = x1; }
                    bf16_t* p = O + row * 2304 + colg + ((fq & 1) ? 16 + 4 * (fq - 1) : 4 * fq);
                    u32x2 w0, w1; w0.x = pk2(v0[0], v0[1]); w0.y = pk2(v0[2], v0[3]); w1.x = pk2(v1[0], v1[1]); w1.y = pk2(v1[2], v1[3]);
                    *(u32x4*)p = pair16(w0, w1);
                }
        }
    }
};
struct EpiP1 {
    static constexpr bool PERM = true; static constexpr int WIDE = 1;
    bf16_t* O; int ldc; const float* rs; int rsel;
    __device__ __forceinline__ void operator()(AccRef acc, const Unit& u, int wr, int wc, int fr, int fq) const {
        float scv[8];
#pragma unroll
        for (int q = 0; q < 8; ++q) { const size_t row = (size_t)u.pm * 256 + 128 * (q >> 2) + 64 * wr + 16 * (q & 3) + fr; scv[q] = rs ? rs[row * 2 + rsel] : 1.f; }
        const bool lo = fr < 8; const int col = 256 * u.pn + 64 * wc + 8 * fq + (lo ? 0 : 32);
#pragma unroll
        for (int ai = 0; ai < 2; ++ai)
#pragma unroll
            for (int m = 0; m < 4; ++m) { const size_t row = (size_t)u.pm * 256 + 128 * ai + 64 * wr + 16 * m + (fr & 7); const float sc = scv[4 * ai + m];
                u32x4 x0, x1;
                { const f32x4 v0 = acc[ai][0][m][0] * sc, v1 = acc[ai][0][m][1] * sc; x0.x = pk2(v0[0], v0[1]); x0.y = pk2(v0[2], v0[3]); x0.z = pk2(v1[0], v1[1]); x0.w = pk2(v1[2], v1[3]); }
                { const f32x4 v0 = acc[ai][1][m][0] * sc, v1 = acc[ai][1][m][1] * sc; x1.x = pk2(v0[0], v0[1]); x1.y = pk2(v0[2], v0[3]); x1.z = pk2(v1[0], v1[1]); x1.w = pk2(v1[2], v1[3]); }
                u32x4 rc;
#pragma unroll
                for (int q = 0; q < 4; ++q) rc[q] = (unsigned)__shfl_xor((int)(lo ? x1[q] : x0[q]), 8);
                const u32x4 da = lo ? x0 : rc, db = lo ? rc : x1;
                *(u32x4*)(O + row * ldc + col) = da; *(u32x4*)(O + (row + 8) * ldc + col) = db; }
    }
};
struct EpiUQ {
    static constexpr bool PERM = false; static constexpr int WIDE = 0;
    bf16_t* O; const float* rs; const float* cosT; const float* sinT;
    __device__ __forceinline__ void operator()(AccRef acc, const Unit& u, int wr, int wc, int fr, int fq) const {
        const int tq = u.pm % 9; const bool ctx = (tq == 0); const int tbase = tq * 256 - 256;
        const int colg0 = 256 * u.pn + 32 * wc, colg1 = colg0 + 128;
        const bool rope0 = ((colg0 >> 5) % 3 == 2) && !ctx, rope1 = ((colg1 >> 5) % 3 == 2) && !ctx;
        float scv[8]; f32x4 cs[8], sn[8];
#pragma unroll
        for (int q = 0; q < 8; ++q) { const int rl = 128 * (q >> 2) + 64 * wr + 16 * (q & 3) + fr; scv[q] = rs[((size_t)u.pm * 256 + rl) * 2]; }
        if (rope0 || rope1) {
#pragma unroll
            for (int q = 0; q < 8; ++q) { const int rl = 128 * (q >> 2) + 64 * wr + 16 * (q & 3) + fr; cs[q] = *(const f32x4*)(cosT + (size_t)(tbase + rl) * 16 + 4 * fq); sn[q] = *(const f32x4*)(sinT + (size_t)(tbase + rl) * 16 + 4 * fq); }
        }
#pragma unroll
        for (int ai = 0; ai < 2; ++ai)
#pragma unroll
            for (int m = 0; m < 4; ++m) {
                const int rl = 128 * ai + 64 * wr + 16 * m + fr; const size_t row = (size_t)u.pm * 256 + rl; const float sc = scv[4 * ai + m];
#pragma unroll
                for (int bj = 0; bj < 2; ++bj) {
                    f32x4 v0 = acc[ai][bj][m][0] * sc, v1 = acc[ai][bj][m][1] * sc;
                    if (bj ? rope1 : rope0) { const f32x4 c4 = cs[4 * ai + m], s4 = sn[4 * ai + m]; const f32x4 x0 = v0 * c4 - v1 * s4, x1 = v0 * s4 + v1 * c4; v0 = x0; v1 = x1; }
                    bf16_t* p = O + row * 768 + (bj ? colg1 : colg0) + ((fq & 1) ? 16 + 4 * (fq - 1) : 4 * fq);
                    u32x2 w0, w1; w0.x = pk2(v0[0], v0[1]); w0.y = pk2(v0[2], v0[3]); w1.x = pk2(v1[0], v1[1]); w1.y = pk2(v1[2], v1[3]);
                    *(u32x4*)p = pair16(w0, w1);
                }
            }
    }
};
struct EpiG1 {
    static constexpr bool PERM = false; static constexpr int WIDE = 1;
    bf16_t* act;
    __device__ __forceinline__ void operator()(AccRef acc, const Unit& u, int wr, int wc, int fr, int fq) const {
        const int colb = 16 * (8 * u.pn + 2 * wc) + ((fq & 1) ? 16 + 4 * (fq - 1) : 4 * fq);
#pragma unroll
        for (int ai = 0; ai < 2; ++ai)
#pragma unroll
            for (int m = 0; m < 4; ++m) {
                const int rl = 128 * ai + 64 * wr + 16 * m + fr; u32x2 o[2];
#pragma unroll
                for (int bj = 0; bj < 2; ++bj) {
                    const f32x4 gt = acc[ai][bj][m][0], up = acc[ai][bj][m][1]; float r[4];
#pragma unroll
                    for (int j = 0; j < 4; ++j) r[j] = gt[j] * __builtin_amdgcn_rcpf(1.f + __expf(-gt[j])) * up[j];
                    o[bj].x = pk2(r[0], r[1]); o[bj].y = pk2(r[2], r[3]);
                }
                *(u32x4*)(act + ((size_t)u.sbase + rl) * 256 + colb) = pair16(o[0], o[1]);
            }
    }
};
struct EpiG2 {
    static constexpr bool PERM = true, WIDE = true;
    bf16_t* slab; int sbase0;
    __device__ __forceinline__ void operator()(AccRef acc, const Unit& u, int wr, int wc, int fr, int fq) const {
        const bool lo = fr < 8; const int col = 256 * u.pn + 64 * wc + 8 * fq + (lo ? 0 : 32);
#pragma unroll
        for (int ai = 0; ai < 2; ++ai)
#pragma unroll
            for (int m = 0; m < 4; ++m) { const size_t row = (size_t)(u.sbase - sbase0) + 128 * ai + 64 * wr + 16 * m + (fr & 7);
                u32x4 x0, x1;
                { const f32x4 v0 = acc[ai][0][m][0], v1 = acc[ai][0][m][1]; x0.x = pk2(v0[0], v0[1]); x0.y = pk2(v0[2], v0[3]); x0.z = pk2(v1[0], v1[1]); x0.w = pk2(v1[2], v1[3]); }
                { const f32x4 v0 = acc[ai][1][m][0], v1 = acc[ai][1][m][1]; x1.x = pk2(v0[0], v0[1]); x1.y = pk2(v0[2], v0[3]); x1.z = pk2(v1[0], v1[1]); x1.w = pk2(v1[2], v1[3]); }
                u32x4 rc;
#pragma unroll
                for (int q = 0; q < 4; ++q) rc[q] = (unsigned)__shfl_xor((int)(lo ? x1[q] : x0[q]), 8);
                const u32x4 da = lo ? x0 : rc, db = lo ? rc : x1;
                __builtin_nontemporal_store(da, (u32x4*)(slab + row * 1024 + col)); __builtin_nontemporal_store(db, (u32x4*)(slab + (row + 8) * 1024 + col)); }
    }
};
}

struct AU {
    const bf16_t* qptr;
    bf16_t* optr;
    const bf16_t* kbase; unsigned kpitch;
    const bf16_t* vbase; unsigned vpitch;
    const bf16_t* k2base; unsigned k2pitch;
    int row_ctx, row_lat;
    int nt;
    int j0;
    int qoff;
    int start;
    float m0, l0;
};
constexpr int ATT_RPB = 122880;
constexpr float THR = 8.f;
__device__ __forceinline__ void glds16(const void* gsrc, unsigned lds_dst) { unsigned keep;
    asm volatile("s_mov_b32 %0, m0\n\ts_mov_b32 m0, %2\n\ts_nop 0\n\tglobal_load_lds_dwordx4 %1, off\n\ts_mov_b32 m0, %0" : "=&s"(keep) : "v"(gsrc), "s"(lds_dst) : "memory"); }
__device__ __forceinline__ float max3f(float a, float b, float c) { float r; asm("v_max3_f32 %0, %1, %2, %3" : "=v"(r) : "v"(a), "v"(b), "v"(c)); return r; }
__device__ __forceinline__ float max2f(float a, float b) { float r; asm("v_max_f32_e32 %0, %1, %2" : "=v"(r) : "v"(a), "v"(b)); return r; }

template <int MODE  , int DQ  >
__device__ __forceinline__ void attn_unit(LAS unsigned char* lds, const AU& a) {
    constexpr int NS = DQ / 16;
    constexpr int BUFB = (DQ == 96) ? 20480 : 16384;
    const int tid = ltid(), lane = tid & 63, wid = __builtin_amdgcn_readfirstlane(tid >> 6), r32 = lane & 31, hi = lane >> 5;
    const bool upper = wid >= 4;
    const int kr = tid >> 3, cp = tid & 7;
    const int ksrc = (cp ^ ((kr >> 1) & 7)) * 8, vsrc = (cp ^ (((kr >> 1) & 1) << 2)) * 8;
    const int kr2 = 16 * wid + (lane >> 2), k2src = ((lane & 3) ^ ((kr2 >> 2) & 3)) * 8;
    unsigned koff[NS];
#pragma unroll
    for (int s = 0; s < NS; ++s) koff[s] = (s < 4) ? (unsigned)(r32 * 128 + (((2 * s + hi) ^ ((r32 >> 1) & 7)) << 4))
                                                   : (unsigned)(16384 + r32 * 64 + (((2 * (s - 4) + hi) ^ ((r32 >> 2) & 3)) << 4));
    const int vg = (lane >> 4) & 1, vq = (lane & 15) >> 2, vp = lane & 3, vsw = (vq >> 1) & 1;
    const unsigned voff0 = (unsigned)(8192 + (4 * hi + vq) * 128 + 64 * vsw + 32 * vg + 8 * vp);
    const unsigned voff1 = (unsigned)(8192 + (4 * hi + vq) * 128 + 64 * (1 - vsw) + 32 * vg + 8 * vp);
    bf16x8 qf[NS];
#pragma unroll
    for (int s = 0; s < NS; ++s) qf[s] = *(const bf16x8*)(a.qptr + 16 * s + 8 * hi);
    f32x16 o0, o1, negm, p0, p1;
    float m = a.m0, l = a.l0;
#pragma unroll
    for (int r = 0; r < 16; ++r) { o0[r] = 0.f; o1[r] = 0.f; negm[r] = -m; p0[r] = 0.f; p1[r] = 0.f; }
    const int nt = a.nt;
    auto krow = [&](int t, int r) -> int {
        if (MODE == 0) return a.row_ctx + 64 * t + r;
        if (t < 4) return a.row_ctx + 64 * t + r;
        if (MODE == 1) return a.row_lat + a.start - 128 + 64 * (a.j0 + t - 4) + r;
        return a.row_lat + 64 * (a.j0 + t - 4) + r;
    };
    const unsigned lds0 = (unsigned)(uintptr_t)lds + (unsigned)wid * 1024u;
    auto dma = [&](int t, int boff) {
        const size_t r = (size_t)krow(t, kr);
        glds16(a.kbase + r * a.kpitch + ksrc, (unsigned)__builtin_amdgcn_readfirstlane((int)(lds0 + boff)));
        glds16(a.vbase + r * a.vpitch + vsrc, (unsigned)__builtin_amdgcn_readfirstlane((int)(lds0 + boff + 8192)));
        if (DQ == 96) { if (!upper) { const size_t r2 = (size_t)krow(t, kr2);
            glds16(a.k2base + r2 * a.k2pitch + k2src, (unsigned)__builtin_amdgcn_readfirstlane((int)(lds0 + boff + 16384))); } }
    };
    auto tile_active = [&](int t) -> bool {
        if (MODE != 2 || t < 4) return true;
        const int qrow = a.qoff >> 6; int rs = qrow - 4; rs = rs < 0 ? 0 : (rs > 24 ? 24 : rs); const int kgr = a.j0 + t - 4;
        return __builtin_amdgcn_readfirstlane((int)((kgr >= rs) && (kgr < rs + 8))) != 0;
    };
    auto QK = [&](int t, int boff) {
        const LAS unsigned char* Bb = lds + boff;
        bf16x8 kf[2 * NS];
#pragma unroll
        for (int s = 0; s < NS; ++s) { kf[2 * s] = *(const LAS bf16x8*)(Bb + koff[s]); kf[2 * s + 1] = *(const LAS bf16x8*)(Bb + koff[s] + (s < 4 ? 4096 : 2048)); }
#pragma unroll
        for (int s = 0; s < NS; ++s) {
            if (s == 0) { p0 = __builtin_amdgcn_mfma_f32_32x32x16_bf16(kf[0], qf[0], negm, 0, 0, 0); p1 = __builtin_amdgcn_mfma_f32_32x32x16_bf16(kf[1], qf[0], negm, 0, 0, 0); }
            else { p0 = __builtin_amdgcn_mfma_f32_32x32x16_bf16(kf[2 * s], qf[s], p0, 0, 0, 0); p1 = __builtin_amdgcn_mfma_f32_32x32x16_bf16(kf[2 * s + 1], qf[s], p1, 0, 0, 0); }
        }
        __builtin_amdgcn_sched_group_barrier(0x100, 2 * NS, 0);
        __builtin_amdgcn_sched_group_barrier(0x008, 2 * NS, 0);
        if (MODE == 1 && t >= 4) {
            const int j = a.j0 + t - 4;
            if (j == 0 || j == 4) {
                const int dbase = -128 + 64 * j - a.qoff + 4 * hi;
#pragma unroll
                for (int r = 0; r < 16; ++r) { const int d = dbase + (r & 3) + 8 * (r >> 2);
                    if ((unsigned)(d + 128) > 256u) p0[r] = -1e30f; if ((unsigned)(d + 32 + 128) > 256u) p1[r] = -1e30f; }
            }
        }
        if (MODE == 2 && t >= 4) {
            const int qrow = a.qoff >> 6, qcol = a.qoff & 63; int cs = qcol - 8; cs = cs < 0 ? 0 : (cs > 48 ? 48 : cs);
            const int krel = a.j0 + t - 4 - qrow + 7;
            const LAS float* bt = (const LAS float*)(lds + ATT_RPB) + krel * 128 + (63 - qcol) + 4 * hi;
            const int cb = 4 * hi - cs;
#pragma unroll
            for (int r = 0; r < 16; ++r) { const int kc = (r & 3) + 8 * (r >> 2);
                const float b0 = bt[kc], b1 = bt[kc + 32];
                p0[r] = ((unsigned)(cb + kc) < 16u) ? p0[r] + b0 : -1e30f;
                p1[r] = ((unsigned)(cb + kc + 32) < 16u) ? p1[r] + b1 : -1e30f; }
        }
    };
    bf16x8 pf0, pf1, pf2, pf3;
    auto SM = [&](bool first) {
        asm volatile("s_nop 15\n\ts_nop 7" : "+v"(p0), "+v"(p1));
        float ra = max3f(p0[0], p0[1], p1[0]), rb = max3f(p0[2], p0[3], p1[1]); ra = max3f(ra, p1[2], p1[3]);
#pragma unroll
        for (int r = 4; r < 16; r += 4) { ra = max3f(ra, p0[r], p0[r + 1]); rb = max3f(rb, p0[r + 2], p0[r + 3]); ra = max3f(ra, p1[r], p1[r + 1]); rb = max3f(rb, p1[r + 2], p1[r + 3]); }
        float rm = max2f(ra, rb);
        { auto rr = __builtin_amdgcn_permlane32_swap(__float_as_uint(rm), __float_as_uint(rm), false, false); rm = max2f(__uint_as_float(rr[0]), __uint_as_float(rr[1])); }
        if (first || __any(rm > THR)) {
            const float dl = first ? rm : fmaxf(rm, 0.f);
            m += dl; const float f = __builtin_amdgcn_exp2f(-dl); l *= f;
#pragma unroll
            for (int r = 0; r < 16; ++r) { p0[r] -= dl; p1[r] -= dl; o0[r] *= f; o1[r] *= f; negm[r] = -m; }
        }
        float ls = 0.f;
#pragma unroll
        for (int r = 0; r < 16; ++r) { p0[r] = __builtin_amdgcn_exp2f(p0[r]); p1[r] = __builtin_amdgcn_exp2f(p1[r]); ls += p0[r] + p1[r]; }
        l += ls;
        u32x4 w;
        w.x = pk2(p0[0], p0[1]); w.y = pk2(p0[2], p0[3]); w.z = pk2(p0[4], p0[5]); w.w = pk2(p0[6], p0[7]); pf0 = __builtin_bit_cast(bf16x8, w);
        w.x = pk2(p0[8], p0[9]); w.y = pk2(p0[10], p0[11]); w.z = pk2(p0[12], p0[13]); w.w = pk2(p0[14], p0[15]); pf1 = __builtin_bit_cast(bf16x8, w);
        w.x = pk2(p1[0], p1[1]); w.y = pk2(p1[2], p1[3]); w.z = pk2(p1[4], p1[5]); w.w = pk2(p1[6], p1[7]); pf2 = __builtin_bit_cast(bf16x8, w);
        w.x = pk2(p1[8], p1[9]); w.y = pk2(p1[10], p1[11]); w.z = pk2(p1[12], p1[13]); w.w = pk2(p1[14], p1[15]); pf3 = __builtin_bit_cast(bf16x8, w);
    };
    auto PV = [&](int boff) {
        const LAS unsigned char* Bb = lds + boff;
        s16x4 va0[4], va1[4], vc0[4], vc1[4];
#pragma unroll
        for (int kk = 0; kk < 4; ++kk) {
            const LAS unsigned char* vb = Bb + kk * 2048;
            va0[kk] = __builtin_bit_cast(s16x4, __builtin_amdgcn_ds_read_tr16_b64_v4i16((LAS s16x4*)(vb + voff0)));
            va1[kk] = __builtin_bit_cast(s16x4, __builtin_amdgcn_ds_read_tr16_b64_v4i16((LAS s16x4*)(vb + voff0 + 1024)));
            vc0[kk] = __builtin_bit_cast(s16x4, __builtin_amdgcn_ds_read_tr16_b64_v4i16((LAS s16x4*)(vb + voff1)));
            vc1[kk] = __builtin_bit_cast(s16x4, __builtin_amdgcn_ds_read_tr16_b64_v4i16((LAS s16x4*)(vb + voff1 + 1024)));
        }
#pragma unroll
        for (int kk = 0; kk < 4; ++kk) {
            const bf16x8 va = (bf16x8){va0[kk][0], va0[kk][1], va0[kk][2], va0[kk][3], va1[kk][0], va1[kk][1], va1[kk][2], va1[kk][3]};
            const bf16x8 vc = (bf16x8){vc0[kk][0], vc0[kk][1], vc0[kk][2], vc0[kk][3], vc1[kk][0], vc1[kk][1], vc1[kk][2], vc1[kk][3]};
            const bf16x8 pk = kk == 0 ? pf0 : (kk == 1 ? pf1 : (kk == 2 ? pf2 : pf3));
            o0 = __builtin_amdgcn_mfma_f32_32x32x16_bf16(va, pk, o0, 0, 0, 0);
            o1 = __builtin_amdgcn_mfma_f32_32x32x16_bf16(vc, pk, o1, 0, 0, 0);
        }
        __builtin_amdgcn_sched_group_barrier(0x100, 16, 0);
        __builtin_amdgcn_sched_group_barrier(0x008, 8, 0);
    };
#define ATT_WAIT_BAR(N) do { asm volatile("s_waitcnt vmcnt(" #N ") lgkmcnt(0)" ::: "memory"); __builtin_amdgcn_s_barrier(); asm volatile("" ::: "memory"); } while (0)
    constexpr int RING = 6, DIST = RING - 1;
    auto wait_bar = [&](int ntiles) {
        if (DQ == 96 && !upper) { switch (ntiles) { case 4: ATT_WAIT_BAR(12); break; case 3: ATT_WAIT_BAR(9); break; case 2: ATT_WAIT_BAR(6); break; case 1: ATT_WAIT_BAR(3); break; default: ATT_WAIT_BAR(0); } }
        else { switch (ntiles) { case 4: ATT_WAIT_BAR(8); break; case 3: ATT_WAIT_BAR(6); break; case 2: ATT_WAIT_BAR(4); break; case 1: ATT_WAIT_BAR(2); break; default: ATT_WAIT_BAR(0); } } };
    if (upper) __builtin_amdgcn_s_setprio(1);
    int issued = 0;
    for (; issued < DIST && issued < nt; ++issued) dma(issued, issued * BUFB);
    wait_bar(issued - 1);
    int b_cur = 0, b_iss = (DIST % RING) * BUFB;
    for (int t = 0; t < nt; ++t) {
        if (issued < nt) { dma(issued, b_iss); ++issued; b_iss += BUFB; if (b_iss == RING * BUFB) b_iss = 0; }
        if (tile_active(t)) { QK(t, b_cur); SM(t == 0); PV(b_cur); }
        { const int infl = issued - t - 2; wait_bar(infl < 0 ? 0 : infl); }
        b_cur += BUFB; if (b_cur == RING * BUFB) b_cur = 0;
    }
#undef ATT_WAIT_BAR
    if (upper) __builtin_amdgcn_s_setprio(0);
    { auto rr = __builtin_amdgcn_permlane32_swap(__float_as_uint(l), __float_as_uint(l), false, false); l = __uint_as_float(rr[0]) + __uint_as_float(rr[1]); }
    const float inv = 1.f / l;
#pragma unroll
    for (int ig = 0; ig < 4; ++ig) {
        u32x2 w0, w1;
        w0.x = pk2(o0[4 * ig] * inv, o0[4 * ig + 1] * inv); w0.y = pk2(o0[4 * ig + 2] * inv, o0[4 * ig + 3] * inv);
        w1.x = pk2(o1[4 * ig] * inv, o1[4 * ig + 1] * inv); w1.y = pk2(o1[4 * ig + 2] * inv, o1[4 * ig + 3] * inv);
        *(u32x2*)(a.optr + 8 * ig + 4 * hi) = w0;
        *(u32x2*)(a.optr + 32 + 8 * ig + 4 * hi) = w1;
    }
}

struct AU2 {
    const bf16_t* qptr; unsigned qpitch;
    bf16_t* optr;
    const bf16_t* kbase; unsigned kpitch; const bf16_t* vbase; unsigned vpitch; const bf16_t* k2base; unsigned k2pitch;
    int row_ctx, nt;
};
template <int DQ  , bool NOMAX  >
__device__ __forceinline__ void attn_unit2(LAS unsigned char* lds, const AU2& a) {
    constexpr int NS = DQ / 16;
    constexpr int BUFB = (DQ == 96) ? 20480 : 16384;
    const int tid = ltid(), lane = tid & 63, wid = __builtin_amdgcn_readfirstlane(tid >> 6), r32 = lane & 31, hi = lane >> 5;
    const bool upper = wid >= 4;
    const int kr = tid >> 3, cp = tid & 7;
    const int ksrc = (cp ^ ((kr >> 1) & 7)) * 8, vsrc = (cp ^ (((kr >> 1) & 1) << 2)) * 8;
    const int kr2 = 16 * wid + (lane >> 2), k2src = ((lane & 3) ^ ((kr2 >> 2) & 3)) * 8;
    unsigned koff[NS];
#pragma unroll
    for (int s = 0; s < NS; ++s) koff[s] = (s < 4) ? (unsigned)(r32 * 128 + (((2 * s + hi) ^ ((r32 >> 1) & 7)) << 4))
                                                   : (unsigned)(16384 + r32 * 64 + (((2 * (s - 4) + hi) ^ ((r32 >> 2) & 3)) << 4));
    const int vg = (lane >> 4) & 1, vq = (lane & 15) >> 2, vp = lane & 3, vsw = (vq >> 1) & 1;
    const unsigned voff0 = (unsigned)(8192 + (4 * hi + vq) * 128 + 64 * vsw + 32 * vg + 8 * vp);
    const unsigned voff1 = (unsigned)(8192 + (4 * hi + vq) * 128 + 64 * (1 - vsw) + 32 * vg + 8 * vp);
    bf16x8 qA[NS], qB[NS];
#pragma unroll
    for (int s = 0; s < NS; ++s) { qA[s] = *(const bf16x8*)(a.qptr + 16 * s + 8 * hi); qB[s] = *(const bf16x8*)(a.qptr + (size_t)32 * a.qpitch + 16 * s + 8 * hi); }
    f32x16 oA0, oA1, oB0, oB1, pA0, pA1, pB0, pB1;
    float mA = 0.f, lA = 0.f, mB = 0.f, lB = 0.f;
#pragma unroll
    for (int r = 0; r < 16; ++r) { oA0[r] = 0.f; oA1[r] = 0.f; oB0[r] = 0.f; oB1[r] = 0.f; }
    const int nt = a.nt;
    const unsigned lds0 = (unsigned)(uintptr_t)lds + (unsigned)wid * 1024u;
    auto dma = [&](int t, int boff) {
        const size_t r = (size_t)(a.row_ctx + 64 * t + kr);
        glds16(a.kbase + r * a.kpitch + ksrc, (unsigned)__builtin_amdgcn_readfirstlane((int)(lds0 + boff)));
        glds16(a.vbase + r * a.vpitch + vsrc, (unsigned)__builtin_amdgcn_readfirstlane((int)(lds0 + boff + 8192)));
        if (DQ == 96) { if (!upper) { const size_t r2 = (size_t)(a.row_ctx + 64 * t + kr2);
            glds16(a.k2base + r2 * a.k2pitch + k2src, (unsigned)__builtin_amdgcn_readfirstlane((int)(lds0 + boff + 16384))); } }
    };
    const f32x16 zero16 = {0.f, 0.f, 0.f, 0.f, 0.f, 0.f, 0.f, 0.f, 0.f, 0.f, 0.f, 0.f, 0.f, 0.f, 0.f, 0.f};
    auto QK = [&](int boff) {
        const LAS unsigned char* Bb = lds + boff;
        bf16x8 kf[2 * NS];
#pragma unroll
        for (int s = 0; s < NS; ++s) { kf[2 * s] = *(const LAS bf16x8*)(Bb + koff[s]); kf[2 * s + 1] = *(const LAS bf16x8*)(Bb + koff[s] + (s < 4 ? 4096 : 2048)); }
#pragma unroll
        for (int s = 0; s < NS; ++s) {
            pA0 = __builtin_amdgcn_mfma_f32_32x32x16_bf16(kf[2 * s], qA[s], s == 0 ? zero16 : pA0, 0, 0, 0); pA1 = __builtin_amdgcn_mfma_f32_32x32x16_bf16(kf[2 * s + 1], qA[s], s == 0 ? zero16 : pA1, 0, 0, 0);
            pB0 = __builtin_amdgcn_mfma_f32_32x32x16_bf16(kf[2 * s], qB[s], s == 0 ? zero16 : pB0, 0, 0, 0); pB1 = __builtin_amdgcn_mfma_f32_32x32x16_bf16(kf[2 * s + 1], qB[s], s == 0 ? zero16 : pB1, 0, 0, 0);
        }
        __builtin_amdgcn_sched_group_barrier(0x100, 2 * NS, 0);
        __builtin_amdgcn_sched_group_barrier(0x008, 4 * NS, 0);
    };
    auto SM = [&](f32x16& p0, f32x16& p1, f32x16& o0, f32x16& o1, float& m, float& l, bool first, bf16x8 (&pf)[4]) {
        float ls = 0.f;
        if constexpr (NOMAX) {
#pragma unroll
            for (int r = 0; r < 16; ++r) { p0[r] = __builtin_amdgcn_exp2f(p0[r]); p1[r] = __builtin_amdgcn_exp2f(p1[r]); ls += p0[r] + p1[r]; }
        } else {
            asm volatile("s_nop 15\n\ts_nop 7" : "+v"(p0), "+v"(p1));
            float ra = max3f(p0[0], p0[1], p1[0]), rb = max3f(p0[2], p0[3], p1[1]); ra = max3f(ra, p1[2], p1[3]);
#pragma unroll
            for (int r = 4; r < 16; r += 4) { ra = max3f(ra, p0[r], p0[r + 1]); rb = max3f(rb, p0[r + 2], p0[r + 3]); ra = max3f(ra, p1[r], p1[r + 1]); rb = max3f(rb, p1[r + 2], p1[r + 3]); }
            float rm = max2f(ra, rb);
            { auto rr = __builtin_amdgcn_permlane32_swap(__float_as_uint(rm), __float_as_uint(rm), false, false); rm = max2f(__uint_as_float(rr[0]), __uint_as_float(rr[1])); }
            if (first) m = rm;
            else if (__any(rm - m > THR)) { const float mn = fmaxf(m, rm); const float f = __builtin_amdgcn_exp2f(m - mn); m = mn; l *= f;
#pragma unroll
                for (int r = 0; r < 16; ++r) { o0[r] *= f; o1[r] *= f; } }
#pragma unroll
            for (int r = 0; r < 16; ++r) { p0[r] = __builtin_amdgcn_exp2f(p0[r] - m); p1[r] = __builtin_amdgcn_exp2f(p1[r] - m); ls += p0[r] + p1[r]; }
        }
        l += ls;
        u32x4 w;
        w.x = pk2(p0[0], p0[1]); w.y = pk2(p0[2], p0[3]); w.z = pk2(p0[4], p0[5]); w.w = pk2(p0[6], p0[7]); pf[0] = __builtin_bit_cast(bf16x8, w);
        w.x = pk2(p0[8], p0[9]); w.y = pk2(p0[10], p0[11]); w.z = pk2(p0[12], p0[13]); w.w = pk2(p0[14], p0[15]); pf[1] = __builtin_bit_cast(bf16x8, w);
        w.x = pk2(p1[0], p1[1]); w.y = pk2(p1[2], p1[3]); w.z = pk2(p1[4], p1[5]); w.w = pk2(p1[6], p1[7]); pf[2] = __builtin_bit_cast(bf16x8, w);
        w.x = pk2(p1[8], p1[9]); w.y = pk2(p1[10], p1[11]); w.z = pk2(p1[12], p1[13]); w.w = pk2(p1[14], p1[15]); pf[3] = __builtin_bit_cast(bf16x8, w);
    };
    bf16x8 pfA[4], pfB[4];
    auto PV = [&](int boff) {
        const LAS unsigned char* Bb = lds + boff;
        s16x4 va0[4], va1[4], vc0[4], vc1[4];
#pragma unroll
        for (int kk = 0; kk < 4; ++kk) {
            const LAS unsigned char* vb = Bb + kk * 2048;
            va0[kk] = __builtin_bit_cast(s16x4, __builtin_amdgcn_ds_read_tr16_b64_v4i16((LAS s16x4*)(vb + voff0)));
            va1[kk] = __builtin_bit_cast(s16x4, __builtin_amdgcn_ds_read_tr16_b64_v4i16((LAS s16x4*)(vb + voff0 + 1024)));
            vc0[kk] = __builtin_bit_cast(s16x4, __builtin_amdgcn_ds_read_tr16_b64_v4i16((LAS s16x4*)(vb + voff1)));
            vc1[kk] = __builtin_bit_cast(s16x4, __builtin_amdgcn_ds_read_tr16_b64_v4i16((LAS s16x4*)(vb + voff1 + 1024)));
        }
#pragma unroll
        for (int kk = 0; kk < 4; ++kk) {
            const bf16x8 va = (bf16x8){va0[kk][0], va0[kk][1], va0[kk][2], va0[kk][3], va1[kk][0], va1[kk][1], va1[kk][2], va1[kk][3]};
            const bf16x8 vc = (bf16x8){vc0[kk][0], vc0[kk][1], vc0[kk][2], vc0[kk][3], vc1[kk][0], vc1[kk][1], vc1[kk][2], vc1[kk][3]};
            oA0 = __builtin_amdgcn_mfma_f32_32x32x16_bf16(va, pfA[kk], oA0, 0, 0, 0); oA1 = __builtin_amdgcn_mfma_f32_32x32x16_bf16(vc, pfA[kk], oA1, 0, 0, 0);
            oB0 = __builtin_amdgcn_mfma_f32_32x32x16_bf16(va, pfB[kk], oB0, 0, 0, 0); oB1 = __builtin_amdgcn_mfma_f32_32x32x16_bf16(vc, pfB[kk], oB1, 0, 0, 0);
        }
        __builtin_amdgcn_sched_group_barrier(0x100, 16, 0);
        __builtin_amdgcn_sched_group_barrier(0x008, 16, 0);
    };
#define ATT_WAIT_BAR(N) do { asm volatile("s_waitcnt vmcnt(" #N ") lgkmcnt(0)" ::: "memory"); __builtin_amdgcn_s_barrier(); asm volatile("" ::: "memory"); } while (0)
    constexpr int RING = 6, DIST = RING - 1;
    auto wait_bar = [&](int ntiles) {
        if (DQ == 96 && !upper) { switch (ntiles) { case 4: ATT_WAIT_BAR(12); break; case 3: ATT_WAIT_BAR(9); break; case 2: ATT_WAIT_BAR(6); break; case 1: ATT_WAIT_BAR(3); break; default: ATT_WAIT_BAR(0); } }
        else { switch (ntiles) { case 4: ATT_WAIT_BAR(8); break; case 3: ATT_WAIT_BAR(6); break; case 2: ATT_WAIT_BAR(4); break; case 1: ATT_WAIT_BAR(2); break; default: ATT_WAIT_BAR(0); } } };
    if (upper) __builtin_amdgcn_s_setprio(1);
    int issued = 0;
    for (; issued < DIST && issued < nt; ++issued) dma(issued, issued * BUFB);
    wait_bar(issued - 1);
    int b_cur = 0, b_iss = (DIST % RING) * BUFB;
    for (int t = 0; t < nt; ++t) {
        if (issued < nt) { dma(issued, b_iss); ++issued; b_iss += BUFB; if (b_iss == RING * BUFB) b_iss = 0; }
        QK(b_cur);
        SM(pA0, pA1, oA0, oA1, mA, lA, t == 0, pfA);
        SM(pB0, pB1, oB0, oB1, mB, lB, t == 0, pfB);
        PV(b_cur);
        { const int infl = issued - t - 2; wait_bar(infl < 0 ? 0 : infl); }
        b_cur += BUFB; if (b_cur == RING * BUFB) b_cur = 0;
    }
#undef ATT_WAIT_BAR
    if (upper) __builtin_amdgcn_s_setprio(0);
    { auto rr = __builtin_amdgcn_permlane32_swap(__float_as_uint(lA), __float_as_uint(lA), false, false); lA = __uint_as_float(rr[0]) + __uint_as_float(rr[1]); }
    { auto rr = __builtin_amdgcn_permlane32_swap(__float_as_uint(lB), __float_as_uint(lB), false, false); lB = __uint_as_float(rr[0]) + __uint_as_float(rr[1]); }
    const float invA = 1.f / lA, invB = 1.f / lB; bf16_t* oB = a.optr + (size_t)32 * 1024;
#pragma unroll
    for (int ig = 0; ig < 4; ++ig) {
        u32x2 w0, w1;
        w0.x = pk2(oA0[4 * ig] * invA, oA0[4 * ig + 1] * invA); w0.y = pk2(oA0[4 * ig + 2] * invA, oA0[4 * ig + 3] * invA);
        w1.x = pk2(oA1[4 * ig] * invA, oA1[4 * ig + 1] * invA); w1.y = pk2(oA1[4 * ig + 2] * invA, oA1[4 * ig + 3] * invA);
        *(u32x2*)(a.optr + 8 * ig + 4 * hi) = w0; *(u32x2*)(a.optr + 32 + 8 * ig + 4 * hi) = w1;
        w0.x = pk2(oB0[4 * ig] * invB, oB0[4 * ig + 1] * invB); w0.y = pk2(oB0[4 * ig + 2] * invB, oB0[4 * ig + 3] * invB);
        w1.x = pk2(oB1[4 * ig] * invB, oB1[4 * ig + 1] * invB); w1.y = pk2(oB1[4 * ig + 2] * invB, oB1[4 * ig + 3] * invB);
        *(u32x2*)(oB + 8 * ig + 4 * hi) = w0; *(u32x2*)(oB + 32 + 8 * ig + 4 * hi) = w1;
    }
}

struct Job { const float* src; bf16_t* dst; int K, N, ldd, nb; size_t sbs, dbs; int mode; const float* rscale; };

__device__ __forceinline__ int hperm64(int c) { const int base = c & ~63, cl = c & 63, p = cl >> 1, n = cl & 1, g = p >> 4, i = p & 15; return base + 32 * g + 16 * n + i; }
__device__ __forceinline__ int rowmap(int mode, int c) {
    switch (mode) {
        case 1: return c < 640 ? hperm64(c) : c;
        case 2: if ((c >= 384 && c < 896) || (c >= 1184 && c < 1312)) { const int b0 = (c >= 1184) ? 1184 : 384; return b0 + hperm64(c - b0); }
                if (c >= 1152 && c < 1184) { const int cl = c - 1152; return 1152 + 16 * (cl & 1) + (cl >> 1); }
                return c;
        case 3: { const int h = c / 96, cl = c % 96; if (cl < 64) return c; const int r = cl - 64; return h * 96 + 64 + 16 * (r & 1) + (r >> 1); }
        case 4: return 32 * (c >> 4) + (c & 15);
        case 5: return 32 * (c >> 4) + 16 + (c & 15);
        default: return c;
    }
}
__device__ __forceinline__ float colscale(int mode, int c) {
    if (mode == 1) return (c < 512 || (c >= 768 && c < 1280)) ? QS64 : 1.f;
    if (mode == 3) return QS96;
    return 1.f;
}
__device__ __forceinline__ bool get_job(PP P, int j, Job& J) {
    const int layer = j >= 9 ? 1 : 0, jj = layer ? j - 9 : j; const int ib = layer ? 20 : 4;
    bf16_t* W = (bf16_t*)(P->ws + (layer ? WS_W1 : WS_W0));
    J.nb = 1; J.sbs = 0; J.dbs = 0; J.rscale = nullptr; J.mode = 0; J.ldd = 1024; J.K = 1024;
    switch (jj) {
        case 0: J.src = P->in[ib + 3]; J.dst = W + WO_IN; J.N = layer ? 1440 : 2304; J.mode = layer ? 2 : 1; break;
        case 1: J.src = P->in[layer ? 30 : 10]; J.dst = W + WO_OUT; J.N = 1024; break;
        case 2: J.src = P->in[layer ? 32 : 12]; J.dst = W + WO_RT; J.N = 64; J.mode = 7; break;
        case 3: J.src = P->in[layer ? 34 : 14]; J.dst = W + WO_GU; J.N = 256; J.nb = 64; J.sbs = (size_t)1024 * 256; J.dbs = (size_t)512 * 1024; J.mode = 4; break;
        case 4: J.src = P->in[layer ? 35 : 15]; J.dst = W + WO_GU; J.N = 256; J.nb = 64; J.sbs = (size_t)1024 * 256; J.dbs = (size_t)512 * 1024; J.mode = 5; break;
        case 5: J.src = P->in[layer ? 36 : 16]; J.dst = W + WO_D; J.K = 256; J.N = 1024; J.ldd = 256; J.nb = 64; J.sbs = (size_t)256 * 1024; J.dbs = (size_t)1024 * 256; break;
        case 6: J.src = P->in[layer ? 37 : 17]; J.dst = W + WO_GU + (size_t)64 * 512 * 1024; J.N = 256; J.mode = 4; break;
        case 7: J.src = P->in[layer ? 38 : 18]; J.dst = W + WO_GU + (size_t)64 * 512 * 1024; J.N = 256; J.mode = 5; break;
        case 8: J.src = P->in[layer ? 39 : 19]; J.dst = W + WO_D + (size_t)64 * 1024 * 256; J.K = 256; J.N = 1024; J.ldd = 256; break;
        case 9: J.src = P->in[25]; J.dst = W + WO_UQ; J.K = 384; J.N = 768; J.ldd = 384; J.mode = 3; J.rscale = P->in[24]; break;
        case 10: J.src = P->in[27]; J.dst = W + WO_UKV; J.K = 256; J.N = 1024; J.ldd = 256; J.mode = 6; J.rscale = P->in[26]; break;
        default: return false;
    }
    return true;
}
constexpr int NJOBS = 20;
__device__ __forceinline__ int job_tiles(const Job& J) { return J.nb * (J.K >> 6) * ((J.N + 255) >> 8); }

__device__ __forceinline__ void conv_tile(const Job& J, int tile, LAS float* T) {
    const int tid = ltid(); const int ntn = (J.N + 255) >> 8, ntk = J.K >> 6;
    const int b = tile / (ntn * ntk), r = tile % (ntn * ntk), tk = r / ntn, tn = r % ntn;
    const float* src = J.src + (size_t)b * J.sbs; bf16_t* dst = J.dst + (size_t)b * J.dbs; const int k0 = tk * 64, n0 = tn * 256;
    { const int n4 = (tid & 63) * 4; const bool ok = (n0 + n4) < J.N;
      f32x4 v[8];
#pragma unroll
      for (int j = 0; j < 8; ++j) { const int k = (tid >> 6) + 8 * j; v[j] = ok ? *(const f32x4*)(src + (size_t)(k0 + k) * J.N + n0 + n4) : (f32x4){0.f, 0.f, 0.f, 0.f}; }
      f32x4 cs; cs[0] = colscale(J.mode, n0 + n4); cs[1] = colscale(J.mode, n0 + n4 + 1); cs[2] = colscale(J.mode, n0 + n4 + 2); cs[3] = colscale(J.mode, n0 + n4 + 3);
#pragma unroll
      for (int j = 0; j < 8; ++j) { const int k = (tid >> 6) + 8 * j; f32x4 x = v[j] * cs; if (J.rscale) x = x * J.rscale[k0 + k]; *(LAS f32x4*)(T + k * 260 + n4) = x; } }
    __syncthreads();
    { const int nn = tid >> 1, kh = (tid & 1) * 32;
      if (n0 + nn < J.N) { const int drow = rowmap(J.mode, n0 + nn); bf16_t* dp = dst + (size_t)drow * J.ldd + k0 + kh;
#pragma unroll
          for (int q = 0; q < 4; ++q) { float v[8];
#pragma unroll
              for (int j = 0; j < 8; ++j) v[j] = T[(kh + 8 * q + j) * 260 + nn];
              u32x4 w; w.x = pk2(v[0], v[1]); w.y = pk2(v[2], v[3]); w.z = pk2(v[4], v[5]); w.w = pk2(v[6], v[7]);
              *(u32x4*)(dp + 8 * q) = w;
              if (J.mode == 7) { u32x4 w2;
                  w2.x = pk2(v[0] - bflo(w.x), v[1] - bfhi(w.x)); w2.y = pk2(v[2] - bflo(w.y), v[3] - bfhi(w.y));
                  w2.z = pk2(v[4] - bflo(w.z), v[5] - bfhi(w.z)); w2.w = pk2(v[6] - bflo(w.w), v[7] - bfhi(w.w));
                  *(u32x4*)(dp + (size_t)64 * 1024 + 8 * q) = w2; } } } }
    __syncthreads();
}

__device__ __forceinline__ void ada_item(PP P, int item, LAS float* S) {
    const int tid = ltid(); const int layer = item / 96, chunk = item % 96;
    for (int idx = tid; idx < 33 * 1024; idx += 512) { const int r = idx >> 10, k = idx & 1023; const float x = (r < 32) ? P->in[1][r * 1024 + k] : P->in[3][k]; S[idx] = x / (1.f + expf(-x)); }
    __syncthreads();
    const int col = chunk * 64 + (tid & 63), kg = tid >> 6;
    float acc[33];
#pragma unroll
    for (int r = 0; r < 33; ++r) acc[r] = 0.f;
    const float* W = P->in[layer ? 20 : 4] + col;
    for (int k = kg * 128; k < kg * 128 + 128; ++k) { const float w = W[(size_t)k * 6144];
#pragma unroll
        for (int r = 0; r < 33; ++r) acc[r] += S[r * 1024 + k] * w; }
    __syncthreads();
#pragma unroll
    for (int r = 0; r < 33; ++r) S[(kg * 33 + r) * 64 + (tid & 63)] = acc[r];
    __syncthreads();
    float* ada = (float*)(P->ws + WS_ADA) + (size_t)layer * 33 * 6144; const float* bias = P->in[layer ? 21 : 5];
    for (int idx = tid; idx < 33 * 64; idx += 512) { const int r = idx >> 6, cc = idx & 63; float s = 0.f;
#pragma unroll
        for (int g = 0; g < 8; ++g) s += S[(g * 33 + r) * 64 + cc];
        ada[(size_t)r * 6144 + chunk * 64 + cc] = s + bias[chunk * 64 + cc]; }
    __syncthreads();
}

__device__ __forceinline__ void phase_prologue(PP P, LAS unsigned char* lds, int c, int G) {
    const int tid = ltid();
    for (int it = c; it < 192; it += G) ada_item(P, it, (LAS float*)lds);
    { float* rp = (float*)(P->ws + WS_ROPE); float* cosh_ = rp; float* sinh_ = rp + 2048 * 32; float* cosr_ = rp + 2 * 2048 * 32; float* sinr_ = cosr_ + 2048 * 16;
      for (int idx = c * 512 + tid; idx < 2048 * 48; idx += G * 512) {
          if (idx < 2048 * 32) { const int t = idx >> 5, p = idx & 31; const float pos = (p < 16) ? (float)(t >> 6) : (float)(t & 63); const int i = p & 15;
              const float inv = powf(10000.0f, -(float)i / 16.0f); const float ang = pos * inv; cosh_[idx] = cosf(ang); sinh_[idx] = sinf(ang); }
          else { const int k = idx - 2048 * 32; const int t = k >> 4, p = k & 15; const float pos = (p < 8) ? (float)(t >> 6) : (float)(t & 63); const int i = p & 7;
              const float inv = powf(10000.0f, -(float)i / 8.0f); const float ang = pos * inv; cosr_[k] = cosf(ang); sinr_[k] = sinf(ang); } } }
    { u32x4* z = (u32x4*)((bf16_t*)(P->ws + WS_W1) + WO_IN + (size_t)1440 * 1024); for (int idx = c * 512 + tid; idx < 96 * 1024 / 8; idx += G * 512) z[idx] = (u32x4){0u, 0u, 0u, 0u}; }
    { int base = 0; int tile = c;
      for (int j = 0; j < NJOBS; ++j) { Job J; get_job(P, j, J); const int n = job_tiles(J);
          while (tile < base + n) { conv_tile(J, tile - base, (LAS float*)lds); tile += G; }
          base += n; } }
}

__device__ __forceinline__ void phase_norm(PP P, int c, int G, const float* xlat, const float* xctx, const float* g, const float* ada  , int sh_off, int sc_off, bool latent_only, bf16_t* H, bf16_t* HLO,
                                           const bool resid = false, float* xlat_dst = nullptr, float* xctx_dst = nullptr) {
    const int tid_ = ltid(); const int lane = tid_ & 63, wv = c * 8 + (tid_ >> 6), nw = G * 8;
    for (int row = wv; row < MROWS; row += nw) {
        const int b = row / TOK, t = row % TOK; const bool ctx = t < CTX;
        if (ctx && latent_only) continue;
        const float* x = ctx ? xctx + ((size_t)b * CTX + t) * 1024 : xlat + ((size_t)b * SEQ + t - CTX) * 1024;
        const float* ap = ada + (size_t)(ctx ? 32 : b) * 6144;
        f32x4 v[4]; float ss = 0.f;
#pragma unroll
        for (int i = 0; i < 2; ++i) { v[2 * i] = *(const f32x4*)(x + 512 * i + 8 * lane); v[2 * i + 1] = *(const f32x4*)(x + 512 * i + 8 * lane + 4); }
        if (resid) {
            float* xd = ctx ? xctx_dst + ((size_t)b * CTX + t) * 1024 : xlat_dst + ((size_t)b * SEQ + t - CTX) * 1024;
#pragma unroll
            for (int i = 0; i < 2; ++i) { const u32x4 yw = *(const u32x4*)(HLO + (size_t)row * 1024 + 512 * i + 8 * lane);
                const f32x4 g0 = *(const f32x4*)(ap + 2048 + 512 * i + 8 * lane), g1 = *(const f32x4*)(ap + 2048 + 512 * i + 8 * lane + 4);
                v[2 * i][0] += g0[0] * bflo(yw.x); v[2 * i][1] += g0[1] * bfhi(yw.x); v[2 * i][2] += g0[2] * bflo(yw.y); v[2 * i][3] += g0[3] * bfhi(yw.y);
                v[2 * i + 1][0] += g1[0] * bflo(yw.z); v[2 * i + 1][1] += g1[1] * bfhi(yw.z); v[2 * i + 1][2] += g1[2] * bflo(yw.w); v[2 * i + 1][3] += g1[3] * bfhi(yw.w);
                *(f32x4*)(xd + 512 * i + 8 * lane) = v[2 * i]; *(f32x4*)(xd + 512 * i + 8 * lane + 4) = v[2 * i + 1]; }
        }
#pragma unroll
        for (int i = 0; i < 4; ++i) ss += v[i][0] * v[i][0] + v[i][1] * v[i][1] + v[i][2] * v[i][2] + v[i][3] * v[i][3];
        ss = wave_sum(ss); const float rstd = rsqrtf(ss * (1.f / 1024.f) + EPS);
#pragma unroll
        for (int i = 0; i < 2; ++i) { const int col = 512 * i + 8 * lane; float o[8];
#pragma unroll
            for (int h = 0; h < 2; ++h) { const f32x4 gg = *(const f32x4*)(g + col + 4 * h), sc = *(const f32x4*)(ap + sc_off + col + 4 * h), sh = *(const f32x4*)(ap + sh_off + col + 4 * h);
#pragma unroll
                for (int j = 0; j < 4; ++j) o[4 * h + j] = v[2 * i + h][j] * rstd * gg[j] * (1.f + sc[j]) + sh[j]; }
            u32x4 w; w.x = pk2(o[0], o[1]); w.y = pk2(o[2], o[3]); w.z = pk2(o[4], o[5]); w.w = pk2(o[6], o[7]);
            *(u32x4*)(H + (size_t)row * 1024 + col) = w;
            if (HLO) { u32x4 w2; w2.x = pk2(o[0] - bflo(w.x), o[1] - bfhi(w.x)); w2.y = pk2(o[2] - bflo(w.y), o[3] - bfhi(w.y)); w2.z = pk2(o[4] - bflo(w.z), o[5] - bfhi(w.z)); w2.w = pk2(o[6] - bflo(w.w), o[7] - bfhi(w.w));
                *(u32x4*)(HLO + (size_t)row * 1024 + col) = w2; } }
    }
}

__device__ __forceinline__ void phase_post1(PP P, int c, int G) {
    const int tid_ = ltid(); const int lane = tid_ & 63, wv = c * 8 + (tid_ >> 6), nw = G * 8;
    bf16_t* Pb = (bf16_t*)(P->ws + WS_BIG + BIG_P); float* RS = (float*)(P->ws + WS_RSTD);
    const float* rp = (const float*)(P->ws + WS_ROPE); const float* cosh_ = rp; const float* sinh_ = rp + 2048 * 32; const float* cosr_ = rp + 2 * 2048 * 32; const float* sinr_ = cosr_ + 2048 * 16;
    const float* gqn = P->in[28]; const float* gkn = P->in[29];
    for (int row = wv; row < MROWS; row += nw) {
        bf16_t* pr = Pb + (size_t)row * 1536; const int t = row % TOK; const bool lat = t >= CTX; const int tt = t - CTX;
        float s1 = 0.f, s2 = 0.f;
        if (lane < 48) { const u32x4 w = *(const u32x4*)(pr + 8 * lane); const float a0 = bflo(w.x), a1 = bfhi(w.x), a2 = bflo(w.y), a3 = bfhi(w.y), a4 = bflo(w.z), a5 = bfhi(w.z), a6 = bflo(w.w), a7 = bfhi(w.w);
            s1 = a0 * a0 + a1 * a1 + a2 * a2 + a3 * a3 + a4 * a4 + a5 * a5 + a6 * a6 + a7 * a7; }
        if (lane < 32) { const u32x4 w = *(const u32x4*)(pr + 896 + 8 * lane); const float a0 = bflo(w.x), a1 = bfhi(w.x), a2 = bflo(w.y), a3 = bfhi(w.y), a4 = bflo(w.z), a5 = bfhi(w.z), a6 = bflo(w.w), a7 = bfhi(w.w);
            s2 = a0 * a0 + a1 * a1 + a2 * a2 + a3 * a3 + a4 * a4 + a5 * a5 + a6 * a6 + a7 * a7; }
        s1 = wave_sum(s1); s2 = wave_sum(s2);
        if (lane == 0) { RS[(size_t)row * 2] = rsqrtf(s1 * (1.f / 384.f) + EPS); RS[(size_t)row * 2 + 1] = rsqrtf(s2 * (1.f / 256.f) + EPS); }
#pragma unroll
        for (int ps = 0; ps < 2; ++ps) {
            const int Gi = lane >> 2, qd = lane & 3; const bool on = (ps == 0) || (lane < 16);
            bf16_t* base = pr + (ps == 0 ? 384 : 1184) + 32 * Gi + 4 * qd;
            float x0[4] = {0.f, 0.f, 0.f, 0.f}, x1[4] = {0.f, 0.f, 0.f, 0.f};
            if (on) { const u32x2 w0 = *(const u32x2*)base, w1 = *(const u32x2*)(base + 16);
                x0[0] = bflo(w0.x); x0[1] = bfhi(w0.x); x0[2] = bflo(w0.y); x0[3] = bfhi(w0.y); x1[0] = bflo(w1.x); x1[1] = bfhi(w1.x); x1[2] = bflo(w1.y); x1[3] = bfhi(w1.y); }
            float ss = 0.f;
#pragma unroll
            for (int j = 0; j < 4; ++j) ss += x0[j] * x0[j] + x1[j] * x1[j];
            ss += __shfl_xor(ss, 1); ss += __shfl_xor(ss, 2); ss += __shfl_xor(ss, 4);
            const float rstd = rsqrtf(ss * (1.f / 64.f) + EPS);
            const int gsel = Gi & 1; const float* gn = ps == 0 ? gqn : gkn; const float qs = ps == 0 ? QS64 : 1.f;
            if (on) { float y0[4], y1[4];
#pragma unroll
                for (int j = 0; j < 4; ++j) { const int pidx = 16 * gsel + 4 * qd + j; y0[j] = x0[j] * rstd * gn[2 * pidx]; y1[j] = x1[j] * rstd * gn[2 * pidx + 1];
                    if (lat) { const float cs = cosh_[(size_t)tt * 32 + pidx], sn = sinh_[(size_t)tt * 32 + pidx]; const float a = y0[j] * cs - y1[j] * sn, bb = y0[j] * sn + y1[j] * cs; y0[j] = a; y1[j] = bb; }
                    y0[j] *= qs; y1[j] *= qs; }
                u32x2 w0, w1; w0.x = pk2(y0[0], y0[1]); w0.y = pk2(y0[2], y0[3]); w1.x = pk2(y1[0], y1[1]); w1.y = pk2(y1[2], y1[3]);
                *(u32x2*)base = w0; *(u32x2*)(base + 16) = w1; }
        }
        if (lat && lane < 4) { bf16_t* base = pr + 1152 + 4 * lane; const u32x2 w0 = *(const u32x2*)base, w1 = *(const u32x2*)(base + 16);
            float x0[4] = {bflo(w0.x), bfhi(w0.x), bflo(w0.y), bfhi(w0.y)}, x1[4] = {bflo(w1.x), bfhi(w1.x), bflo(w1.y), bfhi(w1.y)}; float y0[4], y1[4];
#pragma unroll
            for (int j = 0; j < 4; ++j) { const int pidx = 4 * lane + j; const float cs = cosr_[(size_t)tt * 16 + pidx], sn = sinr_[(size_t)tt * 16 + pidx]; y0[j] = x0[j] * cs - x1[j] * sn; y1[j] = x0[j] * sn + x1[j] * cs; }
            u32x2 o0, o1; o0.x = pk2(y0[0], y0[1]); o0.y = pk2(y0[2], y0[3]); o1.x = pk2(y1[0], y1[1]); o1.y = pk2(y1[2], y1[3]);
            *(u32x2*)base = o0; *(u32x2*)(base + 16) = o1; }
    }
}

__device__ __forceinline__ void phase_router(PP P, LAS unsigned char* lds, int c, int G, int layer) {
    const int tid = ltid(), lane = tid & 63, wid = tid >> 6, r32 = lane & 31, hi = lane >> 5;
    const bf16_t* H = (const bf16_t*)(P->ws + WS_H); const bf16_t* HLO = (const bf16_t*)(P->ws + WS_BIG + BIG_HLO);
    const bf16_t* W = (const bf16_t*)(P->ws + (layer ? WS_W1 : WS_W0)) + WO_RT; const bf16_t* WL = W + 64 * 1024;
    const float* brt = P->in[layer ? 33 : 13];
    int* cnt = (int*)(P->ws + WS_CTL + CTL_CNT) + layer * NG; int* srow = (int*)(P->ws + WS_SROW); float* sw = (float*)(P->ws + WS_SW); int* tslot = (int*)(P->ws + WS_TSLOT);
    LAS float* L = (LAS float*)lds + wid * (32 * 65);
    const int ngroups = MROWS / 32;
    for (int gidx = c * 8 + wid; gidx < ngroups; gidx += G * 8) {
        const int row0 = gidx * 32; const int t0 = row0 % TOK;
        if (layer == 1 && t0 < CTX) continue;
        f32x16 a0, a1;
#pragma unroll
        for (int r = 0; r < 16; ++r) { a0[r] = 0.f; a1[r] = 0.f; }
        const bf16_t* hp = H + (size_t)(row0 + r32) * 1024 + 8 * hi; const bf16_t* hl = HLO + (size_t)(row0 + r32) * 1024 + 8 * hi;
        const bf16_t* w0 = W + (size_t)r32 * 1024 + 8 * hi; const bf16_t* wl0 = WL + (size_t)r32 * 1024 + 8 * hi;
#pragma unroll 4
        for (int s = 0; s < 64; ++s) {
            const bf16x8 xh = *(const bf16x8*)(hp + 16 * s), xl = *(const bf16x8*)(hl + 16 * s);
            const bf16x8 wa = *(const bf16x8*)(w0 + 16 * s), wb = *(const bf16x8*)(w0 + 32 * 1024 + 16 * s);
            const bf16x8 la = *(const bf16x8*)(wl0 + 16 * s), lb = *(const bf16x8*)(wl0 + 32 * 1024 + 16 * s);
            a0 = __builtin_amdgcn_mfma_f32_32x32x16_bf16(wa, xh, a0, 0, 0, 0); a1 = __builtin_amdgcn_mfma_f32_32x32x16_bf16(wb, xh, a1, 0, 0, 0);
            a0 = __builtin_amdgcn_mfma_f32_32x32x16_bf16(wa, xl, a0, 0, 0, 0); a1 = __builtin_amdgcn_mfma_f32_32x32x16_bf16(wb, xl, a1, 0, 0, 0);
            a0 = __builtin_amdgcn_mfma_f32_32x32x16_bf16(la, xh, a0, 0, 0, 0); a1 = __builtin_amdgcn_mfma_f32_32x32x16_bf16(lb, xh, a1, 0, 0, 0);
        }
#pragma unroll
        for (int r = 0; r < 16; ++r) { const int e = (r & 3) + 8 * (r >> 2) + 4 * hi; L[r32 * 65 + e] = a0[r]; L[r32 * 65 + e + 32] = a1[r]; }
        __builtin_amdgcn_s_waitcnt(0xC07F);
        __builtin_amdgcn_wave_barrier();
        if (lane < 32) {
            const int row = row0 + lane; float bk[6], bs[6]; int bi[6];
#pragma unroll
            for (int k = 0; k < 6; ++k) { bk[k] = -1e30f; bs[k] = 0.f; bi[k] = 0; }
            for (int e = 0; e < 64; ++e) { const float x = L[lane * 65 + e]; const float sc = 1.f / (1.f + expf(-x)); float key = sc + brt[e]; float s = sc; int id = e;
#pragma unroll
                for (int k = 0; k < 6; ++k) { if (key > bk[k]) { const float tk = bk[k], ts = bs[k]; const int ti = bi[k]; bk[k] = key; bs[k] = s; bi[k] = id; key = tk; s = ts; id = ti; } } }
            float tot = 0.f;
#pragma unroll
            for (int k = 0; k < 6; ++k) tot += bs[k];
            const float sc = 2.5f / tot; const int ch = row / CHUNK_ROWS;
#pragma unroll
            for (int k = 0; k < 6; ++k) { const int e = bi[k]; const int pos = atomicAdd(cnt + ch * NGRP + e, 1);
                if (pos < CAP) srow[(size_t)(ch * 64 + e) * CAP + pos] = row;
                sw[(size_t)row * 8 + k] = bs[k] * sc; tslot[(size_t)row * 6 + k] = (e << 20) | pos; }
        }
        __builtin_amdgcn_wave_barrier();
    }
    if (c == 0 && tid < NCHUNK) cnt[tid * NGRP + NEXP] = layer ? CHUNK_B * SEQ : CHUNK_ROWS;
}

__device__ __forceinline__ void build_toff(LAS int* toff, const int* cnt) {
    const int tid = ltid();
    if (tid < 64) { int v[5], s = 0;
#pragma unroll
        for (int j = 0; j < 5; ++j) { const int g = tid * 5 + j; const int cv = (g < NG) ? ld_ctl(cnt + g) : 0; if (g < NG) toff[272 + g] = cv; v[j] = (cv + 255) >> 8; s += v[j]; }
        int inc = s;
#pragma unroll
        for (int o = 1; o < 64; o <<= 1) { const int t = __shfl_up(inc, o); if (tid >= o) inc += t; }
        int ex = inc - s;
#pragma unroll
        for (int j = 0; j < 5; ++j) { const int g = tid * 5 + j; if (g <= NG) toff[g] = ex; ex += v[j]; } }
    __syncthreads();
}

__device__ __forceinline__ void phase_combine(PP P, LAS unsigned char* lds, int c, int G, int layer, int ch) {
    const int tid_ = ltid(); const int lane = tid_ & 63, wv = c * 8 + (tid_ >> 6), nw = G * 8;
    LAS const int* toff = (LAS const int*)(lds + LDS_TAB);
    const bf16_t* slab = (const bf16_t*)(P->ws + WS_BIG + BIG_SLAB); const int* tslot = (const int*)(P->ws + WS_TSLOT);
    const float* ada = (const float*)(P->ws + WS_ADA) + (size_t)layer * 33 * 6144; const float* ada1 = (const float*)(P->ws + WS_ADA) + (size_t)33 * 6144;
    float* xc = (float*)(P->ws + WS_XC); bf16_t* H = (bf16_t*)(P->ws + WS_H); const float* tokw = (const float*)(P->ws + WS_SW);
    const int t0 = toff[ch * NGRP];
    for (int rr = wv; rr < CHUNK_ROWS; rr += nw) {
        const int row = ch * CHUNK_ROWS + rr; const int b = row / TOK, t = row % TOK; const bool ctx = t < CTX;
        if (ctx && layer == 1) continue;
        int sidx = 0; float swt = 1.f;
        if (lane < 6) { const int v = __hip_atomic_load(tslot + (size_t)row * 6 + lane, __ATOMIC_RELAXED, __HIP_MEMORY_SCOPE_AGENT); sidx = (toff[ch * NGRP + (v >> 20)] - t0) * 256 + (v & 0xfffff);
            swt = __hip_atomic_load(tokw + (size_t)row * 8 + lane, __ATOMIC_RELAXED, __HIP_MEMORY_SCOPE_AGENT); }
        if (lane == 6) { const int rank = layer ? ((b - ch * CHUNK_B) * SEQ + t - CTX) : rr; sidx = (toff[ch * NGRP + NEXP] - t0) * 256 + rank; }
        float* x = ctx ? xc + ((size_t)b * CTX + t) * 1024 : P->out + ((size_t)b * SEQ + t - CTX) * 1024;
        const float* ap = ada + (size_t)(ctx ? 32 : b) * 6144 + 5 * 1024;
        f32x4 xv[4];
#pragma unroll
        for (int i = 0; i < 4; ++i) xv[i] = *(const f32x4*)(x + 512 * (i >> 1) + 8 * lane + 4 * (i & 1));
        float acc[16];
#pragma unroll
        for (int j = 0; j < 16; ++j) acc[j] = 0.f;
#pragma unroll
        for (int k = 0; k < 7; ++k) { const int s = __shfl(sidx, k); const float wk = __shfl(swt, k); const bf16_t* sp = slab + (size_t)s * 1024;
#pragma unroll
            for (int i = 0; i < 2; ++i) { const u32x4 w = __builtin_nontemporal_load((const u32x4*)(sp + 512 * i + 8 * lane));
                acc[8 * i + 0] += wk * bflo(w.x); acc[8 * i + 1] += wk * bfhi(w.x); acc[8 * i + 2] += wk * bflo(w.y); acc[8 * i + 3] += wk * bfhi(w.y);
                acc[8 * i + 4] += wk * bflo(w.z); acc[8 * i + 5] += wk * bfhi(w.z); acc[8 * i + 6] += wk * bflo(w.w); acc[8 * i + 7] += wk * bfhi(w.w); } }
        float v[16]; float ss = 0.f;
#pragma unroll
        for (int i = 0; i < 4; ++i) { const f32x4 gq = *(const f32x4*)(ap + 512 * (i >> 1) + 8 * lane + 4 * (i & 1));
#pragma unroll
            for (int j = 0; j < 4; ++j) { const float y = xv[i][j] + gq[j] * acc[4 * i + j]; v[4 * i + j] = y; ss += y * y; } }
        ss = wave_sum(ss); const float rstd = rsqrtf(ss * (1.f / 1024.f) + EPS);
        if (layer == 0) {
            const float* gm1 = P->in[22]; const float* a1 = ada1 + (size_t)(ctx ? 32 : b) * 6144; float o[16];
#pragma unroll
            for (int i = 0; i < 4; ++i) { const int col = 512 * (i >> 1) + 8 * lane + 4 * (i & 1);
                *(f32x4*)(x + col) = (f32x4){v[4 * i], v[4 * i + 1], v[4 * i + 2], v[4 * i + 3]};
                const f32x4 gg = *(const f32x4*)(gm1 + col), sc = *(const f32x4*)(a1 + 1024 + col), sh = *(const f32x4*)(a1 + col);
#pragma unroll
                for (int j = 0; j < 4; ++j) o[4 * i + j] = v[4 * i + j] * rstd * gg[j] * (1.f + sc[j]) + sh[j]; }
#pragma unroll
            for (int i = 0; i < 2; ++i) { u32x4 w; w.x = pk2(o[8 * i], o[8 * i + 1]); w.y = pk2(o[8 * i + 2], o[8 * i + 3]); w.z = pk2(o[8 * i + 4], o[8 * i + 5]); w.w = pk2(o[8 * i + 6], o[8 * i + 7]);
                *(u32x4*)(H + (size_t)row * 1024 + 512 * i + 8 * lane) = w; }
        } else {
            const float* gf = P->in[40];
#pragma unroll
            for (int i = 0; i < 4; ++i) { const int col = 512 * (i >> 1) + 8 * lane + 4 * (i & 1); const f32x4 gg = *(const f32x4*)(gf + col); f32x4 o;
#pragma unroll
                for (int j = 0; j < 4; ++j) o[j] = v[4 * i + j] * rstd * gg[j];
                *(f32x4*)(x + col) = o; }
        }
    }
}

__device__ __forceinline__ int remap64(int c, int i, int G) { return c + i * G; }
__device__ __forceinline__ int remap8(int c, int G) { return c; }
__device__ __forceinline__ void phase_attn0(PP P, LAS unsigned char* lds, int c, int G) {
    const int tid = ltid(), lane = tid & 63, wid = __builtin_amdgcn_readfirstlane(tid >> 6), r32 = lane & 31;
    const bf16_t* QKV = (const bf16_t*)(P->ws + WS_BIG + BIG_QKV); bf16_t* ATT = (bf16_t*)(P->ws + WS_H);
    const float* sink = P->in[8]; const float* rpb = P->in[9];
    for (int i = 0; c + i * G < 2048; ++i) {
        const int u = remap64(c, i, G); const int b = u >> 6, kvh = (u >> 5) & 1, blk = u & 31; const int g = wid & 3, ts = wid >> 2; const int head = kvh * 4 + g;
        AU a; const int tok = blk * 64 + 32 * ts + r32; const size_t qrow = (size_t)b * TOK + CTX + tok;
        a.qptr = QKV + qrow * 2304 + head * 64; a.optr = ATT + qrow * 1024 + head * 64;
        a.kbase = QKV + 512 + kvh * 64; a.kpitch = 2304; a.vbase = QKV + 640 + kvh * 64; a.vpitch = 2304; a.k2base = nullptr; a.k2pitch = 0;
        a.row_ctx = b * TOK; a.row_lat = b * TOK + CTX; a.start = blk * 64;
        const int jlo = blk >= 2 ? 0 : 2 - blk; int jhi = (2048 + 128 - blk * 64) / 64; jhi = jhi > 5 ? 5 : jhi;
        a.j0 = jlo; a.nt = 4 + (jhi - jlo); a.qoff = 32 * ts + r32; a.m0 = sink[head] * LOG2E; a.l0 = 1.f;
        attn_unit<1, 64>(lds, a);
    }
    for (int i = 0; c + i * G < 2048; ++i) {
        const int u = remap64(c, i, G); const int b = u >> 6, head = (u >> 3) & 7, uu = u & 7;
        { LAS float* bt = (LAS float*)(lds + ATT_RPB);
          for (int idx = tid; idx < 15 * 128; idx += 512) { const int dr = idx >> 7, dc = (idx & 127) - 48; bt[idx] = (dc >= 0 && dc <= 30) ? rpb[(head * 15 + dr) * 31 + dc] * LOG2E : 0.f; } }
        AU a; const int qr = 4 * uu + (wid >> 1), qc = 32 * (wid & 1) + r32; const int tok = qr * 64 + qc; const size_t qrow = (size_t)b * TOK + CTX + tok;
        a.qptr = QKV + qrow * 2304 + 768 + head * 64; a.optr = ATT + qrow * 1024 + 512 + head * 64;
        a.kbase = QKV + 1280 + head * 64; a.kpitch = 2304; a.vbase = QKV + 1792 + head * 64; a.vpitch = 2304; a.k2base = nullptr; a.k2pitch = 0;
        a.row_ctx = b * TOK; a.row_lat = b * TOK + CTX; a.start = 0;
        int rs0 = 4 * uu - 4; rs0 = rs0 < 0 ? 0 : (rs0 > 24 ? 24 : rs0); int rl = 4 * uu - 1; rl = rl < 0 ? 0 : (rl > 24 ? 24 : rl);
        a.j0 = rs0; a.nt = 4 + (rl + 8 - rs0); a.qoff = tok; a.m0 = 0.f; a.l0 = 0.f;
        attn_unit<2, 64>(lds, a);
    }
    for (int u0 = c; u0 < 256; u0 += G) {
        const int u = remap8(u0, G); const int b = u >> 3, kvh = (u >> 2) & 1, cb = u & 3; const int g = wid & 3, ts = wid >> 2; const int head = kvh * 4 + g;
        AU a; const int tok = cb * 64 + 32 * ts + r32; const size_t qrow = (size_t)b * TOK + tok;
        a.qptr = QKV + qrow * 2304 + head * 64; a.optr = ATT + qrow * 1024 + head * 64;
        a.kbase = QKV + 512 + kvh * 64; a.kpitch = 2304; a.vbase = QKV + 640 + kvh * 64; a.vpitch = 2304; a.k2base = nullptr; a.k2pitch = 0;
        a.row_ctx = b * TOK; a.row_lat = 0; a.start = 0; a.j0 = 0; a.nt = 4; a.qoff = 0; a.m0 = sink[head] * LOG2E; a.l0 = 1.f;
        attn_unit<0, 64>(lds, a);
    }
    for (int u0 = c; u0 < 256; u0 += G) {
        const int u = remap8(u0, G); const int b = u >> 3, head = u & 7;
        AU a; const int tok = 32 * wid + r32; const size_t qrow = (size_t)b * TOK + tok;
        a.qptr = QKV + qrow * 2304 + 768 + head * 64; a.optr = ATT + qrow * 1024 + 512 + head * 64;
        a.kbase = QKV + 1280 + head * 64; a.kpitch = 2304; a.vbase = QKV + 1792 + head * 64; a.vpitch = 2304; a.k2base = nullptr; a.k2pitch = 0;
        a.row_ctx = b * TOK; a.row_lat = 0; a.start = 0; a.j0 = 0; a.nt = 4; a.qoff = 0; a.m0 = 0.f; a.l0 = 0.f;
        attn_unit<0, 64>(lds, a);
    }
}
__device__ __forceinline__ void phase_attn1(PP P, LAS unsigned char* lds, int c, int G) {
    const int tid = ltid(), lane = tid & 63, wid = __builtin_amdgcn_readfirstlane(tid >> 6), r32 = lane & 31;
    const bf16_t* PB = (const bf16_t*)(P->ws + WS_BIG + BIG_P); const bf16_t* QM = (const bf16_t*)(P->ws + WS_BIG + BIG_QM); const bf16_t* KVX = (const bf16_t*)(P->ws + WS_BIG + BIG_KVX);
    bf16_t* ATT = (bf16_t*)(P->ws + WS_H);
    for (int u = c; u < 1024; u += G) {
        const int b = u >> 5, head = (u >> 2) & 7, qb = u & 3;
        AU2 a; const int tok = qb * 512 + 64 * wid + r32; const size_t qrow = (size_t)b * TOK + CTX + tok;
        a.qptr = QM + qrow * 768 + head * 96; a.qpitch = 768; a.optr = ATT + qrow * 1024 + head * 64;
        a.kbase = KVX + head * 128; a.kpitch = 1024; a.vbase = KVX + head * 128 + 64; a.vpitch = 1024; a.k2base = PB + 1152; a.k2pitch = 1536;
        a.row_ctx = b * TOK; a.nt = 36;
        attn_unit2<96, false>(lds, a);
    }
    float gq = fabsf(P->in[28][lane]), gk = fabsf(P->in[29][lane]);
#pragma unroll
    for (int o = 32; o > 0; o >>= 1) { gq = fmaxf(gq, __shfl_xor(gq, o)); gk = fmaxf(gk, __shfl_xor(gk, o)); }
    const bool bounded = __builtin_amdgcn_readfirstlane((int)(64.f * gq * gk * QS64 < 100.f)) != 0;
    for (int u = c; u < 1024; u += G) {
        const int b = u >> 5, kvh = (u >> 4) & 1, blk = u & 15;
        if (bounded) {
            const int g = wid & 3, hf = wid >> 2; const int head = kvh * 4 + g;
            AU2 a; const int tok = blk * 128 + 64 * hf + r32; const size_t qrow = (size_t)b * TOK + CTX + tok;
            a.qptr = PB + qrow * 1536 + 384 + head * 64; a.qpitch = 1536; a.optr = ATT + qrow * 1024 + 512 + head * 64;
            a.kbase = PB + 1184 + kvh * 64; a.kpitch = 1536; a.vbase = PB + 1312 + kvh * 64; a.vpitch = 1536; a.k2base = nullptr; a.k2pitch = 0;
            a.row_ctx = b * TOK; a.nt = 36;
            attn_unit2<64, true>(lds, a);
        } else {
            for (int hfb = 0; hfb < 2; ++hfb) { const int g = wid & 3, ts = wid >> 2; const int head = kvh * 4 + g;
                AU a; const int tok = blk * 128 + 64 * hfb + 32 * ts + r32; const size_t qrow = (size_t)b * TOK + CTX + tok;
                a.qptr = PB + qrow * 1536 + 384 + head * 64; a.optr = ATT + qrow * 1024 + 512 + head * 64;
                a.kbase = PB + 1184 + kvh * 64; a.kpitch = 1536; a.vbase = PB + 1312 + kvh * 64; a.vpitch = 1536; a.k2base = nullptr; a.k2pitch = 0;
                a.row_ctx = b * TOK; a.row_lat = 0; a.start = 0; a.j0 = 0; a.nt = 36; a.qoff = 0; a.m0 = 0.f; a.l0 = 0.f;
                attn_unit<0, 64>(lds, a); }
        }
    }
}

constexpr int PH_MOE0 = 7, PH_L1 = PH_MOE0 + 1 + 2 * NCHUNK, PH_MOE1 = PH_L1 + 7, NPH = PH_MOE1 + 1 + 2 * NCHUNK;
template <int PH>
__device__ __forceinline__ void run_phase(LAS unsigned char* lds, int c, int G) {
    const PP P = get_pp();
    const float* rp = (const float*)(P->ws + WS_ROPE);
    const float* ada0 = (const float*)(P->ws + WS_ADA); const float* ada1 = ada0 + (size_t)33 * 6144;
    bf16_t* W0 = (bf16_t*)(P->ws + WS_W0); bf16_t* W1 = (bf16_t*)(P->ws + WS_W1);
    bf16_t* H = (bf16_t*)(P->ws + WS_H); char* BIG = P->ws + WS_BIG; float* XC = (float*)(P->ws + WS_XC);
    if constexpr (PH == 0) { phase_prologue(P, lds, c, G); }
    else if constexpr (PH == 1) { phase_norm(P, c, G, P->in[0], P->in[2], P->in[6], ada0, 0, 1024, false, H, nullptr); }
    else if constexpr (PH == 2) {
        gm::DenseSched S; S.init(0, 9, G, c); gm::Desc d{(const char*)H, 2048u, (const char*)(W0 + WO_IN), 2048u, 1024};
        gm::EpiQKV0 E{(bf16_t*)(BIG + BIG_QKV), rp, rp + 2048 * 32}; gm::gemm_phase(lds, d, S, E); }
    else if constexpr (PH == 3) { phase_attn0(P, lds, ONE_LAUNCH ? (int)*(volatile LAS int*)(lds + LDS_BARW + 8) : c, G); }
    else if constexpr (PH == 4) {
        gm::DenseSched S; S.init(0, 4, G, c); gm::Desc d{(const char*)H, 2048u, (const char*)(W0 + WO_OUT), 2048u, 1024};
        gm::EpiP1 E{(bf16_t*)(BIG + BIG_HLO), 1024, nullptr, 0}; gm::gemm_phase(lds, d, S, E); }
    else if constexpr (PH == 5) { phase_norm(P, c, G, P->in[0], P->in[2], P->in[11], ada0, 3072, 4096, false, H, (bf16_t*)(BIG + BIG_HLO), true, P->out, XC); }
    else if constexpr (PH == 6) { phase_router(P, lds, c, G, 0); }
    else if constexpr (PH == PH_L1) {
        gm::DenseSched S; S.init(0, 6, G, c); gm::Desc d{(const char*)H, 2048u, (const char*)(W1 + WO_IN), 2048u, 1024};
        gm::EpiP1 E{(bf16_t*)(BIG + BIG_P), 1536, nullptr, 0}; gm::gemm_phase(lds, d, S, E); }
    else if constexpr (PH == PH_L1 + 1) { phase_post1(P, c, G); }
    else if constexpr (PH == PH_L1 + 2) {
        { gm::DenseSched S; S.init(1, 3, G, c); gm::Desc d{(const char*)(BIG + BIG_P), 3072u, (const char*)(W1 + WO_UQ), 768u, 384};
          gm::EpiUQ E{(bf16_t*)(BIG + BIG_QM), (const float*)(P->ws + WS_RSTD), rp + 2 * 2048 * 32, rp + 2 * 2048 * 32 + 2048 * 16}; gm::gemm_phase(lds, d, S, E); }
        { gm::DenseSched S; S.init(0, 4, G, c); gm::Desc d{(const char*)(BIG + BIG_P) + 896 * 2, 3072u, (const char*)(W1 + WO_UKV), 512u, 256};
          gm::EpiP1 E{(bf16_t*)(BIG + BIG_KVX), 1024, (const float*)(P->ws + WS_RSTD), 1}; gm::gemm_phase(lds, d, S, E); } }
    else if constexpr (PH == PH_L1 + 3) { phase_attn1(P, lds, ONE_LAUNCH ? (int)*(volatile LAS int*)(lds + LDS_BARW + 8) : c, G); }
    else if constexpr (PH == PH_L1 + 4) {
        gm::DenseSched S; S.init(1, 4, G, c); gm::Desc d{(const char*)H, 2048u, (const char*)(W1 + WO_OUT), 2048u, 1024};
        gm::EpiP1 E{(bf16_t*)(BIG + BIG_HLO), 1024, nullptr, 0}; gm::gemm_phase(lds, d, S, E); }
    else if constexpr (PH == PH_L1 + 5) { phase_norm(P, c, G, P->out, XC, P->in[31], ada1, 3072, 4096, true, H, (bf16_t*)(BIG + BIG_HLO), true, P->out, XC); }
    else if constexpr (PH == PH_L1 + 6) { phase_router(P, lds, c, G, 1); }
    else {
        constexpr int layer = PH >= PH_MOE1 ? 1 : 0; constexpr int rel = PH - (layer ? PH_MOE1 : PH_MOE0);
        const int* cnt = (const int*)(P->ws + WS_CTL + CTL_CNT) + layer * NG;
        LAS int* toff = (LAS int*)(lds + LDS_TAB);
        bf16_t* W = layer ? W1 : W0;
        build_toff(toff, cnt);
        const int pidx = ONE_LAUNCH ? (int)*(volatile LAS int*)(lds + LDS_BARW + 8) : c;
        const int mxq = ONE_LAUNCH ? pidx / (G >> 3) : (c & 7), mxj = ONE_LAUNCH ? pidx % (G >> 3) : (c >> 3);
        if constexpr (rel == 0) {
            gm::MoeSched<1> S; S.toff = toff; S.slot_row = (const int*)(P->ws + WS_SROW); S.t_lo = 0; S.t_hi = toff[NG]; S.nN = 2; S.G = G; S.c = c; S.bN = 512; S.layer = layer; S.xq = mxq; S.xj = mxj;
            gm::Desc d{(const char*)H, 2048u, (const char*)(W + WO_GU), 2048u, 1024};
            gm::EpiG1 E{(bf16_t*)(BIG + BIG_ACT)}; gm::gemm_phase(lds, d, S, E);
        } else if constexpr ((rel & 1) == 1) {
            constexpr int ch = (rel - 1) >> 1;
            gm::MoeSched<2> S; S.toff = toff; S.slot_row = nullptr; S.t_lo = toff[ch * NGRP]; S.t_hi = toff[(ch + 1) * NGRP]; S.nN = 4; S.G = G; S.c = c; S.bN = 1024; S.layer = layer; S.xq = mxq; S.xj = mxj;
            gm::Desc d{(const char*)(BIG + BIG_ACT), 512u, (const char*)(W + WO_D), 512u, 256};
            gm::EpiG2 E{(bf16_t*)(BIG + BIG_SLAB), toff[ch * NGRP] * 256};
            gm::gemm_phase(lds, d, S, E);
        } else {
            constexpr int ch = (rel - 2) >> 1;
            phase_combine(P, lds, c, G, layer, ch);
        }
    }
}

template <int PH> struct PhaseLoop {
    static __device__ __forceinline__ void run(LAS unsigned char* lds, const XcdBarrier& bar) {
        run_phase<PH>(lds, (int)blockIdx.x, (int)gridDim.x);
        if constexpr (PH + 1 < NPH) { xcd_barrier(bar); PhaseLoop<PH + 1>::run(lds, bar); }
    }
};

extern __shared__ __attribute__((aligned(16))) unsigned char smem_raw[];

#if ONE_LAUNCH
__global__ void __launch_bounds__(512, 2) mega_fwd(Params Pk) {
    LAS unsigned char* lds = (LAS unsigned char*)smem_raw;
    volatile LAS unsigned* st = (volatile LAS unsigned*)(lds + LDS_BARW);
    if (threadIdx.x == 0) { st[0] = 0u; st[1] = 0u; st[2] = 0u; st[3] = 0u; }
    __syncthreads();
    XcdBarrier bar = xcd_barrier_post((unsigned*)(Pk.ws + WS_CTL), st);
    int* xr = (int*)(Pk.ws + WS_CTL + CTL_XRANK);
    int myrank = 0; if (threadIdx.x == 0) myrank = atomicAdd(xr + 64 * (int)bar.x, 1);
    run_phase<0>(lds, (int)blockIdx.x, (int)gridDim.x);
    xcd_barrier(bar);
    if (threadIdx.x == 0) { int base = 0; for (int j = 0; j < (int)bar.x; ++j) base += ld_ctl(xr + 64 * j); st[2] = (unsigned)(base + myrank); }
    __syncthreads();
    PhaseLoop<1>::run(lds, bar);
}
#else
template <int PH> __global__ void __launch_bounds__(512, 2) phase_kernel(Params Pk) {
    LAS unsigned char* lds = (LAS unsigned char*)smem_raw;
    run_phase<PH>(lds, (int)blockIdx.x, (int)gridDim.x);
}
template <int PH> struct PhaseLaunch {
    static void run(const Params& P, int grid, hipStream_t s) {
        (void)hipFuncSetAttribute((const void*)phase_kernel<PH>, hipFuncAttributeMaxDynamicSharedMemorySize, LDS_BYTES);
        hipLaunchKernelGGL(phase_kernel<PH>, dim3(grid), dim3(512), LDS_BYTES, s, P);
        if constexpr (PH + 1 < NPH) PhaseLaunch<PH + 1>::run(P, grid, s);
    }
};
#endif

extern "C" void kernel_launch(void* const* d_in, const int* in_sizes, int n_in, void* d_out, int out_size, void* d_ws, size_t ws_size, hipStream_t stream) {
    static int grid = 0;
    if (n_in != 41 || ws_size < WS_END) { fprintf(stderr, "kernel_launch: need 41 inputs and %zu bytes of workspace (got %d, %zu)\n", (size_t)WS_END, n_in, ws_size); return; }
    if (!grid) {
        int dev = 0, cus = 0;
        (void)hipGetDevice(&dev); (void)hipDeviceGetAttribute(&cus, hipDeviceAttributeMultiprocessorCount, dev);
#if ONE_LAUNCH
        (void)hipFuncSetAttribute((const void*)mega_fwd, hipFuncAttributeMaxDynamicSharedMemorySize, LDS_BYTES);
        int per_cu = 0; (void)hipOccupancyMaxActiveBlocksPerMultiprocessor(&per_cu, (const void*)mega_fwd, 512, LDS_BYTES);
        if (per_cu < 1) fprintf(stderr, "kernel_launch: occupancy query says %d blocks per CU\n", per_cu);
#endif
        grid = cus > 0 ? cus : 256;
    }
    Params P{};
    for (int i = 0; i < 41; ++i) P.in[i] = (const float*)d_in[i];
    P.out = (float*)d_out; P.ws = (char*)d_ws;
    (void)hipMemsetAsync((char*)d_ws + WS_CTL, 0, CTL_BYTES, stream);
#if ONE_LAUNCH
    hipLaunchKernelGGL(mega_fwd, dim3(grid), dim3(512), LDS_BYTES, stream, P);
#else
    PhaseLaunch<0>::run(P, grid, stream);
#endif
}
```

```cpp
#include <hip/hip_runtime.h>
#include <stdint.h>
#include <stdio.h>

#ifndef ONE_LAUNCH
#define ONE_LAUNCH 1
#endif

#define LAS __attribute__((address_space(3)))
typedef unsigned short bf16_t;
typedef short bf16x8 __attribute__((ext_vector_type(8)));
typedef short s16x4 __attribute__((ext_vector_type(4)));
typedef float f32x4 __attribute__((ext_vector_type(4)));
typedef float f32x16 __attribute__((ext_vector_type(16)));
typedef unsigned u32x4 __attribute__((ext_vector_type(4)));
typedef unsigned u32x2 __attribute__((ext_vector_type(2)));

constexpr int NB = 32, SEQ = 2048, DM = 1024, CTX = 256, TOK = CTX + SEQ, MROWS = NB * TOK;
constexpr int NEXP = 64, NGRP = 65, NCHUNK = 4, NG = NCHUNK * NGRP;
constexpr int CAP = MROWS / NCHUNK;
constexpr int CHUNK_ROWS = MROWS / NCHUNK;
constexpr int CHUNK_B = NB / NCHUNK;
constexpr float LOG2E = 1.4426950408889634f;
constexpr float QS64 = 0.125f * LOG2E;
constexpr float QS96 = 0.10206207261596575f * LOG2E;
constexpr float EPS = 1e-6f;

constexpr size_t MiB = 1048576;
constexpr size_t WS_CTL = 0;
constexpr size_t CTL_BYTES = 65536;
constexpr size_t CTL_CNT = 16384;
constexpr size_t CTL_XRANK = 24576;
constexpr size_t WS_ADA = 65536;
constexpr size_t WS_ROPE = WS_ADA + 2 * MiB;
constexpr size_t WO_IN = 0, WO_OUT = WO_IN + 2304 * 1024, WO_RT = WO_OUT + 1024 * 1024, WO_UQ = WO_RT + 2 * 64 * 1024, WO_UKV = WO_UQ + 768 * 384,
                 WO_GU = WO_UKV + 1024 * 256, WO_D = WO_GU + (size_t)65 * 512 * 1024, W_ELEMS = WO_D + (size_t)65 * 1024 * 256;
constexpr size_t W_BYTES = ((W_ELEMS * 2 + 255) / 256) * 256;
constexpr size_t WS_W0 = WS_ROPE + 1 * MiB;
constexpr size_t WS_W1 = WS_W0 + W_BYTES;
constexpr size_t WS_XC = WS_W1 + W_BYTES;
constexpr size_t WS_H = WS_XC + 32 * MiB;
constexpr size_t WS_RSTD = WS_H + 144 * MiB;
constexpr size_t WS_SROW = WS_RSTD + 1 * MiB;
constexpr size_t WS_SW = WS_SROW + (size_t)NCHUNK * 64 * CAP * 4;
constexpr size_t WS_TSLOT = WS_SW + (size_t)NCHUNK * 64 * CAP * 4;
constexpr size_t WS_BIG = ((WS_TSLOT + (size_t)MROWS * 6 * 4 + 255) / 256) * 256;
constexpr size_t BIG_QKV = 0;
constexpr size_t BIG_P = 0;
constexpr size_t BIG_QM = BIG_P + (size_t)MROWS * 1536 * 2;
constexpr size_t BIG_KVX = BIG_QM + (size_t)MROWS * 768 * 2;
constexpr size_t BIG_HLO = 0;
constexpr size_t MAXSLOT = (size_t)MROWS * 7 + (size_t)NG * 256;
constexpr size_t BIG_ACT = 0;
constexpr size_t BIG_SLAB = BIG_ACT + MAXSLOT * 512;
constexpr size_t SLAB_SLOTS = (size_t)CHUNK_ROWS * 7 + (size_t)NGRP * 256;
constexpr size_t WS_END = WS_BIG + BIG_SLAB + SLAB_SLOTS * 2048;

constexpr int LDS_BYTES = 139264;
constexpr int LDS_TAB = 131072;
constexpr int LDS_BARW = LDS_BYTES - 16;

struct Params {
    const float* in[41];
    float* out;
    char* ws;
};
typedef const Params __attribute__((address_space(4)))* PP;
__device__ __forceinline__ PP get_pp() { PP p = (PP)__builtin_amdgcn_kernarg_segment_ptr(); asm volatile("" : "+s"(p)); return p; }
__device__ __forceinline__ int ltid() { int t = threadIdx.x; asm volatile("" : "+v"(t)); return t; }

__device__ __forceinline__ unsigned pk2(float lo, float hi) {
    typedef float f2 __attribute__((ext_vector_type(2))); typedef __bf16 b2 __attribute__((ext_vector_type(2)));
    f2 v = {lo, hi}; b2 b = __builtin_convertvector(v, b2); return __builtin_bit_cast(unsigned, b);
}
__device__ __forceinline__ float bflo(unsigned u) { return __uint_as_float(u << 16); }
__device__ __forceinline__ float bfhi(unsigned u) { return __uint_as_float(u & 0xffff0000u); }
__device__ __forceinline__ float wave_sum(float v) {
#pragma unroll
    for (int o = 32; o > 0; o >>= 1) v += __shfl_xor(v, o);
    return v;
}
__device__ __forceinline__ int ld_ctl(const int* p) { return __hip_atomic_load(p, __ATOMIC_RELAXED, __HIP_MEMORY_SCOPE_AGENT); }

#define XB_TMO      128
#define XB_XCNT(j)  (256  + 64 * (j))
#define XB_XSUB(j)  (1280 + 64 * (j))
#define XB_XGEN(j)  (2304 + 64 * (j))
#define XB_TOP      3328
#define XB_TOPGEN   3392
#define XCD_BAR_WORDS 3456
#define XB_SPIN_CAP (1u << 18)

__device__ __forceinline__ unsigned xb_ld(unsigned* p)              { return __hip_atomic_load(p, __ATOMIC_RELAXED, __HIP_MEMORY_SCOPE_AGENT); }
__device__ __forceinline__ unsigned xb_add(unsigned* p, unsigned v) { return __hip_atomic_fetch_add(p, v, __ATOMIC_RELAXED, __HIP_MEMORY_SCOPE_AGENT); }
__device__ __forceinline__ unsigned xb_xcc_id() { return (unsigned)__builtin_amdgcn_s_getreg((3 << 11) | 20) & 0xFu; }
#define XB_SPIN(cond, bar) do { unsigned _sp = 0; while (cond) { __builtin_amdgcn_s_sleep(1); \
    if ((++_sp & 255u) == 0u) { if (xb_ld(&(bar)[XB_TMO])) break; if (_sp > XB_SPIN_CAP) { atomicAdd(&(bar)[XB_TMO], 1u); break; } } } } while (0)

struct XcdBarrier { unsigned* bar; unsigned x; volatile LAS unsigned* st; };

__device__ __forceinline__ XcdBarrier xcd_barrier_post(unsigned* bar, volatile LAS unsigned* st) {
    XcdBarrier b; b.bar = bar; b.x = xb_xcc_id(); b.st = st;
    if (threadIdx.x == 0) (void)xb_add(&bar[XB_XCNT(b.x)], 1u);
    return b;
}
__device__ __forceinline__ void xcd_barrier_complete(unsigned* bar, unsigned x, unsigned& nloc, unsigned& nx) {
    const unsigned G = gridDim.x * gridDim.y * gridDim.z;
    unsigned sum, cnt, mine, sp = 0u;
    for (;;) {
        sum = 0u; cnt = 0u; mine = 0u;
#pragma unroll
        for (unsigned j = 0; j < 16; ++j) { const unsigned c = xb_ld(&bar[XB_XCNT(j)]); sum += c; cnt += (c > 0u) ? 1u : 0u; mine = (j == x) ? c : mine; }
        if (sum == G) break;
        __builtin_amdgcn_s_sleep(1);
        if ((++sp & 255u) == 0u) { if (xb_ld(&bar[XB_TMO])) break; if (sp > XB_SPIN_CAP) { atomicAdd(&bar[XB_TMO], 1u); break; } }
    }
    nloc = mine > 0u ? mine : 1u; nx = cnt > 0u ? cnt : 1u;
}
__device__ __forceinline__ void xcd_barrier(const XcdBarrier& b) {
    asm volatile("s_waitcnt vmcnt(0)" ::: "memory");
    __syncthreads();
    if (threadIdx.x == 0) {
        unsigned* bar = b.bar;
        __builtin_amdgcn_s_waitcnt(0);
        unsigned nloc = b.st[0], nx = b.st[1];
        if (nloc == 0u) { xcd_barrier_complete(bar, b.x, nloc, nx); b.st[0] = nloc; b.st[1] = nx; }
        const unsigned old = xb_add(&bar[XB_XSUB(b.x)], 1u);
        const unsigned gen = old / nloc;
        if (old + 1u == (gen + 1u) * nloc) {
            __builtin_amdgcn_fence(__ATOMIC_RELEASE, "agent");
            asm volatile("s_waitcnt vmcnt(0)" ::: "memory");
            const unsigned og = xb_add(&bar[XB_TOP], 1u);
            const unsigned tg = og / nx;
            if (og + 1u == (tg + 1u) * nx) xb_add(&bar[XB_TOPGEN], 1u);
            else XB_SPIN(xb_ld(&bar[XB_TOPGEN]) == tg, bar);
            __builtin_amdgcn_fence(__ATOMIC_ACQUIRE, "agent");
            xb_add(&bar[XB_XGEN(b.x)], 1u);
            asm volatile("s_waitcnt vmcnt(0)" ::: "memory");
        } else {
            XB_SPIN(xb_ld(&bar[XB_XGEN(b.x)]) == gen, bar);
            __builtin_amdgcn_fence(__ATOMIC_ACQUIRE, "agent");
            asm volatile("s_waitcnt vmcnt(0)" ::: "memory");
        }
    }
    __syncthreads();
}

namespace gm {
constexpr int BM = 256, BK = 64, HALF = 128, HTB = HALF * BK * 2, STAGE_BYTES = 8 * HTB, NXCD = 8, WGM = 8;
__device__ __forceinline__ int lds_byte(int r, int c) { const int st = (r >> 4) * 2 + (c >> 5), rr = r & 15, cc = c & 31, ob = rr * 64 + cc * 2; return st * 1024 + (ob ^ (((ob >> 9) & 1) << 5)); }
__device__ __forceinline__ void stage_rc(int b, int& R, int& C) { const int st = b / 1024, sb = b % 1024, swz = sb ^ (((sb >> 9) & 1) << 5); R = (st >> 1) * 16 + swz / 64; C = (st & 1) * 32 + (swz % 64) / 2; }
__device__ __forceinline__ int perm32(int rho) { const int n = rho >> 4, i = rho & 15; return 8 * (i >> 2) + 4 * n + (i & 3); }

struct Unit { int pm, pn, g, mt, cnt, sbase; };
struct Desc { const char* A; unsigned lda; const char* B; unsigned ldb; int K; };

struct DenseSched {
    int nMt, nN, nwg, G, c, mmode;
    __device__ __forceinline__ void init(int mmode_, int nN_, int G_, int c_) { mmode = mmode_; nMt = mmode_ ? 256 : 288; nN = nN_; nwg = nMt * nN_; G = G_; c = c_; }
    __device__ __forceinline__ bool next(int i, Unit& u) const {
        const long L = (long)i * G + c; if (L >= nwg) return false;
        int wgid = (int)L; { const int q = nwg / NXCD, r = nwg % NXCD, xcd = wgid % NXCD, off = wgid / NXCD; wgid = (xcd < r ? xcd * (q + 1) : r * (q + 1) + (xcd - r) * q) + off; }
        const int nig = WGM * nN, gid = wgid / nig, fm = gid * WGM, gsz = (nMt - fm) < WGM ? (nMt - fm) : WGM;
        const int pmi = fm + ((wgid % nig) % gsz); u.pn = (wgid % nig) / gsz;
        u.pm = mmode ? (pmi >> 3) * 9 + 1 + (pmi & 7) : pmi; u.g = 0; u.mt = 0; u.cnt = 256; u.sbase = 0; return true;
    }
    __device__ __forceinline__ int a_row(const Unit& u, int r) const { return u.pm * 256 + r; }
    __device__ __forceinline__ int a_raw(const Unit&, int) const { return 0; }
    __device__ __forceinline__ int a_fin(const Unit& u, int r, int) const { return u.pm * 256 + r; }
    __device__ __forceinline__ int b_row(const Unit& u) const { return u.pn * 256; }
};

template <int WHICH  >
struct MoeSched {
    LAS const int* toff; const int* slot_row; int nN, G, c, bN, layer, t_lo, t_hi, xq, xj;
    __device__ __forceinline__ bool next(int i, Unit& u) const {
        const int per = G >> 3, nt_ = t_hi - t_lo;
        const int xs = t_lo + (int)(((long)nt_ * xq) >> 3), xe = t_lo + (int)(((long)nt_ * (xq + 1)) >> 3);
        const int L = i * per + xj; if (L >= (xe - xs) * nN) return false;
        const int tau = L / nN; u.pn = L - tau * nN; const int T = xs + tau;
        int lo = 0, hi = NG;
        while (hi - lo > 1) { const int mid = (lo + hi) >> 1; if (toff[mid] <= T) lo = mid; else hi = mid; }
        u.g = lo; u.mt = T - toff[lo]; u.pm = T; u.sbase = T * 256; u.cnt = toff[272 + lo]; return true;
    }
    __device__ __forceinline__ int a_row(const Unit& u, int r) const {
        if (WHICH == 2) return u.sbase + r;
        const int e = u.g % NGRP, ch = u.g / NGRP, idx = u.mt * 256 + r;
        const bool in = (e < NEXP) && (idx < u.cnt);
        const int lrow = slot_row[(size_t)(ch * 64 + (e < NEXP ? e : 0)) * CAP + (in ? idx : 0)];
        const int b1 = ch * CHUNK_B + (idx >> 11);
        const int srow = (layer == 0) ? (ch * CHUNK_ROWS + idx) : (b1 * TOK + CTX + (idx & 2047));
        return (e == NEXP) ? srow : (in ? lrow : 0);
    }
    __device__ __forceinline__ int a_raw(const Unit& u, int r) const {
        if (WHICH == 2) return 0;
        const int e = u.g % NGRP, ch = u.g / NGRP, idx = u.mt * 256 + r; const bool in = (e < NEXP) && (idx < u.cnt);
        return slot_row[(size_t)(ch * 64 + (e < NEXP ? e : 0)) * CAP + (in ? idx : 0)];
    }
    __device__ __forceinline__ int a_fin(const Unit& u, int r, int raw) const {
        if (WHICH == 2) return u.sbase + r;
        const int e = u.g % NGRP, ch = u.g / NGRP, idx = u.mt * 256 + r; const bool in = (e < NEXP) && (idx < u.cnt);
        const int b1 = ch * CHUNK_B + (idx >> 11);
        const int srow = (layer == 0) ? (ch * CHUNK_ROWS + idx) : (b1 * TOK + CTX + (idx & 2047));
        return (e == NEXP) ? srow : (in ? raw : 0);
    }
    __device__ __forceinline__ int b_row(const Unit& u) const { return (u.g % NGRP) * bN + u.pn * 256; }
};

template <class Epi, class Sched>
__device__ __forceinline__ void gemm_phase(LAS unsigned char* lds, const Desc g, const Sched& S, const Epi& E) {
    const int tid = ltid(), wid = __builtin_amdgcn_readfirstlane(tid >> 6), lane = tid & 63, wr = wid >> 2, wc = wid & 3, fr = lane & 15, fq = lane >> 4;
    const int nt = g.K / BK;
    unsigned voffB[2][2];
#pragma unroll
    for (int i = 0; i < 2; ++i) { int R, C; stage_rc(tid * 16 + i * 8192, R, C); const int Rl = Epi::PERM ? perm32(R & 31) : (R & 31);
#pragma unroll
        for (int h = 0; h < 2; ++h) { const int Rb = Epi::WIDE ? (64 * (R >> 5) + 32 * h + Rl) : (128 * h + (R & ~31) + Rl);
            voffB[h][i] = (unsigned)Rb * g.ldb + (unsigned)C * 2u; } }
    const size_t kstep = (size_t)(BK * 2);
    const unsigned ldsw = (unsigned)wid * 1024u;
    const int aoff = lds_byte(wr * 64 + fr, fq * 8), boff = lds_byte(wc * 32 + fr, fq * 8);
#define GM_SA(b, h) (((b) * 2 + (h)) * HTB)
#define GM_SB(b, h) ((4 + (b) * 2 + (h)) * HTB)
#define GM_STAGE_A(bufoff, kb, va, h) do { _Pragma("unroll") for (int _i = 0; _i < 2; ++_i) \
        __builtin_amdgcn_global_load_lds((const unsigned*)(g.A + (kb) + (va)[h][_i]), (LAS unsigned*)(lds + (bufoff) + ldsw + _i * 8192), 16, 0, 0); } while (0)
#define GM_STAGE_B(bufoff, bp, h) do { _Pragma("unroll") for (int _i = 0; _i < 2; ++_i) \
        __builtin_amdgcn_global_load_lds((const unsigned*)((bp) + voffB[h][_i]), (LAS unsigned*)(lds + (bufoff) + ldsw + _i * 8192), 16, 0, 0); } while (0)
#define GM_LDA(dst, b, h) do { _Pragma("unroll") for (int m = 0; m < 4; ++m) _Pragma("unroll") for (int k = 0; k < 2; ++k) dst[m][k] = *(const LAS bf16x8*)(lds + GM_SA(b, h) + aoff + m * 2048 + k * 1024); } while (0)
#define GM_LDB(dst, b, h) do { _Pragma("unroll") for (int n = 0; n < 2; ++n) _Pragma("unroll") for (int k = 0; k < 2; ++k) dst[n][k] = *(const LAS bf16x8*)(lds + GM_SB(b, h) + boff + n * 2048 + k * 1024); } while (0)
#define GM_MMA(ai, bj, At, Bt) do { __builtin_amdgcn_s_setprio(1); _Pragma("unroll") for (int m = 0; m < 4; ++m) _Pragma("unroll") for (int n = 0; n < 2; ++n) _Pragma("unroll") for (int k = 0; k < 2; ++k) \
        acc[ai][bj][m][n] = __builtin_amdgcn_mfma_f32_16x16x32_bf16(Bt[n][k], At[m][k], acc[ai][bj][m][n], 0, 0, 0); __builtin_amdgcn_s_setprio(0); } while (0)
#define GM_WAIT_V(n) do { asm volatile("" ::: "memory"); __builtin_amdgcn_s_waitcnt(((n) & 15) | (((n) >> 4) << 14) | 0x0F70); asm volatile("" ::: "memory"); } while (0)
#define GM_WAIT_L(n) asm volatile("s_waitcnt lgkmcnt(" #n ")" ::: "memory")
#define GM_BAR __builtin_amdgcn_s_barrier()
#define GM_SCHED __builtin_amdgcn_sched_barrier(0)
#define GM_CALC_VA(va, u) do { int _tz = tid; asm volatile("" : "+v"(_tz)); int _rw[2][2]; unsigned _cc[2]; \
        _Pragma("unroll") for (int _i = 0; _i < 2; ++_i) { int _R, _C; stage_rc(_tz * 16 + _i * 8192, _R, _C); _cc[_i] = (unsigned)_C * 2u; \
            _Pragma("unroll") for (int _h = 0; _h < 2; ++_h) _rw[_h][_i] = S.a_row((u), _h * HALF + _R); } \
        _Pragma("unroll") for (int _i = 0; _i < 2; ++_i) _Pragma("unroll") for (int _h = 0; _h < 2; ++_h) (va)[_h][_i] = (unsigned)_rw[_h][_i] * g.lda + _cc[_i]; } while (0)
#define GM_LOAD_RAW(raw, u) do { int _tz = tid; asm volatile("" : "+v"(_tz)); \
        _Pragma("unroll") for (int _i = 0; _i < 2; ++_i) { int _R, _C; stage_rc(_tz * 16 + _i * 8192, _R, _C); \
            _Pragma("unroll") for (int _h = 0; _h < 2; ++_h) (raw)[_h][_i] = S.a_raw((u), _h * HALF + _R); } } while (0)
#define GM_FIN_VA(va, u, raw) do { int _tz = tid; asm volatile("" : "+v"(_tz)); \
        _Pragma("unroll") for (int _i = 0; _i < 2; ++_i) { int _R, _C; stage_rc(_tz * 16 + _i * 8192, _R, _C); \
            _Pragma("unroll") for (int _h = 0; _h < 2; ++_h) (va)[_h][_i] = (unsigned)S.a_fin((u), _h * HALF + _R, (raw)[_h][_i]) * g.lda + (unsigned)_C * 2u; } } while (0)
    Unit cur, nxt; int ui = 0;
    if (!S.next(0, cur)) return;
    f32x4 acc[2][2][4][2];
#pragma unroll
    for (int a = 0; a < 2; ++a)
#pragma unroll
        for (int b = 0; b < 2; ++b)
#pragma unroll
            for (int m = 0; m < 4; ++m)
#pragma unroll
                for (int n = 0; n < 2; ++n) acc[a][b][m][n] = (f32x4){0.f, 0.f, 0.f, 0.f};
    bf16x8 At[4][2], B0[2][2], B1[2][2];
    unsigned vaC[2][2];
    GM_CALC_VA(vaC, cur);
    const char* cB = g.B + (size_t)S.b_row(cur) * g.ldb;
    GM_STAGE_B(GM_SB(0, 0), cB, 0); GM_STAGE_A(GM_SA(0, 0), (size_t)0, vaC, 0); GM_STAGE_B(GM_SB(0, 1), cB, 1); GM_STAGE_A(GM_SA(0, 1), (size_t)0, vaC, 1);
    if (wr == 1) GM_BAR;
    GM_WAIT_V(4); GM_BAR;
    GM_STAGE_B(GM_SB(1, 0), cB + kstep, 0); GM_STAGE_A(GM_SA(1, 0), kstep, vaC, 0); GM_STAGE_B(GM_SB(1, 1), cB + kstep, 1);
    GM_WAIT_V(6); GM_BAR;
    for (;;) {
        const bool has_next = S.next(ui + 1, nxt);
        const char* nB = cB;
        if (has_next) nB = g.B + (size_t)S.b_row(nxt) * g.ldb;
        unsigned va2[2][2]; int rawN[2][2] = {{0, 0}, {0, 0}};
#pragma clang loop unroll(disable)
        for (int t = 0; t < nt; t += 2) {
            const bool last = (t == nt - 2);
            const size_t k1 = (size_t)(t + 1) * kstep;
            const size_t k2 = last ? (size_t)0 : (size_t)(t + 2) * kstep, k3 = k2 + kstep;
            const char* b2 = last ? nB : cB + k2; const char* b3 = b2 + kstep;
#pragma unroll
            for (int _h = 0; _h < 2; ++_h)
#pragma unroll
                for (int _i = 0; _i < 2; ++_i) va2[_h][_i] = vaC[_h][_i];
            if (last && has_next) { if (t == 0) GM_CALC_VA(va2, nxt); else GM_FIN_VA(va2, nxt, rawN); }
            if (t == 0 && !last && has_next) GM_LOAD_RAW(rawN, nxt);
            GM_LDB(B0, 0, 0); GM_SCHED; GM_LDA(At, 0, 0); GM_STAGE_A(GM_SA(1, 1), k1, vaC, 1);
            GM_WAIT_L(8); GM_BAR; GM_WAIT_L(0); GM_MMA(0, 0, At, B0); GM_BAR; GM_SCHED;
            GM_LDB(B1, 0, 1); GM_STAGE_B(GM_SB(0, 0), b2, 0);
            GM_BAR; GM_WAIT_L(0); GM_MMA(0, 1, At, B1); GM_BAR;
            GM_LDA(At, 0, 1); GM_STAGE_A(GM_SA(0, 0), k2, va2, 0);
            GM_BAR; GM_WAIT_L(0); GM_MMA(1, 0, At, B0); GM_BAR; GM_SCHED;
            GM_STAGE_B(GM_SB(0, 1), b2, 1);
            GM_WAIT_V(6); GM_BAR; GM_MMA(1, 1, At, B1); GM_BAR;
            GM_LDB(B0, 1, 0); GM_SCHED; GM_LDA(At, 1, 0); GM_STAGE_A(GM_SA(0, 1), k2, va2, 1);
            GM_WAIT_L(8); GM_BAR; GM_WAIT_L(0); GM_MMA(0, 0, At, B0); GM_BAR; GM_SCHED;
            GM_LDB(B1, 1, 1); GM_STAGE_B(GM_SB(1, 0), b3, 0);
            GM_BAR; GM_WAIT_L(0); GM_MMA(0, 1, At, B1); GM_BAR;
            GM_LDA(At, 1, 1); GM_STAGE_A(GM_SA(1, 0), k3, va2, 0);
            GM_BAR; GM_WAIT_L(0); GM_MMA(1, 0, At, B0); GM_BAR; GM_SCHED;
            GM_STAGE_B(GM_SB(1, 1), b3, 1);
            GM_WAIT_V(6); GM_BAR; GM_MMA(1, 1, At, B1); GM_BAR;
        }
        { int tz = tid; asm volatile("" : "+v"(tz));
          const int wid2 = __builtin_amdgcn_readfirstlane(tz >> 6), ln2 = tz & 63; E(acc, cur, wid2 >> 2, wid2 & 3, ln2 & 15, ln2 >> 4); }
        if (!has_next) break;
#pragma unroll
        for (int a = 0; a < 2; ++a)
#pragma unroll
            for (int b = 0; b < 2; ++b)
#pragma unroll
                for (int m = 0; m < 4; ++m)
#pragma unroll
                    for (int n = 0; n < 2; ++n) acc[a][b][m][n] = (f32x4){0.f, 0.f, 0.f, 0.f};
        cur = nxt; cB = nB; ++ui;
#pragma unroll
        for (int _h = 0; _h < 2; ++_h)
#pragma unroll
            for (int _i = 0; _i < 2; ++_i) vaC[_h][_i] = va2[_h][_i];
    }
    GM_WAIT_V(0);
    if (wr == 0) GM_BAR;
    GM_BAR;
#undef GM_SA
#undef GM_SB
#undef GM_STAGE_A
#undef GM_STAGE_B
#undef GM_LDA
#undef GM_LDB
#undef GM_MMA
#undef GM_WAIT_V
#undef GM_WAIT_L
#undef GM_BAR
#undef GM_SCHED
#undef GM_CALC_VA
#undef GM_LOAD_RAW
#undef GM_FIN_VA
}

typedef const f32x4 (&AccRef)[2][2][4][2];
__device__ __forceinline__ u32x4 pair16(u32x2 a, u32x2 b) {
    const auto r0 = __builtin_amdgcn_permlane16_swap(a.x, b.x, false, false); const auto r1 = __builtin_amdgcn_permlane16_swap(a.y, b.y, false, false);
    u32x4 w; w.x = r0[0]; w.y = r1[0]; w.z = r0[1]; w.w = r1[1]; return w;
}

struct EpiQKV0 {
    static constexpr bool PERM = false; static constexpr int WIDE = 0;
    bf16_t* O; const float* cosT; const float* sinT;
    __device__ __forceinline__ void operator()(AccRef acc, const Unit& u, int wr, int wc, int fr, int fq) const {
        const int tq = u.pm % 9; const bool ctx = (tq == 0); const int tbase = tq * 256 - 256;
        const int colg0 = 256 * u.pn + 32 * wc; const bool rope0 = (colg0 < 640) && !ctx, rope1 = (colg0 + 128 < 640) && !ctx; const int gi = 16 * (wc & 1) + 4 * fq;
        f32x4 cs[8], sn[8];
        if (rope0) {
#pragma unroll
            for (int q = 0; q < 8; ++q) { const int rl = 128 * (q >> 2) + 64 * wr + 16 * (q & 3) + fr; cs[q] = *(const f32x4*)(cosT + (size_t)(tbase + rl) * 32 + gi); sn[q] = *(const f32x4*)(sinT + (size_t)(tbase + rl) * 32 + gi); }
        }
#pragma unroll
        for (int bj = 0; bj < 2; ++bj) {
            const int colg = colg0 + 128 * bj; const bool rope = bj ? rope1 : rope0;
#pragma unroll
            for (int ai = 0; ai < 2; ++ai)
#pragma unroll
                for (int m = 0; m < 4; ++m) {
                    const int rl = 128 * ai + 64 * wr + 16 * m + fr; const size_t row = (size_t)u.pm * 256 + rl;
                    f32x4 v0 = acc[ai][bj][m][0], v1 = acc[ai][bj][m][1];
                    if (rope) { const f32x4 c4 = cs[4 * ai + m], s4 = sn[4 * ai + m]; const f32x4 x0 = v0 * c4 - v1 * s4, x1 = v0 * s4 + v1 * c4; v0 = x0; v1 = x1; }
                    bf16_t* p = O + row * 2304 + colg + ((fq & 1) ? 16 + 4 * (fq - 1) : 4 * fq);
                    u32x2 w0, w1; w0.x = pk2(v0[0], v0[1]); w0.y = pk2(v0[2], v0[3]); w1.x = pk2(v1[0], v1[1]); w1.y = pk2(v1[2], v1[3]);
                    *(u32x4*)p = pair16(w0, w1);
                }
        }
    }
};
struct EpiP1 {
    static constexpr bool PERM = true; static constexpr int WIDE = 1;
    bf16_t* O; int ldc; const float* rs; int rsel;
    __device__ __forceinline__ void operator()(AccRef acc, const Unit& u, int wr, int wc, int fr, int fq) const {
        float scv[8];
#pragma unroll
        for (int q = 0; q < 8; ++q) { const size_t row = (size_t)u.pm * 256 + 128 * (q >> 2) + 64 * wr + 16 * (q & 3) + fr; scv[q] = rs ? rs[row * 2 + rsel] : 1.f; }
        const bool lo = fr < 8; const int col = 256 * u.pn + 64 * wc + 8 * fq + (lo ? 0 : 32);
#pragma unroll
        for (int ai = 0; ai < 2; ++ai)
#pragma unroll
            for (int m = 0; m < 4; ++m) { const size_t row = (size_t)u.pm * 256 + 128 * ai + 64 * wr + 16 * m + (fr & 7); const float sc = scv[4 * ai + m];
                u32x4 x0, x1;
                { const f32x4 v0 = acc[ai][0][m][0] * sc, v1 = acc[ai][0][m][1] * sc; x0.x = pk2(v0[0], v0[1]); x0.y = pk2(v0[2], v0[3]); x0.z = pk2(v1[0], v1[1]); x0.w = pk2(v1[2], v1[3]); }
                { const f32x4 v0 = acc[ai][1][m][0] * sc, v1 = acc[ai][1][m][1] * sc; x1.x = pk2(v0[0], v0[1]); x1.y = pk2(v0[2], v0[3]); x1.z = pk2(v1[0], v1[1]); x1.w = pk2(v1[2], v1[3]); }
                u32x4 rc;
#pragma unroll
                for (int q = 0; q < 4; ++q) rc[q] = (unsigned)__shfl_xor((int)(lo ? x1[q] : x0[q]), 8);
                const u32x4 da = lo ? x0 : rc, db = lo ? rc : x1;
                *(u32x4*)(O + row * ldc + col) = da; *(u32x4*)(O + (row + 8) * ldc + col) = db; }
    }
};
struct EpiUQ {
    static constexpr bool PERM = false; static constexpr int WIDE = 0;
    bf16_t* O; const float* rs; const float* cosT; const float* sinT;
    __device__ __forceinline__ void operator()(AccRef acc, const Unit& u, int wr, int wc, int fr, int fq) const {
        const int tq = u.pm % 9; const bool ctx = (tq == 0); const int tbase = tq * 256 - 256;
        const int colg0 = 256 * u.pn + 32 * wc, colg1 = colg0 + 128;
        const bool rope0 = ((colg0 >> 5) % 3 == 2) && !ctx, rope1 = ((colg1 >> 5) % 3 == 2) && !ctx;
        float scv[8]; f32x4 cs[8], sn[8];
#pragma unroll
        for (int q = 0; q < 8; ++q) { const int rl = 128 * (q >> 2) + 64 * wr + 16 * (q & 3) + fr; scv[q] = rs[((size_t)u.pm * 256 + rl) * 2]; }
        if (rope0 || rope1) {
#pragma unroll
            for (int q = 0; q < 8; ++q) { const int rl = 128 * (q >> 2) + 64 * wr + 16 * (q & 3) + fr; cs[q] = *(const f32x4*)(cosT + (size_t)(tbase + rl) * 16 + 4 * fq); sn[q] = *(const f32x4*)(sinT + (size_t)(tbase + rl) * 16 + 4 * fq); }
        }
#pragma unroll
        for (int ai = 0; ai < 2; ++ai)
#pragma unroll
            for (int m = 0; m < 4; ++m) {
                const int rl = 128 * ai + 64 * wr + 16 * m + fr; const size_t row = (size_t)u.pm * 256 + rl; const float sc = scv[4 * ai + m];
#pragma unroll
                for (int bj = 0; bj < 2; ++bj) {
                    f32x4 v0 = acc[ai][bj][m][0] * sc, v1 = acc[ai][bj][m][1] * sc;
                    if (bj ? rope1 : rope0) { const f32x4 c4 = cs[4 * ai + m], s4 = sn[4 * ai + m]; const f32x4 x0 = v0 * c4 - v1 * s4, x1 = v0 * s4 + v1 * c4; v0 = x0; v1 = x1; }
                    bf16_t* p = O + row * 768 + (bj ? colg1 : colg0) + ((fq & 1) ? 16 + 4 * (fq - 1) : 4 * fq);
                    u32x2 w0, w1; w0.x = pk2(v0[0], v0[1]); w0.y = pk2(v0[2], v0[3]); w1.x = pk2(v1[0], v1[1]); w1.y = pk2(v1[2], v1[3]);
                    *(u32x4*)p = pair16(w0, w1);
                }
            }
    }
};
struct EpiG1 {
    static constexpr bool PERM = false; static constexpr int WIDE = 1;
    bf16_t* act;
    __device__ __forceinline__ void operator()(AccRef acc, const Unit& u, int wr, int wc, int fr, int fq) const {
        const int colb = 16 * (8 * u.pn + 2 * wc) + ((fq & 1) ? 16 + 4 * (fq - 1) : 4 * fq);
#pragma unroll
        for (int ai = 0; ai < 2; ++ai)
#pragma unroll
            for (int m = 0; m < 4; ++m) {
                const int rl = 128 * ai + 64 * wr + 16 * m + fr; u32x2 o[2];
#pragma unroll
                for (int bj = 0; bj < 2; ++bj) {
                    const f32x4 gt = acc[ai][bj][m][0], up = acc[ai][bj][m][1]; float r[4];
#pragma unroll
                    for (int j = 0; j < 4; ++j) r[j] = gt[j] * __builtin_amdgcn_rcpf(1.f + __expf(-gt[j])) * up[j];
                    o[bj].x = pk2(r[0], r[1]); o[bj].y = pk2(r[2], r[3]);
                }
                *(u32x4*)(act + ((size_t)u.sbase + rl) * 256 + colb) = pair16(o[0], o[1]);
            }
    }
};
struct EpiG2 {
    static constexpr bool PERM = true; static constexpr int WIDE = 1;
    unsigned char* slab; int sbase0;
    static __device__ __forceinline__ unsigned q4(const f32x4 v) {
        const float a = __builtin_amdgcn_fmed3f(v[0], -448.f, 448.f), b = __builtin_amdgcn_fmed3f(v[1], -448.f, 448.f), c = __builtin_amdgcn_fmed3f(v[2], -448.f, 448.f), d = __builtin_amdgcn_fmed3f(v[3], -448.f, 448.f);
        int w = __builtin_amdgcn_cvt_pk_fp8_f32(a, b, 0, false); w = __builtin_amdgcn_cvt_pk_fp8_f32(c, d, w, true); return (unsigned)w;
    }
    __device__ __forceinline__ void operator()(AccRef acc, const Unit& u, int wr, int wc, int fr, int fq) const {
        const int col = 256 * u.pn + 64 * wc + ((fq & 1) ? 32 + 8 * (fq - 1) : 8 * fq);
#pragma unroll
        for (int ai = 0; ai < 2; ++ai)
#pragma unroll
            for (int m = 0; m < 4; ++m) { const size_t row = (size_t)(u.sbase - sbase0) + 128 * ai + 64 * wr + 16 * m + fr;
                u32x2 a, b; a.x = q4(acc[ai][0][m][0]); a.y = q4(acc[ai][0][m][1]); b.x = q4(acc[ai][1][m][0]); b.y = q4(acc[ai][1][m][1]);
                __builtin_nontemporal_store(pair16(a, b), (u32x4*)(slab + row * 1024 + col)); }
    }
};
}

struct AU {
    const bf16_t* qptr;
    bf16_t* optr;
    const bf16_t* kbase; unsigned kpitch;
    const bf16_t* vbase; unsigned vpitch;
    const bf16_t* k2base; unsigned k2pitch;
    int row_ctx, row_lat;
    int nt;
    int j0;
    int qoff;
    int start;
    float m0, l0;
};
constexpr int ATT_RPB = 122880;
constexpr float THR = 8.f;
__device__ __forceinline__ void glds16(const void* gsrc, unsigned lds_dst) { unsigned keep;
    asm volatile("s_mov_b32 %0, m0\n\ts_mov_b32 m0, %2\n\ts_nop 0\n\tglobal_load_lds_dwordx4 %1, off\n\ts_mov_b32 m0, %0" : "=&s"(keep) : "v"(gsrc), "s"(lds_dst) : "memory"); }
__device__ __forceinline__ float max3f(float a, float b, float c) { float r; asm("v_max3_f32 %0, %1, %2, %3" : "=v"(r) : "v"(a), "v"(b), "v"(c)); return r; }
__device__ __forceinline__ float max2f(float a, float b) { float r; asm("v_max_f32_e32 %0, %1, %2" : "=v"(r) : "v"(a), "v"(b)); return r; }

template <int MODE  , int DQ  >
__device__ __forceinline__ void attn_unit(LAS unsigned char* lds, const AU& a) {
    constexpr int NS = DQ / 16;
    constexpr int BUFB = (DQ == 96) ? 20480 : 16384;
    const int tid = ltid(), lane = tid & 63, wid = __builtin_amdgcn_readfirstlane(tid >> 6), r32 = lane & 31, hi = lane >> 5;
    const bool upper = wid >= 4;
    const int kr = tid >> 3, cp = tid & 7;
    const int ksrc = (cp ^ ((kr >> 1) & 7)) * 8, vsrc = (cp ^ (((kr >> 1) & 1) << 2)) * 8;
    const int kr2 = 16 * wid + (lane >> 2), k2src = ((lane & 3) ^ ((kr2 >> 2) & 3)) * 8;
    unsigned koff[NS];
#pragma unroll
    for (int s = 0; s < NS; ++s) koff[s] = (s < 4) ? (unsigned)(r32 * 128 + (((2 * s + hi) ^ ((r32 >> 1) & 7)) << 4))
                                                   : (unsigned)(16384 + r32 * 64 + (((2 * (s - 4) + hi) ^ ((r32 >> 2) & 3)) << 4));
    const int vg = (lane >> 4) & 1, vq = (lane & 15) >> 2, vp = lane & 3, vsw = (vq >> 1) & 1;
    const unsigned voff0 = (unsigned)(8192 + (4 * hi + vq) * 128 + 64 * vsw + 32 * vg + 8 * vp);
    const unsigned voff1 = (unsigned)(8192 + (4 * hi + vq) * 128 + 64 * (1 - vsw) + 32 * vg + 8 * vp);
    bf16x8 qf[NS];
#pragma unroll
    for (int s = 0; s < NS; ++s) qf[s] = *(const bf16x8*)(a.qptr + 16 * s + 8 * hi);
    f32x16 o0, o1, negm, p0, p1;
    float m = a.m0, l = a.l0;
#pragma unroll
    for (int r = 0; r < 16; ++r) { o0[r] = 0.f; o1[r] = 0.f; negm[r] = -m; p0[r] = 0.f; p1[r] = 0.f; }
    const int nt = a.nt;
    auto krow = [&](int t, int r) -> int {
        if (MODE == 0) return a.row_ctx + 64 * t + r;
        if (t < 4) return a.row_ctx + 64 * t + r;
        if (MODE == 1) return a.row_lat + a.start - 128 + 64 * (a.j0 + t - 4) + r;
        return a.row_lat + 64 * (a.j0 + t - 4) + r;
    };
    const unsigned lds0 = (unsigned)(uintptr_t)lds + (unsigned)wid * 1024u;
    auto dma = [&](int t, int boff) {
        const size_t r = (size_t)krow(t, kr);
        glds16(a.kbase + r * a.kpitch + ksrc, (unsigned)__builtin_amdgcn_readfirstlane((int)(lds0 + boff)));
        glds16(a.vbase + r * a.vpitch + vsrc, (unsigned)__builtin_amdgcn_readfirstlane((int)(lds0 + boff + 8192)));
        if (DQ == 96) { if (!upper) { const size_t r2 = (size_t)krow(t, kr2);
            glds16(a.k2base + r2 * a.k2pitch + k2src, (unsigned)__builtin_amdgcn_readfirstlane((int)(lds0 + boff + 16384))); } }
    };
    auto tile_active = [&](int t) -> bool {
        if (MODE != 2 || t < 4) return true;
        const int qrow = a.qoff >> 6; int rs = qrow - 4; rs = rs < 0 ? 0 : (rs > 24 ? 24 : rs); const int kgr = a.j0 + t - 4;
        return __builtin_amdgcn_readfirstlane((int)((kgr >= rs) && (kgr < rs + 8))) != 0;
    };
    auto QK = [&](int t, int boff) {
        const LAS unsigned char* Bb = lds + boff;
        bf16x8 kf[2 * NS];
#pragma unroll
        for (int s = 0; s < NS; ++s) { kf[2 * s] = *(const LAS bf16x8*)(Bb + koff[s]); kf[2 * s + 1] = *(const LAS bf16x8*)(Bb + koff[s] + (s < 4 ? 4096 : 2048)); }
#pragma unroll
        for (int s = 0; s < NS; ++s) {
            if (s == 0) { p0 = __builtin_amdgcn_mfma_f32_32x32x16_bf16(kf[0], qf[0], negm, 0, 0, 0); p1 = __builtin_amdgcn_mfma_f32_32x32x16_bf16(kf[1], qf[0], negm, 0, 0, 0); }
            else { p0 = __builtin_amdgcn_mfma_f32_32x32x16_bf16(kf[2 * s], qf[s], p0, 0, 0, 0); p1 = __builtin_amdgcn_mfma_f32_32x32x16_bf16(kf[2 * s + 1], qf[s], p1, 0, 0, 0); }
        }
        __builtin_amdgcn_sched_group_barrier(0x100, 2 * NS, 0);
        __builtin_amdgcn_sched_group_barrier(0x008, 2 * NS, 0);
        if (MODE == 1 && t >= 4) {
            const int j = a.j0 + t - 4;
            if (j == 0 || j == 4) {
                const int dbase = -128 + 64 * j - a.qoff + 4 * hi;
#pragma unroll
                for (int r = 0; r < 16; ++r) { const int d = dbase + (r & 3) + 8 * (r >> 2);
                    if ((unsigned)(d + 128) > 256u) p0[r] = -1e30f; if ((unsigned)(d + 32 + 128) > 256u) p1[r] = -1e30f; }
            }
        }
        if (MODE == 2 && t >= 4) {
            const int qrow = a.qoff >> 6, qcol = a.qoff & 63; int cs = qcol - 8; cs = cs < 0 ? 0 : (cs > 48 ? 48 : cs);
            const int krel = a.j0 + t - 4 - qrow + 7;
            const LAS float* bt = (const LAS float*)(lds + ATT_RPB) + krel * 128 + (63 - qcol) + 4 * hi;
            const int cb = 4 * hi - cs;
#pragma unroll
            for (int r = 0; r < 16; ++r) { const int kc = (r & 3) + 8 * (r >> 2);
                const float b0 = bt[kc], b1 = bt[kc + 32];
                p0[r] = ((unsigned)(cb + kc) < 16u) ? p0[r] + b0 : -1e30f;
                p1[r] = ((unsigned)(cb + kc + 32) < 16u) ? p1[r] + b1 : -1e30f; }
        }
    };
    bf16x8 pf0, pf1, pf2, pf3;
    auto SM = [&](bool first) {
        asm volatile("s_nop 15\n\ts_nop 7" : "+v"(p0), "+v"(p1));
        float ra = max3f(p0[0], p0[1], p1[0]), rb = max3f(p0[2], p0[3], p1[1]); ra = max3f(ra, p1[2], p1[3]);
#pragma unroll
        for (int r = 4; r < 16; r += 4) { ra = max3f(ra, p0[r], p0[r + 1]); rb = max3f(rb, p0[r + 2], p0[r + 3]); ra = max3f(ra, p1[r], p1[r + 1]); rb = max3f(rb, p1[r + 2], p1[r + 3]); }
        float rm = max2f(ra, rb);
        { auto rr = __builtin_amdgcn_permlane32_swap(__float_as_uint(rm), __float_as_uint(rm), false, false); rm = max2f(__uint_as_float(rr[0]), __uint_as_float(rr[1])); }
        if (first || __any(rm > THR)) {
            const float dl = first ? rm : fmaxf(rm, 0.f);
            m += dl; const float f = __builtin_amdgcn_exp2f(-dl); l *= f;
#pragma unroll
            for (int r = 0; r < 16; ++r) { p0[r] -= dl; p1[r] -= dl; o0[r] *= f; o1[r] *= f; negm[r] = -m; }
        }
        float ls = 0.f;
#pragma unroll
        for (int r = 0; r < 16; ++r) { p0[r] = __builtin_amdgcn_exp2f(p0[r]); p1[r] = __builtin_amdgcn_exp2f(p1[r]); ls += p0[r] + p1[r]; }
        l += ls;
        u32x4 w;
        w.x = pk2(p0[0], p0[1]); w.y = pk2(p0[2], p0[3]); w.z = pk2(p0[4], p0[5]); w.w = pk2(p0[6], p0[7]); pf0 = __builtin_bit_cast(bf16x8, w);
        w.x = pk2(p0[8], p0[9]); w.y = pk2(p0[10], p0[11]); w.z = pk2(p0[12], p0[13]); w.w = pk2(p0[14], p0[15]); pf1 = __builtin_bit_cast(bf16x8, w);
        w.x = pk2(p1[0], p1[1]); w.y = pk2(p1[2], p1[3]); w.z = pk2(p1[4], p1[5]); w.w = pk2(p1[6], p1[7]); pf2 = __builtin_bit_cast(bf16x8, w);
        w.x = pk2(p1[8], p1[9]); w.y = pk2(p1[10], p1[11]); w.z = pk2(p1[12], p1[13]); w.w = pk2(p1[14], p1[15]); pf3 = __builtin_bit_cast(bf16x8, w);
    };
    auto PV = [&](int boff) {
        const LAS unsigned char* Bb = lds + boff;
        s16x4 va0[4], va1[4], vc0[4], vc1[4];
#pragma unroll
        for (int kk = 0; kk < 4; ++kk) {
            const LAS unsigned char* vb = Bb + kk * 2048;
            va0[kk] = __builtin_bit_cast(s16x4, __builtin_amdgcn_ds_read_tr16_b64_v4i16((LAS s16x4*)(vb + voff0)));
            va1[kk] = __builtin_bit_cast(s16x4, __builtin_amdgcn_ds_read_tr16_b64_v4i16((LAS s16x4*)(vb + voff0 + 1024)));
            vc0[kk] = __builtin_bit_cast(s16x4, __builtin_amdgcn_ds_read_tr16_b64_v4i16((LAS s16x4*)(vb + voff1)));
            vc1[kk] = __builtin_bit_cast(s16x4, __builtin_amdgcn_ds_read_tr16_b64_v4i16((LAS s16x4*)(vb + voff1 + 1024)));
        }
#pragma unroll
        for (int kk = 0; kk < 4; ++kk) {
            const bf16x8 va = (bf16x8){va0[kk][0], va0[kk][1], va0[kk][2], va0[kk][3], va1[kk][0], va1[kk][1], va1[kk][2], va1[kk][3]};
            const bf16x8 vc = (bf16x8){vc0[kk][0], vc0[kk][1], vc0[kk][2], vc0[kk][3], vc1[kk][0], vc1[kk][1], vc1[kk][2], vc1[kk][3]};
            const bf16x8 pk = kk == 0 ? pf0 : (kk == 1 ? pf1 : (kk == 2 ? pf2 : pf3));
            o0 = __builtin_amdgcn_mfma_f32_32x32x16_bf16(va, pk, o0, 0, 0, 0);
            o1 = __builtin_amdgcn_mfma_f32_32x32x16_bf16(vc, pk, o1, 0, 0, 0);
        }
        __builtin_amdgcn_sched_group_barrier(0x100, 16, 0);
        __builtin_amdgcn_sched_group_barrier(0x008, 8, 0);
    };
#define ATT_WAIT_BAR(N) do { asm volatile("s_waitcnt vmcnt(" #N ") lgkmcnt(0)" ::: "memory"); __builtin_amdgcn_s_barrier(); asm volatile("" ::: "memory"); } while (0)
    constexpr int RING = 6, DIST = RING - 1;
    auto wait_bar = [&](int ntiles) {
        if (DQ == 96 && !upper) { switch (ntiles) { case 4: ATT_WAIT_BAR(12); break; case 3: ATT_WAIT_BAR(9); break; case 2: ATT_WAIT_BAR(6); break; case 1: ATT_WAIT_BAR(3); break; default: ATT_WAIT_BAR(0); } }
        else { switch (ntiles) { case 4: ATT_WAIT_BAR(8); break; case 3: ATT_WAIT_BAR(6); break; case 2: ATT_WAIT_BAR(4); break; case 1: ATT_WAIT_BAR(2); break; default: ATT_WAIT_BAR(0); } } };
    if (upper) __builtin_amdgcn_s_setprio(1);
    int issued = 0;
    for (; issued < DIST && issued < nt; ++issued) dma(issued, issued * BUFB);
    wait_bar(issued - 1);
    int b_cur = 0, b_iss = (DIST % RING) * BUFB;
    for (int t = 0; t < nt; ++t) {
        if (issued < nt) { dma(issued, b_iss); ++issued; b_iss += BUFB; if (b_iss == RING * BUFB) b_iss = 0; }
        if (tile_active(t)) { QK(t, b_cur); SM(t == 0); PV(b_cur); }
        { const int infl = issued - t - 2; wait_bar(infl < 0 ? 0 : infl); }
        b_cur += BUFB; if (b_cur == RING * BUFB) b_cur = 0;
    }
#undef ATT_WAIT_BAR
    if (upper) __builtin_amdgcn_s_setprio(0);
    { auto rr = __builtin_amdgcn_permlane32_swap(__float_as_uint(l), __float_as_uint(l), false, false); l = __uint_as_float(rr[0]) + __uint_as_float(rr[1]); }
    const float inv = 1.f / l;
#pragma unroll
    for (int ig = 0; ig < 4; ++ig) {
        u32x2 w0, w1;
        w0.x = pk2(o0[4 * ig] * inv, o0[4 * ig + 1] * inv); w0.y = pk2(o0[4 * ig + 2] * inv, o0[4 * ig + 3] * inv);
        w1.x = pk2(o1[4 * ig] * inv, o1[4 * ig + 1] * inv); w1.y = pk2(o1[4 * ig + 2] * inv, o1[4 * ig + 3] * inv);
        *(u32x2*)(a.optr + 8 * ig + 4 * hi) = w0;
        *(u32x2*)(a.optr + 32 + 8 * ig + 4 * hi) = w1;
    }
}

struct AU2 {
    const bf16_t* qptr; unsigned qpitch;
    bf16_t* optr;
    const bf16_t* kbase; unsigned kpitch; const bf16_t* vbase; unsigned vpitch; const bf16_t* k2base; unsigned k2pitch;
    int row_ctx, nt;
};
template <int DQ  , bool NOMAX  >
__device__ __forceinline__ void attn_unit2(LAS unsigned char* lds, const AU2& a) {
    constexpr int NS = DQ / 16;
    constexpr int BUFB = (DQ == 96) ? 20480 : 16384;
    const int tid = ltid(), lane = tid & 63, wid = __builtin_amdgcn_readfirstlane(tid >> 6), r32 = lane & 31, hi = lane >> 5;
    const bool upper = wid >= 4;
    const int kr = tid >> 3, cp = tid & 7;
    const int ksrc = (cp ^ ((kr >> 1) & 7)) * 8, vsrc = (cp ^ (((kr >> 1) & 1) << 2)) * 8;
    const int kr2 = 16 * wid + (lane >> 2), k2src = ((lane & 3) ^ ((kr2 >> 2) & 3)) * 8;
    unsigned koff[NS];
#pragma unroll
    for (int s = 0; s < NS; ++s) koff[s] = (s < 4) ? (unsigned)(r32 * 128 + (((2 * s + hi) ^ ((r32 >> 1) & 7)) << 4))
                                                   : (unsigned)(16384 + r32 * 64 + (((2 * (s - 4) + hi) ^ ((r32 >> 2) & 3)) << 4));
    const int vg = (lane >> 4) & 1, vq = (lane & 15) >> 2, vp = lane & 3, vsw = (vq >> 1) & 1;
    const unsigned voff0 = (unsigned)(8192 + (4 * hi + vq) * 128 + 64 * vsw + 32 * vg + 8 * vp);
    const unsigned voff1 = (unsigned)(8192 + (4 * hi + vq) * 128 + 64 * (1 - vsw) + 32 * vg + 8 * vp);
    bf16x8 qA[NS], qB[NS];
#pragma unroll
    for (int s = 0; s < NS; ++s) { qA[s] = *(const bf16x8*)(a.qptr + 16 * s + 8 * hi); qB[s] = *(const bf16x8*)(a.qptr + (size_t)32 * a.qpitch + 16 * s + 8 * hi); }
    f32x16 oA0, oA1, oB0, oB1, pA0, pA1, pB0, pB1;
    float mA = 0.f, lA = 0.f, mB = 0.f, lB = 0.f;
#pragma unroll
    for (int r = 0; r < 16; ++r) { oA0[r] = 0.f; oA1[r] = 0.f; oB0[r] = 0.f; oB1[r] = 0.f; }
    const int nt = a.nt;
    const unsigned lds0 = (unsigned)(uintptr_t)lds + (unsigned)wid * 1024u;
    auto dma = [&](int t, int boff) {
        const size_t r = (size_t)(a.row_ctx + 64 * t + kr);
        glds16(a.kbase + r * a.kpitch + ksrc, (unsigned)__builtin_amdgcn_readfirstlane((int)(lds0 + boff)));
        glds16(a.vbase + r * a.vpitch + vsrc, (unsigned)__builtin_amdgcn_readfirstlane((int)(lds0 + boff + 8192)));
        if (DQ == 96) { if (!upper) { const size_t r2 = (size_t)(a.row_ctx + 64 * t + kr2);
            glds16(a.k2base + r2 * a.k2pitch + k2src, (unsigned)__builtin_amdgcn_readfirstlane((int)(lds0 + boff + 16384))); } }
    };
    const f32x16 zero16 = {0.f, 0.f, 0.f, 0.f, 0.f, 0.f, 0.f, 0.f, 0.f, 0.f, 0.f, 0.f, 0.f, 0.f, 0.f, 0.f};
    auto QK = [&](int boff) {
        const LAS unsigned char* Bb = lds + boff;
        bf16x8 kf[2 * NS];
#pragma unroll
        for (int s = 0; s < NS; ++s) { kf[2 * s] = *(const LAS bf16x8*)(Bb + koff[s]); kf[2 * s + 1] = *(const LAS bf16x8*)(Bb + koff[s] + (s < 4 ? 4096 : 2048)); }
#pragma unroll
        for (int s = 0; s < NS; ++s) {
            pA0 = __builtin_amdgcn_mfma_f32_32x32x16_bf16(kf[2 * s], qA[s], s == 0 ? zero16 : pA0, 0, 0, 0); pA1 = __builtin_amdgcn_mfma_f32_32x32x16_bf16(kf[2 * s + 1], qA[s], s == 0 ? zero16 : pA1, 0, 0, 0);
            pB0 = __builtin_amdgcn_mfma_f32_32x32x16_bf16(kf[2 * s], qB[s], s == 0 ? zero16 : pB0, 0, 0, 0); pB1 = __builtin_amdgcn_mfma_f32_32x32x16_bf16(kf[2 * s + 1], qB[s], s == 0 ? zero16 : pB1, 0, 0, 0);
        }
        __builtin_amdgcn_sched_group_barrier(0x100, 2 * NS, 0);
        __builtin_amdgcn_sched_group_barrier(0x008, 4 * NS, 0);
    };
    auto SM = [&](f32x16& p0, f32x16& p1, f32x16& o0, f32x16& o1, float& m, float& l, bool first, bf16x8 (&pf)[4]) {
        float ls = 0.f;
        if constexpr (NOMAX) {
#pragma unroll
            for (int r = 0; r < 16; ++r) { p0[r] = __builtin_amdgcn_exp2f(p0[r]); p1[r] = __builtin_amdgcn_exp2f(p1[r]); ls += p0[r] + p1[r]; }
        } else {
            asm volatile("s_nop 15\n\ts_nop 7" : "+v"(p0), "+v"(p1));
            float ra = max3f(p0[0], p0[1], p1[0]), rb = max3f(p0[2], p0[3], p1[1]); ra = max3f(ra, p1[2], p1[3]);
#pragma unroll
            for (int r = 4; r < 16; r += 4) { ra = max3f(ra, p0[r], p0[r + 1]); rb = max3f(rb, p0[r + 2], p0[r + 3]); ra = max3f(ra, p1[r], p1[r + 1]); rb = max3f(rb, p1[r + 2], p1[r + 3]); }
            float rm = max2f(ra, rb);
            { auto rr = __builtin_amdgcn_permlane32_swap(__float_as_uint(rm), __float_as_uint(rm), false, false); rm = max2f(__uint_as_float(rr[0]), __uint_as_float(rr[1])); }
            if (first) m = rm;
            else if (__any(rm - m > THR)) { const float mn = fmaxf(m, rm); const float f = __builtin_amdgcn_exp2f(m - mn); m = mn; l *= f;
#pragma unroll
                for (int r = 0; r < 16; ++r) { o0[r] *= f; o1[r] *= f; } }
#pragma unroll
            for (int r = 0; r < 16; ++r) { p0[r] = __builtin_amdgcn_exp2f(p0[r] - m); p1[r] = __builtin_amdgcn_exp2f(p1[r] - m); ls += p0[r] + p1[r]; }
        }
        l += ls;
        u32x4 w;
        w.x = pk2(p0[0], p0[1]); w.y = pk2(p0[2], p0[3]); w.z = pk2(p0[4], p0[5]); w.w = pk2(p0[6], p0[7]); pf[0] = __builtin_bit_cast(bf16x8, w);
        w.x = pk2(p0[8], p0[9]); w.y = pk2(p0[10], p0[11]); w.z = pk2(p0[12], p0[13]); w.w = pk2(p0[14], p0[15]); pf[1] = __builtin_bit_cast(bf16x8, w);
        w.x = pk2(p1[0], p1[1]); w.y = pk2(p1[2], p1[3]); w.z = pk2(p1[4], p1[5]); w.w = pk2(p1[6], p1[7]); pf[2] = __builtin_bit_cast(bf16x8, w);
        w.x = pk2(p1[8], p1[9]); w.y = pk2(p1[10], p1[11]); w.z = pk2(p1[12], p1[13]); w.w = pk2(p1[14], p1[15]); pf[3] = __builtin_bit_cast(bf16x8, w);
    };
    bf16x8 pfA[4], pfB[4];
    auto PV = [&](int boff) {
        const LAS unsigned char* Bb = lds + boff;
        s16x4 va0[4], va1[4], vc0[4], vc1[4];
#pragma unroll
        for (int kk = 0; kk < 4; ++kk) {
            const LAS unsigned char* vb = Bb + kk * 2048;
            va0[kk] = __builtin_bit_cast(s16x4, __builtin_amdgcn_ds_read_tr16_b64_v4i16((LAS s16x4*)(vb + voff0)));
            va1[kk] = __builtin_bit_cast(s16x4, __builtin_amdgcn_ds_read_tr16_b64_v4i16((LAS s16x4*)(vb + voff0 + 1024)));
            vc0[kk] = __builtin_bit_cast(s16x4, __builtin_amdgcn_ds_read_tr16_b64_v4i16((LAS s16x4*)(vb + voff1)));
            vc1[kk] = __builtin_bit_cast(s16x4, __builtin_amdgcn_ds_read_tr16_b64_v4i16((LAS s16x4*)(vb + voff1 + 1024)));
        }
#pragma unroll
        for (int kk = 0; kk < 4; ++kk) {
            const bf16x8 va = (bf16x8){va0[kk][0], va0[kk][1], va0[kk][2], va0[kk][3], va1[kk][0], va1[kk][1], va1[kk][2], va1[kk][3]};
            const bf16x8 vc = (bf16x8){vc0[kk][0], vc0[kk][1], vc0[kk][2], vc0[kk][3], vc1[kk][0], vc1[kk][1], vc1[kk][2], vc1[kk][3]};
            oA0 = __builtin_amdgcn_mfma_f32_32x32x16_bf16(va, pfA[kk], oA0, 0, 0, 0); oA1 = __builtin_amdgcn_mfma_f32_32x32x16_bf16(vc, pfA[kk], oA1, 0, 0, 0);
            oB0 = __builtin_amdgcn_mfma_f32_32x32x16_bf16(va, pfB[kk], oB0, 0, 0, 0); oB1 = __builtin_amdgcn_mfma_f32_32x32x16_bf16(vc, pfB[kk], oB1, 0, 0, 0);
        }
        __builtin_amdgcn_sched_group_barrier(0x100, 16, 0);
        __builtin_amdgcn_sched_group_barrier(0x008, 16, 0);
    };
#define ATT_WAIT_BAR(N) do { asm volatile("s_waitcnt vmcnt(" #N ") lgkmcnt(0)" ::: "memory"); __builtin_amdgcn_s_barrier(); asm volatile("" ::: "memory"); } while (0)
    constexpr int RING = 6, DIST = RING - 1;
    auto wait_bar = [&](int ntiles) {
        if (DQ == 96 && !upper) { switch (ntiles) { case 4: ATT_WAIT_BAR(12); break; case 3: ATT_WAIT_BAR(9); break; case 2: ATT_WAIT_BAR(6); break; case 1: ATT_WAIT_BAR(3); break; default: ATT_WAIT_BAR(0); } }
        else { switch (ntiles) { case 4: ATT_WAIT_BAR(8); break; case 3: ATT_WAIT_BAR(6); break; case 2: ATT_WAIT_BAR(4); break; case 1: ATT_WAIT_BAR(2); break; default: ATT_WAIT_BAR(0); } } };
    if (upper) __builtin_amdgcn_s_setprio(1);
    int issued = 0;
    for (; issued < DIST && issued < nt; ++issued) dma(issued, issued * BUFB);
    wait_bar(issued - 1);
    int b_cur = 0, b_iss = (DIST % RING) * BUFB;
    for (int t = 0; t < nt; ++t) {
        if (issued < nt) { dma(issued, b_iss); ++issued; b_iss += BUFB; if (b_iss == RING * BUFB) b_iss = 0; }
        QK(b_cur);
        SM(pA0, pA1, oA0, oA1, mA, lA, t == 0, pfA);
        SM(pB0, pB1, oB0, oB1, mB, lB, t == 0, pfB);
        PV(b_cur);
        { const int infl = issued - t - 2; wait_bar(infl < 0 ? 0 : infl); }
        b_cur += BUFB; if (b_cur == RING * BUFB) b_cur = 0;
    }
#undef ATT_WAIT_BAR
    if (upper) __builtin_amdgcn_s_setprio(0);
    { auto rr = __builtin_amdgcn_permlane32_swap(__float_as_uint(lA), __float_as_uint(lA), false, false); lA = __uint_as_float(rr[0]) + __uint_as_float(rr[1]); }
    { auto rr = __builtin_amdgcn_permlane32_swap(__float_as_uint(lB), __float_as_uint(lB), false, false); lB = __uint_as_float(rr[0]) + __uint_as_float(rr[1]); }
    const float invA = 1.f / lA, invB = 1.f / lB; bf16_t* oB = a.optr + (size_t)32 * 1024;
#pragma unroll
    for (int ig = 0; ig < 4; ++ig) {
        u32x2 w0, w1;
        w0.x = pk2(oA0[4 * ig] * invA, oA0[4 * ig + 1] * invA); w0.y = pk2(oA0[4 * ig + 2] * invA, oA0[4 * ig + 3] * invA);
        w1.x = pk2(oA1[4 * ig] * invA, oA1[4 * ig + 1] * invA); w1.y = pk2(oA1[4 * ig + 2] * invA, oA1[4 * ig + 3] * invA);
        *(u32x2*)(a.optr + 8 * ig + 4 * hi) = w0; *(u32x2*)(a.optr + 32 + 8 * ig + 4 * hi) = w1;
        w0.x = pk2(oB0[4 * ig] * invB, oB0[4 * ig + 1] * invB); w0.y = pk2(oB0[4 * ig + 2] * invB, oB0[4 * ig + 3] * invB);
        w1.x = pk2(oB1[4 * ig] * invB, oB1[4 * ig + 1] * invB); w1.y = pk2(oB1[4 * ig + 2] * invB, oB1[4 * ig + 3] * invB);
        *(u32x2*)(oB + 8 * ig + 4 * hi) = w0; *(u32x2*)(oB + 32 + 8 * ig + 4 * hi) = w1;
    }
}

struct Job { const float* src; bf16_t* dst; int K, N, ldd, nb; size_t sbs, dbs; int mode; const float* rscale; };

__device__ __forceinline__ int hperm64(int c) { const int base = c & ~63, cl = c & 63, p = cl >> 1, n = cl & 1, g = p >> 4, i = p & 15; return base + 32 * g + 16 * n + i; }
__device__ __forceinline__ int rowmap(int mode, int c) {
    switch (mode) {
        case 1: return c < 640 ? hperm64(c) : c;
        case 2: if ((c >= 384 && c < 896) || (c >= 1184 && c < 1312)) { const int b0 = (c >= 1184) ? 1184 : 384; return b0 + hperm64(c - b0); }
                if (c >= 1152 && c < 1184) { const int cl = c - 1152; return 1152 + 16 * (cl & 1) + (cl >> 1); }
                return c;
        case 3: { const int h = c / 96, cl = c % 96; if (cl < 64) return c; const int r = cl - 64; return h * 96 + 64 + 16 * (r & 1) + (r >> 1); }
        case 4: return 32 * (c >> 4) + (c & 15);
        case 5: return 32 * (c >> 4) + 16 + (c & 15);
        case 8: return 16 * ((c & 511) >> 3) + 8 * (c >> 9) + (c & 7);
        default: return c;
    }
}
__device__ __forceinline__ float colscale(int mode, int c) {
    if (mode == 1) return (c < 512 || (c >= 768 && c < 1280)) ? QS64 : 1.f;
    if (mode == 3) return QS96;
    return 1.f;
}
__device__ __forceinline__ bool get_job(PP P, int j, Job& J) {
    const int layer = j >= 9 ? 1 : 0, jj = layer ? j - 9 : j; const int ib = layer ? 20 : 4;
    bf16_t* W = (bf16_t*)(P->ws + (layer ? WS_W1 : WS_W0));
    J.nb = 1; J.sbs = 0; J.dbs = 0; J.rscale = nullptr; J.mode = 0; J.ldd = 1024; J.K = 1024;
    switch (jj) {
        case 0: J.src = P->in[ib + 3]; J.dst = W + WO_IN; J.N = layer ? 1440 : 2304; J.mode = layer ? 2 : 1; break;
        case 1: J.src = P->in[layer ? 30 : 10]; J.dst = W + WO_OUT; J.N = 1024; break;
        case 2: J.src = P->in[layer ? 32 : 12]; J.dst = W + WO_RT; J.N = 64; J.mode = 7; break;
        case 3: J.src = P->in[layer ? 34 : 14]; J.dst = W + WO_GU; J.N = 256; J.nb = 64; J.sbs = (size_t)1024 * 256; J.dbs = (size_t)512 * 1024; J.mode = 4; break;
        case 4: J.src = P->in[layer ? 35 : 15]; J.dst = W + WO_GU; J.N = 256; J.nb = 64; J.sbs = (size_t)1024 * 256; J.dbs = (size_t)512 * 1024; J.mode = 5; break;
        case 5: J.src = P->in[layer ? 36 : 16]; J.dst = W + WO_D; J.K = 256; J.N = 1024; J.ldd = 256; J.nb = 64; J.sbs = (size_t)256 * 1024; J.dbs = (size_t)1024 * 256; J.mode = 8; break;
        case 6: J.src = P->in[layer ? 37 : 17]; J.dst = W + WO_GU + (size_t)64 * 512 * 1024; J.N = 256; J.mode = 4; break;
        case 7: J.src = P->in[layer ? 38 : 18]; J.dst = W + WO_GU + (size_t)64 * 512 * 1024; J.N = 256; J.mode = 5; break;
        case 8: J.src = P->in[layer ? 39 : 19]; J.dst = W + WO_D + (size_t)64 * 1024 * 256; J.K = 256; J.N = 1024; J.ldd = 256; J.mode = 8; break;
        case 9: J.src = P->in[25]; J.dst = W + WO_UQ; J.K = 384; J.N = 768; J.ldd = 384; J.mode = 3; J.rscale = P->in[24]; break;
        case 10: J.src = P->in[27]; J.dst = W + WO_UKV; J.K = 256; J.N = 1024; J.ldd = 256; J.mode = 6; J.rscale = P->in[26]; break;
        default: return false;
    }
    return true;
}
constexpr int NJOBS = 20;
__device__ __forceinline__ int job_tiles(const Job& J) { return J.nb * (J.K >> 6) * ((J.N + 255) >> 8); }

__device__ __forceinline__ void conv_tile(const Job& J, int tile, LAS float* T) {
    const int tid = ltid(); const int ntn = (J.N + 255) >> 8, ntk = J.K >> 6;
    const int b = tile / (ntn * ntk), r = tile % (ntn * ntk), tk = r / ntn, tn = r % ntn;
    const float* src = J.src + (size_t)b * J.sbs; bf16_t* dst = J.dst + (size_t)b * J.dbs; const int k0 = tk * 64, n0 = tn * 256;
    { const int n4 = (tid & 63) * 4; const bool ok = (n0 + n4) < J.N;
      f32x4 v[8];
#pragma unroll
      for (int j = 0; j < 8; ++j) { const int k = (tid >> 6) + 8 * j; v[j] = ok ? *(const f32x4*)(src + (size_t)(k0 + k) * J.N + n0 + n4) : (f32x4){0.f, 0.f, 0.f, 0.f}; }
      f32x4 cs; cs[0] = colscale(J.mode, n0 + n4); cs[1] = colscale(J.mode, n0 + n4 + 1); cs[2] = colscale(J.mode, n0 + n4 + 2); cs[3] = colscale(J.mode, n0 + n4 + 3);
#pragma unroll
      for (int j = 0; j < 8; ++j) { const int k = (tid >> 6) + 8 * j; f32x4 x = v[j] * cs; if (J.rscale) x = x * J.rscale[k0 + k]; *(LAS f32x4*)(T + k * 260 + n4) = x; } }
    __syncthreads();
    { const int nn = tid >> 1, kh = (tid & 1) * 32;
      if (n0 + nn < J.N) { const int drow = rowmap(J.mode, n0 + nn); bf16_t* dp = dst + (size_t)drow * J.ldd + k0 + kh;
#pragma unroll
          for (int q = 0; q < 4; ++q) { float v[8];
#pragma unroll
              for (int j = 0; j < 8; ++j) v[j] = T[(kh + 8 * q + j) * 260 + nn];
              u32x4 w; w.x = pk2(v[0], v[1]); w.y = pk2(v[2], v[3]); w.z = pk2(v[4], v[5]); w.w = pk2(v[6], v[7]);
              *(u32x4*)(dp + 8 * q) = w;
              if (J.mode == 7) { u32x4 w2;
                  w2.x = pk2(v[0] - bflo(w.x), v[1] - bfhi(w.x)); w2.y = pk2(v[2] - bflo(w.y), v[3] - bfhi(w.y));
                  w2.z = pk2(v[4] - bflo(w.z), v[5] - bfhi(w.z)); w2.w = pk2(v[6] - bflo(w.w), v[7] - bfhi(w.w));
                  *(u32x4*)(dp + (size_t)64 * 1024 + 8 * q) = w2; } } } }
    __syncthreads();
}

__device__ __forceinline__ void ada_item(PP P, int item, LAS float* S) {
    const int tid = ltid(); const int layer = item / 96, chunk = item % 96;
    for (int idx = tid; idx < 33 * 1024; idx += 512) { const int r = idx >> 10, k = idx & 1023; const float x = (r < 32) ? P->in[1][r * 1024 + k] : P->in[3][k]; S[idx] = x / (1.f + expf(-x)); }
    __syncthreads();
    const int col = chunk * 64 + (tid & 63), kg = tid >> 6;
    float acc[33];
#pragma unroll
    for (int r = 0; r < 33; ++r) acc[r] = 0.f;
    const float* W = P->in[layer ? 20 : 4] + col;
    for (int k = kg * 128; k < kg * 128 + 128; ++k) { const float w = W[(size_t)k * 6144];
#pragma unroll
        for (int r = 0; r < 33; ++r) acc[r] += S[r * 1024 + k] * w; }
    __syncthreads();
#pragma unroll
    for (int r = 0; r < 33; ++r) S[(kg * 33 + r) * 64 + (tid & 63)] = acc[r];
    __syncthreads();
    float* ada = (float*)(P->ws + WS_ADA) + (size_t)layer * 33 * 6144; const float* bias = P->in[layer ? 21 : 5];
    for (int idx = tid; idx < 33 * 64; idx += 512) { const int r = idx >> 6, cc = idx & 63; float s = 0.f;
#pragma unroll
        for (int g = 0; g < 8; ++g) s += S[(g * 33 + r) * 64 + cc];
        ada[(size_t)r * 6144 + chunk * 64 + cc] = s + bias[chunk * 64 + cc]; }
    __syncthreads();
}

__device__ __forceinline__ void phase_prologue(PP P, LAS unsigned char* lds, int c, int G) {
    const int tid = ltid();
    for (int it = c; it < 192; it += G) ada_item(P, it, (LAS float*)lds);
    { float* rp = (float*)(P->ws + WS_ROPE); float* cosh_ = rp; float* sinh_ = rp + 2048 * 32; float* cosr_ = rp + 2 * 2048 * 32; float* sinr_ = cosr_ + 2048 * 16;
      for (int idx = c * 512 + tid; idx < 2048 * 48; idx += G * 512) {
          if (idx < 2048 * 32) { const int t = idx >> 5, p = idx & 31; const float pos = (p < 16) ? (float)(t >> 6) : (float)(t & 63); const int i = p & 15;
              const float inv = powf(10000.0f, -(float)i / 16.0f); const float ang = pos * inv; cosh_[idx] = cosf(ang); sinh_[idx] = sinf(ang); }
          else { const int k = idx - 2048 * 32; const int t = k >> 4, p = k & 15; const float pos = (p < 8) ? (float)(t >> 6) : (float)(t & 63); const int i = p & 7;
              const float inv = powf(10000.0f, -(float)i / 8.0f); const float ang = pos * inv; cosr_[k] = cosf(ang); sinr_[k] = sinf(ang); } } }
    { u32x4* z = (u32x4*)((bf16_t*)(P->ws + WS_W1) + WO_IN + (size_t)1440 * 1024); for (int idx = c * 512 + tid; idx < 96 * 1024 / 8; idx += G * 512) z[idx] = (u32x4){0u, 0u, 0u, 0u}; }
    { int base = 0; int tile = c;
      for (int j = 0; j < NJOBS; ++j) { Job J; get_job(P, j, J); const int n = job_tiles(J);
          while (tile < base + n) { conv_tile(J, tile - base, (LAS float*)lds); tile += G; }
          base += n; } }
}

__device__ __forceinline__ void phase_norm(PP P, int c, int G, const float* xlat, const float* xctx, const float* g, const float* ada  , int sh_off, int sc_off, bool latent_only, bf16_t* H, bf16_t* HLO,
                                           const bool resid = false, float* xlat_dst = nullptr, float* xctx_dst = nullptr) {
    const int tid_ = ltid(); const int lane = tid_ & 63, wv = c * 8 + (tid_ >> 6), nw = G * 8;
    for (int row = wv; row < MROWS; row += nw) {
        const int b = row / TOK, t = row % TOK; const bool ctx = t < CTX;
        if (ctx && latent_only) continue;
        const float* x = ctx ? xctx + ((size_t)b * CTX + t) * 1024 : xlat + ((size_t)b * SEQ + t - CTX) * 1024;
        const float* ap = ada + (size_t)(ctx ? 32 : b) * 6144;
        f32x4 v[4]; float ss = 0.f;
#pragma unroll
        for (int i = 0; i < 2; ++i) { v[2 * i] = *(const f32x4*)(x + 512 * i + 8 * lane); v[2 * i + 1] = *(const f32x4*)(x + 512 * i + 8 * lane + 4); }
        if (resid) {
            float* xd = ctx ? xctx_dst + ((size_t)b * CTX + t) * 1024 : xlat_dst + ((size_t)b * SEQ + t - CTX) * 1024;
#pragma unroll
            for (int i = 0; i < 2; ++i) { const u32x4 yw = *(const u32x4*)(HLO + (size_t)row * 1024 + 512 * i + 8 * lane);
                const f32x4 g0 = *(const f32x4*)(ap + 2048 + 512 * i + 8 * lane), g1 = *(const f32x4*)(ap + 2048 + 512 * i + 8 * lane + 4);
                v[2 * i][0] += g0[0] * bflo(yw.x); v[2 * i][1] += g0[1] * bfhi(yw.x); v[2 * i][2] += g0[2] * bflo(yw.y); v[2 * i][3] += g0[3] * bfhi(yw.y);
                v[2 * i + 1][0] += g1[0] * bflo(yw.z); v[2 * i + 1][1] += g1[1] * bfhi(yw.z); v[2 * i + 1][2] += g1[2] * bflo(yw.w); v[2 * i + 1][3] += g1[3] * bfhi(yw.w);
                *(f32x4*)(xd + 512 * i + 8 * lane) = v[2 * i]; *(f32x4*)(xd + 512 * i + 8 * lane + 4) = v[2 * i + 1]; }
        }
#pragma unroll
        for (int i = 0; i < 4; ++i) ss += v[i][0] * v[i][0] + v[i][1] * v[i][1] + v[i][2] * v[i][2] + v[i][3] * v[i][3];
        ss = wave_sum(ss); const float rstd = rsqrtf(ss * (1.f / 1024.f) + EPS);
#pragma unroll
        for (int i = 0; i < 2; ++i) { const int col = 512 * i + 8 * lane; float o[8];
#pragma unroll
            for (int h = 0; h < 2; ++h) { const f32x4 gg = *(const f32x4*)(g + col + 4 * h), sc = *(const f32x4*)(ap + sc_off + col + 4 * h), sh = *(const f32x4*)(ap + sh_off + col + 4 * h);
#pragma unroll
                for (int j = 0; j < 4; ++j) o[4 * h + j] = v[2 * i + h][j] * rstd * gg[j] * (1.f + sc[j]) + sh[j]; }
            u32x4 w; w.x = pk2(o[0], o[1]); w.y = pk2(o[2], o[3]); w.z = pk2(o[4], o[5]); w.w = pk2(o[6], o[7]);
            *(u32x4*)(H + (size_t)row * 1024 + col) = w;
            if (HLO) { u32x4 w2; w2.x = pk2(o[0] - bflo(w.x), o[1] - bfhi(w.x)); w2.y = pk2(o[2] - bflo(w.y), o[3] - bfhi(w.y)); w2.z = pk2(o[4] - bflo(w.z), o[5] - bfhi(w.z)); w2.w = pk2(o[6] - bflo(w.w), o[7] - bfhi(w.w));
                *(u32x4*)(HLO + (size_t)row * 1024 + col) = w2; } }
    }
}

__device__ __forceinline__ void phase_post1(PP P, int c, int G) {
    const int tid_ = ltid(); const int lane = tid_ & 63, wv = c * 8 + (tid_ >> 6), nw = G * 8;
    bf16_t* Pb = (bf16_t*)(P->ws + WS_BIG + BIG_P); float* RS = (float*)(P->ws + WS_RSTD);
    const float* rp = (const float*)(P->ws + WS_ROPE); const float* cosh_ = rp; const float* sinh_ = rp + 2048 * 32; const float* cosr_ = rp + 2 * 2048 * 32; const float* sinr_ = cosr_ + 2048 * 16;
    const float* gqn = P->in[28]; const float* gkn = P->in[29];
    for (int row = wv; row < MROWS; row += nw) {
        bf16_t* pr = Pb + (size_t)row * 1536; const int t = row % TOK; const bool lat = t >= CTX; const int tt = t - CTX;
        float s1 = 0.f, s2 = 0.f;
        if (lane < 48) { const u32x4 w = *(const u32x4*)(pr + 8 * lane); const float a0 = bflo(w.x), a1 = bfhi(w.x), a2 = bflo(w.y), a3 = bfhi(w.y), a4 = bflo(w.z), a5 = bfhi(w.z), a6 = bflo(w.w), a7 = bfhi(w.w);
            s1 = a0 * a0 + a1 * a1 + a2 * a2 + a3 * a3 + a4 * a4 + a5 * a5 + a6 * a6 + a7 * a7; }
        if (lane < 32) { const u32x4 w = *(const u32x4*)(pr + 896 + 8 * lane); const float a0 = bflo(w.x), a1 = bfhi(w.x), a2 = bflo(w.y), a3 = bfhi(w.y), a4 = bflo(w.z), a5 = bfhi(w.z), a6 = bflo(w.w), a7 = bfhi(w.w);
            s2 = a0 * a0 + a1 * a1 + a2 * a2 + a3 * a3 + a4 * a4 + a5 * a5 + a6 * a6 + a7 * a7; }
        s1 = wave_sum(s1); s2 = wave_sum(s2);
        if (lane == 0) { RS[(size_t)row * 2] = rsqrtf(s1 * (1.f / 384.f) + EPS); RS[(size_t)row * 2 + 1] = rsqrtf(s2 * (1.f / 256.f) + EPS); }
#pragma unroll
        for (int ps = 0; ps < 2; ++ps) {
            const int Gi = lane >> 2, qd = lane & 3; const bool on = (ps == 0) || (lane < 16);
            bf16_t* base = pr + (ps == 0 ? 384 : 1184) + 32 * Gi + 4 * qd;
            float x0[4] = {0.f, 0.f, 0.f, 0.f}, x1[4] = {0.f, 0.f, 0.f, 0.f};
            if (on) { const u32x2 w0 = *(const u32x2*)base, w1 = *(const u32x2*)(base + 16);
                x0[0] = bflo(w0.x); x0[1] = bfhi(w0.x); x0[2] = bflo(w0.y); x0[3] = bfhi(w0.y); x1[0] = bflo(w1.x); x1[1] = bfhi(w1.x); x1[2] = bflo(w1.y); x1[3] = bfhi(w1.y); }
            float ss = 0.f;
#pragma unroll
            for (int j = 0; j < 4; ++j) ss += x0[j] * x0[j] + x1[j] * x1[j];
            ss += __shfl_xor(ss, 1); ss += __shfl_xor(ss, 2); ss += __shfl_xor(ss, 4);
            const float rstd = rsqrtf(ss * (1.f / 64.f) + EPS);
            const int gsel = Gi & 1; const float* gn = ps == 0 ? gqn : gkn; const float qs = ps == 0 ? QS64 : 1.f;
            if (on) { float y0[4], y1[4];
#pragma unroll
                for (int j = 0; j < 4; ++j) { const int pidx = 16 * gsel + 4 * qd + j; y0[j] = x0[j] * rstd * gn[2 * pidx]; y1[j] = x1[j] * rstd * gn[2 * pidx + 1];
                    if (lat) { const float cs = cosh_[(size_t)tt * 32 + pidx], sn = sinh_[(size_t)tt * 32 + pidx]; const float a = y0[j] * cs - y1[j] * sn, bb = y0[j] * sn + y1[j] * cs; y0[j] = a; y1[j] = bb; }
                    y0[j] *= qs; y1[j] *= qs; }
                u32x2 w0, w1; w0.x = pk2(y0[0], y0[1]); w0.y = pk2(y0[2], y0[3]); w1.x = pk2(y1[0], y1[1]); w1.y = pk2(y1[2], y1[3]);
                *(u32x2*)base = w0; *(u32x2*)(base + 16) = w1; }
        }
        if (lat && lane < 4) { bf16_t* base = pr + 1152 + 4 * lane; const u32x2 w0 = *(const u32x2*)base, w1 = *(const u32x2*)(base + 16);
            float x0[4] = {bflo(w0.x), bfhi(w0.x), bflo(w0.y), bfhi(w0.y)}, x1[4] = {bflo(w1.x), bfhi(w1.x), bflo(w1.y), bfhi(w1.y)}; float y0[4], y1[4];
#pragma unroll
            for (int j = 0; j < 4; ++j) { const int pidx = 4 * lane + j; const float cs = cosr_[(size_t)tt * 16 + pidx], sn = sinr_[(size_t)tt * 16 + pidx]; y0[j] = x0[j] * cs - x1[j] * sn; y1[j] = x0[j] * sn + x1[j] * cs; }
            u32x2 o0, o1; o0.x = pk2(y0[0], y0[1]); o0.y = pk2(y0[2], y0[3]); o1.x = pk2(y1[0], y1[1]); o1.y = pk2(y1[2], y1[3]);
            *(u32x2*)base = o0; *(u32x2*)(base + 16) = o1; }
    }
}

__device__ __forceinline__ void phase_router(PP P, LAS unsigned char* lds, int c, int G, int layer) {
    const int tid = ltid(), lane = tid & 63, wid = tid >> 6, r32 = lane & 31, hi = lane >> 5;
    const bf16_t* H = (const bf16_t*)(P->ws + WS_H); const bf16_t* HLO = (const bf16_t*)(P->ws + WS_BIG + BIG_HLO);
    const bf16_t* W = (const bf16_t*)(P->ws + (layer ? WS_W1 : WS_W0)) + WO_RT; const bf16_t* WL = W + 64 * 1024;
    const float* brt = P->in[layer ? 33 : 13];
    int* cnt = (int*)(P->ws + WS_CTL + CTL_CNT) + layer * NG; int* srow = (int*)(P->ws + WS_SROW); float* sw = (float*)(P->ws + WS_SW); int* tslot = (int*)(P->ws + WS_TSLOT);
    LAS float* L = (LAS float*)lds + wid * (32 * 65);
    const int ngroups = MROWS / 32;
    for (int gidx = c * 8 + wid; gidx < ngroups; gidx += G * 8) {
        const int row0 = gidx * 32; const int t0 = row0 % TOK;
        if (layer == 1 && t0 < CTX) continue;
        f32x16 a0, a1;
#pragma unroll
        for (int r = 0; r < 16; ++r) { a0[r] = 0.f; a1[r] = 0.f; }
        const bf16_t* hp = H + (size_t)(row0 + r32) * 1024 + 8 * hi; const bf16_t* hl = HLO + (size_t)(row0 + r32) * 1024 + 8 * hi;
        const bf16_t* w0 = W + (size_t)r32 * 1024 + 8 * hi; const bf16_t* wl0 = WL + (size_t)r32 * 1024 + 8 * hi;
#pragma unroll 4
        for (int s = 0; s < 64; ++s) {
            const bf16x8 xh = *(const bf16x8*)(hp + 16 * s), xl = *(const bf16x8*)(hl + 16 * s);
            const bf16x8 wa = *(const bf16x8*)(w0 + 16 * s), wb = *(const bf16x8*)(w0 + 32 * 1024 + 16 * s);
            const bf16x8 la = *(const bf16x8*)(wl0 + 16 * s), lb = *(const bf16x8*)(wl0 + 32 * 1024 + 16 * s);
            a0 = __builtin_amdgcn_mfma_f32_32x32x16_bf16(wa, xh, a0, 0, 0, 0); a1 = __builtin_amdgcn_mfma_f32_32x32x16_bf16(wb, xh, a1, 0, 0, 0);
            a0 = __builtin_amdgcn_mfma_f32_32x32x16_bf16(wa, xl, a0, 0, 0, 0); a1 = __builtin_amdgcn_mfma_f32_32x32x16_bf16(wb, xl, a1, 0, 0, 0);
            a0 = __builtin_amdgcn_mfma_f32_32x32x16_bf16(la, xh, a0, 0, 0, 0); a1 = __builtin_amdgcn_mfma_f32_32x32x16_bf16(lb, xh, a1, 0, 0, 0);
        }
#pragma unroll
        for (int r = 0; r < 16; ++r) { const int e = (r & 3) + 8 * (r >> 2) + 4 * hi; L[r32 * 65 + e] = a0[r]; L[r32 * 65 + e + 32] = a1[r]; }
        __builtin_amdgcn_s_waitcnt(0xC07F);
        __builtin_amdgcn_wave_barrier();
        if (lane < 32) {
            const int row = row0 + lane; float bk[6], bs[6]; int bi[6];
#pragma unroll
            for (int k = 0; k < 6; ++k) { bk[k] = -1e30f; bs[k] = 0.f; bi[k] = 0; }
            for (int e = 0; e < 64; ++e) { const float x = L[lane * 65 + e]; const float sc = 1.f / (1.f + expf(-x)); float key = sc + brt[e]; float s = sc; int id = e;
#pragma unroll
                for (int k = 0; k < 6; ++k) { if (key > bk[k]) { const float tk = bk[k], ts = bs[k]; const int ti = bi[k]; bk[k] = key; bs[k] = s; bi[k] = id; key = tk; s = ts; id = ti; } } }
            float tot = 0.f;
#pragma unroll
            for (int k = 0; k < 6; ++k) tot += bs[k];
            const float sc = 2.5f / tot; const int ch = row / CHUNK_ROWS;
#pragma unroll
            for (int k = 0; k < 6; ++k) { const int e = bi[k]; const int pos = atomicAdd(cnt + ch * NGRP + e, 1);
                if (pos < CAP) srow[(size_t)(ch * 64 + e) * CAP + pos] = row;
                sw[(size_t)row * 8 + k] = bs[k] * sc; tslot[(size_t)row * 6 + k] = (e << 20) | pos; }
        }
        __builtin_amdgcn_wave_barrier();
    }
    if (c == 0 && tid < NCHUNK) cnt[tid * NGRP + NEXP] = layer ? CHUNK_B * SEQ : CHUNK_ROWS;
}

__device__ __forceinline__ void build_toff(LAS int* toff, const int* cnt) {
    const int tid = ltid();
    if (tid < 64) { int v[5], s = 0;
#pragma unroll
        for (int j = 0; j < 5; ++j) { const int g = tid * 5 + j; const int cv = (g < NG) ? ld_ctl(cnt + g) : 0; if (g < NG) toff[272 + g] = cv; v[j] = (cv + 255) >> 8; s += v[j]; }
        int inc = s;
#pragma unroll
        for (int o = 1; o < 64; o <<= 1) { const int t = __shfl_up(inc, o); if (tid >= o) inc += t; }
        int ex = inc - s;
#pragma unroll
        for (int j = 0; j < 5; ++j) { const int g = tid * 5 + j; if (g <= NG) toff[g] = ex; ex += v[j]; } }
    __syncthreads();
}

__device__ __forceinline__ void phase_combine(PP P, LAS unsigned char* lds, int c, int G, int layer, int ch) {
    const int tid_ = ltid(); const int lane = tid_ & 63, wv = c * 8 + (tid_ >> 6), nw = G * 8;
    LAS const int* toff = (LAS const int*)(lds + LDS_TAB);
    const unsigned char* slab = (const unsigned char*)(P->ws + WS_BIG + BIG_SLAB); const int* tslot = (const int*)(P->ws + WS_TSLOT);
    const float* ada = (const float*)(P->ws + WS_ADA) + (size_t)layer * 33 * 6144; const float* ada1 = (const float*)(P->ws + WS_ADA) + (size_t)33 * 6144;
    float* xc = (float*)(P->ws + WS_XC); bf16_t* H = (bf16_t*)(P->ws + WS_H); const float* tokw = (const float*)(P->ws + WS_SW);
    const int t0 = toff[ch * NGRP];
    for (int rr = wv; rr < CHUNK_ROWS; rr += nw) {
        const int row = ch * CHUNK_ROWS + rr; const int b = row / TOK, t = row % TOK; const bool ctx = t < CTX;
        if (ctx && layer == 1) continue;
        int sidx = 0; float swt = 1.f;
        if (lane < 6) { const int v = __hip_atomic_load(tslot + (size_t)row * 6 + lane, __ATOMIC_RELAXED, __HIP_MEMORY_SCOPE_AGENT); sidx = (toff[ch * NGRP + (v >> 20)] - t0) * 256 + (v & 0xfffff);
            swt = __hip_atomic_load(tokw + (size_t)row * 8 + lane, __ATOMIC_RELAXED, __HIP_MEMORY_SCOPE_AGENT); }
        if (lane == 6) { const int rank = layer ? ((b - ch * CHUNK_B) * SEQ + t - CTX) : rr; sidx = (toff[ch * NGRP + NEXP] - t0) * 256 + rank; }
        float* x = ctx ? xc + ((size_t)b * CTX + t) * 1024 : P->out + ((size_t)b * SEQ + t - CTX) * 1024;
        const float* ap = ada + (size_t)(ctx ? 32 : b) * 6144 + 5 * 1024;
        f32x4 xv[4];
#pragma unroll
        for (int i = 0; i < 4; ++i) xv[i] = *(const f32x4*)(x + 512 * (i >> 1) + 8 * lane + 4 * (i & 1));
        float acc[16];
#pragma unroll
        for (int j = 0; j < 16; ++j) acc[j] = 0.f;
#pragma unroll
        for (int k = 0; k < 7; ++k) { const int s = __shfl(sidx, k); const float wk = __shfl(swt, k);
            const u32x4 w = __builtin_nontemporal_load((const u32x4*)(slab + (size_t)s * 1024 + 16 * lane));
#pragma unroll
            for (int q = 0; q < 4; ++q) { typedef float f2 __attribute__((ext_vector_type(2)));
                const f2 lo = __builtin_amdgcn_cvt_pk_f32_fp8((int)w[q], false), hi = __builtin_amdgcn_cvt_pk_f32_fp8((int)w[q], true);
                acc[4 * q + 0] += wk * lo[0]; acc[4 * q + 1] += wk * lo[1]; acc[4 * q + 2] += wk * hi[0]; acc[4 * q + 3] += wk * hi[1]; } }
        float v[16]; float ss = 0.f;
#pragma unroll
        for (int i = 0; i < 4; ++i) { const f32x4 gq = *(const f32x4*)(ap + 512 * (i >> 1) + 8 * lane + 4 * (i & 1));
#pragma unroll
            for (int j = 0; j < 4; ++j) { const float y = xv[i][j] + gq[j] * acc[4 * i + j]; v[4 * i + j] = y; ss += y * y; } }
        ss = wave_sum(ss); const float rstd = rsqrtf(ss * (1.f / 1024.f) + EPS);
        if (layer == 0) {
            const float* gm1 = P->in[22]; const float* a1 = ada1 + (size_t)(ctx ? 32 : b) * 6144; float o[16];
#pragma unroll
            for (int i = 0; i < 4; ++i) { const int col = 512 * (i >> 1) + 8 * lane + 4 * (i & 1);
                *(f32x4*)(x + col) = (f32x4){v[4 * i], v[4 * i + 1], v[4 * i + 2], v[4 * i + 3]};
                const f32x4 gg = *(const f32x4*)(gm1 + col), sc = *(const f32x4*)(a1 + 1024 + col), sh = *(const f32x4*)(a1 + col);
#pragma unroll
                for (int j = 0; j < 4; ++j) o[4 * i + j] = v[4 * i + j] * rstd * gg[j] * (1.f + sc[j]) + sh[j]; }
#pragma unroll
            for (int i = 0; i < 2; ++i) { u32x4 w; w.x = pk2(o[8 * i], o[8 * i + 1]); w.y = pk2(o[8 * i + 2], o[8 * i + 3]); w.z = pk2(o[8 * i + 4], o[8 * i + 5]); w.w = pk2(o[8 * i + 6], o[8 * i + 7]);
                *(u32x4*)(H + (size_t)row * 1024 + 512 * i + 8 * lane) = w; }
        } else {
            const float* gf = P->in[40];
#pragma unroll
            for (int i = 0; i < 4; ++i) { const int col = 512 * (i >> 1) + 8 * lane + 4 * (i & 1); const f32x4 gg = *(const f32x4*)(gf + col); f32x4 o;
#pragma unroll
                for (int j = 0; j < 4; ++j) o[j] = v[4 * i + j] * rstd * gg[j];
                *(f32x4*)(x + col) = o; }
        }
    }
}

__device__ __forceinline__ int remap64(int c, int i, int G) { return c + i * G; }
__device__ __forceinline__ int remap8(int c, int G) { return c; }
__device__ __forceinline__ void phase_attn0(PP P, LAS unsigned char* lds, int c, int G) {
    const int tid = ltid(), lane = tid & 63, wid = __builtin_amdgcn_readfirstlane(tid >> 6), r32 = lane & 31;
    const bf16_t* QKV = (const bf16_t*)(P->ws + WS_BIG + BIG_QKV); bf16_t* ATT = (bf16_t*)(P->ws + WS_H);
    const float* sink = P->in[8]; const float* rpb = P->in[9];
    for (int i = 0; c + i * G < 2048; ++i) {
        const int u = remap64(c, i, G); const int b = u >> 6, kvh = (u >> 5) & 1, blk = u & 31; const int g = wid & 3, ts = wid >> 2; const int head = kvh * 4 + g;
        AU a; const int tok = blk * 64 + 32 * ts + r32; const size_t qrow = (size_t)b * TOK + CTX + tok;
        a.qptr = QKV + qrow * 2304 + head * 64; a.optr = ATT + qrow * 1024 + head * 64;
        a.kbase = QKV + 512 + kvh * 64; a.kpitch = 2304; a.vbase = QKV + 640 + kvh * 64; a.vpitch = 2304; a.k2base = nullptr; a.k2pitch = 0;
        a.row_ctx = b * TOK; a.row_lat = b * TOK + CTX; a.start = blk * 64;
        const int jlo = blk >= 2 ? 0 : 2 - blk; int jhi = (2048 + 128 - blk * 64) / 64; jhi = jhi > 5 ? 5 : jhi;
        a.j0 = jlo; a.nt = 4 + (jhi - jlo); a.qoff = 32 * ts + r32; a.m0 = sink[head] * LOG2E; a.l0 = 1.f;
        attn_unit<1, 64>(lds, a);
    }
    for (int i = 0; c + i * G < 2048; ++i) {
        const int u = remap64(c, i, G); const int b = u >> 6, head = (u >> 3) & 7, uu = u & 7;
        { LAS float* bt = (LAS float*)(lds + ATT_RPB);
          for (int idx = tid; idx < 15 * 128; idx += 512) { const int dr = idx >> 7, dc = (idx & 127) - 48; bt[idx] = (dc >= 0 && dc <= 30) ? rpb[(head * 15 + dr) * 31 + dc] * LOG2E : 0.f; } }
        AU a; const int qr = 4 * uu + (wid >> 1), qc = 32 * (wid & 1) + r32; const int tok = qr * 64 + qc; const size_t qrow = (size_t)b * TOK + CTX + tok;
        a.qptr = QKV + qrow * 2304 + 768 + head * 64; a.optr = ATT + qrow * 1024 + 512 + head * 64;
        a.kbase = QKV + 1280 + head * 64; a.kpitch = 2304; a.vbase = QKV + 1792 + head * 64; a.vpitch = 2304; a.k2base = nullptr; a.k2pitch = 0;
        a.row_ctx = b * TOK; a.row_lat = b * TOK + CTX; a.start = 0;
        int rs0 = 4 * uu - 4; rs0 = rs0 < 0 ? 0 : (rs0 > 24 ? 24 : rs0); int rl = 4 * uu - 1; rl = rl < 0 ? 0 : (rl > 24 ? 24 : rl);
        a.j0 = rs0; a.nt = 4 + (rl + 8 - rs0); a.qoff = tok; a.m0 = 0.f; a.l0 = 0.f;
        attn_unit<2, 64>(lds, a);
    }
    for (int u0 = c; u0 < 256; u0 += G) {
        const int u = remap8(u0, G); const int b = u >> 3, kvh = (u >> 2) & 1, cb = u & 3; const int g = wid & 3, ts = wid >> 2; const int head = kvh * 4 + g;
        AU a; const int tok = cb * 64 + 32 * ts + r32; const size_t qrow = (size_t)b * TOK + tok;
        a.qptr = QKV + qrow * 2304 + head * 64; a.optr = ATT + qrow * 1024 + head * 64;
        a.kbase = QKV + 512 + kvh * 64; a.kpitch = 2304; a.vbase = QKV + 640 + kvh * 64; a.vpitch = 2304; a.k2base = nullptr; a.k2pitch = 0;
        a.row_ctx = b * TOK; a.row_lat = 0; a.start = 0; a.j0 = 0; a.nt = 4; a.qoff = 0; a.m0 = sink[head] * LOG2E; a.l0 = 1.f;
        attn_unit<0, 64>(lds, a);
    }
    for (int u0 = c; u0 < 256; u0 += G) {
        const int u = remap8(u0, G); const int b = u >> 3, head = u & 7;
        AU a; const int tok = 32 * wid + r32; const size_t qrow = (size_t)b * TOK + tok;
        a.qptr = QKV + qrow * 2304 + 768 + head * 64; a.optr = ATT + qrow * 1024 + 512 + head * 64;
        a.kbase = QKV + 1280 + head * 64; a.kpitch = 2304; a.vbase = QKV + 1792 + head * 64; a.vpitch = 2304; a.k2base = nullptr; a.k2pitch = 0;
        a.row_ctx = b * TOK; a.row_lat = 0; a.start = 0; a.j0 = 0; a.nt = 4; a.qoff = 0; a.m0 = 0.f; a.l0 = 0.f;
        attn_unit<0, 64>(lds, a);
    }
}
__device__ __forceinline__ void phase_attn1(PP P, LAS unsigned char* lds, int c, int G) {
    const int tid = ltid(), lane = tid & 63, wid = __builtin_amdgcn_readfirstlane(tid >> 6), r32 = lane & 31;
    const bf16_t* PB = (const bf16_t*)(P->ws + WS_BIG + BIG_P); const bf16_t* QM = (const bf16_t*)(P->ws + WS_BIG + BIG_QM); const bf16_t* KVX = (const bf16_t*)(P->ws + WS_BIG + BIG_KVX);
    bf16_t* ATT = (bf16_t*)(P->ws + WS_H);
    for (int u = c; u < 1024; u += G) {
        const int b = u >> 5, head = (u >> 2) & 7, qb = u & 3;
        AU2 a; const int tok = qb * 512 + 64 * wid + r32; const size_t qrow = (size_t)b * TOK + CTX + tok;
        a.qptr = QM + qrow * 768 + head * 96; a.qpitch = 768; a.optr = ATT + qrow * 1024 + head * 64;
        a.kbase = KVX + head * 128; a.kpitch = 1024; a.vbase = KVX + head * 128 + 64; a.vpitch = 1024; a.k2base = PB + 1152; a.k2pitch = 1536;
        a.row_ctx = b * TOK; a.nt = 36;
        attn_unit2<96, false>(lds, a);
    }
    float gq = fabsf(P->in[28][lane]), gk = fabsf(P->in[29][lane]);
#pragma unroll
    for (int o = 32; o > 0; o >>= 1) { gq = fmaxf(gq, __shfl_xor(gq, o)); gk = fmaxf(gk, __shfl_xor(gk, o)); }
    const bool bounded = __builtin_amdgcn_readfirstlane((int)(64.f * gq * gk * QS64 < 100.f)) != 0;
    for (int u = c; u < 1024; u += G) {
        const int b = u >> 5, kvh = (u >> 4) & 1, blk = u & 15;
        if (bounded) {
            const int g = wid & 3, hf = wid >> 2; const int head = kvh * 4 + g;
            AU2 a; const int tok = blk * 128 + 64 * hf + r32; const size_t qrow = (size_t)b * TOK + CTX + tok;
            a.qptr = PB + qrow * 1536 + 384 + head * 64; a.qpitch = 1536; a.optr = ATT + qrow * 1024 + 512 + head * 64;
            a.kbase = PB + 1184 + kvh * 64; a.kpitch = 1536; a.vbase = PB + 1312 + kvh * 64; a.vpitch = 1536; a.k2base = nullptr; a.k2pitch = 0;
            a.row_ctx = b * TOK; a.nt = 36;
            attn_unit2<64, true>(lds, a);
        } else {
            for (int hfb = 0; hfb < 2; ++hfb) { const int g = wid & 3, ts = wid >> 2; const int head = kvh * 4 + g;
                AU a; const int tok = blk * 128 + 64 * hfb + 32 * ts + r32; const size_t qrow = (size_t)b * TOK + CTX + tok;
                a.qptr = PB + qrow * 1536 + 384 + head * 64; a.optr = ATT + qrow * 1024 + 512 + head * 64;
                a.kbase = PB + 1184 + kvh * 64; a.kpitch = 1536; a.vbase = PB + 1312 + kvh * 64; a.vpitch = 1536; a.k2base = nullptr; a.k2pitch = 0;
                a.row_ctx = b * TOK; a.row_lat = 0; a.start = 0; a.j0 = 0; a.nt = 36; a.qoff = 0; a.m0 = 0.f; a.l0 = 0.f;
                attn_unit<0, 64>(lds, a); }
        }
    }
}

constexpr int PH_MOE0 = 7, PH_L1 = PH_MOE0 + 1 + 2 * NCHUNK, PH_MOE1 = PH_L1 + 7, NPH = PH_MOE1 + 1 + 2 * NCHUNK;
template <int PH>
__device__ __forceinline__ void run_phase(LAS unsigned char* lds, int c, int G) {
    const PP P = get_pp();
    const float* rp = (const float*)(P->ws + WS_ROPE);
    const float* ada0 = (const float*)(P->ws + WS_ADA); const float* ada1 = ada0 + (size_t)33 * 6144;
    bf16_t* W0 = (bf16_t*)(P->ws + WS_W0); bf16_t* W1 = (bf16_t*)(P->ws + WS_W1);
    bf16_t* H = (bf16_t*)(P->ws + WS_H); char* BIG = P->ws + WS_BIG; float* XC = (float*)(P->ws + WS_XC);
    if constexpr (PH == 0) { phase_prologue(P, lds, c, G); }
    else if constexpr (PH == 1) { phase_norm(P, c, G, P->in[0], P->in[2], P->in[6], ada0, 0, 1024, false, H, nullptr); }
    else if constexpr (PH == 2) {
        gm::DenseSched S; S.init(0, 9, G, c); gm::Desc d{(const char*)H, 2048u, (const char*)(W0 + WO_IN), 2048u, 1024};
        gm::EpiQKV0 E{(bf16_t*)(BIG + BIG_QKV), rp, rp + 2048 * 32}; gm::gemm_phase(lds, d, S, E); }
    else if constexpr (PH == 3) { phase_attn0(P, lds, ONE_LAUNCH ? (int)*(volatile LAS int*)(lds + LDS_BARW + 8) : c, G); }
    else if constexpr (PH == 4) {
        gm::DenseSched S; S.init(0, 4, G, c); gm::Desc d{(const char*)H, 2048u, (const char*)(W0 + WO_OUT), 2048u, 1024};
        gm::EpiP1 E{(bf16_t*)(BIG + BIG_HLO), 1024, nullptr, 0}; gm::gemm_phase(lds, d, S, E); }
    else if constexpr (PH == 5) { phase_norm(P, c, G, P->in[0], P->in[2], P->in[11], ada0, 3072, 4096, false, H, (bf16_t*)(BIG + BIG_HLO), true, P->out, XC); }
    else if constexpr (PH == 6) { phase_router(P, lds, c, G, 0); }
    else if constexpr (PH == PH_L1) {
        gm::DenseSched S; S.init(0, 6, G, c); gm::Desc d{(const char*)H, 2048u, (const char*)(W1 + WO_IN), 2048u, 1024};
        gm::EpiP1 E{(bf16_t*)(BIG + BIG_P), 1536, nullptr, 0}; gm::gemm_phase(lds, d, S, E); }
    else if constexpr (PH == PH_L1 + 1) { phase_post1(P, c, G); }
    else if constexpr (PH == PH_L1 + 2) {
        { gm::DenseSched S; S.init(1, 3, G, c); gm::Desc d{(const char*)(BIG + BIG_P), 3072u, (const char*)(W1 + WO_UQ), 768u, 384};
          gm::EpiUQ E{(bf16_t*)(BIG + BIG_QM), (const float*)(P->ws + WS_RSTD), rp + 2 * 2048 * 32, rp + 2 * 2048 * 32 + 2048 * 16}; gm::gemm_phase(lds, d, S, E); }
        { gm::DenseSched S; S.init(0, 4, G, c); gm::Desc d{(const char*)(BIG + BIG_P) + 896 * 2, 3072u, (const char*)(W1 + WO_UKV), 512u, 256};
          gm::EpiP1 E{(bf16_t*)(BIG + BIG_KVX), 1024, (const float*)(P->ws + WS_RSTD), 1}; gm::gemm_phase(lds, d, S, E); } }
    else if constexpr (PH == PH_L1 + 3) { phase_attn1(P, lds, ONE_LAUNCH ? (int)*(volatile LAS int*)(lds + LDS_BARW + 8) : c, G); }
    else if constexpr (PH == PH_L1 + 4) {
        gm::DenseSched S; S.init(1, 4, G, c); gm::Desc d{(const char*)H, 2048u, (const char*)(W1 + WO_OUT), 2048u, 1024};
        gm::EpiP1 E{(bf16_t*)(BIG + BIG_HLO), 1024, nullptr, 0}; gm::gemm_phase(lds, d, S, E); }
    else if constexpr (PH == PH_L1 + 5) { phase_norm(P, c, G, P->out, XC, P->in[31], ada1, 3072, 4096, true, H, (bf16_t*)(BIG + BIG_HLO), true, P->out, XC); }
    else if constexpr (PH == PH_L1 + 6) { phase_router(P, lds, c, G, 1); }
    else {
        constexpr int layer = PH >= PH_MOE1 ? 1 : 0; constexpr int rel = PH - (layer ? PH_MOE1 : PH_MOE0);
        const int* cnt = (const int*)(P->ws + WS_CTL + CTL_CNT) + layer * NG;
        LAS int* toff = (LAS int*)(lds + LDS_TAB);
        bf16_t* W = layer ? W1 : W0;
        build_toff(toff, cnt);
        const int pidx = ONE_LAUNCH ? (int)*(volatile LAS int*)(lds + LDS_BARW + 8) : c;
        const int mxq = ONE_LAUNCH ? pidx / (G >> 3) : (c & 7), mxj = ONE_LAUNCH ? pidx % (G >> 3) : (c >> 3);
        if constexpr (rel == 0) {
            gm::MoeSched<1> S; S.toff = toff; S.slot_row = (const int*)(P->ws + WS_SROW); S.t_lo = 0; S.t_hi = toff[NG]; S.nN = 2; S.G = G; S.c = c; S.bN = 512; S.layer = layer; S.xq = mxq; S.xj = mxj;
            gm::Desc d{(const char*)H, 2048u, (const char*)(W + WO_GU), 2048u, 1024};
            gm::EpiG1 E{(bf16_t*)(BIG + BIG_ACT)}; gm::gemm_phase(lds, d, S, E);
        } else if constexpr ((rel & 1) == 1) {
            constexpr int ch = (rel - 1) >> 1;
            gm::MoeSched<2> S; S.toff = toff; S.slot_row = nullptr; S.t_lo = toff[ch * NGRP]; S.t_hi = toff[(ch + 1) * NGRP]; S.nN = 4; S.G = G; S.c = c; S.bN = 1024; S.layer = layer; S.xq = mxq; S.xj = mxj;
            gm::Desc d{(const char*)(BIG + BIG_ACT), 512u, (const char*)(W + WO_D), 512u, 256};
            gm::EpiG2 E{(unsigned char*)(BIG + BIG_SLAB), toff[ch * NGRP] * 256};
            gm::gemm_phase(lds, d, S, E);
        } else {
            constexpr int ch = (rel - 2) >> 1;
            phase_combine(P, lds, c, G, layer, ch);
        }
    }
}

template <int PH> struct PhaseLoop {
    static __device__ __forceinline__ void run(LAS unsigned char* lds, const XcdBarrier& bar) {
        run_phase<PH>(lds, (int)blockIdx.x, (int)gridDim.x);
        if constexpr (PH + 1 < NPH) { xcd_barrier(bar); PhaseLoop<PH + 1>::run(lds, bar); }
    }
};

extern __shared__ __attribute__((aligned(16))) unsigned char smem_raw[];

#if ONE_LAUNCH
__global__ void __launch_bounds__(512, 2) mega_fwd(Params Pk) {
    LAS unsigned char* lds = (LAS unsigned char*)smem_raw;
    volatile LAS unsigned* st = (volatile LAS unsigned*)(lds + LDS_BARW);
    if (threadIdx.x == 0) { st[0] = 0u; st[1] = 0u; st[2] = 0u; st[3] = 0u; }
    __syncthreads();
    XcdBarrier bar = xcd_barrier_post((unsigned*)(Pk.ws + WS_CTL), st);
    int* xr = (int*)(Pk.ws + WS_CTL + CTL_XRANK);
    int myrank = 0; if (threadIdx.x == 0) myrank = atomicAdd(xr + 64 * (int)bar.x, 1);
    run_phase<0>(lds, (int)blockIdx.x, (int)gridDim.x);
    xcd_barrier(bar);
    if (threadIdx.x == 0) { int base = 0; for (int j = 0; j < (int)bar.x; ++j) base += ld_ctl(xr + 64 * j); st[2] = (unsigned)(base + myrank); }
    __syncthreads();
    PhaseLoop<1>::run(lds, bar);
}
#else
template <int PH> __global__ void __launch_bounds__(512, 2) phase_kernel(Params Pk) {
    LAS unsigned char* lds = (LAS unsigned char*)smem_raw;
    run_phase<PH>(lds, (int)blockIdx.x, (int)gridDim.x);
}
template <int PH> struct PhaseLaunch {
    static void run(const Params& P, int grid, hipStream_t s) {
        (void)hipFuncSetAttribute((const void*)phase_kernel<PH>, hipFuncAttributeMaxDynamicSharedMemorySize, LDS_BYTES);
        hipLaunchKernelGGL(phase_kernel<PH>, dim3(grid), dim3(512), LDS_BYTES, s, P);
        if constexpr (PH + 1 < NPH) PhaseLaunch<PH + 1>::run(P, grid, s);
    }
};
#endif

extern "C" void kernel_launch(void* const* d_in, const int* in_sizes, int n_in, void* d_out, int out_size, void* d_ws, size_t ws_size, hipStream_t stream) {
    static int grid = 0;
    if (n_in != 41 || ws_size < WS_END) { fprintf(stderr, "kernel_launch: need 41 inputs and %zu bytes of workspace (got %d, %zu)\n", (size_t)WS_END, n_in, ws_size); return; }
    if (!grid) {
        int dev = 0, cus = 0;
        (void)hipGetDevice(&dev); (void)hipDeviceGetAttribute(&cus, hipDeviceAttributeMultiprocessorCount, dev);
#if ONE_LAUNCH
        (void)hipFuncSetAttribute((const void*)mega_fwd, hipFuncAttributeMaxDynamicSharedMemorySize, LDS_BYTES);
        int per_cu = 0; (void)hipOccupancyMaxActiveBlocksPerMultiprocessor(&per_cu, (const void*)mega_fwd, 512, LDS_BYTES);
        if (per_cu < 1) fprintf(stderr, "kernel_launch: occupancy query says %d blocks per CU\n", per_cu);
#endif
        grid = cus > 0 ? cus : 256;
    }
    Params P{};
    for (int i = 0; i < 41; ++i) P.in[i] = (const float*)d_in[i];
    P.out = (float*)d_out; P.ws = (char*)d_ws;
    (void)hipMemsetAsync((char*)d_ws + WS_CTL, 0, CTL_BYTES, stream);
#if ONE_LAUNCH
    hipLaunchKernelGGL(mega_fwd, dim3(grid), dim3(512), LDS_BYTES, stream, P);
#else
    PhaseLaunch<0>::run(P, grid, stream);
#endif
}
```
